# Optimizing an MI355X kernel written in HIP

```python
import jax, jax.numpy as jnp
from jax import lax
import numpy as np

D_MODEL = 1024
BATCH = 8
SEQ = 8192
DEPTH = 2

GRID_W = 64
CTX_LEN = 256
HEAD_DIM = 64
ATTN_WIDTH = D_MODEL // 2
N_HEADS = ATTN_WIDTH // HEAD_DIM
N_KV_HEADS = N_HEADS // 4
GQA_GROUP = N_HEADS // N_KV_HEADS
KV_WIDTH = N_KV_HEADS * HEAD_DIM
ROPE_PAIRS = HEAD_DIM // 4
ROPE_THETA = 10000.0
Q_BLOCK = 128
ATTN_SCALE = HEAD_DIM ** -0.5
LRU_WIDTH = D_MODEL // 4
LRU_BLOCKS = 4
LRU_BLOCK = LRU_WIDTH // LRU_BLOCKS
LRU_CONV_W = 4
LRU_PAD = (2, 1)
LRU_C = 8.0
SC_WIDTH = D_MODEL // 4
SC_CONV_W = 3
SC_PAD = (1, 1)
MIX_WIDTH = ATTN_WIDTH + LRU_WIDTH + SC_WIDTH
IN_WIDTH = ATTN_WIDTH + 2 * KV_WIDTH + 2 * LRU_WIDTH + 3 * SC_WIDTH
D_FF = (8 * D_MODEL // 3 + 127) // 128 * 128
N_MOD = 9
EPS = 1e-6

kernel_name = 'hymba_style_diffusion_hybrid_block'


def _rms(x):
    xf = x.astype(jnp.float32)
    return (xf * lax.rsqrt(jnp.mean(xf * xf, axis=-1, keepdims=True) + EPS)).astype(x.dtype)


def rms_norm(x, g):
    return _rms(x) * g


def ada_norm(x, g, shift, scale):
    return rms_norm(x, g) * (1 + scale[:, None, :]) + shift[:, None, :]


def swiglu(h, w_in, w_out):
    gate, up = jnp.split(h @ w_in, 2, axis=-1)
    return (jax.nn.silu(gate) * up) @ w_out


def dw_conv(x, w, b, pad):
    y = lax.conv_general_dilated(x, w[:, None, :], (1,), [pad],
                                 dimension_numbers=('NWC', 'WIO', 'NWC'),
                                 feature_group_count=x.shape[-1])
    return y + b


def axial_rope_tables(seq):
    rows = seq // GRID_W
    row_ids = jnp.repeat(jnp.arange(rows), GRID_W).astype(jnp.float32)
    col_ids = jnp.tile(jnp.arange(GRID_W), rows).astype(jnp.float32)
    inv_freq = ROPE_THETA ** (-jnp.arange(ROPE_PAIRS, dtype=jnp.float32) / ROPE_PAIRS)
    ang = jnp.stack([row_ids[:, None] * inv_freq, col_ids[:, None] * inv_freq], axis=1)
    return jnp.cos(ang), jnp.sin(ang)


def apply_rope(x, cos, sin):
    b, s, h, _ = x.shape
    xr = x.astype(jnp.float32).reshape(b, s, h, 2, 2, ROPE_PAIRS)
    x1, x2 = xr[..., 0, :], xr[..., 1, :]
    cs, sn = cos[None, :, None], sin[None, :, None]
    out = jnp.stack([x1 * cs - x2 * sn, x2 * cs + x1 * sn], axis=-2)
    return out.reshape(b, s, h, HEAD_DIM).astype(x.dtype)


def head_rms(x, g):
    return rms_norm(x.reshape(*x.shape[:-1], -1, HEAD_DIM), g)


def attend(q, k, v):
    s = jnp.einsum('bqkgd,bskd->bkgqs', q, k, preferred_element_type=jnp.float32) * ATTN_SCALE
    p = jax.nn.softmax(s, axis=-1).astype(v.dtype)
    return jnp.einsum('bkgqs,bskd->bqkgd', p, v)


def blocked_attention(q, k, v):
    b, s = q.shape[:2]
    nb = s // Q_BLOCK
    qb = q.reshape(b, nb, Q_BLOCK, N_KV_HEADS, GQA_GROUP, HEAD_DIM).swapaxes(0, 1)
    o = lax.map(lambda qblk: attend(qblk, k, v), qb)
    return o.swapaxes(0, 1).reshape(b, s, ATTN_WIDTH)


def _lin_combine(left, right):
    a1, b1 = left
    a2, b2 = right
    return a1 * a2, a2 * b1 + b2


def lru_scan(u, wa, ba, wx, bx, lam, h0, reverse):
    b, l, w = u.shape
    ub = u.reshape(b, l, LRU_BLOCKS, LRU_BLOCK)
    r = jax.nn.sigmoid((jnp.einsum('blnd,nde->blne', ub, wa).reshape(b, l, w) + ba).astype(jnp.float32))
    i = jax.nn.sigmoid((jnp.einsum('blnd,nde->blne', ub, wx).reshape(b, l, w) + bx).astype(jnp.float32))
    log_a = -LRU_C * r * jax.nn.softplus(-lam.astype(jnp.float32))
    a = jnp.exp(log_a)
    xin = jnp.sqrt(-jnp.expm1(2 * log_a)) * i * u.astype(jnp.float32)
    edge = l - 1 if reverse else 0
    xin = xin.at[:, edge].add(a[:, edge] * h0)
    _, h = lax.associative_scan(_lin_combine, (a, xin), reverse=reverse, axis=1)
    return h


def lru_dir(u, p, d, h0, reverse):
    return lru_scan(u, p['wa'][d], p['ba'][d], p['wx'][d], p['bx'][d], p['lam'][d], h0, reverse)


def merge_groups(parts, g, w_out):
    return jnp.concatenate([_rms(t) for t in parts], axis=-1) * g @ w_out


def mixer(hx, hc, p, cos, sin, with_ctx):
    bsz, seq, _ = hx.shape
    n_ctx = hc.shape[1]
    cuts = [ATTN_WIDTH, ATTN_WIDTH + KV_WIDTH, ATTN_WIDTH + 2 * KV_WIDTH]
    cuts += [cuts[-1] + LRU_WIDTH, cuts[-1] + 2 * LRU_WIDTH]
    cuts += [cuts[-1] + SC_WIDTH, cuts[-1] + 2 * SC_WIDTH]
    qx, kx, vx, ux, gx, bgx, cgx, sx = jnp.split(hx @ p['w_in'], cuts, axis=-1)
    qc, kc, vc, uc, gc, bgc, cgc, sc = jnp.split(hc @ p['w_in'], cuts, axis=-1)

    qx = apply_rope(head_rms(qx, p['q_g']), cos, sin).reshape(bsz, seq, N_KV_HEADS, GQA_GROUP, HEAD_DIM)
    kx = apply_rope(head_rms(kx, p['k_g']), cos, sin)
    kc = head_rms(kc, p['k_g'])
    vx = vx.reshape(bsz, seq, N_KV_HEADS, HEAD_DIM)
    vc = vc.reshape(bsz, n_ctx, N_KV_HEADS, HEAD_DIM)
    k_all = jnp.concatenate([kc, kx], axis=1)
    v_all = jnp.concatenate([vc, vx], axis=1)
    attn_x = blocked_attention(qx, k_all, v_all)

    ux = dw_conv(ux, p['lru_conv_w'], p['lru_conv_b'], LRU_PAD)
    uc = dw_conv(uc, p['lru_conv_w'], p['lru_conv_b'], LRU_PAD)
    h0 = jnp.zeros((bsz, LRU_WIDTH), jnp.float32)
    hc_f = lru_dir(uc, p, 0, h0, False)
    hc_b = lru_dir(uc, p, 1, h0, True)
    hx_f = lru_dir(ux, p, 0, hc_f[:, -1], False)
    hx_b = lru_dir(ux, p, 1, hc_b[:, 0], True)
    lru_x = (hx_f + hx_b).astype(hx.dtype) * jax.nn.gelu(gx)

    sc_x = bgx * dw_conv(cgx * sx, p['sc_conv_w'], p['sc_conv_b'], SC_PAD)

    out_x = merge_groups([attn_x, lru_x, sc_x], p['grp_g'], p['w_out'])
    if not with_ctx:
        return out_x, None

    qc = head_rms(qc, p['q_g']).reshape(bsz, n_ctx, N_KV_HEADS, GQA_GROUP, HEAD_DIM)
    attn_c = attend(qc, kc, vc).reshape(bsz, n_ctx, ATTN_WIDTH)
    lru_c = (hc_f + hc_b).astype(hc.dtype) * jax.nn.gelu(gc)
    sc_c = bgc * dw_conv(cgc * sc, p['sc_conv_w'], p['sc_conv_b'], SC_PAD)
    out_c = merge_groups([attn_c, lru_c, sc_c], p['grp_g'], p['w_out'])
    return out_x, out_c


def setup_inputs(seed: int = 0) -> dict:
    key = jax.random.key(seed)
    ks = jax.random.split(key, 24)
    f32 = jnp.float32

    def nrm(k, shape, scale):
        return jax.random.normal(k, shape, f32) * scale

    a_pow = jax.random.uniform(ks[18], (DEPTH, 2, LRU_WIDTH), f32, 0.9, 0.999)
    a_base = a_pow ** (1.0 / LRU_C)
    return {
        'x': nrm(ks[0], (BATCH, SEQ, D_MODEL), 1.0),
        'c': nrm(ks[1], (BATCH, D_MODEL), 1.0),
        'ctx': nrm(ks[2], (BATCH, CTX_LEN, D_MODEL), 1.0),
        'c_ctx': nrm(ks[3], (D_MODEL,), 1.0),
        'w_mod': nrm(ks[4], (DEPTH, D_MODEL, N_MOD * D_MODEL), 0.5 * D_MODEL ** -0.5),
        'b_mod': nrm(ks[5], (DEPTH, N_MOD * D_MODEL), 0.02),
        'norm_g': 1.0 + nrm(ks[6], (DEPTH, 3, D_MODEL), 0.02),
        'w_ffn_in': nrm(ks[7], (DEPTH, 2, D_MODEL, 2 * D_FF), D_MODEL ** -0.5),
        'w_ffn_out': nrm(ks[8], (DEPTH, 2, D_FF, D_MODEL), D_FF ** -0.5),
        'w_in': nrm(ks[9], (DEPTH, D_MODEL, IN_WIDTH), D_MODEL ** -0.5),
        'q_norm_g': 1.0 + nrm(ks[10], (DEPTH, HEAD_DIM), 0.02),
        'k_norm_g': 1.0 + nrm(ks[11], (DEPTH, HEAD_DIM), 0.02),
        'lru_conv_w': nrm(ks[12], (DEPTH, LRU_CONV_W, LRU_WIDTH), LRU_CONV_W ** -0.5),
        'lru_conv_b': nrm(ks[13], (DEPTH, LRU_WIDTH), 0.02),
        'lru_wa': nrm(ks[14], (DEPTH, 2, LRU_BLOCKS, LRU_BLOCK, LRU_BLOCK), LRU_BLOCK ** -0.5),
        'lru_ba': nrm(ks[15], (DEPTH, 2, LRU_WIDTH), 0.02),
        'lru_wx': nrm(ks[16], (DEPTH, 2, LRU_BLOCKS, LRU_BLOCK, LRU_BLOCK), LRU_BLOCK ** -0.5),
        'lru_bx': nrm(ks[17], (DEPTH, 2, LRU_WIDTH), 0.02),
        'lru_lambda': jnp.log(a_base) - jnp.log1p(-a_base),
        'sc_conv_w': nrm(ks[19], (DEPTH, SC_CONV_W, SC_WIDTH), SC_CONV_W ** -0.5),
        'sc_conv_b': nrm(ks[20], (DEPTH, SC_WIDTH), 0.02),
        'grp_norm_g': 1.0 + nrm(ks[21], (DEPTH, MIX_WIDTH), 0.02),
        'w_out': nrm(ks[22], (DEPTH, MIX_WIDTH, D_MODEL), MIX_WIDTH ** -0.5),
        'final_norm_g': 1.0 + nrm(ks[23], (D_MODEL,), 0.02),
    }


def reference(x, c, ctx, c_ctx, w_mod, b_mod, norm_g, w_ffn_in, w_ffn_out, w_in,
              q_norm_g, k_norm_g, lru_conv_w, lru_conv_b, lru_wa, lru_ba, lru_wx, lru_bx,
              lru_lambda, sc_conv_w, sc_conv_b, grp_norm_g, w_out, final_norm_g):
    bsz = x.shape[0]
    cos, sin = axial_rope_tables(x.shape[1])
    h_ctx = ctx
    for l in range(DEPTH):
        last = l == DEPTH - 1
        mx = (jax.nn.silu(c) @ w_mod[l] + b_mod[l]).reshape(bsz, N_MOD, D_MODEL)
        mc = (jax.nn.silu(c_ctx) @ w_mod[l] + b_mod[l]).reshape(1, N_MOD, D_MODEL)

        x = x + 0.5 * mx[:, 2, None] * swiglu(ada_norm(x, norm_g[l, 0], mx[:, 0], mx[:, 1]),
                                               w_ffn_in[l, 0], w_ffn_out[l, 0])
        h_ctx = h_ctx + 0.5 * mc[:, 2, None] * swiglu(ada_norm(h_ctx, norm_g[l, 0], mc[:, 0], mc[:, 1]),
                                                       w_ffn_in[l, 0], w_ffn_out[l, 0])

        p = {'w_in': w_in[l], 'q_g': q_norm_g[l], 'k_g': k_norm_g[l],
             'lru_conv_w': lru_conv_w[l], 'lru_conv_b': lru_conv_b[l],
             'wa': lru_wa[l], 'ba': lru_ba[l], 'wx': lru_wx[l], 'bx': lru_bx[l], 'lam': lru_lambda[l],
             'sc_conv_w': sc_conv_w[l], 'sc_conv_b': sc_conv_b[l],
             'grp_g': grp_norm_g[l], 'w_out': w_out[l]}
        hx = ada_norm(x, norm_g[l, 1], mx[:, 3], mx[:, 4])
        hc = ada_norm(h_ctx, norm_g[l, 1], mc[:, 3], mc[:, 4])
        out_x, out_c = mixer(hx, hc, p, cos, sin, not last)
        x = x + mx[:, 5, None] * out_x

        x = x + 0.5 * mx[:, 8, None] * swiglu(ada_norm(x, norm_g[l, 2], mx[:, 6], mx[:, 7]),
                                               w_ffn_in[l, 1], w_ffn_out[l, 1])
        if not last:
            h_ctx = h_ctx + mc[:, 5, None] * out_c
            h_ctx = h_ctx + 0.5 * mc[:, 8, None] * swiglu(ada_norm(h_ctx, norm_g[l, 2], mc[:, 6], mc[:, 7]),
                                                           w_ffn_in[l, 1], w_ffn_out[l, 1])
    return rms_norm(x, final_norm_g)
```

```cpp
#include <hip/hip_runtime.h>
#include <hip/hip_bf16.h>
#include <hip/hip_cooperative_groups.h>
#include <cstdio>
#include <cstdint>
#include <cmath>
namespace cg = cooperative_groups;

constexpr int DM = 1024, NBATCH = 8, SEQ = 8192, CTXL = 256, DEPTH = 2;
constexpr int MLAT = NBATCH * SEQ, MCTX = NBATCH * CTXL, MTOT = MLAT + MCTX;
constexpr int DFF = 2816, NFF2 = 2 * DFF, INW = 2048, NMODV = 9, MODW = 9 * DM;
constexpr int KEYS = SEQ + CTXL, NCHUNK = KEYS / 64;
constexpr float EPS = 1e-6f;
constexpr int NTHREADS = 512;
constexpr int LDS_BYTES = 147456;

constexpr size_t MiB = 1u << 20;
constexpr size_t OFF_MOD = 0;
constexpr size_t OFF_ROPE = 1 * MiB;
constexpr size_t OFF_LW = 1 * MiB + 65536;
constexpr size_t OFF_CSUM = 2 * MiB;
constexpr size_t OFF_CARRY = 7 * MiB;
constexpr size_t OFF_WB = 10 * MiB;
constexpr size_t WB_LAYER = 39 * MiB;
constexpr size_t WB_FFIN = 0, WB_FFIN_SZ = (size_t)NFF2 * DM * 2;
constexpr size_t WB_FFOUT = 2 * WB_FFIN_SZ, WB_FFOUT_SZ = (size_t)DM * DFF * 2;
constexpr size_t WB_WIN = WB_FFOUT + 2 * WB_FFOUT_SZ, WB_WIN_SZ = (size_t)INW * DM * 2;
constexpr size_t WB_WOUT = WB_WIN + WB_WIN_SZ;
static_assert(WB_WOUT + (size_t)DM * DM * 2 == WB_LAYER, "weight map");
constexpr size_t OFF_XRES = 88 * MiB;
constexpr size_t OFF_HBUF = 352 * MiB;
constexpr size_t OFF_R1 = 484 * MiB;
constexpr size_t OFF_MID = OFF_R1;
constexpr size_t OFF_Q = OFF_R1;
constexpr size_t OFF_K = OFF_R1 + 66 * MiB;
constexpr size_t OFF_V = OFF_K + 16 * MiB + 524288;
constexpr size_t OFF_U5 = OFF_R1 + 99 * MiB;
constexpr size_t U5_STRIDE = (size_t)MTOT * 256;
constexpr size_t OFF_S = OFF_R1 + 264 * MiB;
constexpr size_t OFF_PP = OFF_R1 + 330 * MiB;
constexpr size_t WS_NEED = OFF_R1 + 396 * MiB;

#define LAS __attribute__((address_space(3)))
typedef unsigned short bf16_t;
typedef float f32x4 __attribute__((ext_vector_type(4)));
typedef float f32x2 __attribute__((ext_vector_type(2)));
typedef unsigned u32x4 __attribute__((ext_vector_type(4)));
typedef unsigned u32x2 __attribute__((ext_vector_type(2)));

struct Params { const float* in[24]; float* out; unsigned char* ws; };

__device__ __forceinline__ unsigned cvt_pk(float lo, float hi) { unsigned r; asm volatile("v_cvt_pk_bf16_f32 %0, %1, %2" : "=v"(r) : "v"(lo), "v"(hi)); return r; }
__device__ __forceinline__ float bf_lo(unsigned w) { return __uint_as_float(w << 16); }
__device__ __forceinline__ float bf_hi(unsigned w) { return __uint_as_float(w & 0xffff0000u); }
__device__ __forceinline__ float wave_sum(float v) {
#pragma unroll
    for (int o = 1; o < 64; o <<= 1) v += __shfl_xor(v, o);
    return v;
}
__device__ __forceinline__ int opaque_tid() { int t = threadIdx.x; asm volatile("" : "+v"(t)); return t; }
__device__ __forceinline__ float sigmoidf_(float z) { return __builtin_amdgcn_rcpf(1.0f + __expf(-z)); }
namespace pg8 {
#define PG8_LAS __attribute__((address_space(3)))
typedef unsigned short bf16_t;
typedef short bf16x8 __attribute__((ext_vector_type(8)));
typedef float f32x4 __attribute__((ext_vector_type(4)));
typedef unsigned u32x4 __attribute__((ext_vector_type(4)));
constexpr int BM = 256, BK = 64, HALF = 128, HTB = HALF * BK * 2  , STAGE_BYTES = 8 * HTB, NXCD = 8, WGM = 8;

__host__ __device__ __forceinline__ int lds_byte(int r, int c) { const int st = (r >> 4) * 2 + (c >> 5), rr = r & 15, cc = c & 31, ob = rr * 64 + cc * 2; return st * 1024 + (ob ^ (((ob >> 9) & 1) << 5)); }
__host__ __device__ __forceinline__ void stage_rc(int b, int& R, int& C) { const int st = b / 1024, sb = b % 1024, swz = sb ^ (((sb >> 9) & 1) << 5); R = (st >> 1) * 16 + swz / 64; C = (st & 1) * 32 + (swz % 64) / 2; }
__host__ __device__ __forceinline__ int perm32(int rho) { const int n = rho >> 4, i = rho & 15; return 8 * (i >> 2) + 4 * n + (i & 3); }

struct Unit { int pm, pn; };
struct Gemm { const bf16_t* A; const bf16_t* Bt; int M, N, K; };

struct StaticOrder {
    int nM, nN, nwg, G, c;
    __host__ __device__ void init(int M, int N, int G_, int c_) { nM = M / BM; nN = N / BM; nwg = nM * nN; G = G_; c = c_; }
    __host__ __device__ bool next(int i, Unit& u) const {
        const long L = (long)i * G + c; if (L >= nwg) return false;
        int wgid = (int)L; { const int q = nwg / NXCD, r = nwg % NXCD, xcd = wgid % NXCD, off = wgid / NXCD; wgid = (xcd < r ? xcd * (q + 1) : r * (q + 1) + (xcd - r) * q) + off; }
        const int nig = WGM * nN, gid = wgid / nig, fm = gid * WGM, gsz = (nM - fm) < WGM ? (nM - fm) : WGM;
        u.pm = fm + ((wgid % nig) % gsz); u.pn = (wgid % nig) / gsz; return true;
    }
    __device__ __forceinline__ void a_ready(const Unit&) const {}
    __device__ __forceinline__ void done(const Unit&) const {}
};
__device__ __forceinline__ unsigned cvt_pk_bf16(float lo, float hi) { unsigned r; asm volatile("v_cvt_pk_bf16_f32 %0, %1, %2" : "=v"(r) : "v"(lo), "v"(hi)); return r; }

struct EpiSwiglu {
    static constexpr bool PERM = false, AFTER_DRAIN = false;
    bf16_t* O;
    __device__ __forceinline__ void operator()(const f32x4 (&acc)[2][2][4][2], const Unit& u, int wr, int wc, int fr, int fq) const {
        const int row0 = u.pm * BM + wr * 64 + fr, col0 = u.pn * 128 + wc * 32 + 8 * fq;
#pragma unroll
        for (int ai = 0; ai < 2; ++ai)
#pragma unroll
            for (int m = 0; m < 4; ++m) {
                bf16_t* rowp = O + (size_t)(row0 + ai * HALF + m * 16) * 2816 + col0;
                float v[8];
#pragma unroll
                for (int n = 0; n < 2; ++n)
#pragma unroll
                    for (int j = 0; j < 4; ++j) { const float g = acc[ai][0][m][n][j], up = acc[ai][1][m][n][j]; v[n * 4 + j] = g * __builtin_amdgcn_rcpf(1.0f + __expf(-g)) * up; }
                u32x4 w; w.x = cvt_pk_bf16(v[0], v[1]); w.y = cvt_pk_bf16(v[2], v[3]); w.z = cvt_pk_bf16(v[4], v[5]); w.w = cvt_pk_bf16(v[6], v[7]);
                *(u32x4*)rowp = w;
            }
    }
};
struct EpiResid {
    static constexpr bool PERM = false, AFTER_DRAIN = false;
    float* X; const float* gate; float scale;
    __device__ __forceinline__ void operator()(const f32x4 (&acc)[2][2][4][2], const Unit& u, int wr, int wc, int fr, int fq) const {
        const int v = u.pm < 256 ? (u.pm >> 5) : 8;
        const int row0 = u.pm * BM + wr * 64 + fr, col0 = u.pn * BM + wc * 32 + 4 * fq;
        const float* gp = gate + (size_t)v * 9216 + col0;
        f32x4 gv[2][2];
#pragma unroll
        for (int bj = 0; bj < 2; ++bj)
#pragma unroll
            for (int n = 0; n < 2; ++n) gv[bj][n] = *(const f32x4*)(gp + bj * HALF + n * 16) * scale;
#pragma unroll
        for (int ai = 0; ai < 2; ++ai)
#pragma unroll
            for (int m = 0; m < 4; ++m) { float* rowp = X + (size_t)(row0 + ai * HALF + m * 16) * 1024 + col0;
#pragma unroll
                for (int bj = 0; bj < 2; ++bj)
#pragma unroll
                    for (int n = 0; n < 2; ++n) { f32x4* p = (f32x4*)(rowp + bj * HALF + n * 16); *p = *p + gv[bj][n] * acc[ai][bj][m][n]; } }
    }
};
struct EpiWin {
    static constexpr bool PERM = false, AFTER_DRAIN = false;
    bf16_t *Q, *K, *V, *U5; const float *qg, *kg, *rcos, *rsin; float qscale;
    __device__ __forceinline__ void operator()(const f32x4 (&acc)[2][2][4][2], const Unit& u, int wr, int wc, int fr, int fq) const {
        const int row0 = u.pm * BM + wr * 64 + fr;
        if (u.pn >= 3) {
            bf16_t* base = U5 + (size_t)(u.pn - 3) * ((size_t)67584 * 256) + wc * 32 + 8 * fq;
#pragma unroll
            for (int ai = 0; ai < 2; ++ai)
#pragma unroll
                for (int m = 0; m < 4; ++m) { bf16_t* rowp = base + (size_t)(row0 + ai * HALF + m * 16) * 256;
#pragma unroll
                    for (int bj = 0; bj < 2; ++bj) { const f32x4 v0 = acc[ai][bj][m][0], v1 = acc[ai][bj][m][1];
                        u32x4 w; w.x = cvt_pk_bf16(v0[0], v0[1]); w.y = cvt_pk_bf16(v0[2], v0[3]); w.z = cvt_pk_bf16(v1[0], v1[1]); w.w = cvt_pk_bf16(v1[2], v1[3]);
                        *(u32x4*)(rowp + bj * HALF) = w; } }
            return;
        }
        const int kind = u.pn < 2 ? 0 : (wc < 2 ? 1 : 2);
        const bool latent = u.pm < 256;
        const float* gsrc = kind == 0 ? qg : kg;
        f32x4 gv[2][2];
#pragma unroll
        for (int bj = 0; bj < 2; ++bj)
#pragma unroll
            for (int n = 0; n < 2; ++n) gv[bj][n] = *(const f32x4*)(gsrc + 32 * bj + 16 * n + 4 * fq);
#pragma unroll
        for (int ai = 0; ai < 2; ++ai)
#pragma unroll
            for (int m = 0; m < 4; ++m) {
                const int row = row0 + ai * HALF + m * 16;
                f32x4 y[2][2];
#pragma unroll
                for (int bj = 0; bj < 2; ++bj)
#pragma unroll
                    for (int n = 0; n < 2; ++n) y[bj][n] = acc[ai][bj][m][n];
                if (kind != 2) {
                    float ss = 0.f;
#pragma unroll
                    for (int bj = 0; bj < 2; ++bj)
#pragma unroll
                        for (int n = 0; n < 2; ++n) { const f32x4 t = y[bj][n]; ss += (t[0] * t[0] + t[1] * t[1]) + (t[2] * t[2] + t[3] * t[3]); }
                    ss += __shfl_xor(ss, 16); ss += __shfl_xor(ss, 32);
                    const float r = 1.0f / sqrtf(ss * (1.0f / 64.0f) + 1e-6f);
#pragma unroll
                    for (int bj = 0; bj < 2; ++bj)
#pragma unroll
                        for (int n = 0; n < 2; ++n) y[bj][n] = y[bj][n] * r * gv[bj][n];
                    if (latent) {
                        const int s = row & 8191;
#pragma unroll
                        for (int bj = 0; bj < 2; ++bj) { const int pos = bj == 0 ? (s >> 6) : (s & 63);
                            const f32x4 c4 = *(const f32x4*)(rcos + pos * 16 + 4 * fq), s4 = *(const f32x4*)(rsin + pos * 16 + 4 * fq);
                            const f32x4 x1 = y[bj][0], x2 = y[bj][1];
                            y[bj][0] = x1 * c4 - x2 * s4; y[bj][1] = x2 * c4 + x1 * s4; }
                    }
                }
                bf16_t* dst;
                if (kind == 0) { dst = Q + (size_t)row * 512 + (u.pn * 4 + wc) * 64;
#pragma unroll
                    for (int bj = 0; bj < 2; ++bj)
#pragma unroll
                        for (int n = 0; n < 2; ++n) y[bj][n] = y[bj][n] * qscale;
                } else {
                    size_t kr;
                    if (latent) kr = (size_t)(row >> 13) * 8448 + 256 + (row & 8191);
                    else { const int rc = row - 65536; kr = (size_t)(rc >> 8) * 8448 + (rc & 255); }
                    dst = (kind == 1 ? K : V) + kr * 128 + (wc & 1) * 64;
                }
#pragma unroll
                for (int bj = 0; bj < 2; ++bj)
#pragma unroll
                    for (int n = 0; n < 2; ++n) { u32x2 w; w.x = cvt_pk_bf16(y[bj][n][0], y[bj][n][1]); w.y = cvt_pk_bf16(y[bj][n][2], y[bj][n][3]);
                        *(u32x2*)(dst + 32 * bj + 16 * n + 4 * fq) = w; }
            }
    }
};
template <class Epi, class Sched, bool ALIGN_EPI = false, bool SP2 = false>
__device__ __forceinline__ void gemm_phase(PG8_LAS unsigned char* lds, const Gemm g, const Sched& S, const Epi& E) {
    const int tid = opaque_tid(), wid = __builtin_amdgcn_readfirstlane(tid >> 6), lane = tid & 63, wr = wid >> 2, wc = wid & 3, fr = lane & 15, fq = lane >> 4;
    const int K = g.K, nt = K / BK;
    unsigned voffA[2], voffB[2];
#pragma unroll
    for (int i = 0; i < 2; ++i) { int R, C; stage_rc(tid * 16 + i * 8192, R, C); const int Rb = Epi::PERM ? ((R & ~31) + perm32(R & 31)) : R;
        voffA[i] = (unsigned)(R * K + C) * 2u; voffB[i] = (unsigned)(Rb * K + C) * 2u; }
    const size_t kstep = (size_t)(BK * 2);
    const size_t hstep = (size_t)HALF * K * 2;
    const size_t tstep = 2 * hstep;
    const unsigned ldsw = (unsigned)wid * 1024u;
    const int aoff = lds_byte(wr * 64 + fr, fq * 8), boff = lds_byte(wc * 32 + fr, fq * 8);
#define PG8_SA(b, h) (((b) * 2 + (h)) * HTB)
#define PG8_SB(b, h) ((4 + (b) * 2 + (h)) * HTB)
#define PG8_STAGE(bufoff, gbase, voff) do { _Pragma("unroll") for (int _i = 0; _i < 2; ++_i) \
        __builtin_amdgcn_global_load_lds((const unsigned*)((const char*)(gbase) + (voff)[_i]), (PG8_LAS unsigned*)(lds + (bufoff) + ldsw + _i * 8192), 16, 0, 0); } while (0)
#define PG8_LDA(dst, b, h) do { _Pragma("unroll") for (int m = 0; m < 4; ++m) _Pragma("unroll") for (int k = 0; k < 2; ++k) dst[m][k] = *(const PG8_LAS bf16x8*)(lds + PG8_SA(b, h) + aoff + m * 2048 + k * 1024); } while (0)
#define PG8_LDB(dst, b, h) do { _Pragma("unroll") for (int n = 0; n < 2; ++n) _Pragma("unroll") for (int k = 0; k < 2; ++k) dst[n][k] = *(const PG8_LAS bf16x8*)(lds + PG8_SB(b, h) + boff + n * 2048 + k * 1024); } while (0)
#define PG8_MMA(ai, bj, At, Bt) do { __builtin_amdgcn_s_setprio(1); _Pragma("unroll") for (int m = 0; m < 4; ++m) _Pragma("unroll") for (int n = 0; n < 2; ++n) _Pragma("unroll") for (int k = 0; k < 2; ++k) \
        acc[ai][bj][m][n] = __builtin_amdgcn_mfma_f32_16x16x32_bf16(Bt[n][k], At[m][k], acc[ai][bj][m][n], 0, 0, 0); __builtin_amdgcn_s_setprio(0); } while (0)
#define PG8_WAIT_V(n) asm volatile("s_waitcnt vmcnt(" #n ")" ::: "memory")
#define PG8_WAIT_L(n) asm volatile("s_waitcnt lgkmcnt(" #n ")" ::: "memory")
#define PG8_BAR __builtin_amdgcn_s_barrier()
#define PG8_SCHED __builtin_amdgcn_sched_barrier(0)
    Unit cur, nxt; int ui = 0;
    if (!S.next(0, cur)) return;
    f32x4 acc[2][2][4][2];
#pragma unroll
    for (int a = 0; a < 2; ++a)
#pragma unroll
        for (int b = 0; b < 2; ++b)
#pragma unroll
            for (int m = 0; m < 4; ++m)
#pragma unroll
                for (int n = 0; n < 2; ++n) acc[a][b][m][n] = (f32x4){0.f, 0.f, 0.f, 0.f};
    bf16x8 At[4][2], B0[2][2], B1[2][2];
    const char* cA = (const char*)g.A + (size_t)cur.pm * tstep; const char* cB = (const char*)g.Bt + (size_t)cur.pn * tstep;
    S.a_ready(cur);
    if constexpr (SP2) {
        PG8_STAGE(PG8_SB(0, 0), cB, voffB); PG8_STAGE(PG8_SB(0, 1), cB + hstep, voffB); PG8_STAGE(PG8_SA(0, 0), cA, voffA); PG8_STAGE(PG8_SA(0, 1), cA + hstep, voffA);
        if (wr == 1) PG8_BAR;
        PG8_WAIT_V(2); PG8_BAR;
        PG8_STAGE(PG8_SB(1, 0), cB + kstep, voffB); PG8_STAGE(PG8_SA(1, 0), cA + kstep, voffA); PG8_STAGE(PG8_SB(1, 1), cB + hstep + kstep, voffB);
        PG8_WAIT_V(6); PG8_BAR;
    } else {
        PG8_STAGE(PG8_SB(0, 0), cB, voffB); PG8_STAGE(PG8_SA(0, 0), cA, voffA); PG8_STAGE(PG8_SB(0, 1), cB + hstep, voffB); PG8_STAGE(PG8_SA(0, 1), cA + hstep, voffA);
        if (wr == 1) PG8_BAR;
        PG8_WAIT_V(4); PG8_BAR;
        PG8_STAGE(PG8_SB(1, 0), cB + kstep, voffB); PG8_STAGE(PG8_SA(1, 0), cA + kstep, voffA); PG8_STAGE(PG8_SB(1, 1), cB + hstep + kstep, voffB);
        PG8_WAIT_V(6); PG8_BAR;
    }
    for (;;) {
        const bool has_next = S.next(ui + 1, nxt);
        const char* nA = has_next ? (const char*)g.A + (size_t)nxt.pm * tstep : cA; const char* nB = has_next ? (const char*)g.Bt + (size_t)nxt.pn * tstep : cB;
        for (int t = 0; t < nt; t += 2) {
            const bool last = (t == nt - 2);
            const char* a1 = cA + (size_t)(t + 1) * kstep;
            const char* a2 = last ? nA : cA + (size_t)(t + 2) * kstep; const char* b2 = last ? nB : cB + (size_t)(t + 2) * kstep;
            const char* a3 = a2 + kstep; const char* b3 = b2 + kstep;
            if (last && has_next) S.a_ready(nxt);
            if constexpr (SP2) {
            PG8_LDB(B0, 0, 0); PG8_LDB(B1, 0, 1); PG8_SCHED; PG8_LDA(At, 0, 0); PG8_STAGE(PG8_SA(1, 1), a1 + hstep, voffA);
            PG8_WAIT_V(8); PG8_WAIT_L(0); PG8_BAR; PG8_MMA(0, 0, At, B0); PG8_MMA(0, 1, At, B1); PG8_BAR; PG8_SCHED;
            PG8_LDA(At, 0, 1); PG8_STAGE(PG8_SB(0, 0), b2, voffB); PG8_STAGE(PG8_SB(0, 1), b2 + hstep, voffB); PG8_STAGE(PG8_SA(0, 0), a2, voffA);
            PG8_WAIT_V(8); PG8_WAIT_L(0); PG8_BAR; PG8_MMA(1, 0, At, B0); PG8_MMA(1, 1, At, B1); PG8_BAR; PG8_SCHED;
            PG8_LDB(B0, 1, 0); PG8_LDB(B1, 1, 1); PG8_SCHED; PG8_LDA(At, 1, 0); PG8_STAGE(PG8_SA(0, 1), a2 + hstep, voffA);
            PG8_WAIT_V(8); PG8_WAIT_L(0); PG8_BAR; PG8_MMA(0, 0, At, B0); PG8_MMA(0, 1, At, B1); PG8_BAR; PG8_SCHED;
            PG8_LDA(At, 1, 1); PG8_STAGE(PG8_SB(1, 0), b3, voffB); PG8_STAGE(PG8_SB(1, 1), b3 + hstep, voffB); PG8_STAGE(PG8_SA(1, 0), a3, voffA);
            PG8_WAIT_V(8); PG8_WAIT_L(0); PG8_BAR; PG8_MMA(1, 0, At, B0); PG8_MMA(1, 1, At, B1); PG8_BAR; PG8_SCHED;
            } else {
            PG8_LDB(B0, 0, 0); PG8_SCHED; PG8_LDA(At, 0, 0); PG8_STAGE(PG8_SA(1, 1), a1 + hstep, voffA);
            PG8_WAIT_L(8); PG8_BAR; PG8_WAIT_L(0); PG8_MMA(0, 0, At, B0); PG8_BAR; PG8_SCHED;
            PG8_LDB(B1, 0, 1); PG8_STAGE(PG8_SB(0, 0), b2, voffB);
            PG8_BAR; PG8_WAIT_L(0); PG8_MMA(0, 1, At, B1); PG8_BAR;
            PG8_LDA(At, 0, 1); PG8_STAGE(PG8_SA(0, 0), a2, voffA);
            PG8_BAR; PG8_WAIT_L(0); PG8_MMA(1, 0, At, B0); PG8_BAR; PG8_SCHED;
            PG8_STAGE(PG8_SB(0, 1), b2 + hstep, voffB);
            PG8_WAIT_V(6); PG8_BAR; PG8_MMA(1, 1, At, B1); PG8_BAR;
            PG8_LDB(B0, 1, 0); PG8_SCHED; PG8_LDA(At, 1, 0); PG8_STAGE(PG8_SA(0, 1), a2 + hstep, voffA);
            PG8_WAIT_L(8); PG8_BAR; PG8_WAIT_L(0); PG8_MMA(0, 0, At, B0); PG8_BAR; PG8_SCHED;
            PG8_LDB(B1, 1, 1); PG8_STAGE(PG8_SB(1, 0), b3, voffB);
            PG8_BAR; PG8_WAIT_L(0); PG8_MMA(0, 1, At, B1); PG8_BAR;
            PG8_LDA(At, 1, 1); PG8_STAGE(PG8_SA(1, 0), a3, voffA);
            PG8_BAR; PG8_WAIT_L(0); PG8_MMA(1, 0, At, B0); PG8_BAR; PG8_SCHED;
            PG8_STAGE(PG8_SB(1, 1), b3 + hstep, voffB);
            PG8_WAIT_V(6); PG8_BAR; PG8_MMA(1, 1, At, B1); PG8_BAR;
            }
        }
        if constexpr (ALIGN_EPI) { if (wr == 0) PG8_BAR; }
        if constexpr (!Epi::AFTER_DRAIN) { E(acc, cur, wr, wc, fr, fq); S.done(cur); }
        if (!has_next) break;
#pragma unroll
        for (int a = 0; a < 2; ++a)
#pragma unroll
            for (int b = 0; b < 2; ++b)
#pragma unroll
                for (int m = 0; m < 4; ++m)
#pragma unroll
                    for (int n = 0; n < 2; ++n) acc[a][b][m][n] = (f32x4){0.f, 0.f, 0.f, 0.f};
        cur = nxt; cA = nA; cB = nB; ++ui;
        if constexpr (ALIGN_EPI) { if (wr == 1) PG8_BAR; }
    }
    PG8_WAIT_V(0);
    if constexpr (!ALIGN_EPI) { if (wr == 0) PG8_BAR; }
    PG8_BAR;
    if constexpr (Epi::AFTER_DRAIN) { E.fused(acc, cur, wr, wc, fr, fq, lds, wid, lane); S.done(cur); }
#undef PG8_SA
#undef PG8_SB
#undef PG8_STAGE
#undef PG8_LDA
#undef PG8_LDB
#undef PG8_MMA
#undef PG8_WAIT_V
#undef PG8_WAIT_L
#undef PG8_BAR
#undef PG8_SCHED
}
}

namespace attn_body {
using bf16=__hip_bfloat16;
using bf16x8=__attribute__((ext_vector_type(8)))short;
using s16x4=__attribute__((ext_vector_type(4)))short;
using f32x16=__attribute__((ext_vector_type(16)))float;
using u32x4=__attribute__((ext_vector_type(4)))unsigned;
constexpr int D=64, QP=512, KP=128, OP=1024;
constexpr int NW=8,QBLK=32,QB=QBLK*NW,KVBLK=64;
__device__ __forceinline__ int crow(int r,int hi){return (r&3)+8*(r>>2)+4*hi;}
#define SBAR() __builtin_amdgcn_sched_barrier(0)
#define ATTN_STORE16(p,v) (*(u32x4*)(p)=(v))
constexpr int NSLOT=3, SLOTB=8192;
constexpr int LDS_K=0, LDS_V=NSLOT*SLOTB, LDS_WS=2*NSLOT*SLOTB, LDS_OST=LDS_WS+NW*64*4, LDS_BYTES=LDS_OST+NW*4096;
constexpr float C2=0.125f*1.4426950408889634f;
__device__ __forceinline__ void glds16(const void*gsrc,unsigned lds_dst){unsigned keep;
  asm volatile("s_mov_b32 %0, m0\n\ts_mov_b32 m0, %2\n\ts_nop 0\n\tglobal_load_lds_dwordx4 %1, off\n\ts_mov_b32 m0, %0":"=&s"(keep):"v"(gsrc),"s"(lds_dst):"memory");}
__device__ __forceinline__ float max3f(float a,float b,float c){float r;asm("v_max3_f32 %0, %1, %2, %3":"=v"(r):"v"(a),"v"(b),"v"(c));return r;}
__device__ __forceinline__ float max2f(float a,float b){float r;asm("v_max_f32_e32 %0, %1, %2":"=v"(r):"v"(a),"v"(b));return r;}
__device__ __forceinline__ float fadd_s(float a,float b){float r;asm("v_add_f32_e32 %0, %1, %2":"=v"(r):"v"(a),"v"(b));return r;}
__device__ __forceinline__ float fsub_s(float a,float b){float r;asm("v_sub_f32_e32 %0, %1, %2":"=v"(r):"v"(a),"v"(b));return r;}
typedef float f32x2_t __attribute__((ext_vector_type(2))); typedef __bf16 bf16x2_t __attribute__((ext_vector_type(2)));
__device__ __forceinline__ unsigned cvtpk_s(float lo,float hi){f32x2_t v={lo,hi};bf16x2_t b=__builtin_convertvector(v,bf16x2_t);return __builtin_bit_cast(unsigned,b);}
#define WAIT_BAR(N) asm volatile("s_waitcnt vmcnt(" #N ") lgkmcnt(0)\n\ts_barrier":::"memory")

__device__ __forceinline__ void qkt(f32x16&p0,f32x16&p1,const char*Kslot,const bf16x8*qr,const f32x16&negm,int r32,int hi){
  const char*kb=Kslot+hi*1024+r32*16;
  #pragma unroll
  for(int d0=0;d0<4;++d0){
    const bf16x8 b0=*reinterpret_cast<const bf16x8*>(kb+d0*2048);
    const bf16x8 b1=*reinterpret_cast<const bf16x8*>(kb+d0*2048+512);
    if(d0==0){p0=__builtin_amdgcn_mfma_f32_32x32x16_bf16(b0,qr[0],negm,0,0,0);p1=__builtin_amdgcn_mfma_f32_32x32x16_bf16(b1,qr[0],negm,0,0,0);}
    else{p0=__builtin_amdgcn_mfma_f32_32x32x16_bf16(b0,qr[d0],p0,0,0,0);p1=__builtin_amdgcn_mfma_f32_32x32x16_bf16(b1,qr[d0],p1,0,0,0);}}
}
typedef __attribute__((address_space(3))) const char* lds_cptr;
typedef short v4i16_t __attribute__((ext_vector_type(4)));
__device__ __forceinline__ void kload8(bf16x8*kf,lds_cptr kp){
  kf[0]=*(const __attribute__((address_space(3))) bf16x8*)(kp);      kf[1]=*(const __attribute__((address_space(3))) bf16x8*)(kp+512);
  kf[2]=*(const __attribute__((address_space(3))) bf16x8*)(kp+2048); kf[3]=*(const __attribute__((address_space(3))) bf16x8*)(kp+2560);
  kf[4]=*(const __attribute__((address_space(3))) bf16x8*)(kp+4096); kf[5]=*(const __attribute__((address_space(3))) bf16x8*)(kp+4608);
  kf[6]=*(const __attribute__((address_space(3))) bf16x8*)(kp+6144); kf[7]=*(const __attribute__((address_space(3))) bf16x8*)(kp+6656);
}
__device__ __forceinline__ void kload2(bf16x8*kf,lds_cptr kp,int j){ kf[2*j]=*(const __attribute__((address_space(3))) bf16x8*)(kp+j*2048); kf[2*j+1]=*(const __attribute__((address_space(3))) bf16x8*)(kp+j*2048+512); }
__device__ __forceinline__ s16x4 vtr(lds_cptr p){ return __builtin_bit_cast(s16x4,__builtin_amdgcn_ds_read_tr16_b64_v4i16((__attribute__((address_space(3))) v4i16_t*)p)); }
__device__ __forceinline__ float rowmax(const f32x16&p0,const f32x16&p1){
  float a=max3f(p0[0],p0[1],p1[0]),b=max3f(p0[2],p0[3],p1[1]);a=max3f(a,p1[2],p1[3]);
  #pragma unroll
  for(int r=4;r<16;r+=4){a=max3f(a,p0[r],p0[r+1]);b=max3f(b,p0[r+2],p0[r+3]);a=max3f(a,p1[r],p1[r+1]);b=max3f(b,p1[r+2],p1[r+3]);}
  const float m=max2f(a,b);
  auto rr=__builtin_amdgcn_permlane32_swap(__float_as_uint(m),__float_as_uint(m),false,false);
  return max2f(__uint_as_float(rr[0]),__uint_as_float(rr[1]));
}
__device__ __forceinline__ void pv(f32x16*o,int vb,bf16x8 pa0,bf16x8 pa1,bf16x8 pa2,bf16x8 pa3){
  #pragma unroll
  for(int d0=0;d0<2;++d0){s16x4 lo[4],hi[4];
    #pragma unroll
    for(int ks=0;ks<4;++ks){
      asm volatile("ds_read_b64_tr_b16 %0,%1 offset:%c2":"=&v"(lo[ks]):"v"(vb),"i"(d0*4096+ks*1024):"memory");
      asm volatile("ds_read_b64_tr_b16 %0,%1 offset:%c2":"=&v"(hi[ks]):"v"(vb),"i"(d0*4096+ks*1024+512):"memory");}
    asm volatile("s_waitcnt lgkmcnt(0)":::"memory");SBAR();
    #define PK(k) (bf16x8){lo[k][0],lo[k][1],lo[k][2],lo[k][3],hi[k][0],hi[k][1],hi[k][2],hi[k][3]}
    o[d0]=__builtin_amdgcn_mfma_f32_32x32x16_bf16(pa0,PK(0),o[d0],0,0,0);
    o[d0]=__builtin_amdgcn_mfma_f32_32x32x16_bf16(pa1,PK(1),o[d0],0,0,0);
    o[d0]=__builtin_amdgcn_mfma_f32_32x32x16_bf16(pa2,PK(2),o[d0],0,0,0);
    o[d0]=__builtin_amdgcn_mfma_f32_32x32x16_bf16(pa3,PK(3),o[d0],0,0,0);
    #undef PK
  }
}
template<int THRL> __device__ __forceinline__ void attn_unit(const bf16*Qw0,const bf16*__restrict__ Kh,const bf16*__restrict__ Vh,bf16*Ow0,const int NT,char*shm){
  const int tid=opaque_tid(),lane=tid&63,r32=lane&31,hi=lane>>5; const int wid=__builtin_amdgcn_readfirstlane(tid>>6);
  const bf16*Qw=Qw0+(long)wid*QBLK*QP;
  const unsigned lds0=(unsigned)(uintptr_t)shm;
  float*wsf=(float*)(shm+LDS_WS)+wid*64;
  const bf16*ksrc=Kh+(long)lane*KP+wid*8;
  const bf16*vsrc=Vh+(long)(16*(wid&3)+(lane>>2))*KP+(wid>>2)*32+(lane&3)*8;
  const unsigned kdst=lds0+LDS_K+wid*1024, vdst=lds0+LDS_V+wid*1024;
  #define DMA_K(t,slot) glds16(ksrc+(long)(t)*KVBLK*KP,(unsigned)__builtin_amdgcn_readfirstlane(kdst+(slot)))
  #define DMA_V(t,slot) glds16(vsrc+(long)(t)*KVBLK*KP,(unsigned)__builtin_amdgcn_readfirstlane(vdst+(slot)))
  const int vb0=(int)(lds0+LDS_V)+((lane>>4)&1)*32+(lane&3)*8+(4*hi+((lane&15)>>2))*64;
  const char*Kbase=shm+LDS_K; bf16x8 kf[8];
  const lds_cptr shm3=(lds_cptr)shm; const lds_cptr kp0=shm3+LDS_K+hi*1024+r32*16; const lds_cptr vp0=shm3+LDS_V+((lane>>4)&1)*32+(lane&3)*8+(4*hi+((lane&15)>>2))*64;
  DMA_K(0,0);DMA_V(0,0);DMA_K(1,SLOTB);
  bf16x8 qr[4];
  #pragma unroll
  for(int d0=0;d0<4;++d0)qr[d0]=*reinterpret_cast<const bf16x8*>(&Qw[(long)r32*QP+d0*16+hi*8]);
  float mhat=0.f,l_reg=0.f;f32x16 o[2];o[0]=f32x16{};o[1]=f32x16{};f32x16 negm=f32x16{};asm volatile("":"+v"(negm));
  #define CMASK(P0,P1,t) do{}while(0)
  bool resc=false;
  #define START(P0,P1) do{ const float rm=rowmax(P0,P1); resc=false; \
    { const float dl=rm; mhat=fadd_s(mhat,dl); \
      _Pragma("unroll") for(int r=0;r<16;++r){P0[r]=fsub_s(P0[r],dl);P1[r]=fsub_s(P1[r],dl);} \
      _Pragma("unroll") for(int r=0;r<16;++r)negm[r]=-mhat; asm volatile("":"+v"(negm)); } \
    _Pragma("unroll") for(int r=0;r<16;++r)P0[r]=__builtin_amdgcn_exp2f(P0[r]); }while(0)
  #define RESC() do{ if(resc){ asm volatile("s_waitcnt lgkmcnt(0)":::"memory"); \
      _Pragma("unroll") for(int d_=0;d_<2;++d_) _Pragma("unroll") for(int r=0;r<16;++r)o[d_][r]*=wsf[crow(r,hi)]; } }while(0)
  f32x16 pA0,pA1,pB0,pB1;
  int sl_prev=0,sl_cur=0,sl_next=SLOTB;
  #define ROT() do{sl_prev=sl_cur;sl_cur=sl_next;sl_next=(sl_next==(NSLOT-1)*SLOTB)?0:sl_next+SLOTB;}while(0)
  DMA_K(2,2*SLOTB);
  WAIT_BAR(3);
  qkt(pA0,pA1,Kbase,qr,negm,r32,hi);asm volatile("s_nop 15\n\ts_nop 7":"+v"(pA0),"+v"(pA1));CMASK(pA0,pA1,0);
  START(pA0,pA1);
  _Pragma("unroll") for(int r=0;r<16;++r)pA1[r]=__builtin_amdgcn_exp2f(pA1[r]);
  WAIT_BAR(0);
  DMA_K(3,0);DMA_V(1,SLOTB);
  ROT();
  kload8(kf,kp0+sl_cur);
  WAIT_BAR(2);
  s16x4 vlo[8],vhi[8]; u32x4 pw0,pw1,pw2,pw3;
  #define PKW(P,B) cvtpk_s(P[B],P[B+1])
  #define PAF(k) __builtin_bit_cast(bf16x8,pw##k)
  #define VFR(i) (bf16x8){vlo[i][0],vlo[i][1],vlo[i][2],vlo[i][3],vhi[i][0],vhi[i][1],vhi[i][2],vhi[i][3]}
  #define PIN(x) asm volatile("":"+v"(x))
  #define MX3(a,b,c) __builtin_fmaxf(__builtin_fmaxf((a),(b)),(c))
  #define GAPA(MF,A0,A1,A2,A3,W0,W1,PW) do{ MF; sacc+=A0; sacc+=A1; sacc+=A2; sacc+=A3; PIN(sacc); W0; W1; PIN(PW); SBAR(); }while(0)
  #define EX(v) __builtin_amdgcn_exp2f(v)
  #define GAPB(MF,X,B) do{ MF; X[B]=EX(X[B]); X[B+1]=EX(X[B+1]); X[B+2]=EX(X[B+2]); X[B+3]=EX(X[B+3]); PIN(X); SBAR(); }while(0)
  #define VRD(i) do{ vlo[i]=vtr(vp_+(((i)>>2)*4096+((i)&3)*1024)); vhi[i]=vtr(vp_+(((i)>>2)*4096+((i)&3)*1024+512)); }while(0)
  #define KRD(G,j) do{ if(G){ kload2(kf,kp0+sl_next,j); SBAR(); } }while(0)
  #define STEP(C0,C1,P0,P1,t,GK,GV,GL) do{ SBAR(); \
    const lds_cptr vp_=vp0+sl_prev; \
    VRD(0); SBAR(); float sacc=(P0[0]+P0[1]); \
    GAPA(C0=__builtin_amdgcn_mfma_f32_32x32x16_bf16(kf[0],qr[0],negm,0,0,0), P0[2],P0[3],P0[4],P0[5],     pw0[0]=PKW(P0,0), pw0[1]=PKW(P0,2), pw0); \
    VRD(4); SBAR(); GAPA(C1=__builtin_amdgcn_mfma_f32_32x32x16_bf16(kf[1],qr[0],negm,0,0,0), P0[6],P0[7],P0[8],P0[9],     pw0[2]=PKW(P0,4), pw0[3]=PKW(P0,6), pw0); \
    VRD(1); SBAR(); GAPA(C0=__builtin_amdgcn_mfma_f32_32x32x16_bf16(kf[2],qr[1],C0,0,0,0),   P0[10],P0[11],P0[12],P0[13], pw1[0]=PKW(P0,8), pw1[1]=PKW(P0,10), pw1); \
    VRD(5); SBAR(); GAPA(C1=__builtin_amdgcn_mfma_f32_32x32x16_bf16(kf[3],qr[1],C1,0,0,0),   P0[14],P0[15],P1[0],P1[1],   pw1[2]=PKW(P0,12),pw1[3]=PKW(P0,14), pw1); \
    VRD(2); SBAR(); GAPA(C0=__builtin_amdgcn_mfma_f32_32x32x16_bf16(kf[4],qr[2],C0,0,0,0),   P1[2],P1[3],P1[4],P1[5],     pw2[0]=PKW(P1,0), pw2[1]=PKW(P1,2), pw2); \
    VRD(6); SBAR(); GAPA(C1=__builtin_amdgcn_mfma_f32_32x32x16_bf16(kf[5],qr[2],C1,0,0,0),   P1[6],P1[7],P1[8],P1[9],     pw2[2]=PKW(P1,4), pw2[3]=PKW(P1,6), pw2); \
    VRD(3); SBAR(); GAPA(C0=__builtin_amdgcn_mfma_f32_32x32x16_bf16(kf[6],qr[3],C0,0,0,0),   P1[10],P1[11],P1[12],P1[13], pw3[0]=PKW(P1,8), pw3[1]=PKW(P1,10), pw3); \
    VRD(7); SBAR(); GAPA(C1=__builtin_amdgcn_mfma_f32_32x32x16_bf16(kf[7],qr[3],C1,0,0,0),   P1[14],P1[15],0.f,0.f,       pw3[2]=PKW(P1,12),pw3[3]=PKW(P1,14), pw3); \
    l_reg+=sacc; \
    if(GK){DMA_K((t)+3,sl_cur);} if(GV){DMA_V((t)+1,sl_next);} \
    CMASK(C0,C1,t); \
    { float a=MX3(C0[0],C0[1],C1[0]),b=MX3(C0[2],C0[3],C1[1]); a=MX3(a,C1[2],C1[3]); \
      _Pragma("unroll") for(int r=4;r<16;r+=4){a=MX3(a,C0[r],C0[r+1]);b=MX3(b,C0[r+2],C0[r+3]);a=MX3(a,C1[r],C1[r+1]);b=MX3(b,C1[r+2],C1[r+3]);} \
      float rm=__builtin_fmaxf(a,b); { auto rr=__builtin_amdgcn_permlane32_swap(__float_as_uint(rm),__float_as_uint(rm),false,false); rm=__builtin_fmaxf(__uint_as_float(rr[0]),__uint_as_float(rr[1])); } \
      resc=false; \
      if(__builtin_expect(__any(rm>(float)THRL),0)){ const float dl=__builtin_fmaxf(rm,0.f); mhat+=dl; \
        _Pragma("unroll") for(int r=0;r<16;++r){C0[r]-=dl;C1[r]-=dl;} \
        _Pragma("unroll") for(int r=0;r<16;++r)negm[r]=-mhat; asm volatile("":"+v"(negm)); \
        const float f=__builtin_amdgcn_exp2f(-dl); l_reg*=f; if(hi==0)wsf[r32]=f; resc=true; } } \
    SBAR(); \
    GAPB(o[0]=__builtin_amdgcn_mfma_f32_32x32x16_bf16(PAF(0),VFR(0),o[0],0,0,0), C0,0); \
    GAPB(o[1]=__builtin_amdgcn_mfma_f32_32x32x16_bf16(PAF(0),VFR(4),o[1],0,0,0), C0,4); \
    KRD(GL,0); GAPB(o[0]=__builtin_amdgcn_mfma_f32_32x32x16_bf16(PAF(1),VFR(1),o[0],0,0,0), C0,8); \
    KRD(GL,1); GAPB(o[1]=__builtin_amdgcn_mfma_f32_32x32x16_bf16(PAF(1),VFR(5),o[1],0,0,0), C0,12); \
    KRD(GL,2); GAPB(o[0]=__builtin_amdgcn_mfma_f32_32x32x16_bf16(PAF(2),VFR(2),o[0],0,0,0), C1,0); \
    KRD(GL,3); GAPB(o[1]=__builtin_amdgcn_mfma_f32_32x32x16_bf16(PAF(2),VFR(6),o[1],0,0,0), C1,4); \
    GAPB(o[0]=__builtin_amdgcn_mfma_f32_32x32x16_bf16(PAF(3),VFR(3),o[0],0,0,0), C1,8); \
    GAPB(o[1]=__builtin_amdgcn_mfma_f32_32x32x16_bf16(PAF(3),VFR(7),o[1],0,0,0), C1,12); \
    }while(0)
  int t=1;
  #undef CMASK
  #define CMASK(P0,P1,t) do{}while(0)
  for(;t+5<NT;t+=2){
    STEP(pB0,pB1,pA0,pA1,t,true,true,true);     WAIT_BAR(2); RESC(); ROT();
    STEP(pA0,pA1,pB0,pB1,t+1,true,true,true);   WAIT_BAR(2); RESC(); ROT();
  }
  #undef CMASK
  #define CMASK(P0,P1,t) do{}while(0)
  #define ENDW(tt) do{ if((tt)+3<NT){WAIT_BAR(2);} else if((tt)+2<NT){WAIT_BAR(1);} else {WAIT_BAR(0);} }while(0)
  for(;t+1<NT;t+=2){
    STEP(pB0,pB1,pA0,pA1,t,(t+3<NT),(t+1<NT),(t+1<NT));       ENDW(t);   RESC(); ROT();
    STEP(pA0,pA1,pB0,pB1,t+1,(t+4<NT),(t+2<NT),(t+2<NT));     ENDW(t+1); RESC(); ROT();
  }
  STEP(pB0,pB1,pA0,pA1,NT-1,false,false,false); RESC();
  { float sacc=pB0[0]+pB0[1]; _Pragma("unroll") for(int r=2;r<16;++r)sacc+=pB0[r]; _Pragma("unroll") for(int r=0;r<16;++r)sacc+=pB1[r]; l_reg+=sacc;
    pw0=(u32x4){PKW(pB0,0),PKW(pB0,2),PKW(pB0,4),PKW(pB0,6)};pw1=(u32x4){PKW(pB0,8),PKW(pB0,10),PKW(pB0,12),PKW(pB0,14)};pw2=(u32x4){PKW(pB1,0),PKW(pB1,2),PKW(pB1,4),PKW(pB1,6)};pw3=(u32x4){PKW(pB1,8),PKW(pB1,10),PKW(pB1,12),PKW(pB1,14)};
    SBAR(); pv(o,vb0+sl_cur,PAF(0),PAF(1),PAF(2),PAF(3)); }
  #undef PKW
  #undef PAF
  #undef VFR
  #undef PIN
  #undef MX3
  #undef GAPA
  #undef GAPB
  #undef EX
  #undef VRD
  #undef KRD
  #undef STEP
  #undef ENDW
  {auto rr=__builtin_amdgcn_permlane32_swap(__float_as_uint(l_reg),__float_as_uint(l_reg),false,false);l_reg=__uint_as_float(rr[0])+__uint_as_float(rr[1]);}
  if(hi==0)wsf[32+r32]=l_reg;asm volatile("s_waitcnt lgkmcnt(0)":::"memory");
  float rli[16];
  #pragma unroll
  for(int r=0;r<16;++r)rli[r]=__builtin_amdgcn_rcpf(wsf[32+crow(r,hi)]);
  bf16*Ow=Ow0+(long)wid*QBLK*OP;
  { bf16*stg=(bf16*)(shm+LDS_OST)+wid*2048;
    #pragma unroll
    for(int r=0;r<16;++r){const int orow=crow(r,hi);
      #pragma unroll
      for(int d0=0;d0<2;++d0)stg[orow*64+d0*32+r32]=__float2bfloat16(o[d0][r]*rli[r]);}
    asm volatile("s_waitcnt lgkmcnt(0)":::"memory");
    #pragma unroll
    for(int i=0;i<4;++i){const int row=i*8+(lane>>3),ch=lane&7; const u32x4 v=*(const u32x4*)(stg+row*64+ch*8); ATTN_STORE16(Ow+(long)row*OP+ch*8,v);} }
  asm volatile("s_waitcnt lgkmcnt(0)\n\ts_barrier":::"memory");
  #undef DMA_K
  #undef DMA_V
  #undef CMASK
  #undef START
  #undef RESC
  #undef ROT
}

#undef SBAR
#undef WAIT_BAR
}

typedef short bf16x8_t __attribute__((ext_vector_type(8)));
#define LDS_WAIT() asm volatile("s_waitcnt lgkmcnt(0)" ::: "memory")

__device__ __forceinline__ int inv32(int c) { return 16 * ((c >> 2) & 1) + 4 * (c >> 3) + (c & 3); }
__device__ __forceinline__ int dest_row(int type, int n) {
    if (type == 0) return n;
    if (type == 1) { const int half = n >= DFF ? 1 : 0, j = n - half * DFF, pn = j >> 7, c = j & 127; return pn * 256 + half * 128 + (c & ~31) + inv32(c & 31); }
    if (n < 768) { const int hd = n >> 6, d = n & 63, a = d >> 5, t = (d >> 4) & 1, p = d & 15; return (hd >> 2) * 256 + a * 128 + (hd & 3) * 32 + t * 16 + p; }
    const int pn = n >> 8, c = n & 255, half = c >> 7, c7 = c & 127; return pn * 256 + half * 128 + (c7 & ~31) + inv32(c7 & 31);
}
__device__ __forceinline__ void transpose_item(const float* W, int K, int N, bf16_t* WT, int type, LAS float* scr, int item, int lane) {
    const int nblk = N / 32, kb = item / nblk, nb = item % nblk, k0 = 64 * kb, n0 = 32 * nb;
#pragma unroll 8
    for (int i = 0; i < 32; ++i) { const int kk = 2 * i + (lane >> 5); scr[kk * 33 + (lane & 31)] = W[(size_t)(k0 + kk) * N + n0 + (lane & 31)]; }
    LDS_WAIT(); asm volatile("" ::: "memory");
    const int c = lane & 7;
#pragma unroll
    for (int j = 0; j < 4; ++j) { const int n = (lane >> 3) + 8 * j; const LAS float* s = scr + (8 * c) * 33 + n;
        u32x4 o; o.x = cvt_pk(s[0 * 33], s[1 * 33]); o.y = cvt_pk(s[2 * 33], s[3 * 33]); o.z = cvt_pk(s[4 * 33], s[5 * 33]); o.w = cvt_pk(s[6 * 33], s[7 * 33]);
        *(u32x4*)(WT + (size_t)dest_row(type, n0 + n) * K + k0 + 8 * c) = o; }
    LDS_WAIT(); asm volatile("" ::: "memory");
}

__device__ __forceinline__ void prologue_phase(const Params& P, LAS unsigned char* lds, int G) {
    const int tid = opaque_tid(), lane = tid & 63, wid = __builtin_amdgcn_readfirstlane(tid >> 6), bid = blockIdx.x;
    unsigned char* ws = P.ws;
    {
        LAS float* sc = (LAS float*)lds;
        LAS float* red = (LAS float*)(lds + 36864);
        for (int i = tid; i < 9 * 1024; i += NTHREADS) { const int v = i >> 10, k = i & 1023; const float cv = v < 8 ? P.in[1][v * 1024 + k] : P.in[3][k]; sc[i] = cv / (1.0f + expf(-cv)); }
        __syncthreads();
        float* mod = (float*)(ws + OFF_MOD);
        for (int item = bid; item < 2 * 144; item += G) {
            const int l = item / 144, cgp = item % 144, col = cgp * 64 + lane, kc = wid;
            const float* W = P.in[4] + (size_t)l * 1024 * MODW + col;
            float acc[9];
#pragma unroll
            for (int v = 0; v < 9; ++v) acc[v] = 0.f;
#pragma unroll 8
            for (int k = kc * 128; k < kc * 128 + 128; ++k) { const float w = W[(size_t)k * MODW];
#pragma unroll
                for (int v = 0; v < 9; ++v) acc[v] += sc[v * 1024 + k] * w; }
#pragma unroll
            for (int v = 0; v < 9; ++v) red[(kc * 9 + v) * 64 + lane] = acc[v];
            __syncthreads();
            for (int i = tid; i < 576; i += NTHREADS) { const int v = i >> 6, cc = i & 63; float s = 0.f;
#pragma unroll
                for (int q = 0; q < 8; ++q) s += red[(q * 9 + v) * 64 + cc];
                mod[(size_t)(l * 9 + v) * MODW + cgp * 64 + cc] = s + P.in[5][l * MODW + cgp * 64 + cc]; }
            __syncthreads();
        }
    }
    __syncthreads();
    {
        LAS float* scr = (LAS float*)(lds + wid * 16384);
        const int gw = bid * 8 + wid, NGW = G * 8;
        constexpr int I_FI = 16 * (NFF2 / 32), I_FO = (DFF / 64) * 32, I_WI = 16 * (INW / 32), I_WO = 16 * 32;
        constexpr int PER_L = 2 * I_FI + 2 * I_FO + I_WI + I_WO;
        for (int it = gw; it < DEPTH * PER_L; it += NGW) {
            const int l = it / PER_L; int r = it % PER_L;
            unsigned char* wb = ws + OFF_WB + (size_t)l * WB_LAYER;
            if (r < 2 * I_FI) { const int f = r / I_FI; transpose_item(P.in[7] + (size_t)(l * 2 + f) * DM * NFF2, DM, NFF2, (bf16_t*)(wb + WB_FFIN + f * WB_FFIN_SZ), 1, scr, r % I_FI, lane); continue; } r -= 2 * I_FI;
            if (r < 2 * I_FO) { const int f = r / I_FO; transpose_item(P.in[8] + (size_t)(l * 2 + f) * DFF * DM, DFF, DM, (bf16_t*)(wb + WB_FFOUT + f * WB_FFOUT_SZ), 0, scr, r % I_FO, lane); continue; } r -= 2 * I_FO;
            if (r < I_WI) { transpose_item(P.in[9] + (size_t)l * DM * INW, DM, INW, (bf16_t*)(wb + WB_WIN), 2, scr, r, lane); continue; } r -= I_WI;
            transpose_item(P.in[22] + (size_t)l * DM * DM, DM, DM, (bf16_t*)(wb + WB_WOUT), 0, scr, r, lane);
        }
        bf16_t* LW = (bf16_t*)(ws + OFF_LW);
        const int gt = bid * NTHREADS + tid, NGT = G * NTHREADS;
        for (int i = gt; i < DEPTH * 4 * 256 * 64; i += NGT) {
            const int d = i & 63, c = (i >> 6) & 255, g = (i >> 14) & 3, l = i >> 16, n = c >> 6, e = c & 63;
            const float* src = (g & 1) ? P.in[16] : P.in[14];
            const float v = src[((((size_t)l * 2 + (g >> 1)) * 4 + n) * 64 + d) * 64 + e];
            LW[i] = (bf16_t)(cvt_pk(v, 0.f) & 0xffffu);
        }
        float* rc = (float*)(ws + OFF_ROPE); float* rs = rc + 2048;
        for (int i = gt; i < 2048; i += NGT) { const int pos = i >> 4, p = i & 15; const float inv = powf(10000.0f, -(float)p / 16.0f), ang = (float)pos * inv; rc[i] = cosf(ang); rs[i] = sinf(ang); }
    }
}

__device__ __forceinline__ void norm_phase(const Params& P, int l, int idx, int Mrows, bool first, int G) {
    const int tid = opaque_tid(), lane = tid & 63, wid = __builtin_amdgcn_readfirstlane(tid >> 6);
    const int gw = blockIdx.x * 8 + wid, NGW = G * 8, per = (Mrows + NGW - 1) / NGW;
    const int r0 = gw * per, r1 = (r0 + per < Mrows) ? r0 + per : Mrows;
    const float* mod = (const float*)(P.ws + OFF_MOD) + (size_t)l * 9 * MODW;
    const float* gsrc = P.in[6] + (size_t)(l * 3 + idx) * DM;
    float* xres = (float*)(P.ws + OFF_XRES); bf16_t* hb = (bf16_t*)(P.ws + OFF_HBUF);
    int curv = -1; f32x4 Aa[4], Bb[4];
    for (int row = r0; row < r1; ++row) {
        const int v = row < MLAT ? (row >> 13) : 8;
        if (v != curv) { curv = v;
#pragma unroll
            for (int j = 0; j < 4; ++j) { const int c = 4 * lane + 256 * j; const f32x4 g4 = *(const f32x4*)(gsrc + c), sh = *(const f32x4*)(mod + (size_t)v * MODW + (3 * idx) * DM + c), sc = *(const f32x4*)(mod + (size_t)v * MODW + (3 * idx + 1) * DM + c);
                Aa[j] = g4 * (sc + 1.0f); Bb[j] = sh; } }
        const float* xr = first ? (row < MLAT ? P.in[0] + (size_t)row * DM : P.in[2] + (size_t)(row - MLAT) * DM) : xres + (size_t)row * DM;
        f32x4 x[4]; float ss = 0.f;
#pragma unroll
        for (int j = 0; j < 4; ++j) { x[j] = *(const f32x4*)(xr + 4 * lane + 256 * j); ss += (x[j][0] * x[j][0] + x[j][1] * x[j][1]) + (x[j][2] * x[j][2] + x[j][3] * x[j][3]); }
        const float rstd = 1.0f / sqrtf(wave_sum(ss) * (1.0f / DM) + EPS);
#pragma unroll
        for (int j = 0; j < 4; ++j) { const f32x4 y = x[j] * rstd * Aa[j] + Bb[j]; u32x2 w; w.x = cvt_pk(y[0], y[1]); w.y = cvt_pk(y[2], y[3]);
            *(u32x2*)(hb + (size_t)row * DM + 4 * lane + 256 * j) = w;
            if (first) *(f32x4*)(xres + (size_t)row * DM + 4 * lane + 256 * j) = x[j]; }
    }
}
__device__ __forceinline__ void final_norm_phase(const Params& P, int G) {
    const int tid = opaque_tid(), lane = tid & 63, wid = __builtin_amdgcn_readfirstlane(tid >> 6);
    const int gw = blockIdx.x * 8 + wid, NGW = G * 8;
    const float* xres = (const float*)(P.ws + OFF_XRES);
    f32x4 g4[4];
#pragma unroll
    for (int j = 0; j < 4; ++j) g4[j] = *(const f32x4*)(P.in[23] + 4 * lane + 256 * j);
    for (int row = gw; row < MLAT; row += NGW) {
        f32x4 x[4]; float ss = 0.f;
#pragma unroll
        for (int j = 0; j < 4; ++j) { x[j] = *(const f32x4*)(xres + (size_t)row * DM + 4 * lane + 256 * j); ss += (x[j][0] * x[j][0] + x[j][1] * x[j][1]) + (x[j][2] * x[j][2] + x[j][3] * x[j][3]); }
        const float rstd = 1.0f / sqrtf(wave_sum(ss) * (1.0f / DM) + EPS);
#pragma unroll
        for (int j = 0; j < 4; ++j) *(f32x4*)(P.out + (size_t)row * DM + 4 * lane + 256 * j) = x[j] * rstd * g4[j];
    }
}

constexpr int L1_AST = 528;
constexpr int L1_UST = 260;
constexpr int L1_UOFF = 66560;
__device__ __forceinline__ void lru1_phase(const Params& P, int l, LAS unsigned char* lds, int G) {
    const int tid = opaque_tid(), lane = tid & 63, wid = __builtin_amdgcn_readfirstlane(tid >> 6), fr = lane & 15, fq = lane >> 4;
    LAS unsigned char* ldsA = lds; LAS float* ldsU = (LAS float*)(lds + L1_UOFF);
    const bf16_t* Ubuf = (const bf16_t*)(P.ws + OFF_U5);
    float* Sg = (float*)(P.ws + OFF_S); unsigned* PPg = (unsigned*)(P.ws + OFF_PP); float* csum = (float*)(P.ws + OFF_CSUM);
    const bf16_t* LW = (const bf16_t*)(P.ws + OFF_LW) + (size_t)l * 4 * 256 * 64;
    const int ch4 = (tid & 63) * 4, pg = tid >> 6;
    f32x4 cw[4], cbias;
#pragma unroll
    for (int i = 0; i < 4; ++i) cw[i] = *(const f32x4*)(P.in[12] + (size_t)(l * 4 + i) * 256 + ch4);
    cbias = *(const f32x4*)(P.in[13] + (size_t)l * 256 + ch4);
    const int nblk = wid >> 1;
    for (int tile = blockIdx.x; tile < NBATCH * NCHUNK; tile += G) {
        const int b = tile / NCHUNK, cidx = tile % NCHUNK, P0 = cidx * 64; const bool latent = cidx >= 4;
        const int seg_lo = latent ? 256 : 0, seg_hi = latent ? KEYS : 256;
        const int rbase = latent ? b * SEQ - 256 : MLAT + b * CTXL;
        {
            const int pp0 = P0 + pg * 8;
            f32x4 win[11];
#pragma unroll
            for (int i = 0; i < 11; ++i) { const int Pq = pp0 - 2 + i; f32x4 w4 = {0.f, 0.f, 0.f, 0.f};
                if (Pq >= seg_lo && Pq < seg_hi) { const u32x2 raw = *(const u32x2*)(Ubuf + (size_t)(rbase + Pq) * 256 + ch4); w4 = (f32x4){bf_lo(raw.x), bf_hi(raw.x), bf_lo(raw.y), bf_hi(raw.y)}; }
                win[i] = w4; }
#pragma unroll
            for (int q = 0; q < 8; ++q) { f32x4 y = cbias;
#pragma unroll
                for (int i = 0; i < 4; ++i) y = y + cw[i] * win[q + i];
                const int pos = pg * 8 + q;
                u32x2 w; w.x = cvt_pk(y[0], y[1]); w.y = cvt_pk(y[2], y[3]);
                *(LAS u32x2*)(ldsA + pos * L1_AST + ch4 * 2) = w;
                *(LAS f32x4*)(ldsU + pos * L1_UST + ch4) = y; }
        }
        __syncthreads();
#pragma unroll 1
        for (int cc = 0; cc < 2; ++cc) {
            const int c = 32 * wid + 16 * cc + fr;
            const float baf = P.in[15][(l * 2 + 0) * 256 + c], bab = P.in[15][(l * 2 + 1) * 256 + c], bxf = P.in[17][(l * 2 + 0) * 256 + c], bxb = P.in[17][(l * 2 + 1) * 256 + c];
            const float nspf = -8.0f * log1pf(expf(-P.in[18][(l * 2 + 0) * 256 + c])), nspb = -8.0f * log1pf(expf(-P.in[18][(l * 2 + 1) * 256 + c]));
            f32x4 acc[4][4];
            {
                bf16x8_t bw[4][2];
#pragma unroll
                for (int g = 0; g < 4; ++g)
#pragma unroll
                    for (int kk = 0; kk < 2; ++kk) bw[g][kk] = *(const bf16x8_t*)(LW + ((size_t)(g * 256 + c) * 64 + kk * 32 + fq * 8));
#pragma unroll
                for (int m = 0; m < 4; ++m) {
#pragma unroll
                    for (int g = 0; g < 4; ++g) acc[m][g] = (f32x4){0.f, 0.f, 0.f, 0.f};
#pragma unroll
                    for (int kk = 0; kk < 2; ++kk) { const bf16x8_t a = *(const LAS bf16x8_t*)(ldsA + (16 * m + fr) * L1_AST + (64 * nblk + 32 * kk + 8 * fq) * 2);
#pragma unroll
                        for (int g = 0; g < 4; ++g) acc[m][g] = __builtin_amdgcn_mfma_f32_16x16x32_bf16(a, bw[g][kk], acc[m][g], 0, 0, 0); }
                }
            }
#pragma unroll
            for (int m = 0; m < 4; ++m)
#pragma unroll
                for (int j = 0; j < 4; ++j) {
                    const float u = ldsU[(16 * m + 4 * fq + j) * L1_UST + c];
                    {   const float r = sigmoidf_(acc[m][0][j] + baf), ig = sigmoidf_(acc[m][1][j] + bxf);
                        const float la = nspf * r, a = __expf(la), y = 2.0f * la;
                        const float em = (y > -0.1f) ? y * (1.0f + y * (0.5f + y * (0.16666667f + y * 0.041666668f))) : (__expf(y) - 1.0f);
                        acc[m][0][j] = a; acc[m][1][j] = sqrtf(-em) * ig * u; }
                    {   const float r = sigmoidf_(acc[m][2][j] + bab), ig = sigmoidf_(acc[m][3][j] + bxb);
                        const float la = nspb * r, a = __expf(la), y = 2.0f * la;
                        const float em = (y > -0.1f) ? y * (1.0f + y * (0.5f + y * (0.16666667f + y * 0.041666668f))) : (__expf(y) - 1.0f);
                        acc[m][2][j] = a; acc[m][3][j] = sqrtf(-em) * ig * u; }
                }
            f32x4 hf[4], pf[4];
            {
                float cA = 1.f, cH = 0.f;
#pragma unroll
                for (int m = 0; m < 4; ++m) {
                    const f32x4 a = acc[m][0], x = acc[m][1];
                    const float A0 = a[0], H0 = x[0], A1 = A0 * a[1], H1 = a[1] * H0 + x[1], A2 = A1 * a[2], H2 = a[2] * H1 + x[2], A3 = A2 * a[3], H3 = a[3] * H2 + x[3];
                    float TA = A3, TH = H3;
                    float tA = __shfl_up(TA, 16), tH = __shfl_up(TH, 16); if (fq >= 1) { TH = TA * tH + TH; TA = TA * tA; }
                    tA = __shfl_up(TA, 32); tH = __shfl_up(TH, 32); if (fq >= 2) { TH = TA * tH + TH; TA = TA * tA; }
                    float EA = __shfl_up(TA, 16), EH = __shfl_up(TH, 16); if (fq == 0) { EA = 1.f; EH = 0.f; }
                    const float inA = cA * EA, inH = EA * cH + EH;
                    pf[m] = (f32x4){inA * A0, inA * A1, inA * A2, inA * A3};
                    hf[m] = (f32x4){A0 * inH + H0, A1 * inH + H1, A2 * inH + H2, A3 * inH + H3};
                    const float gA = __shfl(TA, fr + 48), gH = __shfl(TH, fr + 48);
                    cH = gA * cH + gH; cA = cA * gA;
                }
                if (fq == 0) { float* cs = csum + ((size_t)(b * NCHUNK + cidx) * 2 + 0) * 512 + c; cs[0] = cA; cs[256] = cH; }
            }
            {
                float cA = 1.f, cH = 0.f;
#pragma unroll
                for (int mm = 0; mm < 4; ++mm) { const int m = 3 - mm;
                    const f32x4 a = acc[m][2], x = acc[m][3];
                    const float A3 = a[3], H3 = x[3], A2 = A3 * a[2], H2 = a[2] * H3 + x[2], A1 = A2 * a[1], H1 = a[1] * H2 + x[1], A0 = A1 * a[0], H0 = a[0] * H1 + x[0];
                    float TA = A0, TH = H0;
                    float tA = __shfl_down(TA, 16), tH = __shfl_down(TH, 16); if (fq <= 2) { TH = TA * tH + TH; TA = TA * tA; }
                    tA = __shfl_down(TA, 32); tH = __shfl_down(TH, 32); if (fq <= 1) { TH = TA * tH + TH; TA = TA * tA; }
                    float EA = __shfl_down(TA, 16), EH = __shfl_down(TH, 16); if (fq == 3) { EA = 1.f; EH = 0.f; }
                    const float inA = cA * EA, inH = EA * cH + EH;
                    const f32x4 pb = (f32x4){inA * A0, inA * A1, inA * A2, inA * A3};
                    const f32x4 hb = (f32x4){A0 * inH + H0, A1 * inH + H1, A2 * inH + H2, A3 * inH + H3};
#pragma unroll
                    for (int j = 0; j < 4; ++j) { const int tk = 16 * m + 4 * fq + j;
                        ldsU[tk * L1_UST + c] = hf[m][j] + hb[j];
                        PPg[(size_t)(rbase + P0 + tk) * 256 + c] = (cvt_pk(pf[m][j], 0.f) & 0xffffu) | (cvt_pk(0.f, pb[j]) & 0xffff0000u); }
                    const float gA = __shfl(TA, fr), gH = __shfl(TH, fr);
                    cH = gA * cH + gH; cA = cA * gA;
                }
                if (fq == 0) { float* cs = csum + ((size_t)(b * NCHUNK + cidx) * 2 + 1) * 512 + c; cs[0] = cA; cs[256] = cH; }
            }
        }
        __syncthreads();
#pragma unroll
        for (int it = 0; it < 8; ++it) { const int idx = it * NTHREADS + tid, r = idx >> 6, c16 = idx & 63; const size_t grow = (size_t)(rbase + P0 + r) * 256 + c16 * 4;
            *(f32x4*)(Sg + grow) = *(const LAS f32x4*)(ldsU + r * L1_UST + c16 * 4);
 }
        __syncthreads();
    }
}
__device__ __forceinline__ void lru2_batch(const Params& P, int b) {
    const int tid = opaque_tid(), dir = tid >> 8, c = tid & 255;
    const float* csum = (const float*)(P.ws + OFF_CSUM); float* carry = (float*)(P.ws + OFF_CARRY);
    float h = 0.f;
#pragma unroll 1
    for (int k0 = 0; k0 < NCHUNK; k0 += 12) {
        float A[12], H[12]; int ci[12];
#pragma unroll
        for (int q = 0; q < 12; ++q) { const int k = k0 + q; ci[q] = dir == 0 ? k : (k < 4 ? 3 - k : 135 - k);
            const float* cs = csum + ((size_t)(b * NCHUNK + ci[q]) * 2 + dir) * 512 + c; A[q] = cs[0]; H[q] = cs[256]; }
#pragma unroll
        for (int q = 0; q < 12; ++q) { carry[((size_t)(b * NCHUNK + ci[q]) * 2 + dir) * 256 + c] = h; h = A[q] * h + H[q]; }
    }
}
__device__ __forceinline__ float gelu_tanh(float x) { const float z = 0.7978845608f * (x + 0.044715f * x * x * x); const float t = 1.0f - 2.0f * __builtin_amdgcn_rcpf(1.0f + __expf(2.0f * z)); return 0.5f * x * (1.0f + t); }
__device__ __forceinline__ void merge_phase(const Params& P, int l, int Mrows, int G) {
    const int tid = opaque_tid(), lane = tid & 63, wid = __builtin_amdgcn_readfirstlane(tid >> 6);
    const int gw = blockIdx.x * 8 + wid, NGW = G * 8, nruns = Mrows / 8, c4 = 4 * lane;
    const bf16_t* U5 = (const bf16_t*)(P.ws + OFF_U5);
    const bf16_t *Gb = U5 + U5_STRIDE, *BGb = U5 + 2 * U5_STRIDE, *CGb = U5 + 3 * U5_STRIDE, *SSb = U5 + 4 * U5_STRIDE;
    const float* Sg = (const float*)(P.ws + OFF_S); const unsigned* PPg = (const unsigned*)(P.ws + OFF_PP); const float* carry = (const float*)(P.ws + OFF_CARRY);
    bf16_t* hb = (bf16_t*)(P.ws + OFF_HBUF);
    f32x4 w0 = *(const f32x4*)(P.in[19] + (size_t)(l * 3 + 0) * 256 + c4), w1 = *(const f32x4*)(P.in[19] + (size_t)(l * 3 + 1) * 256 + c4), w2 = *(const f32x4*)(P.in[19] + (size_t)(l * 3 + 2) * 256 + c4);
    f32x4 cb4 = *(const f32x4*)(P.in[20] + (size_t)l * 256 + c4);
    const float* gg = P.in[21] + (size_t)l * 1024;
    const f32x4 ga0 = *(const f32x4*)(gg + 8 * lane), ga1 = *(const f32x4*)(gg + 8 * lane + 4), gl = *(const f32x4*)(gg + 512 + c4), gs = *(const f32x4*)(gg + 768 + c4);
    for (int run = gw; run < nruns; run += NGW) {
        const int row0 = run * 8; int b, cidx; bool seg_first, seg_last;
        if (row0 < MLAT) { b = row0 >> 13; const int s0 = row0 & 8191; cidx = 4 + (s0 >> 6); seg_first = s0 == 0; seg_last = s0 + 8 == SEQ; }
        else { const int rc = row0 - MLAT; b = rc >> 8; const int j0 = rc & 255; cidx = j0 >> 6; seg_first = j0 == 0; seg_last = j0 + 8 == CTXL; }
        const f32x4 cf = *(const f32x4*)(carry + ((size_t)(b * NCHUNK + cidx) * 2 + 0) * 256 + c4), cbk = *(const f32x4*)(carry + ((size_t)(b * NCHUNK + cidx) * 2 + 1) * 256 + c4);
        f32x4 prod[10];
#pragma unroll
        for (int i = 0; i < 10; ++i) { f32x4 p4 = {0.f, 0.f, 0.f, 0.f};
            if (!((i == 0 && seg_first) || (i == 9 && seg_last))) { const size_t o = (size_t)(row0 - 1 + i) * 256 + c4; const u32x2 a = *(const u32x2*)(CGb + o), s = *(const u32x2*)(SSb + o);
                p4 = (f32x4){bf_lo(a.x) * bf_lo(s.x), bf_hi(a.x) * bf_hi(s.x), bf_lo(a.y) * bf_lo(s.y), bf_hi(a.y) * bf_hi(s.y)}; }
            prod[i] = p4; }
#pragma unroll
        for (int i = 0; i < 8; ++i) { const int row = row0 + i; const size_t o = (size_t)row * 256 + c4;
            const f32x4 S4 = *(const f32x4*)(Sg + o); const u32x4 pp = *(const u32x4*)(PPg + o);
            const u32x2 g2 = *(const u32x2*)(Gb + o), bg2 = *(const u32x2*)(BGb + o);
            const u32x4 at = *(const u32x4*)(hb + (size_t)row * DM + 8 * lane);
            f32x4 hv;
#pragma unroll
            for (int j = 0; j < 4; ++j) hv[j] = S4[j] + bf_lo(pp[j]) * cf[j] + bf_hi(pp[j]) * cbk[j];
            const f32x4 g4 = (f32x4){bf_lo(g2.x), bf_hi(g2.x), bf_lo(g2.y), bf_hi(g2.y)}, bg4 = (f32x4){bf_lo(bg2.x), bf_hi(bg2.x), bf_lo(bg2.y), bf_hi(bg2.y)};
            f32x4 lru, scv;
#pragma unroll
            for (int j = 0; j < 4; ++j) { lru[j] = hv[j] * gelu_tanh(g4[j]); scv[j] = bg4[j] * (w0[j] * prod[i][j] + w1[j] * prod[i + 1][j] + w2[j] * prod[i + 2][j] + cb4[j]); }
            float av[8];
#pragma unroll
            for (int j = 0; j < 4; ++j) { av[2 * j] = bf_lo(at[j]); av[2 * j + 1] = bf_hi(at[j]); }
            float ssa = 0.f, ssl = 0.f, sss = 0.f;
#pragma unroll
            for (int j = 0; j < 8; ++j) ssa += av[j] * av[j];
#pragma unroll
            for (int j = 0; j < 4; ++j) { ssl += lru[j] * lru[j]; sss += scv[j] * scv[j]; }
            ssa = wave_sum(ssa); ssl = wave_sum(ssl); sss = wave_sum(sss);
            const float ra = 1.0f / sqrtf(ssa * (1.0f / 512.0f) + EPS), rl = 1.0f / sqrtf(ssl * (1.0f / 256.0f) + EPS), rs = 1.0f / sqrtf(sss * (1.0f / 256.0f) + EPS);
            u32x4 wa; wa.x = cvt_pk(av[0] * ra * ga0[0], av[1] * ra * ga0[1]); wa.y = cvt_pk(av[2] * ra * ga0[2], av[3] * ra * ga0[3]); wa.z = cvt_pk(av[4] * ra * ga1[0], av[5] * ra * ga1[1]); wa.w = cvt_pk(av[6] * ra * ga1[2], av[7] * ra * ga1[3]);
            *(u32x4*)(hb + (size_t)row * DM + 8 * lane) = wa;
            u32x2 wl; wl.x = cvt_pk(lru[0] * rl * gl[0], lru[1] * rl * gl[1]); wl.y = cvt_pk(lru[2] * rl * gl[2], lru[3] * rl * gl[3]);
            *(u32x2*)(hb + (size_t)row * DM + 512 + c4) = wl;
            u32x2 wsv; wsv.x = cvt_pk(scv[0] * rs * gs[0], scv[1] * rs * gs[1]); wsv.y = cvt_pk(scv[2] * rs * gs[2], scv[3] * rs * gs[3]);
            *(u32x2*)(hb + (size_t)row * DM + 768 + c4) = wsv;
        }
    }
}
__device__ __forceinline__ void attention_phase(const Params& P, int l, char* lds, int G) {
    using abf = attn_body::bf16;
    const abf* Q = (const abf*)(P.ws + OFF_Q); const abf* K = (const abf*)(P.ws + OFF_K); const abf* V = (const abf*)(P.ws + OFF_V); abf* O = (abf*)(P.ws + OFF_HBUF);
    if (blockIdx.x < NBATCH) lru2_batch(P, blockIdx.x);
    const int nunits = NBATCH * 8 * 32 + ((l + 1 < DEPTH) ? NBATCH * 8 : 0);
    for (int uid = blockIdx.x; uid < nunits; uid += G) {
        int b, h, NT; size_t qrow;
        if (uid < NBATCH * 8 * 32) { b = uid & 7; const int rest = uid >> 3, kvh = rest >> 7, u = rest & 127; h = kvh * 4 + (u >> 5); qrow = (size_t)b * SEQ + (u & 31) * 256; NT = NCHUNK; }
        else { const int v = uid - NBATCH * 8 * 32; b = v & 7; h = v >> 3; qrow = (size_t)MLAT + b * CTXL; NT = 4; }
        const size_t kvoff = (size_t)b * KEYS * 128 + (h >> 2) * 64;
        attn_body::attn_unit<8>(Q + qrow * 512 + h * 64, K + kvoff, V + kvoff, O + qrow * 1024 + h * 64, NT, lds);
    }
}

#ifndef PH_MASK
#define PH_MASK 0x1FF
#endif
__global__ void __launch_bounds__(NTHREADS, 2) fwd_megakernel(Params P) {
    extern __shared__ __attribute__((aligned(16))) unsigned char lds_raw[];
    LAS unsigned char* lds = (LAS unsigned char*)lds_raw;
    cg::grid_group grid = cg::this_grid();
    const int G = gridDim.x;
    unsigned char* ws = P.ws;
    if constexpr (PH_MASK & 1) prologue_phase(P, lds, G);
    grid.sync();
    for (int step = 0; step < DEPTH * 3; ++step) {
        const int l = step / 3, s3 = step % 3;
        const bool last = (l == DEPTH - 1);
        const int Mn = (last && s3 == 2) ? MLAT : MTOT;
        if constexpr (PH_MASK & 2) norm_phase(P, l, s3, Mn, step == 0, G);
        grid.sync();
        unsigned char* wb = ws + OFF_WB + (size_t)l * WB_LAYER;
        pg8::Gemm gr; pg8::EpiResid er; int Mr;
        const float* modl = (const float*)(ws + OFF_MOD) + (size_t)l * 9 * MODW;
        if (s3 != 1) {
            const int f = s3 >> 1;
            { pg8::Gemm g{(const bf16_t*)(ws + OFF_HBUF), (const bf16_t*)(wb + WB_FFIN + f * WB_FFIN_SZ), Mn, NFF2, DM};
              pg8::StaticOrder S; S.init(Mn, NFF2, G, (int)blockIdx.x);
              pg8::EpiSwiglu E{(bf16_t*)(ws + OFF_MID)};
              if constexpr (PH_MASK & 4) pg8::gemm_phase<pg8::EpiSwiglu, pg8::StaticOrder, true, true>(lds, g, S, E); }
            grid.sync();
            Mr = Mn;
            gr = pg8::Gemm{(const bf16_t*)(ws + OFF_MID), (const bf16_t*)(wb + WB_FFOUT + f * WB_FFOUT_SZ), Mr, DM, DFF};
            er = pg8::EpiResid{(float*)(ws + OFF_XRES), modl + (3 * s3 + 2) * DM, 0.5f};
        } else {
            { pg8::Gemm g{(const bf16_t*)(ws + OFF_HBUF), (const bf16_t*)(wb + WB_WIN), MTOT, INW, DM};
              pg8::StaticOrder S; S.init(MTOT, INW, G, (int)blockIdx.x);
              pg8::EpiWin E{(bf16_t*)(ws + OFF_Q), (bf16_t*)(ws + OFF_K), (bf16_t*)(ws + OFF_V), (bf16_t*)(ws + OFF_U5), P.in[10] + l * 64, P.in[11] + l * 64,
                            (const float*)(ws + OFF_ROPE), (const float*)(ws + OFF_ROPE) + 2048, 0.125f * 1.4426950408889634f};
              if constexpr (PH_MASK & 8) pg8::gemm_phase<pg8::EpiWin, pg8::StaticOrder, true, true>(lds, g, S, E); }
            grid.sync();
            if constexpr (PH_MASK & 16) lru1_phase(P, l, lds, G);
            grid.sync();
            if constexpr (PH_MASK & 32) attention_phase(P, l, (char*)lds_raw, G);
            grid.sync();
            Mr = last ? MLAT : MTOT;
            if constexpr (PH_MASK & 64) merge_phase(P, l, Mr, G);
            grid.sync();
            gr = pg8::Gemm{(const bf16_t*)(ws + OFF_HBUF), (const bf16_t*)(wb + WB_WOUT), Mr, DM, DM};
            er = pg8::EpiResid{(float*)(ws + OFF_XRES), modl + 5 * DM, 1.0f};
        }
        { pg8::StaticOrder S; S.init(Mr, DM, G, (int)blockIdx.x);
          if constexpr (PH_MASK & 128) pg8::gemm_phase<pg8::EpiResid, pg8::StaticOrder, true, true>(lds, gr, S, er); }
        grid.sync();
    }
    if constexpr (PH_MASK & 256) final_norm_phase(P, G);
}

extern "C" void kernel_launch(void* const* d_in, const int* in_sizes, int n_in, void* d_out, int out_size, void* d_ws, size_t ws_size, hipStream_t stream) {
    static int grid = 0;
    if (grid == 0) {
        if (n_in != 24 || out_size != MLAT * DM || ws_size < WS_NEED) { fprintf(stderr, "kernel_launch: unexpected shapes (n_in %d, out %d, ws %zu, need %zu)\n", n_in, out_size, ws_size, (size_t)WS_NEED); grid = -1; return; }
        int dev = 0, cus = 0, per_cu = 0;
        hipGetDevice(&dev); hipDeviceGetAttribute(&cus, hipDeviceAttributeMultiprocessorCount, dev);
        if (hipFuncSetAttribute((const void*)fwd_megakernel, hipFuncAttributeMaxDynamicSharedMemorySize, LDS_BYTES) != hipSuccess) { fprintf(stderr, "kernel_launch: hipFuncSetAttribute failed\n"); grid = -1; return; }
        if (hipOccupancyMaxActiveBlocksPerMultiprocessor(&per_cu, (const void*)fwd_megakernel, NTHREADS, LDS_BYTES) != hipSuccess || per_cu < 1) { fprintf(stderr, "kernel_launch: occupancy query says %d\n", per_cu); per_cu = 1; (void)hipGetLastError(); }
        grid = cus * 1;
        if (grid % 8 != 0 || grid <= 0) grid = 256;
        fprintf(stderr, "kernel_launch: grid %d (cus %d, per_cu %d)\n", grid, cus, per_cu);
    }
    if (grid < 0) return;
    Params p{};
    for (int i = 0; i < 24; ++i) p.in[i] = (const float*)d_in[i];
    p.out = (float*)d_out; p.ws = (unsigned char*)d_ws;
    void* args[] = {&p};
    hipError_t e = hipLaunchCooperativeKernel((const void*)fwd_megakernel, dim3(grid), dim3(NTHREADS), args, LDS_BYTES, stream);
    if (e != hipSuccess) fprintf(stderr, "kernel_launch: cooperative launch failed: %s (grid %d)\n", hipGetErrorString(e), grid);
}
```

```cpp
#include <hip/hip_runtime.h>
#include <hip/hip_bf16.h>
#include <hip/hip_cooperative_groups.h>
#include <cstdio>
#include <cstdint>
#include <cmath>
namespace cg = cooperative_groups;

constexpr int DM = 1024, NBATCH = 8, SEQ = 8192, CTXL = 256, DEPTH = 2;
constexpr int MLAT = NBATCH * SEQ, MCTX = NBATCH * CTXL, MTOT = MLAT + MCTX;
constexpr int DFF = 2816, NFF2 = 2 * DFF, INW = 2048, NMODV = 9, MODW = 9 * DM;
constexpr int KEYS = SEQ + CTXL, NCHUNK = KEYS / 64;
constexpr float EPS = 1e-6f;
constexpr int NTHREADS = 512;
constexpr int LDS_BYTES = 147456;

constexpr size_t MiB = 1u << 20;
constexpr size_t OFF_MOD = 0;
constexpr size_t OFF_ROPE = 1 * MiB;
constexpr size_t OFF_LW = 1 * MiB + 65536;
constexpr size_t OFF_CSUM = 2 * MiB;
constexpr size_t OFF_CARRY = 7 * MiB;
constexpr size_t OFF_CTL = 9 * MiB + 524288, CTL_BYTES = 65536;
constexpr int LDS_BAR_OFF = 147200;
constexpr size_t OFF_WB = 10 * MiB;
constexpr size_t WB_LAYER = 39 * MiB;
constexpr size_t WB_FFIN = 0, WB_FFIN_SZ = (size_t)NFF2 * DM * 2;
constexpr size_t WB_FFOUT = 2 * WB_FFIN_SZ, WB_FFOUT_SZ = (size_t)DM * DFF * 2;
constexpr size_t WB_WIN = WB_FFOUT + 2 * WB_FFOUT_SZ, WB_WIN_SZ = (size_t)INW * DM * 2;
constexpr size_t WB_WOUT = WB_WIN + WB_WIN_SZ;
static_assert(WB_WOUT + (size_t)DM * DM * 2 == WB_LAYER, "weight map");
constexpr size_t OFF_XRES = 88 * MiB;
constexpr size_t OFF_HBUF = 352 * MiB;
constexpr size_t OFF_R1 = 484 * MiB;
constexpr size_t OFF_MID = OFF_R1;
constexpr size_t OFF_Q = OFF_R1;
constexpr size_t OFF_K = OFF_R1 + 66 * MiB;
constexpr size_t OFF_V = OFF_K + 16 * MiB + 524288;
constexpr size_t OFF_U5 = OFF_R1 + 99 * MiB;
constexpr size_t U5_STRIDE = (size_t)MTOT * 256;
constexpr size_t OFF_S = OFF_R1 + 264 * MiB;
constexpr size_t OFF_PP = OFF_R1 + 330 * MiB;
constexpr size_t WS_NEED = OFF_R1 + 396 * MiB;

#define LAS __attribute__((address_space(3)))
typedef unsigned short bf16_t;
typedef float f32x4 __attribute__((ext_vector_type(4)));
typedef float f32x2 __attribute__((ext_vector_type(2)));
typedef unsigned u32x4 __attribute__((ext_vector_type(4)));
typedef unsigned u32x2 __attribute__((ext_vector_type(2)));

struct Params { const float* in[24]; float* out; unsigned char* ws; };

__device__ __forceinline__ unsigned cvt_pk(float lo, float hi) { unsigned r; asm volatile("v_cvt_pk_bf16_f32 %0, %1, %2" : "=v"(r) : "v"(lo), "v"(hi)); return r; }
__device__ __forceinline__ float bf_lo(unsigned w) { return __uint_as_float(w << 16); }
__device__ __forceinline__ float bf_hi(unsigned w) { return __uint_as_float(w & 0xffff0000u); }
__device__ __forceinline__ float wave_sum(float v) {
#pragma unroll
    for (int o = 1; o < 64; o <<= 1) v += __shfl_xor(v, o);
    return v;
}
__device__ __forceinline__ int opaque_tid() { int t = threadIdx.x; asm volatile("" : "+v"(t)); return t; }
__device__ __forceinline__ float sigmoidf_(float z) { return __builtin_amdgcn_rcpf(1.0f + __expf(-z)); }
namespace pg8 {
#define PG8_LAS __attribute__((address_space(3)))
typedef unsigned short bf16_t;
typedef short bf16x8 __attribute__((ext_vector_type(8)));
typedef float f32x4 __attribute__((ext_vector_type(4)));
typedef unsigned u32x4 __attribute__((ext_vector_type(4)));
constexpr int BM = 256, BK = 64, HALF = 128, HTB = HALF * BK * 2  , STAGE_BYTES = 8 * HTB, NXCD = 8, WGM = 8;

__host__ __device__ __forceinline__ int lds_byte(int r, int c) { const int st = (r >> 4) * 2 + (c >> 5), rr = r & 15, cc = c & 31, ob = rr * 64 + cc * 2; return st * 1024 + (ob ^ (((ob >> 9) & 1) << 5)); }
__host__ __device__ __forceinline__ void stage_rc(int b, int& R, int& C) { const int st = b / 1024, sb = b % 1024, swz = sb ^ (((sb >> 9) & 1) << 5); R = (st >> 1) * 16 + swz / 64; C = (st & 1) * 32 + (swz % 64) / 2; }
__host__ __device__ __forceinline__ int perm32(int rho) { const int n = rho >> 4, i = rho & 15; return 8 * (i >> 2) + 4 * n + (i & 3); }

struct Unit { int pm, pn; };
struct Gemm { const bf16_t* A; const bf16_t* Bt; int M, N, K; };

struct StaticOrder {
    int nM, nN, nwg, G, c;
    __host__ __device__ void init(int M, int N, int G_, int c_) { nM = M / BM; nN = N / BM; nwg = nM * nN; G = G_; c = c_; }
    __host__ __device__ bool next(int i, Unit& u) const {
        const long L = (long)i * G + c; if (L >= nwg) return false;
        int wgid = (int)L; { const int q = nwg / NXCD, r = nwg % NXCD, xcd = wgid % NXCD, off = wgid / NXCD; wgid = (xcd < r ? xcd * (q + 1) : r * (q + 1) + (xcd - r) * q) + off; }
        const int nig = WGM * nN, gid = wgid / nig, fm = gid * WGM, gsz = (nM - fm) < WGM ? (nM - fm) : WGM;
        u.pm = fm + ((wgid % nig) % gsz); u.pn = (wgid % nig) / gsz; return true;
    }
    __device__ __forceinline__ void a_ready(const Unit&) const {}
    __device__ __forceinline__ void done(const Unit&) const {}
};
__device__ __forceinline__ unsigned cvt_pk_bf16(float lo, float hi) { unsigned r; asm volatile("v_cvt_pk_bf16_f32 %0, %1, %2" : "=v"(r) : "v"(lo), "v"(hi)); return r; }

struct EpiSwiglu {
    static constexpr bool PERM = false, AFTER_DRAIN = false;
    bf16_t* O;
    __device__ __forceinline__ void operator()(const f32x4 (&acc)[2][2][4][2], const Unit& u, int wr, int wc, int fr, int fq) const {
        const int row0 = u.pm * BM + wr * 64 + fr, col0 = u.pn * 128 + wc * 32 + 8 * fq;
#pragma unroll
        for (int ai = 0; ai < 2; ++ai)
#pragma unroll
            for (int m = 0; m < 4; ++m) {
                bf16_t* rowp = O + (size_t)(row0 + ai * HALF + m * 16) * 2816 + col0;
                float v[8];
#pragma unroll
                for (int n = 0; n < 2; ++n)
#pragma unroll
                    for (int j = 0; j < 4; ++j) { const float g = acc[ai][0][m][n][j], up = acc[ai][1][m][n][j]; v[n * 4 + j] = g * __builtin_amdgcn_rcpf(1.0f + __expf(-g)) * up; }
                u32x4 w; w.x = cvt_pk_bf16(v[0], v[1]); w.y = cvt_pk_bf16(v[2], v[3]); w.z = cvt_pk_bf16(v[4], v[5]); w.w = cvt_pk_bf16(v[6], v[7]);
                *(u32x4*)rowp = w;
            }
    }
};
struct EpiResid {
    static constexpr bool PERM = false, AFTER_DRAIN = false;
    float* X; const float* gate; float scale;
    __device__ __forceinline__ void operator()(const f32x4 (&acc)[2][2][4][2], const Unit& u, int wr, int wc, int fr, int fq) const {
        const int v = u.pm < 256 ? (u.pm >> 5) : 8;
        const int row0 = u.pm * BM + wr * 64 + fr, col0 = u.pn * BM + wc * 32 + 4 * fq;
        const float* gp = gate + (size_t)v * 9216 + col0;
        f32x4 gv[2][2];
#pragma unroll
        for (int bj = 0; bj < 2; ++bj)
#pragma unroll
            for (int n = 0; n < 2; ++n) gv[bj][n] = *(const f32x4*)(gp + bj * HALF + n * 16) * scale;
#pragma unroll
        for (int ai = 0; ai < 2; ++ai)
#pragma unroll
            for (int m = 0; m < 4; ++m) { float* rowp = X + (size_t)(row0 + ai * HALF + m * 16) * 1024 + col0;
#pragma unroll
                for (int bj = 0; bj < 2; ++bj)
#pragma unroll
                    for (int n = 0; n < 2; ++n) { f32x4* p = (f32x4*)(rowp + bj * HALF + n * 16); *p = *p + gv[bj][n] * acc[ai][bj][m][n]; } }
    }
};
struct EpiWin {
    static constexpr bool PERM = false, AFTER_DRAIN = false;
    bf16_t *Q, *K, *V, *U5; const float *qg, *kg, *rcos, *rsin; float qscale;
    __device__ __forceinline__ void operator()(const f32x4 (&acc)[2][2][4][2], const Unit& u, int wr, int wc, int fr, int fq) const {
        const int row0 = u.pm * BM + wr * 64 + fr;
        if (u.pn >= 3) {
            bf16_t* base = U5 + (size_t)(u.pn - 3) * ((size_t)67584 * 256) + wc * 32 + 8 * fq;
#pragma unroll
            for (int ai = 0; ai < 2; ++ai)
#pragma unroll
                for (int m = 0; m < 4; ++m) { bf16_t* rowp = base + (size_t)(row0 + ai * HALF + m * 16) * 256;
#pragma unroll
                    for (int bj = 0; bj < 2; ++bj) { const f32x4 v0 = acc[ai][bj][m][0], v1 = acc[ai][bj][m][1];
                        u32x4 w; w.x = cvt_pk_bf16(v0[0], v0[1]); w.y = cvt_pk_bf16(v0[2], v0[3]); w.z = cvt_pk_bf16(v1[0], v1[1]); w.w = cvt_pk_bf16(v1[2], v1[3]);
                        *(u32x4*)(rowp + bj * HALF) = w; } }
            return;
        }
        const int kind = u.pn < 2 ? 0 : (wc < 2 ? 1 : 2);
        const bool latent = u.pm < 256;
        const float* gsrc = kind == 0 ? qg : kg;
        f32x4 gv[2][2];
#pragma unroll
        for (int bj = 0; bj < 2; ++bj)
#pragma unroll
            for (int n = 0; n < 2; ++n) gv[bj][n] = *(const f32x4*)(gsrc + 32 * bj + 16 * n + 4 * fq);
#pragma unroll
        for (int ai = 0; ai < 2; ++ai)
#pragma unroll
            for (int m = 0; m < 4; ++m) {
                const int row = row0 + ai * HALF + m * 16;
                f32x4 y[2][2];
#pragma unroll
                for (int bj = 0; bj < 2; ++bj)
#pragma unroll
                    for (int n = 0; n < 2; ++n) y[bj][n] = acc[ai][bj][m][n];
                if (kind != 2) {
                    float ss = 0.f;
#pragma unroll
                    for (int bj = 0; bj < 2; ++bj)
#pragma unroll
                        for (int n = 0; n < 2; ++n) { const f32x4 t = y[bj][n]; ss += (t[0] * t[0] + t[1] * t[1]) + (t[2] * t[2] + t[3] * t[3]); }
                    ss += __shfl_xor(ss, 16); ss += __shfl_xor(ss, 32);
                    const float r = 1.0f / sqrtf(ss * (1.0f / 64.0f) + 1e-6f);
#pragma unroll
                    for (int bj = 0; bj < 2; ++bj)
#pragma unroll
                        for (int n = 0; n < 2; ++n) y[bj][n] = y[bj][n] * r * gv[bj][n];
                    if (latent) {
                        const int s = row & 8191;
#pragma unroll
                        for (int bj = 0; bj < 2; ++bj) { const int pos = bj == 0 ? (s >> 6) : (s & 63);
                            const f32x4 c4 = *(const f32x4*)(rcos + pos * 16 + 4 * fq), s4 = *(const f32x4*)(rsin + pos * 16 + 4 * fq);
                            const f32x4 x1 = y[bj][0], x2 = y[bj][1];
                            y[bj][0] = x1 * c4 - x2 * s4; y[bj][1] = x2 * c4 + x1 * s4; }
                    }
                }
                bf16_t* dst;
                if (kind == 0) { dst = Q + (size_t)row * 512 + (u.pn * 4 + wc) * 64;
#pragma unroll
                    for (int bj = 0; bj < 2; ++bj)
#pragma unroll
                        for (int n = 0; n < 2; ++n) y[bj][n] = y[bj][n] * qscale;
                } else {
                    size_t kr;
                    if (latent) kr = (size_t)(row >> 13) * 8448 + 256 + (row & 8191);
                    else { const int rc = row - 65536; kr = (size_t)(rc >> 8) * 8448 + (rc & 255); }
                    dst = (kind == 1 ? K : V) + kr * 128 + (wc & 1) * 64;
                }
#pragma unroll
                for (int bj = 0; bj < 2; ++bj)
#pragma unroll
                    for (int n = 0; n < 2; ++n) { u32x2 w; w.x = cvt_pk_bf16(y[bj][n][0], y[bj][n][1]); w.y = cvt_pk_bf16(y[bj][n][2], y[bj][n][3]);
                        *(u32x2*)(dst + 32 * bj + 16 * n + 4 * fq) = w; }
            }
    }
};
template <class Epi, class Sched, bool ALIGN_EPI = false, bool SP2 = false>
__device__ __forceinline__ void gemm_phase(PG8_LAS unsigned char* lds, const Gemm g, const Sched& S, const Epi& E) {
    const int tid = opaque_tid(), wid = __builtin_amdgcn_readfirstlane(tid >> 6), lane = tid & 63, wr = wid >> 2, wc = wid & 3, fr = lane & 15, fq = lane >> 4;
    const int K = g.K, nt = K / BK;
    unsigned voffA[2], voffB[2];
#pragma unroll
    for (int i = 0; i < 2; ++i) { int R, C; stage_rc(tid * 16 + i * 8192, R, C); const int Rb = Epi::PERM ? ((R & ~31) + perm32(R & 31)) : R;
        voffA[i] = (unsigned)(R * K + C) * 2u; voffB[i] = (unsigned)(Rb * K + C) * 2u; }
    const size_t kstep = (size_t)(BK * 2);
    const size_t hstep = (size_t)HALF * K * 2;
    const size_t tstep = 2 * hstep;
    const unsigned ldsw = (unsigned)wid * 1024u;
    const int aoff = lds_byte(wr * 64 + fr, fq * 8), boff = lds_byte(wc * 32 + fr, fq * 8);
#define PG8_SA(b, h) (((b) * 2 + (h)) * HTB)
#define PG8_SB(b, h) ((4 + (b) * 2 + (h)) * HTB)
#define PG8_STAGE(bufoff, gbase, voff) do { _Pragma("unroll") for (int _i = 0; _i < 2; ++_i) \
        __builtin_amdgcn_global_load_lds((const unsigned*)((const char*)(gbase) + (voff)[_i]), (PG8_LAS unsigned*)(lds + (bufoff) + ldsw + _i * 8192), 16, 0, 0); } while (0)
#define PG8_LDA(dst, b, h) do { _Pragma("unroll") for (int m = 0; m < 4; ++m) _Pragma("unroll") for (int k = 0; k < 2; ++k) dst[m][k] = *(const PG8_LAS bf16x8*)(lds + PG8_SA(b, h) + aoff + m * 2048 + k * 1024); } while (0)
#define PG8_LDB(dst, b, h) do { _Pragma("unroll") for (int n = 0; n < 2; ++n) _Pragma("unroll") for (int k = 0; k < 2; ++k) dst[n][k] = *(const PG8_LAS bf16x8*)(lds + PG8_SB(b, h) + boff + n * 2048 + k * 1024); } while (0)
#define PG8_MMA(ai, bj, At, Bt) do { __builtin_amdgcn_s_setprio(1); _Pragma("unroll") for (int m = 0; m < 4; ++m) _Pragma("unroll") for (int n = 0; n < 2; ++n) _Pragma("unroll") for (int k = 0; k < 2; ++k) \
        acc[ai][bj][m][n] = __builtin_amdgcn_mfma_f32_16x16x32_bf16(Bt[n][k], At[m][k], acc[ai][bj][m][n], 0, 0, 0); __builtin_amdgcn_s_setprio(0); } while (0)
#define PG8_WAIT_V(n) asm volatile("s_waitcnt vmcnt(" #n ")" ::: "memory")
#define PG8_WAIT_L(n) asm volatile("s_waitcnt lgkmcnt(" #n ")" ::: "memory")
#define PG8_BAR __builtin_amdgcn_s_barrier()
#define PG8_SCHED __builtin_amdgcn_sched_barrier(0)
    Unit cur, nxt; int ui = 0;
    if (!S.next(0, cur)) return;
    f32x4 acc[2][2][4][2];
#pragma unroll
    for (int a = 0; a < 2; ++a)
#pragma unroll
        for (int b = 0; b < 2; ++b)
#pragma unroll
            for (int m = 0; m < 4; ++m)
#pragma unroll
                for (int n = 0; n < 2; ++n) acc[a][b][m][n] = (f32x4){0.f, 0.f, 0.f, 0.f};
    bf16x8 At[4][2], B0[2][2], B1[2][2];
    const char* cA = (const char*)g.A + (size_t)cur.pm * tstep; const char* cB = (const char*)g.Bt + (size_t)cur.pn * tstep;
    S.a_ready(cur);
    if constexpr (SP2) {
        PG8_STAGE(PG8_SB(0, 0), cB, voffB); PG8_STAGE(PG8_SB(0, 1), cB + hstep, voffB); PG8_STAGE(PG8_SA(0, 0), cA, voffA); PG8_STAGE(PG8_SA(0, 1), cA + hstep, voffA);
        if (wr == 1) PG8_BAR;
        PG8_WAIT_V(2); PG8_BAR;
        PG8_STAGE(PG8_SB(1, 0), cB + kstep, voffB); PG8_STAGE(PG8_SA(1, 0), cA + kstep, voffA); PG8_STAGE(PG8_SB(1, 1), cB + hstep + kstep, voffB);
        PG8_WAIT_V(6); PG8_BAR;
    } else {
        PG8_STAGE(PG8_SB(0, 0), cB, voffB); PG8_STAGE(PG8_SA(0, 0), cA, voffA); PG8_STAGE(PG8_SB(0, 1), cB + hstep, voffB); PG8_STAGE(PG8_SA(0, 1), cA + hstep, voffA);
        if (wr == 1) PG8_BAR;
        PG8_WAIT_V(4); PG8_BAR;
        PG8_STAGE(PG8_SB(1, 0), cB + kstep, voffB); PG8_STAGE(PG8_SA(1, 0), cA + kstep, voffA); PG8_STAGE(PG8_SB(1, 1), cB + hstep + kstep, voffB);
        PG8_WAIT_V(6); PG8_BAR;
    }
    for (;;) {
        const bool has_next = S.next(ui + 1, nxt);
        const char* nA = has_next ? (const char*)g.A + (size_t)nxt.pm * tstep : cA; const char* nB = has_next ? (const char*)g.Bt + (size_t)nxt.pn * tstep : cB;
        for (int t = 0; t < nt; t += 2) {
            const bool last = (t == nt - 2);
            const char* a1 = cA + (size_t)(t + 1) * kstep;
            const char* a2 = last ? nA : cA + (size_t)(t + 2) * kstep; const char* b2 = last ? nB : cB + (size_t)(t + 2) * kstep;
            const char* a3 = a2 + kstep; const char* b3 = b2 + kstep;
            if (last && has_next) S.a_ready(nxt);
            if constexpr (SP2) {
            PG8_LDB(B0, 0, 0); PG8_LDB(B1, 0, 1); PG8_SCHED; PG8_LDA(At, 0, 0); PG8_STAGE(PG8_SA(1, 1), a1 + hstep, voffA);
            PG8_WAIT_V(8); PG8_WAIT_L(0); PG8_BAR; PG8_MMA(0, 0, At, B0); PG8_MMA(0, 1, At, B1); PG8_BAR; PG8_SCHED;
            PG8_LDA(At, 0, 1); PG8_STAGE(PG8_SB(0, 0), b2, voffB); PG8_STAGE(PG8_SB(0, 1), b2 + hstep, voffB); PG8_STAGE(PG8_SA(0, 0), a2, voffA);
            PG8_WAIT_V(8); PG8_WAIT_L(0); PG8_BAR; PG8_MMA(1, 0, At, B0); PG8_MMA(1, 1, At, B1); PG8_BAR; PG8_SCHED;
            PG8_LDB(B0, 1, 0); PG8_LDB(B1, 1, 1); PG8_SCHED; PG8_LDA(At, 1, 0); PG8_STAGE(PG8_SA(0, 1), a2 + hstep, voffA);
            PG8_WAIT_V(8); PG8_WAIT_L(0); PG8_BAR; PG8_MMA(0, 0, At, B0); PG8_MMA(0, 1, At, B1); PG8_BAR; PG8_SCHED;
            PG8_LDA(At, 1, 1); PG8_STAGE(PG8_SB(1, 0), b3, voffB); PG8_STAGE(PG8_SB(1, 1), b3 + hstep, voffB); PG8_STAGE(PG8_SA(1, 0), a3, voffA);
            PG8_WAIT_V(8); PG8_WAIT_L(0); PG8_BAR; PG8_MMA(1, 0, At, B0); PG8_MMA(1, 1, At, B1); PG8_BAR; PG8_SCHED;
            } else {
            PG8_LDB(B0, 0, 0); PG8_SCHED; PG8_LDA(At, 0, 0); PG8_STAGE(PG8_SA(1, 1), a1 + hstep, voffA);
            PG8_WAIT_L(8); PG8_BAR; PG8_WAIT_L(0); PG8_MMA(0, 0, At, B0); PG8_BAR; PG8_SCHED;
            PG8_LDB(B1, 0, 1); PG8_STAGE(PG8_SB(0, 0), b2, voffB);
            PG8_BAR; PG8_WAIT_L(0); PG8_MMA(0, 1, At, B1); PG8_BAR;
            PG8_LDA(At, 0, 1); PG8_STAGE(PG8_SA(0, 0), a2, voffA);
            PG8_BAR; PG8_WAIT_L(0); PG8_MMA(1, 0, At, B0); PG8_BAR; PG8_SCHED;
            PG8_STAGE(PG8_SB(0, 1), b2 + hstep, voffB);
            PG8_WAIT_V(6); PG8_BAR; PG8_MMA(1, 1, At, B1); PG8_BAR;
            PG8_LDB(B0, 1, 0); PG8_SCHED; PG8_LDA(At, 1, 0); PG8_STAGE(PG8_SA(0, 1), a2 + hstep, voffA);
            PG8_WAIT_L(8); PG8_BAR; PG8_WAIT_L(0); PG8_MMA(0, 0, At, B0); PG8_BAR; PG8_SCHED;
            PG8_LDB(B1, 1, 1); PG8_STAGE(PG8_SB(1, 0), b3, voffB);
            PG8_BAR; PG8_WAIT_L(0); PG8_MMA(0, 1, At, B1); PG8_BAR;
            PG8_LDA(At, 1, 1); PG8_STAGE(PG8_SA(1, 0), a3, voffA);
            PG8_BAR; PG8_WAIT_L(0); PG8_MMA(1, 0, At, B0); PG8_BAR; PG8_SCHED;
            PG8_STAGE(PG8_SB(1, 1), b3 + hstep, voffB);
            PG8_WAIT_V(6); PG8_BAR; PG8_MMA(1, 1, At, B1); PG8_BAR;
            }
        }
        if constexpr (ALIGN_EPI) { if (wr == 0) PG8_BAR; }
        if constexpr (!Epi::AFTER_DRAIN) { E(acc, cur, wr, wc, fr, fq); S.done(cur); }
        if (!has_next) break;
#pragma unroll
        for (int a = 0; a < 2; ++a)
#pragma unroll
            for (int b = 0; b < 2; ++b)
#pragma unroll
                for (int m = 0; m < 4; ++m)
#pragma unroll
                    for (int n = 0; n < 2; ++n) acc[a][b][m][n] = (f32x4){0.f, 0.f, 0.f, 0.f};
        cur = nxt; cA = nA; cB = nB; ++ui;
        if constexpr (ALIGN_EPI) { if (wr == 1) PG8_BAR; }
    }
    PG8_WAIT_V(0);
    if constexpr (!ALIGN_EPI) { if (wr == 0) PG8_BAR; }
    PG8_BAR;
    if constexpr (Epi::AFTER_DRAIN) { E.fused(acc, cur, wr, wc, fr, fq, lds, wid, lane); S.done(cur); }
#undef PG8_SA
#undef PG8_SB
#undef PG8_STAGE
#undef PG8_LDA
#undef PG8_LDB
#undef PG8_MMA
#undef PG8_WAIT_V
#undef PG8_WAIT_L
#undef PG8_BAR
#undef PG8_SCHED
}
}

namespace attn_body {
using bf16=__hip_bfloat16;
using bf16x8=__attribute__((ext_vector_type(8)))short;
using s16x4=__attribute__((ext_vector_type(4)))short;
using f32x16=__attribute__((ext_vector_type(16)))float;
using u32x4=__attribute__((ext_vector_type(4)))unsigned;
constexpr int D=64, QP=512, KP=128, OP=1024;
constexpr int NW=8,QBLK=32,QB=QBLK*NW,KVBLK=64;
__device__ __forceinline__ int crow(int r,int hi){return (r&3)+8*(r>>2)+4*hi;}
#define SBAR() __builtin_amdgcn_sched_barrier(0)
#define ATTN_STORE16(p,v) (*(u32x4*)(p)=(v))
constexpr int NSLOT=3, SLOTB=8192;
constexpr int LDS_K=0, LDS_V=NSLOT*SLOTB, LDS_WS=2*NSLOT*SLOTB, LDS_OST=LDS_WS+NW*64*4, LDS_BYTES=LDS_OST+NW*4096;
constexpr float C2=0.125f*1.4426950408889634f;
__device__ __forceinline__ void glds16(const void*gsrc,unsigned lds_dst){unsigned keep;
  asm volatile("s_mov_b32 %0, m0\n\ts_mov_b32 m0, %2\n\ts_nop 0\n\tglobal_load_lds_dwordx4 %1, off\n\ts_mov_b32 m0, %0":"=&s"(keep):"v"(gsrc),"s"(lds_dst):"memory");}
__device__ __forceinline__ float max3f(float a,float b,float c){float r;asm("v_max3_f32 %0, %1, %2, %3":"=v"(r):"v"(a),"v"(b),"v"(c));return r;}
__device__ __forceinline__ float max2f(float a,float b){float r;asm("v_max_f32_e32 %0, %1, %2":"=v"(r):"v"(a),"v"(b));return r;}
__device__ __forceinline__ float fadd_s(float a,float b){float r;asm("v_add_f32_e32 %0, %1, %2":"=v"(r):"v"(a),"v"(b));return r;}
__device__ __forceinline__ float fsub_s(float a,float b){float r;asm("v_sub_f32_e32 %0, %1, %2":"=v"(r):"v"(a),"v"(b));return r;}
typedef float f32x2_t __attribute__((ext_vector_type(2))); typedef __bf16 bf16x2_t __attribute__((ext_vector_type(2)));
__device__ __forceinline__ unsigned cvtpk_s(float lo,float hi){f32x2_t v={lo,hi};bf16x2_t b=__builtin_convertvector(v,bf16x2_t);return __builtin_bit_cast(unsigned,b);}
#define WAIT_BAR(N) asm volatile("s_waitcnt vmcnt(" #N ") lgkmcnt(0)\n\ts_barrier":::"memory")

__device__ __forceinline__ void qkt(f32x16&p0,f32x16&p1,const char*Kslot,const bf16x8*qr,const f32x16&negm,int r32,int hi){
  const char*kb=Kslot+hi*1024+r32*16;
  #pragma unroll
  for(int d0=0;d0<4;++d0){
    const bf16x8 b0=*reinterpret_cast<const bf16x8*>(kb+d0*2048);
    const bf16x8 b1=*reinterpret_cast<const bf16x8*>(kb+d0*2048+512);
    if(d0==0){p0=__builtin_amdgcn_mfma_f32_32x32x16_bf16(b0,qr[0],negm,0,0,0);p1=__builtin_amdgcn_mfma_f32_32x32x16_bf16(b1,qr[0],negm,0,0,0);}
    else{p0=__builtin_amdgcn_mfma_f32_32x32x16_bf16(b0,qr[d0],p0,0,0,0);p1=__builtin_amdgcn_mfma_f32_32x32x16_bf16(b1,qr[d0],p1,0,0,0);}}
}
typedef __attribute__((address_space(3))) const char* lds_cptr;
typedef short v4i16_t __attribute__((ext_vector_type(4)));
__device__ __forceinline__ void kload8(bf16x8*kf,lds_cptr kp){
  kf[0]=*(const __attribute__((address_space(3))) bf16x8*)(kp);      kf[1]=*(const __attribute__((address_space(3))) bf16x8*)(kp+512);
  kf[2]=*(const __attribute__((address_space(3))) bf16x8*)(kp+2048); kf[3]=*(const __attribute__((address_space(3))) bf16x8*)(kp+2560);
  kf[4]=*(const __attribute__((address_space(3))) bf16x8*)(kp+4096); kf[5]=*(const __attribute__((address_space(3))) bf16x8*)(kp+4608);
  kf[6]=*(const __attribute__((address_space(3))) bf16x8*)(kp+6144); kf[7]=*(const __attribute__((address_space(3))) bf16x8*)(kp+6656);
}
__device__ __forceinline__ void kload2(bf16x8*kf,lds_cptr kp,int j){ kf[2*j]=*(const __attribute__((address_space(3))) bf16x8*)(kp+j*2048); kf[2*j+1]=*(const __attribute__((address_space(3))) bf16x8*)(kp+j*2048+512); }
__device__ __forceinline__ s16x4 vtr(lds_cptr p){ return __builtin_bit_cast(s16x4,__builtin_amdgcn_ds_read_tr16_b64_v4i16((__attribute__((address_space(3))) v4i16_t*)p)); }
__device__ __forceinline__ float rowmax(const f32x16&p0,const f32x16&p1){
  float a=max3f(p0[0],p0[1],p1[0]),b=max3f(p0[2],p0[3],p1[1]);a=max3f(a,p1[2],p1[3]);
  #pragma unroll
  for(int r=4;r<16;r+=4){a=max3f(a,p0[r],p0[r+1]);b=max3f(b,p0[r+2],p0[r+3]);a=max3f(a,p1[r],p1[r+1]);b=max3f(b,p1[r+2],p1[r+3]);}
  const float m=max2f(a,b);
  auto rr=__builtin_amdgcn_permlane32_swap(__float_as_uint(m),__float_as_uint(m),false,false);
  return max2f(__uint_as_float(rr[0]),__uint_as_float(rr[1]));
}
__device__ __forceinline__ void pv(f32x16*o,int vb,bf16x8 pa0,bf16x8 pa1,bf16x8 pa2,bf16x8 pa3){
  #pragma unroll
  for(int d0=0;d0<2;++d0){s16x4 lo[4],hi[4];
    #pragma unroll
    for(int ks=0;ks<4;++ks){
      asm volatile("ds_read_b64_tr_b16 %0,%1 offset:%c2":"=&v"(lo[ks]):"v"(vb),"i"(d0*4096+ks*1024):"memory");
      asm volatile("ds_read_b64_tr_b16 %0,%1 offset:%c2":"=&v"(hi[ks]):"v"(vb),"i"(d0*4096+ks*1024+512):"memory");}
    asm volatile("s_waitcnt lgkmcnt(0)":::"memory");SBAR();
    #define PK(k) (bf16x8){lo[k][0],lo[k][1],lo[k][2],lo[k][3],hi[k][0],hi[k][1],hi[k][2],hi[k][3]}
    o[d0]=__builtin_amdgcn_mfma_f32_32x32x16_bf16(pa0,PK(0),o[d0],0,0,0);
    o[d0]=__builtin_amdgcn_mfma_f32_32x32x16_bf16(pa1,PK(1),o[d0],0,0,0);
    o[d0]=__builtin_amdgcn_mfma_f32_32x32x16_bf16(pa2,PK(2),o[d0],0,0,0);
    o[d0]=__builtin_amdgcn_mfma_f32_32x32x16_bf16(pa3,PK(3),o[d0],0,0,0);
    #undef PK
  }
}
template<int THRL> __device__ __forceinline__ void attn_unit(const bf16*Qw0,const bf16*__restrict__ Kh,const bf16*__restrict__ Vh,bf16*Ow0,const int NT,char*shm){
  const int tid=opaque_tid(),lane=tid&63,r32=lane&31,hi=lane>>5; const int wid=__builtin_amdgcn_readfirstlane(tid>>6);
  const bf16*Qw=Qw0+(long)wid*QBLK*QP;
  const unsigned lds0=(unsigned)(uintptr_t)shm;
  float*wsf=(float*)(shm+LDS_WS)+wid*64;
  const bf16*ksrc=Kh+(long)lane*KP+wid*8;
  const bf16*vsrc=Vh+(long)(16*(wid&3)+(lane>>2))*KP+(wid>>2)*32+(lane&3)*8;
  const unsigned kdst=lds0+LDS_K+wid*1024, vdst=lds0+LDS_V+wid*1024;
  #define DMA_K(t,slot) glds16(ksrc+(long)(t)*KVBLK*KP,(unsigned)__builtin_amdgcn_readfirstlane(kdst+(slot)))
  #define DMA_V(t,slot) glds16(vsrc+(long)(t)*KVBLK*KP,(unsigned)__builtin_amdgcn_readfirstlane(vdst+(slot)))
  const int vb0=(int)(lds0+LDS_V)+((lane>>4)&1)*32+(lane&3)*8+(4*hi+((lane&15)>>2))*64;
  const char*Kbase=shm+LDS_K; bf16x8 kf[8];
  const lds_cptr shm3=(lds_cptr)shm; const lds_cptr kp0=shm3+LDS_K+hi*1024+r32*16; const lds_cptr vp0=shm3+LDS_V+((lane>>4)&1)*32+(lane&3)*8+(4*hi+((lane&15)>>2))*64;
  DMA_K(0,0);DMA_V(0,0);DMA_K(1,SLOTB);
  bf16x8 qr[4];
  #pragma unroll
  for(int d0=0;d0<4;++d0)qr[d0]=*reinterpret_cast<const bf16x8*>(&Qw[(long)r32*QP+d0*16+hi*8]);
  float mhat=0.f,l_reg=0.f;f32x16 o[2];o[0]=f32x16{};o[1]=f32x16{};f32x16 negm=f32x16{};asm volatile("":"+v"(negm));
  #define CMASK(P0,P1,t) do{}while(0)
  bool resc=false;
  #define START(P0,P1) do{ const float rm=rowmax(P0,P1); resc=false; \
    { const float dl=rm; mhat=fadd_s(mhat,dl); \
      _Pragma("unroll") for(int r=0;r<16;++r){P0[r]=fsub_s(P0[r],dl);P1[r]=fsub_s(P1[r],dl);} \
      _Pragma("unroll") for(int r=0;r<16;++r)negm[r]=-mhat; asm volatile("":"+v"(negm)); } \
    _Pragma("unroll") for(int r=0;r<16;++r)P0[r]=__builtin_amdgcn_exp2f(P0[r]); }while(0)
  #define RESC() do{ if(resc){ asm volatile("s_waitcnt lgkmcnt(0)":::"memory"); \
      _Pragma("unroll") for(int d_=0;d_<2;++d_) _Pragma("unroll") for(int r=0;r<16;++r)o[d_][r]*=wsf[crow(r,hi)]; } }while(0)
  f32x16 pA0,pA1,pB0,pB1;
  int sl_prev=0,sl_cur=0,sl_next=SLOTB;
  #define ROT() do{sl_prev=sl_cur;sl_cur=sl_next;sl_next=(sl_next==(NSLOT-1)*SLOTB)?0:sl_next+SLOTB;}while(0)
  DMA_K(2,2*SLOTB);
  WAIT_BAR(3);
  qkt(pA0,pA1,Kbase,qr,negm,r32,hi);asm volatile("s_nop 15\n\ts_nop 7":"+v"(pA0),"+v"(pA1));CMASK(pA0,pA1,0);
  START(pA0,pA1);
  _Pragma("unroll") for(int r=0;r<16;++r)pA1[r]=__builtin_amdgcn_exp2f(pA1[r]);
  WAIT_BAR(0);
  DMA_K(3,0);DMA_V(1,SLOTB);
  ROT();
  kload8(kf,kp0+sl_cur);
  WAIT_BAR(2);
  s16x4 vlo[8],vhi[8]; u32x4 pw0,pw1,pw2,pw3;
  #define PKW(P,B) cvtpk_s(P[B],P[B+1])
  #define PAF(k) __builtin_bit_cast(bf16x8,pw##k)
  #define VFR(i) (bf16x8){vlo[i][0],vlo[i][1],vlo[i][2],vlo[i][3],vhi[i][0],vhi[i][1],vhi[i][2],vhi[i][3]}
  #define PIN(x) asm volatile("":"+v"(x))
  #define MX3(a,b,c) __builtin_fmaxf(__builtin_fmaxf((a),(b)),(c))
  #define GAPA(MF,A0,A1,A2,A3,W0,W1,PW) do{ MF; sacc+=A0; sacc+=A1; sacc+=A2; sacc+=A3; PIN(sacc); W0; W1; PIN(PW); SBAR(); }while(0)
  #define EX(v) __builtin_amdgcn_exp2f(v)
  #define GAPB(MF,X,B) do{ MF; X[B]=EX(X[B]); X[B+1]=EX(X[B+1]); X[B+2]=EX(X[B+2]); X[B+3]=EX(X[B+3]); PIN(X); SBAR(); }while(0)
  #define VRD(i) do{ vlo[i]=vtr(vp_+(((i)>>2)*4096+((i)&3)*1024)); vhi[i]=vtr(vp_+(((i)>>2)*4096+((i)&3)*1024+512)); }while(0)
  #define KRD(G,j) do{ if(G){ kload2(kf,kp0+sl_next,j); SBAR(); } }while(0)
  #define STEP(C0,C1,P0,P1,t,GK,GV,GL) do{ SBAR(); \
    const lds_cptr vp_=vp0+sl_prev; \
    VRD(0); SBAR(); float sacc=(P0[0]+P0[1]); \
    GAPA(C0=__builtin_amdgcn_mfma_f32_32x32x16_bf16(kf[0],qr[0],negm,0,0,0), P0[2],P0[3],P0[4],P0[5],     pw0[0]=PKW(P0,0), pw0[1]=PKW(P0,2), pw0); \
    VRD(4); SBAR(); GAPA(C1=__builtin_amdgcn_mfma_f32_32x32x16_bf16(kf[1],qr[0],negm,0,0,0), P0[6],P0[7],P0[8],P0[9],     pw0[2]=PKW(P0,4), pw0[3]=PKW(P0,6), pw0); \
    VRD(1); SBAR(); GAPA(C0=__builtin_amdgcn_mfma_f32_32x32x16_bf16(kf[2],qr[1],C0,0,0,0),   P0[10],P0[11],P0[12],P0[13], pw1[0]=PKW(P0,8), pw1[1]=PKW(P0,10), pw1); \
    VRD(5); SBAR(); GAPA(C1=__builtin_amdgcn_mfma_f32_32x32x16_bf16(kf[3],qr[1],C1,0,0,0),   P0[14],P0[15],P1[0],P1[1],   pw1[2]=PKW(P0,12),pw1[3]=PKW(P0,14), pw1); \
    VRD(2); SBAR(); GAPA(C0=__builtin_amdgcn_mfma_f32_32x32x16_bf16(kf[4],qr[2],C0,0,0,0),   P1[2],P1[3],P1[4],P1[5],     pw2[0]=PKW(P1,0), pw2[1]=PKW(P1,2), pw2); \
    VRD(6); SBAR(); GAPA(C1=__builtin_amdgcn_mfma_f32_32x32x16_bf16(kf[5],qr[2],C1,0,0,0),   P1[6],P1[7],P1[8],P1[9],     pw2[2]=PKW(P1,4), pw2[3]=PKW(P1,6), pw2); \
    VRD(3); SBAR(); GAPA(C0=__builtin_amdgcn_mfma_f32_32x32x16_bf16(kf[6],qr[3],C0,0,0,0),   P1[10],P1[11],P1[12],P1[13], pw3[0]=PKW(P1,8), pw3[1]=PKW(P1,10), pw3); \
    VRD(7); SBAR(); GAPA(C1=__builtin_amdgcn_mfma_f32_32x32x16_bf16(kf[7],qr[3],C1,0,0,0),   P1[14],P1[15],0.f,0.f,       pw3[2]=PKW(P1,12),pw3[3]=PKW(P1,14), pw3); \
    l_reg+=sacc; \
    if(GK){DMA_K((t)+3,sl_cur);} if(GV){DMA_V((t)+1,sl_next);} \
    CMASK(C0,C1,t); \
    { float a=MX3(C0[0],C0[1],C1[0]),b=MX3(C0[2],C0[3],C1[1]); a=MX3(a,C1[2],C1[3]); \
      _Pragma("unroll") for(int r=4;r<16;r+=4){a=MX3(a,C0[r],C0[r+1]);b=MX3(b,C0[r+2],C0[r+3]);a=MX3(a,C1[r],C1[r+1]);b=MX3(b,C1[r+2],C1[r+3]);} \
      float rm=__builtin_fmaxf(a,b); { auto rr=__builtin_amdgcn_permlane32_swap(__float_as_uint(rm),__float_as_uint(rm),false,false); rm=__builtin_fmaxf(__uint_as_float(rr[0]),__uint_as_float(rr[1])); } \
      resc=false; \
      if(__builtin_expect(__any(rm>(float)THRL),0)){ const float dl=__builtin_fmaxf(rm,0.f); mhat+=dl; \
        _Pragma("unroll") for(int r=0;r<16;++r){C0[r]-=dl;C1[r]-=dl;} \
        _Pragma("unroll") for(int r=0;r<16;++r)negm[r]=-mhat; asm volatile("":"+v"(negm)); \
        const float f=__builtin_amdgcn_exp2f(-dl); l_reg*=f; if(hi==0)wsf[r32]=f; resc=true; } } \
    SBAR(); \
    GAPB(o[0]=__builtin_amdgcn_mfma_f32_32x32x16_bf16(PAF(0),VFR(0),o[0],0,0,0), C0,0); \
    GAPB(o[1]=__builtin_amdgcn_mfma_f32_32x32x16_bf16(PAF(0),VFR(4),o[1],0,0,0), C0,4); \
    KRD(GL,0); GAPB(o[0]=__builtin_amdgcn_mfma_f32_32x32x16_bf16(PAF(1),VFR(1),o[0],0,0,0), C0,8); \
    KRD(GL,1); GAPB(o[1]=__builtin_amdgcn_mfma_f32_32x32x16_bf16(PAF(1),VFR(5),o[1],0,0,0), C0,12); \
    KRD(GL,2); GAPB(o[0]=__builtin_amdgcn_mfma_f32_32x32x16_bf16(PAF(2),VFR(2),o[0],0,0,0), C1,0); \
    KRD(GL,3); GAPB(o[1]=__builtin_amdgcn_mfma_f32_32x32x16_bf16(PAF(2),VFR(6),o[1],0,0,0), C1,4); \
    GAPB(o[0]=__builtin_amdgcn_mfma_f32_32x32x16_bf16(PAF(3),VFR(3),o[0],0,0,0), C1,8); \
    GAPB(o[1]=__builtin_amdgcn_mfma_f32_32x32x16_bf16(PAF(3),VFR(7),o[1],0,0,0), C1,12); \
    }while(0)
  int t=1;
  #undef CMASK
  #define CMASK(P0,P1,t) do{}while(0)
  for(;t+5<NT;t+=2){
    STEP(pB0,pB1,pA0,pA1,t,true,true,true);     WAIT_BAR(2); RESC(); ROT();
    STEP(pA0,pA1,pB0,pB1,t+1,true,true,true);   WAIT_BAR(2); RESC(); ROT();
  }
  #undef CMASK
  #define CMASK(P0,P1,t) do{}while(0)
  #define ENDW(tt) do{ if((tt)+3<NT){WAIT_BAR(2);} else if((tt)+2<NT){WAIT_BAR(1);} else {WAIT_BAR(0);} }while(0)
  for(;t+1<NT;t+=2){
    STEP(pB0,pB1,pA0,pA1,t,(t+3<NT),(t+1<NT),(t+1<NT));       ENDW(t);   RESC(); ROT();
    STEP(pA0,pA1,pB0,pB1,t+1,(t+4<NT),(t+2<NT),(t+2<NT));     ENDW(t+1); RESC(); ROT();
  }
  STEP(pB0,pB1,pA0,pA1,NT-1,false,false,false); RESC();
  { float sacc=pB0[0]+pB0[1]; _Pragma("unroll") for(int r=2;r<16;++r)sacc+=pB0[r]; _Pragma("unroll") for(int r=0;r<16;++r)sacc+=pB1[r]; l_reg+=sacc;
    pw0=(u32x4){PKW(pB0,0),PKW(pB0,2),PKW(pB0,4),PKW(pB0,6)};pw1=(u32x4){PKW(pB0,8),PKW(pB0,10),PKW(pB0,12),PKW(pB0,14)};pw2=(u32x4){PKW(pB1,0),PKW(pB1,2),PKW(pB1,4),PKW(pB1,6)};pw3=(u32x4){PKW(pB1,8),PKW(pB1,10),PKW(pB1,12),PKW(pB1,14)};
    SBAR(); pv(o,vb0+sl_cur,PAF(0),PAF(1),PAF(2),PAF(3)); }
  #undef PKW
  #undef PAF
  #undef VFR
  #undef PIN
  #undef MX3
  #undef GAPA
  #undef GAPB
  #undef EX
  #undef VRD
  #undef KRD
  #undef STEP
  #undef ENDW
  {auto rr=__builtin_amdgcn_permlane32_swap(__float_as_uint(l_reg),__float_as_uint(l_reg),false,false);l_reg=__uint_as_float(rr[0])+__uint_as_float(rr[1]);}
  if(hi==0)wsf[32+r32]=l_reg;asm volatile("s_waitcnt lgkmcnt(0)":::"memory");
  float rli[16];
  #pragma unroll
  for(int r=0;r<16;++r)rli[r]=__builtin_amdgcn_rcpf(wsf[32+crow(r,hi)]);
  bf16*Ow=Ow0+(long)wid*QBLK*OP;
  { bf16*stg=(bf16*)(shm+LDS_OST)+wid*2048;
    #pragma unroll
    for(int r=0;r<16;++r){const int orow=crow(r,hi);
      #pragma unroll
      for(int d0=0;d0<2;++d0)stg[orow*64+d0*32+r32]=__float2bfloat16(o[d0][r]*rli[r]);}
    asm volatile("s_waitcnt lgkmcnt(0)":::"memory");
    #pragma unroll
    for(int i=0;i<4;++i){const int row=i*8+(lane>>3),ch=lane&7; const u32x4 v=*(const u32x4*)(stg+row*64+ch*8); ATTN_STORE16(Ow+(long)row*OP+ch*8,v);} }
  asm volatile("s_waitcnt lgkmcnt(0)\n\ts_barrier":::"memory");
  #undef DMA_K
  #undef DMA_V
  #undef CMASK
  #undef START
  #undef RESC
  #undef ROT
}

#undef SBAR
#undef WAIT_BAR
}

typedef short bf16x8_t __attribute__((ext_vector_type(8)));
#define LDS_WAIT() asm volatile("s_waitcnt lgkmcnt(0)" ::: "memory")

__device__ __forceinline__ int inv32(int c) { return 16 * ((c >> 2) & 1) + 4 * (c >> 3) + (c & 3); }
__device__ __forceinline__ int dest_row(int type, int n) {
    if (type == 0) return n;
    if (type == 1) { const int half = n >= DFF ? 1 : 0, j = n - half * DFF, pn = j >> 7, c = j & 127; return pn * 256 + half * 128 + (c & ~31) + inv32(c & 31); }
    if (n < 768) { const int hd = n >> 6, d = n & 63, a = d >> 5, t = (d >> 4) & 1, p = d & 15; return (hd >> 2) * 256 + a * 128 + (hd & 3) * 32 + t * 16 + p; }
    const int pn = n >> 8, c = n & 255, half = c >> 7, c7 = c & 127; return pn * 256 + half * 128 + (c7 & ~31) + inv32(c7 & 31);
}
__device__ __forceinline__ void transpose_item(const float* W, int K, int N, bf16_t* WT, int type, LAS float* scr, int item, int lane) {
    const int nblk = N / 32, kb = item / nblk, nb = item % nblk, k0 = 64 * kb, n0 = 32 * nb;
#pragma unroll 8
    for (int i = 0; i < 32; ++i) { const int kk = 2 * i + (lane >> 5); scr[kk * 33 + (lane & 31)] = W[(size_t)(k0 + kk) * N + n0 + (lane & 31)]; }
    LDS_WAIT(); asm volatile("" ::: "memory");
    const int c = lane & 7;
#pragma unroll
    for (int j = 0; j < 4; ++j) { const int n = (lane >> 3) + 8 * j; const LAS float* s = scr + (8 * c) * 33 + n;
        u32x4 o; o.x = cvt_pk(s[0 * 33], s[1 * 33]); o.y = cvt_pk(s[2 * 33], s[3 * 33]); o.z = cvt_pk(s[4 * 33], s[5 * 33]); o.w = cvt_pk(s[6 * 33], s[7 * 33]);
        *(u32x4*)(WT + (size_t)dest_row(type, n0 + n) * K + k0 + 8 * c) = o; }
    LDS_WAIT(); asm volatile("" ::: "memory");
}

__device__ __forceinline__ void prologue_phase(const Params& P, LAS unsigned char* lds, int G) {
    const int tid = opaque_tid(), lane = tid & 63, wid = __builtin_amdgcn_readfirstlane(tid >> 6), bid = blockIdx.x;
    unsigned char* ws = P.ws;
    {
        LAS float* sc = (LAS float*)lds;
        LAS float* red = (LAS float*)(lds + 36864);
        for (int i = tid; i < 9 * 1024; i += NTHREADS) { const int v = i >> 10, k = i & 1023; const float cv = v < 8 ? P.in[1][v * 1024 + k] : P.in[3][k]; sc[i] = cv / (1.0f + expf(-cv)); }
        __syncthreads();
        float* mod = (float*)(ws + OFF_MOD);
        for (int item = bid; item < 2 * 144; item += G) {
            const int l = item / 144, cgp = item % 144, col = cgp * 64 + lane, kc = wid;
            const float* W = P.in[4] + (size_t)l * 1024 * MODW + col;
            float acc[9];
#pragma unroll
            for (int v = 0; v < 9; ++v) acc[v] = 0.f;
#pragma unroll 8
            for (int k = kc * 128; k < kc * 128 + 128; ++k) { const float w = W[(size_t)k * MODW];
#pragma unroll
                for (int v = 0; v < 9; ++v) acc[v] += sc[v * 1024 + k] * w; }
#pragma unroll
            for (int v = 0; v < 9; ++v) red[(kc * 9 + v) * 64 + lane] = acc[v];
            __syncthreads();
            for (int i = tid; i < 576; i += NTHREADS) { const int v = i >> 6, cc = i & 63; float s = 0.f;
#pragma unroll
                for (int q = 0; q < 8; ++q) s += red[(q * 9 + v) * 64 + cc];
                mod[(size_t)(l * 9 + v) * MODW + cgp * 64 + cc] = s + P.in[5][l * MODW + cgp * 64 + cc]; }
            __syncthreads();
        }
    }
    __syncthreads();
    {
        LAS float* scr = (LAS float*)(lds + wid * 16384);
        const int gw = bid * 8 + wid, NGW = G * 8;
        constexpr int I_FI = 16 * (NFF2 / 32), I_FO = (DFF / 64) * 32, I_WI = 16 * (INW / 32), I_WO = 16 * 32;
        constexpr int PER_L = 2 * I_FI + 2 * I_FO + I_WI + I_WO;
        for (int it = gw; it < DEPTH * PER_L; it += NGW) {
            const int l = it / PER_L; int r = it % PER_L;
            unsigned char* wb = ws + OFF_WB + (size_t)l * WB_LAYER;
            if (r < 2 * I_FI) { const int f = r / I_FI; transpose_item(P.in[7] + (size_t)(l * 2 + f) * DM * NFF2, DM, NFF2, (bf16_t*)(wb + WB_FFIN + f * WB_FFIN_SZ), 1, scr, r % I_FI, lane); continue; } r -= 2 * I_FI;
            if (r < 2 * I_FO) { const int f = r / I_FO; transpose_item(P.in[8] + (size_t)(l * 2 + f) * DFF * DM, DFF, DM, (bf16_t*)(wb + WB_FFOUT + f * WB_FFOUT_SZ), 0, scr, r % I_FO, lane); continue; } r -= 2 * I_FO;
            if (r < I_WI) { transpose_item(P.in[9] + (size_t)l * DM * INW, DM, INW, (bf16_t*)(wb + WB_WIN), 2, scr, r, lane); continue; } r -= I_WI;
            transpose_item(P.in[22] + (size_t)l * DM * DM, DM, DM, (bf16_t*)(wb + WB_WOUT), 0, scr, r, lane);
        }
        bf16_t* LW = (bf16_t*)(ws + OFF_LW);
        const int gt = bid * NTHREADS + tid, NGT = G * NTHREADS;
        for (int i = gt; i < DEPTH * 4 * 256 * 64; i += NGT) {
            const int d = i & 63, c = (i >> 6) & 255, g = (i >> 14) & 3, l = i >> 16, n = c >> 6, e = c & 63;
            const float* src = (g & 1) ? P.in[16] : P.in[14];
            const float v = src[((((size_t)l * 2 + (g >> 1)) * 4 + n) * 64 + d) * 64 + e];
            LW[i] = (bf16_t)(cvt_pk(v, 0.f) & 0xffffu);
        }
        float* rc = (float*)(ws + OFF_ROPE); float* rs = rc + 2048;
        for (int i = gt; i < 2048; i += NGT) { const int pos = i >> 4, p = i & 15; const float inv = powf(10000.0f, -(float)p / 16.0f), ang = (float)pos * inv; rc[i] = cosf(ang); rs[i] = sinf(ang); }
    }
}

__device__ __forceinline__ void norm_phase(const Params& P, int l, int idx, int Mrows, bool first, int G) {
    const int tid = opaque_tid(), lane = tid & 63, wid = __builtin_amdgcn_readfirstlane(tid >> 6);
    const int gw = blockIdx.x * 8 + wid, NGW = G * 8, per = (Mrows + NGW - 1) / NGW;
    const int r0 = gw * per, r1 = (r0 + per < Mrows) ? r0 + per : Mrows;
    const float* mod = (const float*)(P.ws + OFF_MOD) + (size_t)l * 9 * MODW;
    const float* gsrc = P.in[6] + (size_t)(l * 3 + idx) * DM;
    float* xres = (float*)(P.ws + OFF_XRES); bf16_t* hb = (bf16_t*)(P.ws + OFF_HBUF);
    int curv = -1; f32x4 Aa[4], Bb[4];
    for (int row = r0; row < r1; ++row) {
        const int v = row < MLAT ? (row >> 13) : 8;
        if (v != curv) { curv = v;
#pragma unroll
            for (int j = 0; j < 4; ++j) { const int c = 4 * lane + 256 * j; const f32x4 g4 = *(const f32x4*)(gsrc + c), sh = *(const f32x4*)(mod + (size_t)v * MODW + (3 * idx) * DM + c), sc = *(const f32x4*)(mod + (size_t)v * MODW + (3 * idx + 1) * DM + c);
                Aa[j] = g4 * (sc + 1.0f); Bb[j] = sh; } }
        const float* xr = first ? (row < MLAT ? P.in[0] + (size_t)row * DM : P.in[2] + (size_t)(row - MLAT) * DM) : xres + (size_t)row * DM;
        f32x4 x[4]; float ss = 0.f;
#pragma unroll
        for (int j = 0; j < 4; ++j) { x[j] = *(const f32x4*)(xr + 4 * lane + 256 * j); ss += (x[j][0] * x[j][0] + x[j][1] * x[j][1]) + (x[j][2] * x[j][2] + x[j][3] * x[j][3]); }
        const float rstd = 1.0f / sqrtf(wave_sum(ss) * (1.0f / DM) + EPS);
#pragma unroll
        for (int j = 0; j < 4; ++j) { const f32x4 y = x[j] * rstd * Aa[j] + Bb[j]; u32x2 w; w.x = cvt_pk(y[0], y[1]); w.y = cvt_pk(y[2], y[3]);
            *(u32x2*)(hb + (size_t)row * DM + 4 * lane + 256 * j) = w;
            if (first) *(f32x4*)(xres + (size_t)row * DM + 4 * lane + 256 * j) = x[j]; }
    }
}
__device__ __forceinline__ void final_norm_phase(const Params& P, int G) {
    const int tid = opaque_tid(), lane = tid & 63, wid = __builtin_amdgcn_readfirstlane(tid >> 6);
    const int gw = blockIdx.x * 8 + wid, NGW = G * 8;
    const float* xres = (const float*)(P.ws + OFF_XRES);
    f32x4 g4[4];
#pragma unroll
    for (int j = 0; j < 4; ++j) g4[j] = *(const f32x4*)(P.in[23] + 4 * lane + 256 * j);
    for (int row = gw; row < MLAT; row += NGW) {
        f32x4 x[4]; float ss = 0.f;
#pragma unroll
        for (int j = 0; j < 4; ++j) { x[j] = *(const f32x4*)(xres + (size_t)row * DM + 4 * lane + 256 * j); ss += (x[j][0] * x[j][0] + x[j][1] * x[j][1]) + (x[j][2] * x[j][2] + x[j][3] * x[j][3]); }
        const float rstd = 1.0f / sqrtf(wave_sum(ss) * (1.0f / DM) + EPS);
#pragma unroll
        for (int j = 0; j < 4; ++j) *(f32x4*)(P.out + (size_t)row * DM + 4 * lane + 256 * j) = x[j] * rstd * g4[j];
    }
}

constexpr int L1_AST = 528;
constexpr int L1_UST = 260;
constexpr int L1_UOFF = 66560;
__device__ __forceinline__ void lru1_phase(const Params& P, int l, LAS unsigned char* lds, int G) {
    const int tid = opaque_tid(), lane = tid & 63, wid = __builtin_amdgcn_readfirstlane(tid >> 6), fr = lane & 15, fq = lane >> 4;
    LAS unsigned char* ldsA = lds; LAS float* ldsU = (LAS float*)(lds + L1_UOFF);
    const bf16_t* Ubuf = (const bf16_t*)(P.ws + OFF_U5);
    float* Sg = (float*)(P.ws + OFF_S); unsigned* PPg = (unsigned*)(P.ws + OFF_PP); float* csum = (float*)(P.ws + OFF_CSUM);
    const bf16_t* LW = (const bf16_t*)(P.ws + OFF_LW) + (size_t)l * 4 * 256 * 64;
    const int ch4 = (tid & 63) * 4, pg = tid >> 6;
    f32x4 cw[4], cbias;
#pragma unroll
    for (int i = 0; i < 4; ++i) cw[i] = *(const f32x4*)(P.in[12] + (size_t)(l * 4 + i) * 256 + ch4);
    cbias = *(const f32x4*)(P.in[13] + (size_t)l * 256 + ch4);
    const int nblk = wid >> 1;
    for (int tile = blockIdx.x; tile < NBATCH * NCHUNK; tile += G) {
        const int b = tile / NCHUNK, cidx = tile % NCHUNK, P0 = cidx * 64; const bool latent = cidx >= 4;
        const int seg_lo = latent ? 256 : 0, seg_hi = latent ? KEYS : 256;
        const int rbase = latent ? b * SEQ - 256 : MLAT + b * CTXL;
        {
            const int pp0 = P0 + pg * 8;
            f32x4 win[11];
#pragma unroll
            for (int i = 0; i < 11; ++i) { const int Pq = pp0 - 2 + i; f32x4 w4 = {0.f, 0.f, 0.f, 0.f};
                if (Pq >= seg_lo && Pq < seg_hi) { const u32x2 raw = *(const u32x2*)(Ubuf + (size_t)(rbase + Pq) * 256 + ch4); w4 = (f32x4){bf_lo(raw.x), bf_hi(raw.x), bf_lo(raw.y), bf_hi(raw.y)}; }
                win[i] = w4; }
#pragma unroll
            for (int q = 0; q < 8; ++q) { f32x4 y = cbias;
#pragma unroll
                for (int i = 0; i < 4; ++i) y = y + cw[i] * win[q + i];
                const int pos = pg * 8 + q;
                u32x2 w; w.x = cvt_pk(y[0], y[1]); w.y = cvt_pk(y[2], y[3]);
                *(LAS u32x2*)(ldsA + pos * L1_AST + ch4 * 2) = w;
                *(LAS f32x4*)(ldsU + pos * L1_UST + ch4) = y; }
        }
        __syncthreads();
#pragma unroll 1
        for (int cc = 0; cc < 2; ++cc) {
            const int c = 32 * wid + 16 * cc + fr;
            const float baf = P.in[15][(l * 2 + 0) * 256 + c], bab = P.in[15][(l * 2 + 1) * 256 + c], bxf = P.in[17][(l * 2 + 0) * 256 + c], bxb = P.in[17][(l * 2 + 1) * 256 + c];
            const float nspf = -8.0f * log1pf(expf(-P.in[18][(l * 2 + 0) * 256 + c])), nspb = -8.0f * log1pf(expf(-P.in[18][(l * 2 + 1) * 256 + c]));
            f32x4 acc[4][4];
            {
                bf16x8_t bw[4][2];
#pragma unroll
                for (int g = 0; g < 4; ++g)
#pragma unroll
                    for (int kk = 0; kk < 2; ++kk) bw[g][kk] = *(const bf16x8_t*)(LW + ((size_t)(g * 256 + c) * 64 + kk * 32 + fq * 8));
#pragma unroll
                for (int m = 0; m < 4; ++m) {
#pragma unroll
                    for (int g = 0; g < 4; ++g) acc[m][g] = (f32x4){0.f, 0.f, 0.f, 0.f};
#pragma unroll
                    for (int kk = 0; kk < 2; ++kk) { const bf16x8_t a = *(const LAS bf16x8_t*)(ldsA + (16 * m + fr) * L1_AST + (64 * nblk + 32 * kk + 8 * fq) * 2);
#pragma unroll
                        for (int g = 0; g < 4; ++g) acc[m][g] = __builtin_amdgcn_mfma_f32_16x16x32_bf16(a, bw[g][kk], acc[m][g], 0, 0, 0); }
                }
            }
#pragma unroll
            for (int m = 0; m < 4; ++m)
#pragma unroll
                for (int j = 0; j < 4; ++j) {
                    const float u = ldsU[(16 * m + 4 * fq + j) * L1_UST + c];
                    {   const float r = sigmoidf_(acc[m][0][j] + baf), ig = sigmoidf_(acc[m][1][j] + bxf);
                        const float la = nspf * r, a = __expf(la), y = 2.0f * la;
                        const float em = (y > -0.1f) ? y * (1.0f + y * (0.5f + y * (0.16666667f + y * 0.041666668f))) : (__expf(y) - 1.0f);
                        acc[m][0][j] = a; acc[m][1][j] = sqrtf(-em) * ig * u; }
                    {   const float r = sigmoidf_(acc[m][2][j] + bab), ig = sigmoidf_(acc[m][3][j] + bxb);
                        const float la = nspb * r, a = __expf(la), y = 2.0f * la;
                        const float em = (y > -0.1f) ? y * (1.0f + y * (0.5f + y * (0.16666667f + y * 0.041666668f))) : (__expf(y) - 1.0f);
                        acc[m][2][j] = a; acc[m][3][j] = sqrtf(-em) * ig * u; }
                }
            f32x4 hf[4], pf[4];
            {
                float cA = 1.f, cH = 0.f;
#pragma unroll
                for (int m = 0; m < 4; ++m) {
                    const f32x4 a = acc[m][0], x = acc[m][1];
                    const float A0 = a[0], H0 = x[0], A1 = A0 * a[1], H1 = a[1] * H0 + x[1], A2 = A1 * a[2], H2 = a[2] * H1 + x[2], A3 = A2 * a[3], H3 = a[3] * H2 + x[3];
                    float TA = A3, TH = H3;
                    float tA = __shfl_up(TA, 16), tH = __shfl_up(TH, 16); if (fq >= 1) { TH = TA * tH + TH; TA = TA * tA; }
                    tA = __shfl_up(TA, 32); tH = __shfl_up(TH, 32); if (fq >= 2) { TH = TA * tH + TH; TA = TA * tA; }
                    float EA = __shfl_up(TA, 16), EH = __shfl_up(TH, 16); if (fq == 0) { EA = 1.f; EH = 0.f; }
                    const float inA = cA * EA, inH = EA * cH + EH;
                    pf[m] = (f32x4){inA * A0, inA * A1, inA * A2, inA * A3};
                    hf[m] = (f32x4){A0 * inH + H0, A1 * inH + H1, A2 * inH + H2, A3 * inH + H3};
                    const float gA = __shfl(TA, fr + 48), gH = __shfl(TH, fr + 48);
                    cH = gA * cH + gH; cA = cA * gA;
                }
                if (fq == 0) { float* cs = csum + ((size_t)(b * NCHUNK + cidx) * 2 + 0) * 512 + c; cs[0] = cA; cs[256] = cH; }
            }
            {
                float cA = 1.f, cH = 0.f;
#pragma unroll
                for (int mm = 0; mm < 4; ++mm) { const int m = 3 - mm;
                    const f32x4 a = acc[m][2], x = acc[m][3];
                    const float A3 = a[3], H3 = x[3], A2 = A3 * a[2], H2 = a[2] * H3 + x[2], A1 = A2 * a[1], H1 = a[1] * H2 + x[1], A0 = A1 * a[0], H0 = a[0] * H1 + x[0];
                    float TA = A0, TH = H0;
                    float tA = __shfl_down(TA, 16), tH = __shfl_down(TH, 16); if (fq <= 2) { TH = TA * tH + TH; TA = TA * tA; }
                    tA = __shfl_down(TA, 32); tH = __shfl_down(TH, 32); if (fq <= 1) { TH = TA * tH + TH; TA = TA * tA; }
                    float EA = __shfl_down(TA, 16), EH = __shfl_down(TH, 16); if (fq == 3) { EA = 1.f; EH = 0.f; }
                    const float inA = cA * EA, inH = EA * cH + EH;
                    const f32x4 pb = (f32x4){inA * A0, inA * A1, inA * A2, inA * A3};
                    const f32x4 hb = (f32x4){A0 * inH + H0, A1 * inH + H1, A2 * inH + H2, A3 * inH + H3};
#pragma unroll
                    for (int j = 0; j < 4; ++j) { const int tk = 16 * m + 4 * fq + j;
                        ldsU[tk * L1_UST + c] = hf[m][j] + hb[j];
                        PPg[(size_t)(rbase + P0 + tk) * 256 + c] = (cvt_pk(pf[m][j], 0.f) & 0xffffu) | (cvt_pk(0.f, pb[j]) & 0xffff0000u); }
                    const float gA = __shfl(TA, fr), gH = __shfl(TH, fr);
                    cH = gA * cH + gH; cA = cA * gA;
                }
                if (fq == 0) { float* cs = csum + ((size_t)(b * NCHUNK + cidx) * 2 + 1) * 512 + c; cs[0] = cA; cs[256] = cH; }
            }
        }
        __syncthreads();
#pragma unroll
        for (int it = 0; it < 8; ++it) { const int idx = it * NTHREADS + tid, r = idx >> 6, c16 = idx & 63; const size_t grow = (size_t)(rbase + P0 + r) * 256 + c16 * 4;
            *(f32x4*)(Sg + grow) = *(const LAS f32x4*)(ldsU + r * L1_UST + c16 * 4);
 }
        __syncthreads();
    }
}
__device__ __forceinline__ void lru2_batch(const Params& P, int b) {
    const int tid = opaque_tid(), dir = tid >> 8, c = tid & 255;
    const float* csum = (const float*)(P.ws + OFF_CSUM); float* carry = (float*)(P.ws + OFF_CARRY);
    float h = 0.f;
#pragma unroll 1
    for (int k0 = 0; k0 < NCHUNK; k0 += 12) {
        float A[12], H[12]; int ci[12];
#pragma unroll
        for (int q = 0; q < 12; ++q) { const int k = k0 + q; ci[q] = dir == 0 ? k : (k < 4 ? 3 - k : 135 - k);
            const float* cs = csum + ((size_t)(b * NCHUNK + ci[q]) * 2 + dir) * 512 + c; A[q] = cs[0]; H[q] = cs[256]; }
#pragma unroll
        for (int q = 0; q < 12; ++q) { carry[((size_t)(b * NCHUNK + ci[q]) * 2 + dir) * 256 + c] = h; h = A[q] * h + H[q]; }
    }
}
__device__ __forceinline__ float gelu_tanh(float x) { const float z = 0.7978845608f * (x + 0.044715f * x * x * x); const float t = 1.0f - 2.0f * __builtin_amdgcn_rcpf(1.0f + __expf(2.0f * z)); return 0.5f * x * (1.0f + t); }
__device__ __forceinline__ void merge_phase(const Params& P, int l, int Mrows, int G) {
    const int tid = opaque_tid(), lane = tid & 63, wid = __builtin_amdgcn_readfirstlane(tid >> 6);
    const int gw = blockIdx.x * 8 + wid, NGW = G * 8, nruns = Mrows / 8, c4 = 4 * lane;
    const bf16_t* U5 = (const bf16_t*)(P.ws + OFF_U5);
    const bf16_t *Gb = U5 + U5_STRIDE, *BGb = U5 + 2 * U5_STRIDE, *CGb = U5 + 3 * U5_STRIDE, *SSb = U5 + 4 * U5_STRIDE;
    const float* Sg = (const float*)(P.ws + OFF_S); const unsigned* PPg = (const unsigned*)(P.ws + OFF_PP); const float* carry = (const float*)(P.ws + OFF_CARRY);
    bf16_t* hb = (bf16_t*)(P.ws + OFF_HBUF);
    f32x4 w0 = *(const f32x4*)(P.in[19] + (size_t)(l * 3 + 0) * 256 + c4), w1 = *(const f32x4*)(P.in[19] + (size_t)(l * 3 + 1) * 256 + c4), w2 = *(const f32x4*)(P.in[19] + (size_t)(l * 3 + 2) * 256 + c4);
    f32x4 cb4 = *(const f32x4*)(P.in[20] + (size_t)l * 256 + c4);
    const float* gg = P.in[21] + (size_t)l * 1024;
    const f32x4 ga0 = *(const f32x4*)(gg + 8 * lane), ga1 = *(const f32x4*)(gg + 8 * lane + 4), gl = *(const f32x4*)(gg + 512 + c4), gs = *(const f32x4*)(gg + 768 + c4);
    for (int run = gw; run < nruns; run += NGW) {
        const int row0 = run * 8; int b, cidx; bool seg_first, seg_last;
        if (row0 < MLAT) { b = row0 >> 13; const int s0 = row0 & 8191; cidx = 4 + (s0 >> 6); seg_first = s0 == 0; seg_last = s0 + 8 == SEQ; }
        else { const int rc = row0 - MLAT; b = rc >> 8; const int j0 = rc & 255; cidx = j0 >> 6; seg_first = j0 == 0; seg_last = j0 + 8 == CTXL; }
        const f32x4 cf = *(const f32x4*)(carry + ((size_t)(b * NCHUNK + cidx) * 2 + 0) * 256 + c4), cbk = *(const f32x4*)(carry + ((size_t)(b * NCHUNK + cidx) * 2 + 1) * 256 + c4);
        f32x4 prod[10];
#pragma unroll
        for (int i = 0; i < 10; ++i) { f32x4 p4 = {0.f, 0.f, 0.f, 0.f};
            if (!((i == 0 && seg_first) || (i == 9 && seg_last))) { const size_t o = (size_t)(row0 - 1 + i) * 256 + c4; const u32x2 a = *(const u32x2*)(CGb + o), s = *(const u32x2*)(SSb + o);
                p4 = (f32x4){bf_lo(a.x) * bf_lo(s.x), bf_hi(a.x) * bf_hi(s.x), bf_lo(a.y) * bf_lo(s.y), bf_hi(a.y) * bf_hi(s.y)}; }
            prod[i] = p4; }
#pragma unroll
        for (int i = 0; i < 8; ++i) { const int row = row0 + i; const size_t o = (size_t)row * 256 + c4;
            const f32x4 S4 = *(const f32x4*)(Sg + o); const u32x4 pp = *(const u32x4*)(PPg + o);
            const u32x2 g2 = *(const u32x2*)(Gb + o), bg2 = *(const u32x2*)(BGb + o);
            const u32x4 at = *(const u32x4*)(hb + (size_t)row * DM + 8 * lane);
            f32x4 hv;
#pragma unroll
            for (int j = 0; j < 4; ++j) hv[j] = S4[j] + bf_lo(pp[j]) * cf[j] + bf_hi(pp[j]) * cbk[j];
            const f32x4 g4 = (f32x4){bf_lo(g2.x), bf_hi(g2.x), bf_lo(g2.y), bf_hi(g2.y)}, bg4 = (f32x4){bf_lo(bg2.x), bf_hi(bg2.x), bf_lo(bg2.y), bf_hi(bg2.y)};
            f32x4 lru, scv;
#pragma unroll
            for (int j = 0; j < 4; ++j) { lru[j] = hv[j] * gelu_tanh(g4[j]); scv[j] = bg4[j] * (w0[j] * prod[i][j] + w1[j] * prod[i + 1][j] + w2[j] * prod[i + 2][j] + cb4[j]); }
            float av[8];
#pragma unroll
            for (int j = 0; j < 4; ++j) { av[2 * j] = bf_lo(at[j]); av[2 * j + 1] = bf_hi(at[j]); }
            float ssa = 0.f, ssl = 0.f, sss = 0.f;
#pragma unroll
            for (int j = 0; j < 8; ++j) ssa += av[j] * av[j];
#pragma unroll
            for (int j = 0; j < 4; ++j) { ssl += lru[j] * lru[j]; sss += scv[j] * scv[j]; }
            ssa = wave_sum(ssa); ssl = wave_sum(ssl); sss = wave_sum(sss);
            const float ra = 1.0f / sqrtf(ssa * (1.0f / 512.0f) + EPS), rl = 1.0f / sqrtf(ssl * (1.0f / 256.0f) + EPS), rs = 1.0f / sqrtf(sss * (1.0f / 256.0f) + EPS);
            u32x4 wa; wa.x = cvt_pk(av[0] * ra * ga0[0], av[1] * ra * ga0[1]); wa.y = cvt_pk(av[2] * ra * ga0[2], av[3] * ra * ga0[3]); wa.z = cvt_pk(av[4] * ra * ga1[0], av[5] * ra * ga1[1]); wa.w = cvt_pk(av[6] * ra * ga1[2], av[7] * ra * ga1[3]);
            *(u32x4*)(hb + (size_t)row * DM + 8 * lane) = wa;
            u32x2 wl; wl.x = cvt_pk(lru[0] * rl * gl[0], lru[1] * rl * gl[1]); wl.y = cvt_pk(lru[2] * rl * gl[2], lru[3] * rl * gl[3]);
            *(u32x2*)(hb + (size_t)row * DM + 512 + c4) = wl;
            u32x2 wsv; wsv.x = cvt_pk(scv[0] * rs * gs[0], scv[1] * rs * gs[1]); wsv.y = cvt_pk(scv[2] * rs * gs[2], scv[3] * rs * gs[3]);
            *(u32x2*)(hb + (size_t)row * DM + 768 + c4) = wsv;
        }
    }
}
__device__ __forceinline__ void attention_phase(const Params& P, int l, char* lds, int G) {
    using abf = attn_body::bf16;
    const abf* Q = (const abf*)(P.ws + OFF_Q); const abf* K = (const abf*)(P.ws + OFF_K); const abf* V = (const abf*)(P.ws + OFF_V); abf* O = (abf*)(P.ws + OFF_HBUF);
    if (blockIdx.x < NBATCH) lru2_batch(P, blockIdx.x);
    const int nunits = NBATCH * 8 * 32 + ((l + 1 < DEPTH) ? NBATCH * 8 : 0);
    for (int uid = blockIdx.x; uid < nunits; uid += G) {
        int b, h, NT; size_t qrow;
        if (uid < NBATCH * 8 * 32) { b = uid & 7; const int rest = uid >> 3, kvh = rest >> 7, u = rest & 127; h = kvh * 4 + (u >> 5); qrow = (size_t)b * SEQ + (u & 31) * 256; NT = NCHUNK; }
        else { const int v = uid - NBATCH * 8 * 32; b = v & 7; h = v >> 3; qrow = (size_t)MLAT + b * CTXL; NT = 4; }
        const size_t kvoff = (size_t)b * KEYS * 128 + (h >> 2) * 64;
        attn_body::attn_unit<8>(Q + qrow * 512 + h * 64, K + kvoff, V + kvoff, O + qrow * 1024 + h * 64, NT, lds);
    }
}

#define XB_TMO      128
#define XB_XCNT(j)  (256  + 64 * (j))
#define XB_XSUB(j)  (1280 + 64 * (j))
#define XB_XGEN(j)  (2304 + 64 * (j))
#define XB_TOP      3328
#define XB_TOPGEN   3392
#define XCD_BAR_WORDS 3456
#define XB_SPIN_CAP (1u << 18)

__device__ __forceinline__ unsigned xb_ld(unsigned* p)              { return __hip_atomic_load(p, __ATOMIC_RELAXED, __HIP_MEMORY_SCOPE_AGENT); }
__device__ __forceinline__ unsigned xb_add(unsigned* p, unsigned v) { return __hip_atomic_fetch_add(p, v, __ATOMIC_RELAXED, __HIP_MEMORY_SCOPE_AGENT); }
__device__ __forceinline__ unsigned xb_xcc_id() { return (unsigned)__builtin_amdgcn_s_getreg((3 << 11) | 20) & 0xFu; }
#define XB_SPIN(cond, bar) do { unsigned _sp = 0; while (cond) { __builtin_amdgcn_s_sleep(1); \
    if ((++_sp & 255u) == 0u) { if (xb_ld(&(bar)[XB_TMO])) break; if (_sp > XB_SPIN_CAP) { atomicAdd(&(bar)[XB_TMO], 1u); break; } } } } while (0)

struct XcdBarrier {
    unsigned* bar; unsigned x;
    volatile LAS unsigned* st;
};

__device__ __forceinline__ XcdBarrier xcd_barrier_post(unsigned* bar, volatile LAS unsigned* st) {
    XcdBarrier b; b.bar = bar; b.x = xb_xcc_id(); b.st = st;
    if (threadIdx.x == 0) (void)xb_add(&bar[XB_XCNT(b.x)], 1u);
    return b;
}
__device__ __forceinline__ void xcd_barrier_complete(unsigned* bar, unsigned x, unsigned& nloc, unsigned& nx) {
    const unsigned G = gridDim.x * gridDim.y * gridDim.z;
    unsigned sum, cnt, mine, sp = 0u;
    for (;;) {
        sum = 0u; cnt = 0u; mine = 0u;
#pragma unroll
        for (unsigned j = 0; j < 16; ++j) { const unsigned c = xb_ld(&bar[XB_XCNT(j)]); sum += c; cnt += (c > 0u) ? 1u : 0u; mine = (j == x) ? c : mine; }
        if (sum == G) break;
        __builtin_amdgcn_s_sleep(1);
        if ((++sp & 255u) == 0u) { if (xb_ld(&bar[XB_TMO])) break; if (sp > XB_SPIN_CAP) { atomicAdd(&bar[XB_TMO], 1u); break; } }
    }
    nloc = mine > 0u ? mine : 1u; nx = cnt > 0u ? cnt : 1u;
}

__device__ __forceinline__ void xcd_barrier(const XcdBarrier& b) {
    asm volatile("s_waitcnt vmcnt(0)" ::: "memory");
    __syncthreads();
    if (threadIdx.x == 0) {
        unsigned* bar = b.bar;
        __builtin_amdgcn_s_waitcnt(0);
        unsigned nloc = b.st[0], nx = b.st[1];
        if (nloc == 0u) { xcd_barrier_complete(bar, b.x, nloc, nx); b.st[0] = nloc; b.st[1] = nx; }
        const unsigned old = xb_add(&bar[XB_XSUB(b.x)], 1u);
        const unsigned gen = old / nloc;
        if (old + 1u == (gen + 1u) * nloc) {
            __builtin_amdgcn_fence(__ATOMIC_RELEASE, "agent");
            asm volatile("s_waitcnt vmcnt(0)" ::: "memory");
            const unsigned og = xb_add(&bar[XB_TOP], 1u);
            const unsigned tg = og / nx;
            if (og + 1u == (tg + 1u) * nx) xb_add(&bar[XB_TOPGEN], 1u);
            else XB_SPIN(xb_ld(&bar[XB_TOPGEN]) == tg, bar);
            __builtin_amdgcn_fence(__ATOMIC_ACQUIRE, "agent");
            xb_add(&bar[XB_XGEN(b.x)], 1u);
            asm volatile("s_waitcnt vmcnt(0)" ::: "memory");
        } else {
            XB_SPIN(xb_ld(&bar[XB_XGEN(b.x)]) == gen, bar);
            __builtin_amdgcn_fence(__ATOMIC_ACQUIRE, "agent");
            asm volatile("s_waitcnt vmcnt(0)" ::: "memory");
        }
    }
    __syncthreads();
}

#ifndef PH_MASK
#define PH_MASK 0x1FF
#endif
__global__ void __launch_bounds__(NTHREADS, 2) fwd_megakernel(Params P) {
    extern __shared__ __attribute__((aligned(16))) unsigned char lds_raw[];
    LAS unsigned char* lds = (LAS unsigned char*)lds_raw;
    cg::grid_group grid = cg::this_grid();
    volatile LAS unsigned* bst = (volatile LAS unsigned*)(lds + LDS_BAR_OFF);
    if (threadIdx.x < 2) bst[threadIdx.x] = 0u;
    __syncthreads();
    const XcdBarrier xbar = xcd_barrier_post((unsigned*)(P.ws + OFF_CTL), bst);
#define GRID_SYNC() xcd_barrier(xbar)
    const int G = gridDim.x;
    unsigned char* ws = P.ws;
    if constexpr (PH_MASK & 1) prologue_phase(P, lds, G);
    grid.sync();
    for (int step = 0; step < DEPTH * 3; ++step) {
        const int l = step / 3, s3 = step % 3;
        const bool last = (l == DEPTH - 1);
        const int Mn = (last && s3 == 2) ? MLAT : MTOT;
        if constexpr (PH_MASK & 2) norm_phase(P, l, s3, Mn, step == 0, G);
        GRID_SYNC();
        unsigned char* wb = ws + OFF_WB + (size_t)l * WB_LAYER;
        pg8::Gemm gr; pg8::EpiResid er; int Mr;
        const float* modl = (const float*)(ws + OFF_MOD) + (size_t)l * 9 * MODW;
        if (s3 != 1) {
            const int f = s3 >> 1;
            { pg8::Gemm g{(const bf16_t*)(ws + OFF_HBUF), (const bf16_t*)(wb + WB_FFIN + f * WB_FFIN_SZ), Mn, NFF2, DM};
              pg8::StaticOrder S; S.init(Mn, NFF2, G, (int)blockIdx.x);
              pg8::EpiSwiglu E{(bf16_t*)(ws + OFF_MID)};
              if constexpr (PH_MASK & 4) pg8::gemm_phase<pg8::EpiSwiglu, pg8::StaticOrder, true, true>(lds, g, S, E); }
            GRID_SYNC();
            Mr = Mn;
            gr = pg8::Gemm{(const bf16_t*)(ws + OFF_MID), (const bf16_t*)(wb + WB_FFOUT + f * WB_FFOUT_SZ), Mr, DM, DFF};
            er = pg8::EpiResid{(float*)(ws + OFF_XRES), modl + (3 * s3 + 2) * DM, 0.5f};
        } else {
            { pg8::Gemm g{(const bf16_t*)(ws + OFF_HBUF), (const bf16_t*)(wb + WB_WIN), MTOT, INW, DM};
              pg8::StaticOrder S; S.init(MTOT, INW, G, (int)blockIdx.x);
              pg8::EpiWin E{(bf16_t*)(ws + OFF_Q), (bf16_t*)(ws + OFF_K), (bf16_t*)(ws + OFF_V), (bf16_t*)(ws + OFF_U5), P.in[10] + l * 64, P.in[11] + l * 64,
                            (const float*)(ws + OFF_ROPE), (const float*)(ws + OFF_ROPE) + 2048, 0.125f * 1.4426950408889634f};
              if constexpr (PH_MASK & 8) pg8::gemm_phase<pg8::EpiWin, pg8::StaticOrder, true, true>(lds, g, S, E); }
            GRID_SYNC();
            if constexpr (PH_MASK & 16) lru1_phase(P, l, lds, G);
            GRID_SYNC();
            if constexpr (PH_MASK & 32) attention_phase(P, l, (char*)lds_raw, G);
            GRID_SYNC();
            Mr = last ? MLAT : MTOT;
            if constexpr (PH_MASK & 64) merge_phase(P, l, Mr, G);
            GRID_SYNC();
            gr = pg8::Gemm{(const bf16_t*)(ws + OFF_HBUF), (const bf16_t*)(wb + WB_WOUT), Mr, DM, DM};
            er = pg8::EpiResid{(float*)(ws + OFF_XRES), modl + 5 * DM, 1.0f};
        }
        { pg8::StaticOrder S; S.init(Mr, DM, G, (int)blockIdx.x);
          if constexpr (PH_MASK & 128) pg8::gemm_phase<pg8::EpiResid, pg8::StaticOrder, true, true>(lds, gr, S, er); }
        GRID_SYNC();
    }
    if constexpr (PH_MASK & 256) final_norm_phase(P, G);
}

extern "C" void kernel_launch(void* const* d_in, const int* in_sizes, int n_in, void* d_out, int out_size, void* d_ws, size_t ws_size, hipStream_t stream) {
    static int grid = 0;
    if (grid == 0) {
        if (n_in != 24 || out_size != MLAT * DM || ws_size < WS_NEED) { fprintf(stderr, "kernel_launch: unexpected shapes (n_in %d, out %d, ws %zu, need %zu)\n", n_in, out_size, ws_size, (size_t)WS_NEED); grid = -1; return; }
        int dev = 0, cus = 0, per_cu = 0;
        hipGetDevice(&dev); hipDeviceGetAttribute(&cus, hipDeviceAttributeMultiprocessorCount, dev);
        if (hipFuncSetAttribute((const void*)fwd_megakernel, hipFuncAttributeMaxDynamicSharedMemorySize, LDS_BYTES) != hipSuccess) { fprintf(stderr, "kernel_launch: hipFuncSetAttribute failed\n"); grid = -1; return; }
        if (hipOccupancyMaxActiveBlocksPerMultiprocessor(&per_cu, (const void*)fwd_megakernel, NTHREADS, LDS_BYTES) != hipSuccess || per_cu < 1) { fprintf(stderr, "kernel_launch: occupancy query says %d\n", per_cu); per_cu = 1; (void)hipGetLastError(); }
        grid = cus * 1;
        if (grid % 8 != 0 || grid <= 0) grid = 256;
        fprintf(stderr, "kernel_launch: grid %d (cus %d, per_cu %d)\n", grid, cus, per_cu);
    }
    if (grid < 0) return;
    Params p{};
    for (int i = 0; i < 24; ++i) p.in[i] = (const float*)d_in[i];
    p.out = (float*)d_out; p.ws = (unsigned char*)d_ws;
    if (hipMemsetAsync((unsigned char*)d_ws + OFF_CTL, 0, CTL_BYTES, stream) != hipSuccess) { fprintf(stderr, "kernel_launch: memset of the barrier words failed\n"); return; }
    void* args[] = {&p};
    hipError_t e = hipLaunchCooperativeKernel((const void*)fwd_megakernel, dim3(grid), dim3(NTHREADS), args, LDS_BYTES, stream);
    if (e != hipSuccess) fprintf(stderr, "kernel_launch: cooperative launch failed: %s (grid %d)\n", hipGetErrorString(e), grid);
}
```

```cpp
#include <hip/hip_runtime.h>
#include <hip/hip_bf16.h>
#include <hip/hip_cooperative_groups.h>
#include <cstdio>
#include <cstdint>
#include <cmath>
namespace cg = cooperative_groups;

constexpr int DM = 1024, NBATCH = 8, SEQ = 8192, CTXL = 256, DEPTH = 2;
constexpr int MLAT = NBATCH * SEQ, MCTX = NBATCH * CTXL, MTOT = MLAT + MCTX;
constexpr int DFF = 2816, NFF2 = 2 * DFF, INW = 2048, NMODV = 9, MODW = 9 * DM;
constexpr int KEYS = SEQ + CTXL, NCHUNK = KEYS / 64;
constexpr float EPS = 1e-6f;
constexpr int NTHREADS = 512;
constexpr int LDS_BYTES = 147456;

constexpr size_t MiB = 1u << 20;
constexpr size_t OFF_MOD = 0;
constexpr size_t OFF_ROPE = 1 * MiB;
constexpr size_t OFF_LW = 1 * MiB + 65536;
constexpr size_t OFF_CSUM = 2 * MiB;
constexpr size_t OFF_CARRY = 7 * MiB;
constexpr size_t OFF_CTL = 9 * MiB + 524288, CTL_BYTES = 65536;
constexpr int LDS_BAR_OFF = 147200;
constexpr size_t OFF_WB = 10 * MiB;
constexpr size_t WB_LAYER = 39 * MiB;
constexpr size_t WB_FFIN = 0, WB_FFIN_SZ = (size_t)NFF2 * DM * 2;
constexpr size_t WB_FFOUT = 2 * WB_FFIN_SZ, WB_FFOUT_SZ = (size_t)DM * DFF * 2;
constexpr size_t WB_WIN = WB_FFOUT + 2 * WB_FFOUT_SZ, WB_WIN_SZ = (size_t)INW * DM * 2;
constexpr size_t WB_WOUT = WB_WIN + WB_WIN_SZ;
static_assert(WB_WOUT + (size_t)DM * DM * 2 == WB_LAYER, "weight map");
constexpr size_t OFF_XRES = 88 * MiB;
constexpr size_t OFF_HBUF = 352 * MiB;
constexpr size_t OFF_R1 = 484 * MiB;
constexpr size_t OFF_MID = OFF_R1;
constexpr size_t OFF_Q = OFF_R1;
constexpr size_t OFF_K = OFF_R1 + 66 * MiB;
constexpr size_t OFF_V = OFF_K + 16 * MiB + 524288;
constexpr size_t OFF_U5 = OFF_R1 + 99 * MiB;
constexpr size_t U5_STRIDE = (size_t)MTOT * 256;
constexpr size_t OFF_S = OFF_R1 + 264 * MiB;
constexpr size_t OFF_PP = OFF_R1 + 330 * MiB;
constexpr size_t OFF_ATT = OFF_R1 + 396 * MiB;
constexpr size_t WS_NEED = OFF_ATT + 66 * MiB;

#define LAS __attribute__((address_space(3)))
typedef unsigned short bf16_t;
typedef float f32x4 __attribute__((ext_vector_type(4)));
typedef float f32x2 __attribute__((ext_vector_type(2)));
typedef unsigned u32x4 __attribute__((ext_vector_type(4)));
typedef unsigned u32x2 __attribute__((ext_vector_type(2)));

struct Params { const float* in[24]; float* out; unsigned char* ws; };

__device__ __forceinline__ unsigned cvt_pk(float lo, float hi) { unsigned r; asm volatile("v_cvt_pk_bf16_f32 %0, %1, %2" : "=v"(r) : "v"(lo), "v"(hi)); return r; }
__device__ __forceinline__ float bf_lo(unsigned w) { return __uint_as_float(w << 16); }
__device__ __forceinline__ float bf_hi(unsigned w) { return __uint_as_float(w & 0xffff0000u); }
__device__ __forceinline__ float wave_sum(float v) {
#pragma unroll
    for (int o = 1; o < 64; o <<= 1) v += __shfl_xor(v, o);
    return v;
}
__device__ __forceinline__ int opaque_tid() { int t = threadIdx.x; asm volatile("" : "+v"(t)); return t; }
__device__ __forceinline__ float sigmoidf_(float z) { return __builtin_amdgcn_rcpf(1.0f + __expf(-z)); }
namespace pg8 {
#define PG8_LAS __attribute__((address_space(3)))
typedef unsigned short bf16_t;
typedef short bf16x8 __attribute__((ext_vector_type(8)));
typedef float f32x4 __attribute__((ext_vector_type(4)));
typedef unsigned u32x4 __attribute__((ext_vector_type(4)));
constexpr int BM = 256, BK = 64, HALF = 128, HTB = HALF * BK * 2  , STAGE_BYTES = 8 * HTB, NXCD = 8, WGM = 8;

__host__ __device__ __forceinline__ int lds_byte(int r, int c) { const int st = (r >> 4) * 2 + (c >> 5), rr = r & 15, cc = c & 31, ob = rr * 64 + cc * 2; return st * 1024 + (ob ^ (((ob >> 9) & 1) << 5)); }
__host__ __device__ __forceinline__ void stage_rc(int b, int& R, int& C) { const int st = b / 1024, sb = b % 1024, swz = sb ^ (((sb >> 9) & 1) << 5); R = (st >> 1) * 16 + swz / 64; C = (st & 1) * 32 + (swz % 64) / 2; }
__host__ __device__ __forceinline__ int perm32(int rho) { const int n = rho >> 4, i = rho & 15; return 8 * (i >> 2) + 4 * n + (i & 3); }

struct Unit { int pm, pn; };
struct Gemm { const bf16_t* A; const bf16_t* Bt; int M, N, K; };

struct StaticOrder {
    int nM, nN, nwg, G, c;
    __host__ __device__ void init(int M, int N, int G_, int c_) { nM = M / BM; nN = N / BM; nwg = nM * nN; G = G_; c = c_; }
    __host__ __device__ bool next(int i, Unit& u) const {
        const long L = (long)i * G + c; if (L >= nwg) return false;
        int wgid = (int)L; { const int q = nwg / NXCD, r = nwg % NXCD, xcd = wgid % NXCD, off = wgid / NXCD; wgid = (xcd < r ? xcd * (q + 1) : r * (q + 1) + (xcd - r) * q) + off; }
        const int nig = WGM * nN, gid = wgid / nig, fm = gid * WGM, gsz = (nM - fm) < WGM ? (nM - fm) : WGM;
        u.pm = fm + ((wgid % nig) % gsz); u.pn = (wgid % nig) / gsz; return true;
    }
    __device__ __forceinline__ void a_ready(const Unit&) const {}
    __device__ __forceinline__ void done(const Unit&) const {}
};
__device__ __forceinline__ unsigned cvt_pk_bf16(float lo, float hi) { unsigned r; asm volatile("v_cvt_pk_bf16_f32 %0, %1, %2" : "=v"(r) : "v"(lo), "v"(hi)); return r; }

struct EpiSwiglu {
    static constexpr bool PERM = false, AFTER_DRAIN = false;
    bf16_t* O;
    __device__ __forceinline__ void operator()(const f32x4 (&acc)[2][2][4][2], const Unit& u, int wr, int wc, int fr, int fq) const {
        const int row0 = u.pm * BM + wr * 64 + fr, col0 = u.pn * 128 + wc * 32 + 8 * fq;
#pragma unroll
        for (int ai = 0; ai < 2; ++ai)
#pragma unroll
            for (int m = 0; m < 4; ++m) {
                bf16_t* rowp = O + (size_t)(row0 + ai * HALF + m * 16) * 2816 + col0;
                float v[8];
#pragma unroll
                for (int n = 0; n < 2; ++n)
#pragma unroll
                    for (int j = 0; j < 4; ++j) { const float g = acc[ai][0][m][n][j], up = acc[ai][1][m][n][j]; v[n * 4 + j] = g * __builtin_amdgcn_rcpf(1.0f + __expf(-g)) * up; }
                u32x4 w; w.x = cvt_pk_bf16(v[0], v[1]); w.y = cvt_pk_bf16(v[2], v[3]); w.z = cvt_pk_bf16(v[4], v[5]); w.w = cvt_pk_bf16(v[6], v[7]);
                *(u32x4*)rowp = w;
            }
    }
};
struct EpiResid {
    static constexpr bool PERM = false, AFTER_DRAIN = false;
    float* X; const float* gate; float scale;
    __device__ __forceinline__ void operator()(const f32x4 (&acc)[2][2][4][2], const Unit& u, int wr, int wc, int fr, int fq) const {
        const int v = u.pm < 256 ? (u.pm >> 5) : 8;
        const int row0 = u.pm * BM + wr * 64 + fr, col0 = u.pn * BM + wc * 32 + 4 * fq;
        const float* gp = gate + (size_t)v * 9216 + col0;
        f32x4 gv[2][2];
#pragma unroll
        for (int bj = 0; bj < 2; ++bj)
#pragma unroll
            for (int n = 0; n < 2; ++n) gv[bj][n] = *(const f32x4*)(gp + bj * HALF + n * 16) * scale;
#pragma unroll
        for (int ai = 0; ai < 2; ++ai) {
            float* rowp = X + (size_t)(row0 + ai * HALF) * 1024 + col0;
            f32x4 xv[4][2][2];
#pragma unroll
            for (int m = 0; m < 4; ++m)
#pragma unroll
                for (int bj = 0; bj < 2; ++bj)
#pragma unroll
                    for (int n = 0; n < 2; ++n) xv[m][bj][n] = *(const f32x4*)(rowp + (size_t)m * 16 * 1024 + bj * HALF + n * 16);
#pragma unroll
            for (int m = 0; m < 4; ++m)
#pragma unroll
                for (int bj = 0; bj < 2; ++bj)
#pragma unroll
                    for (int n = 0; n < 2; ++n) *(f32x4*)(rowp + (size_t)m * 16 * 1024 + bj * HALF + n * 16) = xv[m][bj][n] + gv[bj][n] * acc[ai][bj][m][n];
        }
    }
};
struct EpiWin {
    static constexpr bool PERM = false, AFTER_DRAIN = false;
    bf16_t *Q, *K, *V, *U5; const float *qg, *kg, *rcos, *rsin; float qscale;
    __device__ __forceinline__ void operator()(const f32x4 (&acc)[2][2][4][2], const Unit& u, int wr, int wc, int fr, int fq) const {
        const int row0 = u.pm * BM + wr * 64 + fr;
        if (u.pn >= 3) {
            bf16_t* base = U5 + (size_t)(u.pn - 3) * ((size_t)67584 * 256) + wc * 32 + 8 * fq;
#pragma unroll
            for (int ai = 0; ai < 2; ++ai)
#pragma unroll
                for (int m = 0; m < 4; ++m) { bf16_t* rowp = base + (size_t)(row0 + ai * HALF + m * 16) * 256;
#pragma unroll
                    for (int bj = 0; bj < 2; ++bj) { const f32x4 v0 = acc[ai][bj][m][0], v1 = acc[ai][bj][m][1];
                        u32x4 w; w.x = cvt_pk_bf16(v0[0], v0[1]); w.y = cvt_pk_bf16(v0[2], v0[3]); w.z = cvt_pk_bf16(v1[0], v1[1]); w.w = cvt_pk_bf16(v1[2], v1[3]);
                        *(u32x4*)(rowp + bj * HALF) = w; } }
            return;
        }
        const int kind = u.pn < 2 ? 0 : (wc < 2 ? 1 : 2);
        const bool latent = u.pm < 256;
        const float* gsrc = kind == 0 ? qg : kg;
        f32x4 gv[2][2];
#pragma unroll
        for (int bj = 0; bj < 2; ++bj)
#pragma unroll
            for (int n = 0; n < 2; ++n) gv[bj][n] = *(const f32x4*)(gsrc + 32 * bj + 16 * n + 4 * fq);
#pragma unroll
        for (int ai = 0; ai < 2; ++ai)
#pragma unroll
            for (int m = 0; m < 4; ++m) {
                const int row = row0 + ai * HALF + m * 16;
                f32x4 y[2][2];
#pragma unroll
                for (int bj = 0; bj < 2; ++bj)
#pragma unroll
                    for (int n = 0; n < 2; ++n) y[bj][n] = acc[ai][bj][m][n];
                if (kind != 2) {
                    float ss = 0.f;
#pragma unroll
                    for (int bj = 0; bj < 2; ++bj)
#pragma unroll
                        for (int n = 0; n < 2; ++n) { const f32x4 t = y[bj][n]; ss += (t[0] * t[0] + t[1] * t[1]) + (t[2] * t[2] + t[3] * t[3]); }
                    ss += __shfl_xor(ss, 16); ss += __shfl_xor(ss, 32);
                    const float r = 1.0f / sqrtf(ss * (1.0f / 64.0f) + 1e-6f);
#pragma unroll
                    for (int bj = 0; bj < 2; ++bj)
#pragma unroll
                        for (int n = 0; n < 2; ++n) y[bj][n] = y[bj][n] * r * gv[bj][n];
                    if (latent) {
                        const int s = row & 8191;
#pragma unroll
                        for (int bj = 0; bj < 2; ++bj) { const int pos = bj == 0 ? (s >> 6) : (s & 63);
                            const f32x4 c4 = *(const f32x4*)(rcos + pos * 16 + 4 * fq), s4 = *(const f32x4*)(rsin + pos * 16 + 4 * fq);
                            const f32x4 x1 = y[bj][0], x2 = y[bj][1];
                            y[bj][0] = x1 * c4 - x2 * s4; y[bj][1] = x2 * c4 + x1 * s4; }
                    }
                }
                bf16_t* dst;
                if (kind == 0) { dst = Q + (size_t)row * 512 + (u.pn * 4 + wc) * 64;
#pragma unroll
                    for (int bj = 0; bj < 2; ++bj)
#pragma unroll
                        for (int n = 0; n < 2; ++n) y[bj][n] = y[bj][n] * qscale;
                } else {
                    size_t kr;
                    if (latent) kr = (size_t)(row >> 13) * 8448 + 256 + (row & 8191);
                    else { const int rc = row - 65536; kr = (size_t)(rc >> 8) * 8448 + (rc & 255); }
                    dst = (kind == 1 ? K : V) + kr * 128 + (wc & 1) * 64;
                }
#pragma unroll
                for (int bj = 0; bj < 2; ++bj)
#pragma unroll
                    for (int n = 0; n < 2; ++n) { u32x2 w; w.x = cvt_pk_bf16(y[bj][n][0], y[bj][n][1]); w.y = cvt_pk_bf16(y[bj][n][2], y[bj][n][3]);
                        *(u32x2*)(dst + 32 * bj + 16 * n + 4 * fq) = w; }
            }
    }
};
template <class Epi, class Sched, bool ALIGN_EPI = false, bool SP2 = false>
__device__ __forceinline__ void gemm_phase(PG8_LAS unsigned char* lds, const Gemm g, const Sched& S, const Epi& E) {
    const int tid = opaque_tid(), wid = __builtin_amdgcn_readfirstlane(tid >> 6), lane = tid & 63, wr = wid >> 2, wc = wid & 3, fr = lane & 15, fq = lane >> 4;
    const int K = g.K, nt = K / BK;
    unsigned voffA[2], voffB[2];
#pragma unroll
    for (int i = 0; i < 2; ++i) { int R, C; stage_rc(tid * 16 + i * 8192, R, C); const int Rb = Epi::PERM ? ((R & ~31) + perm32(R & 31)) : R;
        voffA[i] = (unsigned)(R * K + C) * 2u; voffB[i] = (unsigned)(Rb * K + C) * 2u; }
    const size_t kstep = (size_t)(BK * 2);
    const size_t hstep = (size_t)HALF * K * 2;
    const size_t tstep = 2 * hstep;
    const unsigned ldsw = (unsigned)wid * 1024u;
    const int aoff = lds_byte(wr * 64 + fr, fq * 8), boff = lds_byte(wc * 32 + fr, fq * 8);
#define PG8_SA(b, h) (((b) * 2 + (h)) * HTB)
#define PG8_SB(b, h) ((4 + (b) * 2 + (h)) * HTB)
#define PG8_STAGE(bufoff, gbase, voff) do { _Pragma("unroll") for (int _i = 0; _i < 2; ++_i) \
        __builtin_amdgcn_global_load_lds((const unsigned*)((const char*)(gbase) + (voff)[_i]), (PG8_LAS unsigned*)(lds + (bufoff) + ldsw + _i * 8192), 16, 0, 0); } while (0)
#define PG8_LDA(dst, b, h) do { _Pragma("unroll") for (int m = 0; m < 4; ++m) _Pragma("unroll") for (int k = 0; k < 2; ++k) dst[m][k] = *(const PG8_LAS bf16x8*)(lds + PG8_SA(b, h) + aoff + m * 2048 + k * 1024); } while (0)
#define PG8_LDB(dst, b, h) do { _Pragma("unroll") for (int n = 0; n < 2; ++n) _Pragma("unroll") for (int k = 0; k < 2; ++k) dst[n][k] = *(const PG8_LAS bf16x8*)(lds + PG8_SB(b, h) + boff + n * 2048 + k * 1024); } while (0)
#define PG8_MMA(ai, bj, At, Bt) do { __builtin_amdgcn_s_setprio(1); _Pragma("unroll") for (int m = 0; m < 4; ++m) _Pragma("unroll") for (int n = 0; n < 2; ++n) _Pragma("unroll") for (int k = 0; k < 2; ++k) \
        acc[ai][bj][m][n] = __builtin_amdgcn_mfma_f32_16x16x32_bf16(Bt[n][k], At[m][k], acc[ai][bj][m][n], 0, 0, 0); __builtin_amdgcn_s_setprio(0); } while (0)
#define PG8_WAIT_V(n) asm volatile("s_waitcnt vmcnt(" #n ")" ::: "memory")
#define PG8_WAIT_L(n) asm volatile("s_waitcnt lgkmcnt(" #n ")" ::: "memory")
#define PG8_BAR __builtin_amdgcn_s_barrier()
#define PG8_SCHED __builtin_amdgcn_sched_barrier(0)
    Unit cur, nxt; int ui = 0;
    if (!S.next(0, cur)) return;
    f32x4 acc[2][2][4][2];
#pragma unroll
    for (int a = 0; a < 2; ++a)
#pragma unroll
        for (int b = 0; b < 2; ++b)
#pragma unroll
            for (int m = 0; m < 4; ++m)
#pragma unroll
                for (int n = 0; n < 2; ++n) acc[a][b][m][n] = (f32x4){0.f, 0.f, 0.f, 0.f};
    bf16x8 At[4][2], B0[2][2], B1[2][2];
    const char* cA = (const char*)g.A + (size_t)cur.pm * tstep; const char* cB = (const char*)g.Bt + (size_t)cur.pn * tstep;
    S.a_ready(cur);
    if constexpr (SP2) {
        PG8_STAGE(PG8_SB(0, 0), cB, voffB); PG8_STAGE(PG8_SB(0, 1), cB + hstep, voffB); PG8_STAGE(PG8_SA(0, 0), cA, voffA); PG8_STAGE(PG8_SA(0, 1), cA + hstep, voffA);
        if (wr == 1) PG8_BAR;
        PG8_WAIT_V(2); PG8_BAR;
        PG8_STAGE(PG8_SB(1, 0), cB + kstep, voffB); PG8_STAGE(PG8_SA(1, 0), cA + kstep, voffA); PG8_STAGE(PG8_SB(1, 1), cB + hstep + kstep, voffB);
        PG8_WAIT_V(6); PG8_BAR;
    } else {
        PG8_STAGE(PG8_SB(0, 0), cB, voffB); PG8_STAGE(PG8_SA(0, 0), cA, voffA); PG8_STAGE(PG8_SB(0, 1), cB + hstep, voffB); PG8_STAGE(PG8_SA(0, 1), cA + hstep, voffA);
        if (wr == 1) PG8_BAR;
        PG8_WAIT_V(4); PG8_BAR;
        PG8_STAGE(PG8_SB(1, 0), cB + kstep, voffB); PG8_STAGE(PG8_SA(1, 0), cA + kstep, voffA); PG8_STAGE(PG8_SB(1, 1), cB + hstep + kstep, voffB);
        PG8_WAIT_V(6); PG8_BAR;
    }
    for (;;) {
        const bool has_next = S.next(ui + 1, nxt);
        const char* nA = has_next ? (const char*)g.A + (size_t)nxt.pm * tstep : cA; const char* nB = has_next ? (const char*)g.Bt + (size_t)nxt.pn * tstep : cB;
        for (int t = 0; t < nt; t += 2) {
            const bool last = (t == nt - 2);
            const char* a1 = cA + (size_t)(t + 1) * kstep;
            const char* a2 = last ? nA : cA + (size_t)(t + 2) * kstep; const char* b2 = last ? nB : cB + (size_t)(t + 2) * kstep;
            const char* a3 = a2 + kstep; const char* b3 = b2 + kstep;
            if (last && has_next) S.a_ready(nxt);
            if constexpr (SP2) {
            PG8_LDB(B0, 0, 0); PG8_LDB(B1, 0, 1); PG8_SCHED; PG8_LDA(At, 0, 0); PG8_STAGE(PG8_SA(1, 1), a1 + hstep, voffA);
            PG8_WAIT_V(8); PG8_WAIT_L(0); PG8_BAR; PG8_MMA(0, 0, At, B0); PG8_MMA(0, 1, At, B1); PG8_BAR; PG8_SCHED;
            PG8_LDA(At, 0, 1); PG8_STAGE(PG8_SB(0, 0), b2, voffB); PG8_STAGE(PG8_SB(0, 1), b2 + hstep, voffB); PG8_STAGE(PG8_SA(0, 0), a2, voffA);
            PG8_WAIT_V(8); PG8_WAIT_L(0); PG8_BAR; PG8_MMA(1, 0, At, B0); PG8_MMA(1, 1, At, B1); PG8_BAR; PG8_SCHED;
            PG8_LDB(B0, 1, 0); PG8_LDB(B1, 1, 1); PG8_SCHED; PG8_LDA(At, 1, 0); PG8_STAGE(PG8_SA(0, 1), a2 + hstep, voffA);
            PG8_WAIT_V(8); PG8_WAIT_L(0); PG8_BAR; PG8_MMA(0, 0, At, B0); PG8_MMA(0, 1, At, B1); PG8_BAR; PG8_SCHED;
            PG8_LDA(At, 1, 1); PG8_STAGE(PG8_SB(1, 0), b3, voffB); PG8_STAGE(PG8_SB(1, 1), b3 + hstep, voffB); PG8_STAGE(PG8_SA(1, 0), a3, voffA);
            PG8_WAIT_V(8); PG8_WAIT_L(0); PG8_BAR; PG8_MMA(1, 0, At, B0); PG8_MMA(1, 1, At, B1); PG8_BAR; PG8_SCHED;
            } else {
            PG8_LDB(B0, 0, 0); PG8_SCHED; PG8_LDA(At, 0, 0); PG8_STAGE(PG8_SA(1, 1), a1 + hstep, voffA);
            PG8_WAIT_L(8); PG8_BAR; PG8_WAIT_L(0); PG8_MMA(0, 0, At, B0); PG8_BAR; PG8_SCHED;
            PG8_LDB(B1, 0, 1); PG8_STAGE(PG8_SB(0, 0), b2, voffB);
            PG8_BAR; PG8_WAIT_L(0); PG8_MMA(0, 1, At, B1); PG8_BAR;
            PG8_LDA(At, 0, 1); PG8_STAGE(PG8_SA(0, 0), a2, voffA);
            PG8_BAR; PG8_WAIT_L(0); PG8_MMA(1, 0, At, B0); PG8_BAR; PG8_SCHED;
            PG8_STAGE(PG8_SB(0, 1), b2 + hstep, voffB);
            PG8_WAIT_V(6); PG8_BAR; PG8_MMA(1, 1, At, B1); PG8_BAR;
            PG8_LDB(B0, 1, 0); PG8_SCHED; PG8_LDA(At, 1, 0); PG8_STAGE(PG8_SA(0, 1), a2 + hstep, voffA);
            PG8_WAIT_L(8); PG8_BAR; PG8_WAIT_L(0); PG8_MMA(0, 0, At, B0); PG8_BAR; PG8_SCHED;
            PG8_LDB(B1, 1, 1); PG8_STAGE(PG8_SB(1, 0), b3, voffB);
            PG8_BAR; PG8_WAIT_L(0); PG8_MMA(0, 1, At, B1); PG8_BAR;
            PG8_LDA(At, 1, 1); PG8_STAGE(PG8_SA(1, 0), a3, voffA);
            PG8_BAR; PG8_WAIT_L(0); PG8_MMA(1, 0, At, B0); PG8_BAR; PG8_SCHED;
            PG8_STAGE(PG8_SB(1, 1), b3 + hstep, voffB);
            PG8_WAIT_V(6); PG8_BAR; PG8_MMA(1, 1, At, B1); PG8_BAR;
            }
        }
        if constexpr (ALIGN_EPI) { if (wr == 0) PG8_BAR; }
        if constexpr (!Epi::AFTER_DRAIN) { E(acc, cur, wr, wc, fr, fq); S.done(cur); }
        if (!has_next) break;
#pragma unroll
        for (int a = 0; a < 2; ++a)
#pragma unroll
            for (int b = 0; b < 2; ++b)
#pragma unroll
                for (int m = 0; m < 4; ++m)
#pragma unroll
                    for (int n = 0; n < 2; ++n) acc[a][b][m][n] = (f32x4){0.f, 0.f, 0.f, 0.f};
        cur = nxt; cA = nA; cB = nB; ++ui;
        if constexpr (ALIGN_EPI) { if (wr == 1) PG8_BAR; }
    }
    PG8_WAIT_V(0);
    if constexpr (!ALIGN_EPI) { if (wr == 0) PG8_BAR; }
    PG8_BAR;
    if constexpr (Epi::AFTER_DRAIN) { E.fused(acc, cur, wr, wc, fr, fq, lds, wid, lane); S.done(cur); }
#undef PG8_SA
#undef PG8_SB
#undef PG8_STAGE
#undef PG8_LDA
#undef PG8_LDB
#undef PG8_MMA
#undef PG8_WAIT_V
#undef PG8_WAIT_L
#undef PG8_BAR
#undef PG8_SCHED
}
}

namespace attn_body {
using bf16=__hip_bfloat16;
using bf16x8=__attribute__((ext_vector_type(8)))short;
using s16x4=__attribute__((ext_vector_type(4)))short;
using f32x16=__attribute__((ext_vector_type(16)))float;
using u32x4=__attribute__((ext_vector_type(4)))unsigned;
constexpr int D=64, QP=512, KP=128, OP=512;
constexpr int NW=8,QBLK=32,QB=QBLK*NW,KVBLK=64;
__device__ __forceinline__ int crow(int r,int hi){return (r&3)+8*(r>>2)+4*hi;}
#define SBAR() __builtin_amdgcn_sched_barrier(0)
#define ATTN_STORE16(p,v) (*(u32x4*)(p)=(v))
constexpr int NSLOT=3, SLOTB=8192;
constexpr int LDS_K=0, LDS_V=NSLOT*SLOTB, LDS_WS=2*NSLOT*SLOTB, LDS_OST=LDS_WS+NW*64*4, LDS_BYTES=LDS_OST+NW*4096;
constexpr float C2=0.125f*1.4426950408889634f;
__device__ __forceinline__ void glds16(const void*gsrc,unsigned lds_dst){unsigned keep;
  asm volatile("s_mov_b32 %0, m0\n\ts_mov_b32 m0, %2\n\ts_nop 0\n\tglobal_load_lds_dwordx4 %1, off\n\ts_mov_b32 m0, %0":"=&s"(keep):"v"(gsrc),"s"(lds_dst):"memory");}
__device__ __forceinline__ float max3f(float a,float b,float c){float r;asm("v_max3_f32 %0, %1, %2, %3":"=v"(r):"v"(a),"v"(b),"v"(c));return r;}
__device__ __forceinline__ float max2f(float a,float b){float r;asm("v_max_f32_e32 %0, %1, %2":"=v"(r):"v"(a),"v"(b));return r;}
__device__ __forceinline__ float fadd_s(float a,float b){float r;asm("v_add_f32_e32 %0, %1, %2":"=v"(r):"v"(a),"v"(b));return r;}
__device__ __forceinline__ float fsub_s(float a,float b){float r;asm("v_sub_f32_e32 %0, %1, %2":"=v"(r):"v"(a),"v"(b));return r;}
typedef float f32x2_t __attribute__((ext_vector_type(2))); typedef __bf16 bf16x2_t __attribute__((ext_vector_type(2)));
__device__ __forceinline__ unsigned cvtpk_s(float lo,float hi){f32x2_t v={lo,hi};bf16x2_t b=__builtin_convertvector(v,bf16x2_t);return __builtin_bit_cast(unsigned,b);}
#define WAIT_BAR(N) asm volatile("s_waitcnt vmcnt(" #N ") lgkmcnt(0)\n\ts_barrier":::"memory")

__device__ __forceinline__ void qkt(f32x16&p0,f32x16&p1,const char*Kslot,const bf16x8*qr,const f32x16&negm,int r32,int hi){
  const char*kb=Kslot+hi*1024+r32*16;
  #pragma unroll
  for(int d0=0;d0<4;++d0){
    const bf16x8 b0=*reinterpret_cast<const bf16x8*>(kb+d0*2048);
    const bf16x8 b1=*reinterpret_cast<const bf16x8*>(kb+d0*2048+512);
    if(d0==0){p0=__builtin_amdgcn_mfma_f32_32x32x16_bf16(b0,qr[0],negm,0,0,0);p1=__builtin_amdgcn_mfma_f32_32x32x16_bf16(b1,qr[0],negm,0,0,0);}
    else{p0=__builtin_amdgcn_mfma_f32_32x32x16_bf16(b0,qr[d0],p0,0,0,0);p1=__builtin_amdgcn_mfma_f32_32x32x16_bf16(b1,qr[d0],p1,0,0,0);}}
}
typedef __attribute__((address_space(3))) const char* lds_cptr;
typedef short v4i16_t __attribute__((ext_vector_type(4)));
__device__ __forceinline__ void kload8(bf16x8*kf,lds_cptr kp){
  kf[0]=*(const __attribute__((address_space(3))) bf16x8*)(kp);      kf[1]=*(const __attribute__((address_space(3))) bf16x8*)(kp+512);
  kf[2]=*(const __attribute__((address_space(3))) bf16x8*)(kp+2048); kf[3]=*(const __attribute__((address_space(3))) bf16x8*)(kp+2560);
  kf[4]=*(const __attribute__((address_space(3))) bf16x8*)(kp+4096); kf[5]=*(const __attribute__((address_space(3))) bf16x8*)(kp+4608);
  kf[6]=*(const __attribute__((address_space(3))) bf16x8*)(kp+6144); kf[7]=*(const __attribute__((address_space(3))) bf16x8*)(kp+6656);
}
__device__ __forceinline__ void kload2(bf16x8*kf,lds_cptr kp,int j){ kf[2*j]=*(const __attribute__((address_space(3))) bf16x8*)(kp+j*2048); kf[2*j+1]=*(const __attribute__((address_space(3))) bf16x8*)(kp+j*2048+512); }
__device__ __forceinline__ s16x4 vtr(lds_cptr p){ return __builtin_bit_cast(s16x4,__builtin_amdgcn_ds_read_tr16_b64_v4i16((__attribute__((address_space(3))) v4i16_t*)p)); }
__device__ __forceinline__ float rowmax(const f32x16&p0,const f32x16&p1){
  float a=max3f(p0[0],p0[1],p1[0]),b=max3f(p0[2],p0[3],p1[1]);a=max3f(a,p1[2],p1[3]);
  #pragma unroll
  for(int r=4;r<16;r+=4){a=max3f(a,p0[r],p0[r+1]);b=max3f(b,p0[r+2],p0[r+3]);a=max3f(a,p1[r],p1[r+1]);b=max3f(b,p1[r+2],p1[r+3]);}
  const float m=max2f(a,b);
  auto rr=__builtin_amdgcn_permlane32_swap(__float_as_uint(m),__float_as_uint(m),false,false);
  return max2f(__uint_as_float(rr[0]),__uint_as_float(rr[1]));
}
__device__ __forceinline__ void pv(f32x16*o,int vb,bf16x8 pa0,bf16x8 pa1,bf16x8 pa2,bf16x8 pa3){
  #pragma unroll
  for(int d0=0;d0<2;++d0){s16x4 lo[4],hi[4];
    #pragma unroll
    for(int ks=0;ks<4;++ks){
      asm volatile("ds_read_b64_tr_b16 %0,%1 offset:%c2":"=&v"(lo[ks]):"v"(vb),"i"(d0*4096+ks*1024):"memory");
      asm volatile("ds_read_b64_tr_b16 %0,%1 offset:%c2":"=&v"(hi[ks]):"v"(vb),"i"(d0*4096+ks*1024+512):"memory");}
    asm volatile("s_waitcnt lgkmcnt(0)":::"memory");SBAR();
    #define PK(k) (bf16x8){lo[k][0],lo[k][1],lo[k][2],lo[k][3],hi[k][0],hi[k][1],hi[k][2],hi[k][3]}
    o[d0]=__builtin_amdgcn_mfma_f32_32x32x16_bf16(pa0,PK(0),o[d0],0,0,0);
    o[d0]=__builtin_amdgcn_mfma_f32_32x32x16_bf16(pa1,PK(1),o[d0],0,0,0);
    o[d0]=__builtin_amdgcn_mfma_f32_32x32x16_bf16(pa2,PK(2),o[d0],0,0,0);
    o[d0]=__builtin_amdgcn_mfma_f32_32x32x16_bf16(pa3,PK(3),o[d0],0,0,0);
    #undef PK
  }
}
template<int THRL> __device__ __forceinline__ void attn_unit(const bf16*Qw0,const bf16*__restrict__ Kh,const bf16*__restrict__ Vh,bf16*Ow0,const int NT,char*shm){
  const int tid=opaque_tid(),lane=tid&63,r32=lane&31,hi=lane>>5; const int wid=__builtin_amdgcn_readfirstlane(tid>>6);
  const bf16*Qw=Qw0+(long)wid*QBLK*QP;
  const unsigned lds0=(unsigned)(uintptr_t)shm;
  float*wsf=(float*)(shm+LDS_WS)+wid*64;
  const bf16*ksrc=Kh+(long)lane*KP+wid*8;
  const bf16*vsrc=Vh+(long)(16*(wid&3)+(lane>>2))*KP+(wid>>2)*32+(lane&3)*8;
  const unsigned kdst=lds0+LDS_K+wid*1024, vdst=lds0+LDS_V+wid*1024;
  #define DMA_K(t,slot) glds16(ksrc+(long)(t)*KVBLK*KP,(unsigned)__builtin_amdgcn_readfirstlane(kdst+(slot)))
  #define DMA_V(t,slot) glds16(vsrc+(long)(t)*KVBLK*KP,(unsigned)__builtin_amdgcn_readfirstlane(vdst+(slot)))
  const int vb0=(int)(lds0+LDS_V)+((lane>>4)&1)*32+(lane&3)*8+(4*hi+((lane&15)>>2))*64;
  const char*Kbase=shm+LDS_K; bf16x8 kf[8];
  const lds_cptr shm3=(lds_cptr)shm; const lds_cptr kp0=shm3+LDS_K+hi*1024+r32*16; const lds_cptr vp0=shm3+LDS_V+((lane>>4)&1)*32+(lane&3)*8+(4*hi+((lane&15)>>2))*64;
  DMA_K(0,0);DMA_V(0,0);DMA_K(1,SLOTB);
  bf16x8 qr[4];
  #pragma unroll
  for(int d0=0;d0<4;++d0)qr[d0]=*reinterpret_cast<const bf16x8*>(&Qw[(long)r32*QP+d0*16+hi*8]);
  float mhat=0.f,l_reg=0.f;f32x16 o[2];o[0]=f32x16{};o[1]=f32x16{};f32x16 negm=f32x16{};asm volatile("":"+v"(negm));
  #define CMASK(P0,P1,t) do{}while(0)
  bool resc=false;
  #define START(P0,P1) do{ const float rm=rowmax(P0,P1); resc=false; \
    { const float dl=rm; mhat=fadd_s(mhat,dl); \
      _Pragma("unroll") for(int r=0;r<16;++r){P0[r]=fsub_s(P0[r],dl);P1[r]=fsub_s(P1[r],dl);} \
      _Pragma("unroll") for(int r=0;r<16;++r)negm[r]=-mhat; asm volatile("":"+v"(negm)); } \
    _Pragma("unroll") for(int r=0;r<16;++r)P0[r]=__builtin_amdgcn_exp2f(P0[r]); }while(0)
  #define RESC() do{ if(resc){ asm volatile("s_waitcnt lgkmcnt(0)":::"memory"); \
      _Pragma("unroll") for(int d_=0;d_<2;++d_) _Pragma("unroll") for(int r=0;r<16;++r)o[d_][r]*=wsf[crow(r,hi)]; } }while(0)
  f32x16 pA0,pA1,pB0,pB1;
  int sl_prev=0,sl_cur=0,sl_next=SLOTB;
  #define ROT() do{sl_prev=sl_cur;sl_cur=sl_next;sl_next=(sl_next==(NSLOT-1)*SLOTB)?0:sl_next+SLOTB;}while(0)
  DMA_K(2,2*SLOTB);
  WAIT_BAR(3);
  qkt(pA0,pA1,Kbase,qr,negm,r32,hi);asm volatile("s_nop 15\n\ts_nop 7":"+v"(pA0),"+v"(pA1));CMASK(pA0,pA1,0);
  START(pA0,pA1);
  _Pragma("unroll") for(int r=0;r<16;++r)pA1[r]=__builtin_amdgcn_exp2f(pA1[r]);
  WAIT_BAR(0);
  DMA_K(3,0);DMA_V(1,SLOTB);
  ROT();
  kload8(kf,kp0+sl_cur);
  WAIT_BAR(2);
  s16x4 vlo[8],vhi[8]; u32x4 pw0,pw1,pw2,pw3;
  #define PKW(P,B) cvtpk_s(P[B],P[B+1])
  #define PAF(k) __builtin_bit_cast(bf16x8,pw##k)
  #define VFR(i) (bf16x8){vlo[i][0],vlo[i][1],vlo[i][2],vlo[i][3],vhi[i][0],vhi[i][1],vhi[i][2],vhi[i][3]}
  #define PIN(x) asm volatile("":"+v"(x))
  #define MX3(a,b,c) __builtin_fmaxf(__builtin_fmaxf((a),(b)),(c))
  #define GAPA(MF,A0,A1,A2,A3,W0,W1,PW) do{ MF; sacc+=A0; sacc+=A1; sacc+=A2; sacc+=A3; PIN(sacc); W0; W1; PIN(PW); SBAR(); }while(0)
  #define EX(v) __builtin_amdgcn_exp2f(v)
  #define GAPB(MF,X,B) do{ MF; X[B]=EX(X[B]); X[B+1]=EX(X[B+1]); X[B+2]=EX(X[B+2]); X[B+3]=EX(X[B+3]); PIN(X); SBAR(); }while(0)
  #define VRD(i) do{ vlo[i]=vtr(vp_+(((i)>>2)*4096+((i)&3)*1024)); vhi[i]=vtr(vp_+(((i)>>2)*4096+((i)&3)*1024+512)); }while(0)
  #define KRD(G,j) do{ if(G){ kload2(kf,kp0+sl_next,j); SBAR(); } }while(0)
  #define STEP(C0,C1,P0,P1,t,GK,GV,GL) do{ SBAR(); \
    const lds_cptr vp_=vp0+sl_prev; \
    VRD(0); SBAR(); float sacc=(P0[0]+P0[1]); \
    GAPA(C0=__builtin_amdgcn_mfma_f32_32x32x16_bf16(kf[0],qr[0],negm,0,0,0), P0[2],P0[3],P0[4],P0[5],     pw0[0]=PKW(P0,0), pw0[1]=PKW(P0,2), pw0); \
    VRD(4); SBAR(); GAPA(C1=__builtin_amdgcn_mfma_f32_32x32x16_bf16(kf[1],qr[0],negm,0,0,0), P0[6],P0[7],P0[8],P0[9],     pw0[2]=PKW(P0,4), pw0[3]=PKW(P0,6), pw0); \
    VRD(1); SBAR(); GAPA(C0=__builtin_amdgcn_mfma_f32_32x32x16_bf16(kf[2],qr[1],C0,0,0,0),   P0[10],P0[11],P0[12],P0[13], pw1[0]=PKW(P0,8), pw1[1]=PKW(P0,10), pw1); \
    VRD(5); SBAR(); GAPA(C1=__builtin_amdgcn_mfma_f32_32x32x16_bf16(kf[3],qr[1],C1,0,0,0),   P0[14],P0[15],P1[0],P1[1],   pw1[2]=PKW(P0,12),pw1[3]=PKW(P0,14), pw1); \
    VRD(2); SBAR(); GAPA(C0=__builtin_amdgcn_mfma_f32_32x32x16_bf16(kf[4],qr[2],C0,0,0,0),   P1[2],P1[3],P1[4],P1[5],     pw2[0]=PKW(P1,0), pw2[1]=PKW(P1,2), pw2); \
    VRD(6); SBAR(); GAPA(C1=__builtin_amdgcn_mfma_f32_32x32x16_bf16(kf[5],qr[2],C1,0,0,0),   P1[6],P1[7],P1[8],P1[9],     pw2[2]=PKW(P1,4), pw2[3]=PKW(P1,6), pw2); \
    VRD(3); SBAR(); GAPA(C0=__builtin_amdgcn_mfma_f32_32x32x16_bf16(kf[6],qr[3],C0,0,0,0),   P1[10],P1[11],P1[12],P1[13], pw3[0]=PKW(P1,8), pw3[1]=PKW(P1,10), pw3); \
    VRD(7); SBAR(); GAPA(C1=__builtin_amdgcn_mfma_f32_32x32x16_bf16(kf[7],qr[3],C1,0,0,0),   P1[14],P1[15],0.f,0.f,       pw3[2]=PKW(P1,12),pw3[3]=PKW(P1,14), pw3); \
    l_reg+=sacc; \
    if(GK){DMA_K((t)+3,sl_cur);} if(GV){DMA_V((t)+1,sl_next);} \
    CMASK(C0,C1,t); \
    { float a=MX3(C0[0],C0[1],C1[0]),b=MX3(C0[2],C0[3],C1[1]); a=MX3(a,C1[2],C1[3]); \
      _Pragma("unroll") for(int r=4;r<16;r+=4){a=MX3(a,C0[r],C0[r+1]);b=MX3(b,C0[r+2],C0[r+3]);a=MX3(a,C1[r],C1[r+1]);b=MX3(b,C1[r+2],C1[r+3]);} \
      float rm=__builtin_fmaxf(a,b); { auto rr=__builtin_amdgcn_permlane32_swap(__float_as_uint(rm),__float_as_uint(rm),false,false); rm=__builtin_fmaxf(__uint_as_float(rr[0]),__uint_as_float(rr[1])); } \
      resc=false; \
      if(__builtin_expect(__any(rm>(float)THRL),0)){ const float dl=__builtin_fmaxf(rm,0.f); mhat+=dl; \
        _Pragma("unroll") for(int r=0;r<16;++r){C0[r]-=dl;C1[r]-=dl;} \
        _Pragma("unroll") for(int r=0;r<16;++r)negm[r]=-mhat; asm volatile("":"+v"(negm)); \
        const float f=__builtin_amdgcn_exp2f(-dl); l_reg*=f; if(hi==0)wsf[r32]=f; resc=true; } } \
    SBAR(); \
    GAPB(o[0]=__builtin_amdgcn_mfma_f32_32x32x16_bf16(PAF(0),VFR(0),o[0],0,0,0), C0,0); \
    GAPB(o[1]=__builtin_amdgcn_mfma_f32_32x32x16_bf16(PAF(0),VFR(4),o[1],0,0,0), C0,4); \
    KRD(GL,0); GAPB(o[0]=__builtin_amdgcn_mfma_f32_32x32x16_bf16(PAF(1),VFR(1),o[0],0,0,0), C0,8); \
    KRD(GL,1); GAPB(o[1]=__builtin_amdgcn_mfma_f32_32x32x16_bf16(PAF(1),VFR(5),o[1],0,0,0), C0,12); \
    KRD(GL,2); GAPB(o[0]=__builtin_amdgcn_mfma_f32_32x32x16_bf16(PAF(2),VFR(2),o[0],0,0,0), C1,0); \
    KRD(GL,3); GAPB(o[1]=__builtin_amdgcn_mfma_f32_32x32x16_bf16(PAF(2),VFR(6),o[1],0,0,0), C1,4); \
    GAPB(o[0]=__builtin_amdgcn_mfma_f32_32x32x16_bf16(PAF(3),VFR(3),o[0],0,0,0), C1,8); \
    GAPB(o[1]=__builtin_amdgcn_mfma_f32_32x32x16_bf16(PAF(3),VFR(7),o[1],0,0,0), C1,12); \
    }while(0)
  int t=1;
  #undef CMASK
  #define CMASK(P0,P1,t) do{}while(0)
  for(;t+5<NT;t+=2){
    STEP(pB0,pB1,pA0,pA1,t,true,true,true);     WAIT_BAR(2); RESC(); ROT();
    STEP(pA0,pA1,pB0,pB1,t+1,true,true,true);   WAIT_BAR(2); RESC(); ROT();
  }
  #undef CMASK
  #define CMASK(P0,P1,t) do{}while(0)
  #define ENDW(tt) do{ if((tt)+3<NT){WAIT_BAR(2);} else if((tt)+2<NT){WAIT_BAR(1);} else {WAIT_BAR(0);} }while(0)
  for(;t+1<NT;t+=2){
    STEP(pB0,pB1,pA0,pA1,t,(t+3<NT),(t+1<NT),(t+1<NT));       ENDW(t);   RESC(); ROT();
    STEP(pA0,pA1,pB0,pB1,t+1,(t+4<NT),(t+2<NT),(t+2<NT));     ENDW(t+1); RESC(); ROT();
  }
  STEP(pB0,pB1,pA0,pA1,NT-1,false,false,false); RESC();
  { float sacc=pB0[0]+pB0[1]; _Pragma("unroll") for(int r=2;r<16;++r)sacc+=pB0[r]; _Pragma("unroll") for(int r=0;r<16;++r)sacc+=pB1[r]; l_reg+=sacc;
    pw0=(u32x4){PKW(pB0,0),PKW(pB0,2),PKW(pB0,4),PKW(pB0,6)};pw1=(u32x4){PKW(pB0,8),PKW(pB0,10),PKW(pB0,12),PKW(pB0,14)};pw2=(u32x4){PKW(pB1,0),PKW(pB1,2),PKW(pB1,4),PKW(pB1,6)};pw3=(u32x4){PKW(pB1,8),PKW(pB1,10),PKW(pB1,12),PKW(pB1,14)};
    SBAR(); pv(o,vb0+sl_cur,PAF(0),PAF(1),PAF(2),PAF(3)); }
  #undef PKW
  #undef PAF
  #undef VFR
  #undef PIN
  #undef MX3
  #undef GAPA
  #undef GAPB
  #undef EX
  #undef VRD
  #undef KRD
  #undef STEP
  #undef ENDW
  {auto rr=__builtin_amdgcn_permlane32_swap(__float_as_uint(l_reg),__float_as_uint(l_reg),false,false);l_reg=__uint_as_float(rr[0])+__uint_as_float(rr[1]);}
  if(hi==0)wsf[32+r32]=l_reg;asm volatile("s_waitcnt lgkmcnt(0)":::"memory");
  float rli[16];
  #pragma unroll
  for(int r=0;r<16;++r)rli[r]=__builtin_amdgcn_rcpf(wsf[32+crow(r,hi)]);
  bf16*Ow=Ow0+(long)wid*QBLK*OP;
  { bf16*stg=(bf16*)(shm+LDS_OST)+wid*2048;
    #pragma unroll
    for(int r=0;r<16;++r){const int orow=crow(r,hi);
      #pragma unroll
      for(int d0=0;d0<2;++d0)stg[orow*64+d0*32+r32]=__float2bfloat16(o[d0][r]*rli[r]);}
    asm volatile("s_waitcnt lgkmcnt(0)":::"memory");
    #pragma unroll
    for(int i=0;i<4;++i){const int row=i*8+(lane>>3),ch=lane&7; const u32x4 v=*(const u32x4*)(stg+row*64+ch*8); ATTN_STORE16(Ow+(long)row*OP+ch*8,v);} }
  asm volatile("s_waitcnt lgkmcnt(0)\n\ts_barrier":::"memory");
  #undef DMA_K
  #undef DMA_V
  #undef CMASK
  #undef START
  #undef RESC
  #undef ROT
}

#undef SBAR
#undef WAIT_BAR
}

typedef short bf16x8_t __attribute__((ext_vector_type(8)));
#define LDS_WAIT() asm volatile("s_waitcnt lgkmcnt(0)" ::: "memory")

__device__ __forceinline__ int inv32(int c) { return 16 * ((c >> 2) & 1) + 4 * (c >> 3) + (c & 3); }
__device__ __forceinline__ int dest_row(int type, int n) {
    if (type == 0) return n;
    if (type == 1) { const int half = n >= DFF ? 1 : 0, j = n - half * DFF, pn = j >> 7, c = j & 127; return pn * 256 + half * 128 + (c & ~31) + inv32(c & 31); }
    if (n < 768) { const int hd = n >> 6, d = n & 63, a = d >> 5, t = (d >> 4) & 1, p = d & 15; return (hd >> 2) * 256 + a * 128 + (hd & 3) * 32 + t * 16 + p; }
    const int pn = n >> 8, c = n & 255, half = c >> 7, c7 = c & 127; return pn * 256 + half * 128 + (c7 & ~31) + inv32(c7 & 31);
}
__device__ __forceinline__ void transpose_item(const float* W, int K, int N, bf16_t* WT, int type, LAS float* scr, int item, int lane) {
    const int nblk = N / 32, kb = item / nblk, nb = item % nblk, k0 = 64 * kb, n0 = 32 * nb;
#pragma unroll 8
    for (int i = 0; i < 32; ++i) { const int kk = 2 * i + (lane >> 5); scr[kk * 33 + (lane & 31)] = W[(size_t)(k0 + kk) * N + n0 + (lane & 31)]; }
    LDS_WAIT(); asm volatile("" ::: "memory");
    const int c = lane & 7;
#pragma unroll
    for (int j = 0; j < 4; ++j) { const int n = (lane >> 3) + 8 * j; const LAS float* s = scr + (8 * c) * 33 + n;
        u32x4 o; o.x = cvt_pk(s[0 * 33], s[1 * 33]); o.y = cvt_pk(s[2 * 33], s[3 * 33]); o.z = cvt_pk(s[4 * 33], s[5 * 33]); o.w = cvt_pk(s[6 * 33], s[7 * 33]);
        *(u32x4*)(WT + (size_t)dest_row(type, n0 + n) * K + k0 + 8 * c) = o; }
    LDS_WAIT(); asm volatile("" ::: "memory");
}

__device__ __forceinline__ void prologue_phase(const Params& P, LAS unsigned char* lds, int G) {
    const int tid = opaque_tid(), lane = tid & 63, wid = __builtin_amdgcn_readfirstlane(tid >> 6), bid = blockIdx.x;
    unsigned char* ws = P.ws;
    {
        LAS float* sc = (LAS float*)lds;
        LAS float* red = (LAS float*)(lds + 36864);
        for (int i = tid; i < 9 * 1024; i += NTHREADS) { const int v = i >> 10, k = i & 1023; const float cv = v < 8 ? P.in[1][v * 1024 + k] : P.in[3][k]; sc[i] = cv / (1.0f + expf(-cv)); }
        __syncthreads();
        float* mod = (float*)(ws + OFF_MOD);
        for (int item = bid; item < 2 * 144; item += G) {
            const int l = item / 144, cgp = item % 144, col = cgp * 64 + lane, kc = wid;
            const float* W = P.in[4] + (size_t)l * 1024 * MODW + col;
            float acc[9];
#pragma unroll
            for (int v = 0; v < 9; ++v) acc[v] = 0.f;
#pragma unroll 8
            for (int k = kc * 128; k < kc * 128 + 128; ++k) { const float w = W[(size_t)k * MODW];
#pragma unroll
                for (int v = 0; v < 9; ++v) acc[v] += sc[v * 1024 + k] * w; }
#pragma unroll
            for (int v = 0; v < 9; ++v) red[(kc * 9 + v) * 64 + lane] = acc[v];
            __syncthreads();
            for (int i = tid; i < 576; i += NTHREADS) { const int v = i >> 6, cc = i & 63; float s = 0.f;
#pragma unroll
                for (int q = 0; q < 8; ++q) s += red[(q * 9 + v) * 64 + cc];
                mod[(size_t)(l * 9 + v) * MODW + cgp * 64 + cc] = s + P.in[5][l * MODW + cgp * 64 + cc]; }
            __syncthreads();
        }
    }
    __syncthreads();
    {
        LAS float* scr = (LAS float*)(lds + wid * 16384);
        const int gw = bid * 8 + wid, NGW = G * 8;
        constexpr int I_FI = 16 * (NFF2 / 32), I_FO = (DFF / 64) * 32, I_WI = 16 * (INW / 32), I_WO = 16 * 32;
        constexpr int PER_L = 2 * I_FI + 2 * I_FO + I_WI + I_WO;
        for (int it = gw; it < DEPTH * PER_L; it += NGW) {
            const int l = it / PER_L; int r = it % PER_L;
            unsigned char* wb = ws + OFF_WB + (size_t)l * WB_LAYER;
            if (r < 2 * I_FI) { const int f = r / I_FI; transpose_item(P.in[7] + (size_t)(l * 2 + f) * DM * NFF2, DM, NFF2, (bf16_t*)(wb + WB_FFIN + f * WB_FFIN_SZ), 1, scr, r % I_FI, lane); continue; } r -= 2 * I_FI;
            if (r < 2 * I_FO) { const int f = r / I_FO; transpose_item(P.in[8] + (size_t)(l * 2 + f) * DFF * DM, DFF, DM, (bf16_t*)(wb + WB_FFOUT + f * WB_FFOUT_SZ), 0, scr, r % I_FO, lane); continue; } r -= 2 * I_FO;
            if (r < I_WI) { transpose_item(P.in[9] + (size_t)l * DM * INW, DM, INW, (bf16_t*)(wb + WB_WIN), 2, scr, r, lane); continue; } r -= I_WI;
            transpose_item(P.in[22] + (size_t)l * DM * DM, DM, DM, (bf16_t*)(wb + WB_WOUT), 0, scr, r, lane);
        }
        bf16_t* LW = (bf16_t*)(ws + OFF_LW);
        const int gt = bid * NTHREADS + tid, NGT = G * NTHREADS;
        for (int i = gt; i < DEPTH * 4 * 256 * 64; i += NGT) {
            const int d = i & 63, c = (i >> 6) & 255, g = (i >> 14) & 3, l = i >> 16, n = c >> 6, e = c & 63;
            const float* src = (g & 1) ? P.in[16] : P.in[14];
            const float v = src[((((size_t)l * 2 + (g >> 1)) * 4 + n) * 64 + d) * 64 + e];
            LW[i] = (bf16_t)(cvt_pk(v, 0.f) & 0xffffu);
        }
        float* rc = (float*)(ws + OFF_ROPE); float* rs = rc + 2048;
        for (int i = gt; i < 2048; i += NGT) { const int pos = i >> 4, p = i & 15; const float inv = powf(10000.0f, -(float)p / 16.0f), ang = (float)pos * inv; rc[i] = cosf(ang); rs[i] = sinf(ang); }
    }
}

__device__ __forceinline__ void norm_phase(const Params& P, int l, int idx, int Mrows, bool first, int G) {
    const int tid = opaque_tid(), lane = tid & 63, wid = __builtin_amdgcn_readfirstlane(tid >> 6);
    const int gw = blockIdx.x * 8 + wid, NGW = G * 8, per = (Mrows + NGW - 1) / NGW;
    const int r0 = gw * per, r1 = (r0 + per < Mrows) ? r0 + per : Mrows;
    const float* mod = (const float*)(P.ws + OFF_MOD) + (size_t)l * 9 * MODW;
    const float* gsrc = P.in[6] + (size_t)(l * 3 + idx) * DM;
    float* xres = (float*)(P.ws + OFF_XRES); bf16_t* hb = (bf16_t*)(P.ws + OFF_HBUF);
    int curv = -1; f32x4 Aa[4], Bb[4];
    for (int row = r0; row < r1; ++row) {
        const int v = row < MLAT ? (row >> 13) : 8;
        if (v != curv) { curv = v;
#pragma unroll
            for (int j = 0; j < 4; ++j) { const int c = 4 * lane + 256 * j; const f32x4 g4 = *(const f32x4*)(gsrc + c), sh = *(const f32x4*)(mod + (size_t)v * MODW + (3 * idx) * DM + c), sc = *(const f32x4*)(mod + (size_t)v * MODW + (3 * idx + 1) * DM + c);
                Aa[j] = g4 * (sc + 1.0f); Bb[j] = sh; } }
        const float* xr = first ? (row < MLAT ? P.in[0] + (size_t)row * DM : P.in[2] + (size_t)(row - MLAT) * DM) : xres + (size_t)row * DM;
        f32x4 x[4]; float ss = 0.f;
#pragma unroll
        for (int j = 0; j < 4; ++j) { x[j] = *(const f32x4*)(xr + 4 * lane + 256 * j); ss += (x[j][0] * x[j][0] + x[j][1] * x[j][1]) + (x[j][2] * x[j][2] + x[j][3] * x[j][3]); }
        const float rstd = 1.0f / sqrtf(wave_sum(ss) * (1.0f / DM) + EPS);
#pragma unroll
        for (int j = 0; j < 4; ++j) { const f32x4 y = x[j] * rstd * Aa[j] + Bb[j]; u32x2 w; w.x = cvt_pk(y[0], y[1]); w.y = cvt_pk(y[2], y[3]);
            *(u32x2*)(hb + (size_t)row * DM + 4 * lane + 256 * j) = w;
            if (first) *(f32x4*)(xres + (size_t)row * DM + 4 * lane + 256 * j) = x[j]; }
    }
}
__device__ __forceinline__ void final_norm_phase(const Params& P, int G) {
    const int tid = opaque_tid(), lane = tid & 63, wid = __builtin_amdgcn_readfirstlane(tid >> 6);
    const int gw = blockIdx.x * 8 + wid, NGW = G * 8;
    const float* xres = (const float*)(P.ws + OFF_XRES);
    f32x4 g4[4];
#pragma unroll
    for (int j = 0; j < 4; ++j) g4[j] = *(const f32x4*)(P.in[23] + 4 * lane + 256 * j);
    for (int row = gw; row < MLAT; row += NGW) {
        f32x4 x[4]; float ss = 0.f;
#pragma unroll
        for (int j = 0; j < 4; ++j) { x[j] = *(const f32x4*)(xres + (size_t)row * DM + 4 * lane + 256 * j); ss += (x[j][0] * x[j][0] + x[j][1] * x[j][1]) + (x[j][2] * x[j][2] + x[j][3] * x[j][3]); }
        const float rstd = 1.0f / sqrtf(wave_sum(ss) * (1.0f / DM) + EPS);
#pragma unroll
        for (int j = 0; j < 4; ++j) *(f32x4*)(P.out + (size_t)row * DM + 4 * lane + 256 * j) = x[j] * rstd * g4[j];
    }
}

constexpr int L1_AST = 528;
constexpr int L1_UST = 260;
constexpr int L1_UOFF = 66560;
__device__ __forceinline__ void lru1_phase(const Params& P, int l, LAS unsigned char* lds, int G) {
    const int tid = opaque_tid(), lane = tid & 63, wid = __builtin_amdgcn_readfirstlane(tid >> 6), fr = lane & 15, fq = lane >> 4;
    LAS unsigned char* ldsA = lds; LAS float* ldsU = (LAS float*)(lds + L1_UOFF);
    const bf16_t* Ubuf = (const bf16_t*)(P.ws + OFF_U5);
    float* Sg = (float*)(P.ws + OFF_S); unsigned* PPg = (unsigned*)(P.ws + OFF_PP); float* csum = (float*)(P.ws + OFF_CSUM);
    const bf16_t* LW = (const bf16_t*)(P.ws + OFF_LW) + (size_t)l * 4 * 256 * 64;
    const int ch4 = (tid & 63) * 4, pg = tid >> 6;
    f32x4 cw[4], cbias;
#pragma unroll
    for (int i = 0; i < 4; ++i) cw[i] = *(const f32x4*)(P.in[12] + (size_t)(l * 4 + i) * 256 + ch4);
    cbias = *(const f32x4*)(P.in[13] + (size_t)l * 256 + ch4);
    const int nblk = wid >> 1;
    for (int tile = blockIdx.x; tile < NBATCH * NCHUNK; tile += G) {
        const int b = tile / NCHUNK, cidx = tile % NCHUNK, P0 = cidx * 64; const bool latent = cidx >= 4;
        const int seg_lo = latent ? 256 : 0, seg_hi = latent ? KEYS : 256;
        const int rbase = latent ? b * SEQ - 256 : MLAT + b * CTXL;
        {
            const int pp0 = P0 + pg * 8;
            f32x4 win[11];
#pragma unroll
            for (int i = 0; i < 11; ++i) { const int Pq = pp0 - 2 + i; f32x4 w4 = {0.f, 0.f, 0.f, 0.f};
                if (Pq >= seg_lo && Pq < seg_hi) { const u32x2 raw = *(const u32x2*)(Ubuf + (size_t)(rbase + Pq) * 256 + ch4); w4 = (f32x4){bf_lo(raw.x), bf_hi(raw.x), bf_lo(raw.y), bf_hi(raw.y)}; }
                win[i] = w4; }
#pragma unroll
            for (int q = 0; q < 8; ++q) { f32x4 y = cbias;
#pragma unroll
                for (int i = 0; i < 4; ++i) y = y + cw[i] * win[q + i];
                const int pos = pg * 8 + q;
                u32x2 w; w.x = cvt_pk(y[0], y[1]); w.y = cvt_pk(y[2], y[3]);
                *(LAS u32x2*)(ldsA + pos * L1_AST + ch4 * 2) = w;
                *(LAS f32x4*)(ldsU + pos * L1_UST + ch4) = y; }
        }
        __syncthreads();
#pragma unroll 1
        for (int cc = 0; cc < 2; ++cc) {
            const int c = 32 * wid + 16 * cc + fr;
            const float baf = P.in[15][(l * 2 + 0) * 256 + c], bab = P.in[15][(l * 2 + 1) * 256 + c], bxf = P.in[17][(l * 2 + 0) * 256 + c], bxb = P.in[17][(l * 2 + 1) * 256 + c];
            const float nspf = -8.0f * log1pf(expf(-P.in[18][(l * 2 + 0) * 256 + c])), nspb = -8.0f * log1pf(expf(-P.in[18][(l * 2 + 1) * 256 + c]));
            f32x4 acc[4][4];
            {
                bf16x8_t bw[4][2];
#pragma unroll
                for (int g = 0; g < 4; ++g)
#pragma unroll
                    for (int kk = 0; kk < 2; ++kk) bw[g][kk] = *(const bf16x8_t*)(LW + ((size_t)(g * 256 + c) * 64 + kk * 32 + fq * 8));
#pragma unroll
                for (int m = 0; m < 4; ++m) {
#pragma unroll
                    for (int g = 0; g < 4; ++g) acc[m][g] = (f32x4){0.f, 0.f, 0.f, 0.f};
#pragma unroll
                    for (int kk = 0; kk < 2; ++kk) { const bf16x8_t a = *(const LAS bf16x8_t*)(ldsA + (16 * m + fr) * L1_AST + (64 * nblk + 32 * kk + 8 * fq) * 2);
#pragma unroll
                        for (int g = 0; g < 4; ++g) acc[m][g] = __builtin_amdgcn_mfma_f32_16x16x32_bf16(a, bw[g][kk], acc[m][g], 0, 0, 0); }
                }
            }
#pragma unroll
            for (int m = 0; m < 4; ++m)
#pragma unroll
                for (int j = 0; j < 4; ++j) {
                    const float u = ldsU[(16 * m + 4 * fq + j) * L1_UST + c];
                    {   const float r = sigmoidf_(acc[m][0][j] + baf), ig = sigmoidf_(acc[m][1][j] + bxf);
                        const float la = nspf * r, a = __expf(la), y = 2.0f * la;
                        const float em = (y > -0.1f) ? y * (1.0f + y * (0.5f + y * (0.16666667f + y * 0.041666668f))) : (__expf(y) - 1.0f);
                        acc[m][0][j] = a; acc[m][1][j] = sqrtf(-em) * ig * u; }
                    {   const float r = sigmoidf_(acc[m][2][j] + bab), ig = sigmoidf_(acc[m][3][j] + bxb);
                        const float la = nspb * r, a = __expf(la), y = 2.0f * la;
                        const float em = (y > -0.1f) ? y * (1.0f + y * (0.5f + y * (0.16666667f + y * 0.041666668f))) : (__expf(y) - 1.0f);
                        acc[m][2][j] = a; acc[m][3][j] = sqrtf(-em) * ig * u; }
                }
            f32x4 hf[4], pf[4];
            {
                float cA = 1.f, cH = 0.f;
#pragma unroll
                for (int m = 0; m < 4; ++m) {
                    const f32x4 a = acc[m][0], x = acc[m][1];
                    const float A0 = a[0], H0 = x[0], A1 = A0 * a[1], H1 = a[1] * H0 + x[1], A2 = A1 * a[2], H2 = a[2] * H1 + x[2], A3 = A2 * a[3], H3 = a[3] * H2 + x[3];
                    float TA = A3, TH = H3;
                    float tA = __shfl_up(TA, 16), tH = __shfl_up(TH, 16); if (fq >= 1) { TH = TA * tH + TH; TA = TA * tA; }
                    tA = __shfl_up(TA, 32); tH = __shfl_up(TH, 32); if (fq >= 2) { TH = TA * tH + TH; TA = TA * tA; }
                    float EA = __shfl_up(TA, 16), EH = __shfl_up(TH, 16); if (fq == 0) { EA = 1.f; EH = 0.f; }
                    const float inA = cA * EA, inH = EA * cH + EH;
                    pf[m] = (f32x4){inA * A0, inA * A1, inA * A2, inA * A3};
                    hf[m] = (f32x4){A0 * inH + H0, A1 * inH + H1, A2 * inH + H2, A3 * inH + H3};
                    const float gA = __shfl(TA, fr + 48), gH = __shfl(TH, fr + 48);
                    cH = gA * cH + gH; cA = cA * gA;
                }
                if (fq == 0) { float* cs = csum + ((size_t)(b * NCHUNK + cidx) * 2 + 0) * 512 + c; cs[0] = cA; cs[256] = cH; }
            }
            {
                float cA = 1.f, cH = 0.f;
#pragma unroll
                for (int mm = 0; mm < 4; ++mm) { const int m = 3 - mm;
                    const f32x4 a = acc[m][2], x = acc[m][3];
                    const float A3 = a[3], H3 = x[3], A2 = A3 * a[2], H2 = a[2] * H3 + x[2], A1 = A2 * a[1], H1 = a[1] * H2 + x[1], A0 = A1 * a[0], H0 = a[0] * H1 + x[0];
                    float TA = A0, TH = H0;
                    float tA = __shfl_down(TA, 16), tH = __shfl_down(TH, 16); if (fq <= 2) { TH = TA * tH + TH; TA = TA * tA; }
                    tA = __shfl_down(TA, 32); tH = __shfl_down(TH, 32); if (fq <= 1) { TH = TA * tH + TH; TA = TA * tA; }
                    float EA = __shfl_down(TA, 16), EH = __shfl_down(TH, 16); if (fq == 3) { EA = 1.f; EH = 0.f; }
                    const float inA = cA * EA, inH = EA * cH + EH;
                    const f32x4 pb = (f32x4){inA * A0, inA * A1, inA * A2, inA * A3};
                    const f32x4 hb = (f32x4){A0 * inH + H0, A1 * inH + H1, A2 * inH + H2, A3 * inH + H3};
#pragma unroll
                    for (int j = 0; j < 4; ++j) { const int tk = 16 * m + 4 * fq + j;
                        ldsU[tk * L1_UST + c] = hf[m][j] + hb[j];
                        PPg[(size_t)(rbase + P0 + tk) * 256 + c] = (cvt_pk(pf[m][j], 0.f) & 0xffffu) | (cvt_pk(0.f, pb[j]) & 0xffff0000u); }
                    const float gA = __shfl(TA, fr), gH = __shfl(TH, fr);
                    cH = gA * cH + gH; cA = cA * gA;
                }
                if (fq == 0) { float* cs = csum + ((size_t)(b * NCHUNK + cidx) * 2 + 1) * 512 + c; cs[0] = cA; cs[256] = cH; }
            }
        }
        __syncthreads();
#pragma unroll
        for (int it = 0; it < 8; ++it) { const int idx = it * NTHREADS + tid, r = idx >> 6, c16 = idx & 63; const size_t grow = (size_t)(rbase + P0 + r) * 256 + c16 * 4;
            *(f32x4*)(Sg + grow) = *(const LAS f32x4*)(ldsU + r * L1_UST + c16 * 4);
 }
        __syncthreads();
    }
}
__device__ __forceinline__ void lru2_batch(const Params& P, int b) {
    const int tid = opaque_tid(), dir = tid >> 8, c = tid & 255;
    const float* csum = (const float*)(P.ws + OFF_CSUM); float* carry = (float*)(P.ws + OFF_CARRY);
    float h = 0.f;
#pragma unroll 1
    for (int k0 = 0; k0 < NCHUNK; k0 += 12) {
        float A[12], H[12]; int ci[12];
#pragma unroll
        for (int q = 0; q < 12; ++q) { const int k = k0 + q; ci[q] = dir == 0 ? k : (k < 4 ? 3 - k : 135 - k);
            const float* cs = csum + ((size_t)(b * NCHUNK + ci[q]) * 2 + dir) * 512 + c; A[q] = cs[0]; H[q] = cs[256]; }
#pragma unroll
        for (int q = 0; q < 12; ++q) { carry[((size_t)(b * NCHUNK + ci[q]) * 2 + dir) * 256 + c] = h; h = A[q] * h + H[q]; }
    }
}
__device__ __forceinline__ float gelu_tanh(float x) { const float z = 0.7978845608f * (x + 0.044715f * x * x * x); const float t = 1.0f - 2.0f * __builtin_amdgcn_rcpf(1.0f + __expf(2.0f * z)); return 0.5f * x * (1.0f + t); }
__device__ __forceinline__ void merge_phase(const Params& P, int l, int Mrows, int G) {
    const int tid = opaque_tid(), lane = tid & 63, wid = __builtin_amdgcn_readfirstlane(tid >> 6);
    const int gw = blockIdx.x * 8 + wid, NGW = G * 8, nruns = Mrows / 8, c4 = 4 * lane;
    const bf16_t* U5 = (const bf16_t*)(P.ws + OFF_U5);
    const bf16_t *Gb = U5 + U5_STRIDE, *BGb = U5 + 2 * U5_STRIDE, *CGb = U5 + 3 * U5_STRIDE, *SSb = U5 + 4 * U5_STRIDE;
    const float* Sg = (const float*)(P.ws + OFF_S); const unsigned* PPg = (const unsigned*)(P.ws + OFF_PP); const float* carry = (const float*)(P.ws + OFF_CARRY);
    bf16_t* hb = (bf16_t*)(P.ws + OFF_HBUF); const bf16_t* att = (const bf16_t*)(P.ws + OFF_ATT);
    f32x4 w0 = *(const f32x4*)(P.in[19] + (size_t)(l * 3 + 0) * 256 + c4), w1 = *(const f32x4*)(P.in[19] + (size_t)(l * 3 + 1) * 256 + c4), w2 = *(const f32x4*)(P.in[19] + (size_t)(l * 3 + 2) * 256 + c4);
    f32x4 cb4 = *(const f32x4*)(P.in[20] + (size_t)l * 256 + c4);
    const float* gg = P.in[21] + (size_t)l * 1024;
    const f32x4 ga0 = *(const f32x4*)(gg + 8 * lane), ga1 = *(const f32x4*)(gg + 8 * lane + 4), gl = *(const f32x4*)(gg + 512 + c4), gs = *(const f32x4*)(gg + 768 + c4);
    for (int run = gw; run < nruns; run += NGW) {
        const int row0 = run * 8; int b, cidx; bool seg_first, seg_last;
        if (row0 < MLAT) { b = row0 >> 13; const int s0 = row0 & 8191; cidx = 4 + (s0 >> 6); seg_first = s0 == 0; seg_last = s0 + 8 == SEQ; }
        else { const int rc = row0 - MLAT; b = rc >> 8; const int j0 = rc & 255; cidx = j0 >> 6; seg_first = j0 == 0; seg_last = j0 + 8 == CTXL; }
        const f32x4 cf = *(const f32x4*)(carry + ((size_t)(b * NCHUNK + cidx) * 2 + 0) * 256 + c4), cbk = *(const f32x4*)(carry + ((size_t)(b * NCHUNK + cidx) * 2 + 1) * 256 + c4);
        f32x4 prod[10];
#pragma unroll
        for (int i = 0; i < 10; ++i) { f32x4 p4 = {0.f, 0.f, 0.f, 0.f};
            if (!((i == 0 && seg_first) || (i == 9 && seg_last))) { const size_t o = (size_t)(row0 - 1 + i) * 256 + c4; const u32x2 a = *(const u32x2*)(CGb + o), s = *(const u32x2*)(SSb + o);
                p4 = (f32x4){bf_lo(a.x) * bf_lo(s.x), bf_hi(a.x) * bf_hi(s.x), bf_lo(a.y) * bf_lo(s.y), bf_hi(a.y) * bf_hi(s.y)}; }
            prod[i] = p4; }
#pragma unroll
        for (int i = 0; i < 8; ++i) { const int row = row0 + i; const size_t o = (size_t)row * 256 + c4;
            const f32x4 S4 = *(const f32x4*)(Sg + o); const u32x4 pp = *(const u32x4*)(PPg + o);
            const u32x2 g2 = *(const u32x2*)(Gb + o), bg2 = *(const u32x2*)(BGb + o);
            const u32x4 at = *(const u32x4*)(att + (size_t)row * 512 + 8 * lane);
            f32x4 hv;
#pragma unroll
            for (int j = 0; j < 4; ++j) hv[j] = S4[j] + bf_lo(pp[j]) * cf[j] + bf_hi(pp[j]) * cbk[j];
            const f32x4 g4 = (f32x4){bf_lo(g2.x), bf_hi(g2.x), bf_lo(g2.y), bf_hi(g2.y)}, bg4 = (f32x4){bf_lo(bg2.x), bf_hi(bg2.x), bf_lo(bg2.y), bf_hi(bg2.y)};
            f32x4 lru, scv;
#pragma unroll
            for (int j = 0; j < 4; ++j) { lru[j] = hv[j] * gelu_tanh(g4[j]); scv[j] = bg4[j] * (w0[j] * prod[i][j] + w1[j] * prod[i + 1][j] + w2[j] * prod[i + 2][j] + cb4[j]); }
            float av[8];
#pragma unroll
            for (int j = 0; j < 4; ++j) { av[2 * j] = bf_lo(at[j]); av[2 * j + 1] = bf_hi(at[j]); }
            float ssa = 0.f, ssl = 0.f, sss = 0.f;
#pragma unroll
            for (int j = 0; j < 8; ++j) ssa += av[j] * av[j];
#pragma unroll
            for (int j = 0; j < 4; ++j) { ssl += lru[j] * lru[j]; sss += scv[j] * scv[j]; }
            ssa = wave_sum(ssa); ssl = wave_sum(ssl); sss = wave_sum(sss);
            const float ra = 1.0f / sqrtf(ssa * (1.0f / 512.0f) + EPS), rl = 1.0f / sqrtf(ssl * (1.0f / 256.0f) + EPS), rs = 1.0f / sqrtf(sss * (1.0f / 256.0f) + EPS);
            u32x4 wa; wa.x = cvt_pk(av[0] * ra * ga0[0], av[1] * ra * ga0[1]); wa.y = cvt_pk(av[2] * ra * ga0[2], av[3] * ra * ga0[3]); wa.z = cvt_pk(av[4] * ra * ga1[0], av[5] * ra * ga1[1]); wa.w = cvt_pk(av[6] * ra * ga1[2], av[7] * ra * ga1[3]);
            *(u32x4*)(hb + (size_t)row * DM + 8 * lane) = wa;
            u32x2 wl; wl.x = cvt_pk(lru[0] * rl * gl[0], lru[1] * rl * gl[1]); wl.y = cvt_pk(lru[2] * rl * gl[2], lru[3] * rl * gl[3]);
            *(u32x2*)(hb + (size_t)row * DM + 512 + c4) = wl;
            u32x2 wsv; wsv.x = cvt_pk(scv[0] * rs * gs[0], scv[1] * rs * gs[1]); wsv.y = cvt_pk(scv[2] * rs * gs[2], scv[3] * rs * gs[3]);
            *(u32x2*)(hb + (size_t)row * DM + 768 + c4) = wsv;
        }
    }
}
__device__ __forceinline__ void attention_phase(const Params& P, int l, char* lds, int G) {
    using abf = attn_body::bf16;
    const abf* Q = (const abf*)(P.ws + OFF_Q); const abf* K = (const abf*)(P.ws + OFF_K); const abf* V = (const abf*)(P.ws + OFF_V); abf* O = (abf*)(P.ws + OFF_ATT);
    if (blockIdx.x < NBATCH) lru2_batch(P, blockIdx.x);
    const int nunits = NBATCH * 8 * 32 + ((l + 1 < DEPTH) ? NBATCH * 8 : 0);
    for (int uid = blockIdx.x; uid < nunits; uid += G) {
        int b, h, NT; size_t qrow;
        if (uid < NBATCH * 8 * 32) { b = uid & 7; const int rest = uid >> 3, kvh = rest >> 7, u = rest & 127; h = kvh * 4 + (u >> 5); qrow = (size_t)b * SEQ + (u & 31) * 256; NT = NCHUNK; }
        else { const int v = uid - NBATCH * 8 * 32; b = v & 7; h = v >> 3; qrow = (size_t)MLAT + b * CTXL; NT = 4; }
        const size_t kvoff = (size_t)b * KEYS * 128 + (h >> 2) * 64;
        attn_body::attn_unit<8>(Q + qrow * 512 + h * 64, K + kvoff, V + kvoff, O + qrow * 512 + h * 64, NT, lds);
    }
}

#define XB_TMO      128
#define XB_XCNT(j)  (256  + 64 * (j))
#define XB_XSUB(j)  (1280 + 64 * (j))
#define XB_XGEN(j)  (2304 + 64 * (j))
#define XB_TOP      3328
#define XB_TOPGEN   3392
#define XCD_BAR_WORDS 3456
#define XB_SPIN_CAP (1u << 18)

__device__ __forceinline__ unsigned xb_ld(unsigned* p)              { return __hip_atomic_load(p, __ATOMIC_RELAXED, __HIP_MEMORY_SCOPE_AGENT); }
__device__ __forceinline__ unsigned xb_add(unsigned* p, unsigned v) { return __hip_atomic_fetch_add(p, v, __ATOMIC_RELAXED, __HIP_MEMORY_SCOPE_AGENT); }
__device__ __forceinline__ unsigned xb_xcc_id() { return (unsigned)__builtin_amdgcn_s_getreg((3 << 11) | 20) & 0xFu; }
#define XB_SPIN(cond, bar) do { unsigned _sp = 0; while (cond) { __builtin_amdgcn_s_sleep(1); \
    if ((++_sp & 255u) == 0u) { if (xb_ld(&(bar)[XB_TMO])) break; if (_sp > XB_SPIN_CAP) { atomicAdd(&(bar)[XB_TMO], 1u); break; } } } } while (0)

struct XcdBarrier {
    unsigned* bar; unsigned x;
    volatile LAS unsigned* st;
};

__device__ __forceinline__ XcdBarrier xcd_barrier_post(unsigned* bar, volatile LAS unsigned* st) {
    XcdBarrier b; b.bar = bar; b.x = xb_xcc_id(); b.st = st;
    if (threadIdx.x == 0) (void)xb_add(&bar[XB_XCNT(b.x)], 1u);
    return b;
}
__device__ __forceinline__ void xcd_barrier_complete(unsigned* bar, unsigned x, unsigned& nloc, unsigned& nx) {
    const unsigned G = gridDim.x * gridDim.y * gridDim.z;
    unsigned sum, cnt, mine, sp = 0u;
    for (;;) {
        sum = 0u; cnt = 0u; mine = 0u;
#pragma unroll
        for (unsigned j = 0; j < 16; ++j) { const unsigned c = xb_ld(&bar[XB_XCNT(j)]); sum += c; cnt += (c > 0u) ? 1u : 0u; mine = (j == x) ? c : mine; }
        if (sum == G) break;
        __builtin_amdgcn_s_sleep(1);
        if ((++sp & 255u) == 0u) { if (xb_ld(&bar[XB_TMO])) break; if (sp > XB_SPIN_CAP) { atomicAdd(&bar[XB_TMO], 1u); break; } }
    }
    nloc = mine > 0u ? mine : 1u; nx = cnt > 0u ? cnt : 1u;
}

__device__ __forceinline__ void xcd_barrier(const XcdBarrier& b) {
    asm volatile("s_waitcnt vmcnt(0)" ::: "memory");
    __syncthreads();
    if (threadIdx.x == 0) {
        unsigned* bar = b.bar;
        __builtin_amdgcn_s_waitcnt(0);
        unsigned nloc = b.st[0], nx = b.st[1];
        if (nloc == 0u) { xcd_barrier_complete(bar, b.x, nloc, nx); b.st[0] = nloc; b.st[1] = nx; }
        const unsigned old = xb_add(&bar[XB_XSUB(b.x)], 1u);
        const unsigned gen = old / nloc;
        if (old + 1u == (gen + 1u) * nloc) {
            __builtin_amdgcn_fence(__ATOMIC_RELEASE, "agent");
            asm volatile("s_waitcnt vmcnt(0)" ::: "memory");
            const unsigned og = xb_add(&bar[XB_TOP], 1u);
            const unsigned tg = og / nx;
            if (og + 1u == (tg + 1u) * nx) xb_add(&bar[XB_TOPGEN], 1u);
            else XB_SPIN(xb_ld(&bar[XB_TOPGEN]) == tg, bar);
            __builtin_amdgcn_fence(__ATOMIC_ACQUIRE, "agent");
            xb_add(&bar[XB_XGEN(b.x)], 1u);
            asm volatile("s_waitcnt vmcnt(0)" ::: "memory");
        } else {
            XB_SPIN(xb_ld(&bar[XB_XGEN(b.x)]) == gen, bar);
            __builtin_amdgcn_fence(__ATOMIC_ACQUIRE, "agent");
            asm volatile("s_waitcnt vmcnt(0)" ::: "memory");
        }
    }
    __syncthreads();
}

#ifndef PH_MASK
#define PH_MASK 0x1FF
#endif
__global__ void __launch_bounds__(NTHREADS, 2) fwd_megakernel(Params P) {
    extern __shared__ __attribute__((aligned(16))) unsigned char lds_raw[];
    LAS unsigned char* lds = (LAS unsigned char*)lds_raw;
    cg::grid_group grid = cg::this_grid();
    volatile LAS unsigned* bst = (volatile LAS unsigned*)(lds + LDS_BAR_OFF);
    if (threadIdx.x < 2) bst[threadIdx.x] = 0u;
    __syncthreads();
    const XcdBarrier xbar = xcd_barrier_post((unsigned*)(P.ws + OFF_CTL), bst);
#define GRID_SYNC() xcd_barrier(xbar)
    const int G = gridDim.x;
    unsigned char* ws = P.ws;
    if constexpr (PH_MASK & 1) prologue_phase(P, lds, G);
    grid.sync();
    for (int step = 0; step < DEPTH * 3; ++step) {
        const int l = step / 3, s3 = step % 3;
        const bool last = (l == DEPTH - 1);
        const int Mn = (last && s3 == 2) ? MLAT : MTOT;
        if constexpr (PH_MASK & 2) norm_phase(P, l, s3, Mn, step == 0, G);
        GRID_SYNC();
        unsigned char* wb = ws + OFF_WB + (size_t)l * WB_LAYER;
        pg8::Gemm gr; pg8::EpiResid er; int Mr;
        const float* modl = (const float*)(ws + OFF_MOD) + (size_t)l * 9 * MODW;
        if (s3 != 1) {
            const int f = s3 >> 1;
            { pg8::Gemm g{(const bf16_t*)(ws + OFF_HBUF), (const bf16_t*)(wb + WB_FFIN + f * WB_FFIN_SZ), Mn, NFF2, DM};
              pg8::StaticOrder S; S.init(Mn, NFF2, G, (int)blockIdx.x);
              pg8::EpiSwiglu E{(bf16_t*)(ws + OFF_MID)};
              if constexpr (PH_MASK & 4) pg8::gemm_phase<pg8::EpiSwiglu, pg8::StaticOrder, true, true>(lds, g, S, E); }
            GRID_SYNC();
            Mr = Mn;
            gr = pg8::Gemm{(const bf16_t*)(ws + OFF_MID), (const bf16_t*)(wb + WB_FFOUT + f * WB_FFOUT_SZ), Mr, DM, DFF};
            er = pg8::EpiResid{(float*)(ws + OFF_XRES), modl + (3 * s3 + 2) * DM, 0.5f};
        } else {
            { pg8::Gemm g{(const bf16_t*)(ws + OFF_HBUF), (const bf16_t*)(wb + WB_WIN), MTOT, INW, DM};
              pg8::StaticOrder S; S.init(MTOT, INW, G, (int)blockIdx.x);
              pg8::EpiWin E{(bf16_t*)(ws + OFF_Q), (bf16_t*)(ws + OFF_K), (bf16_t*)(ws + OFF_V), (bf16_t*)(ws + OFF_U5), P.in[10] + l * 64, P.in[11] + l * 64,
                            (const float*)(ws + OFF_ROPE), (const float*)(ws + OFF_ROPE) + 2048, 0.125f * 1.4426950408889634f};
              if constexpr (PH_MASK & 8) pg8::gemm_phase<pg8::EpiWin, pg8::StaticOrder, true, true>(lds, g, S, E); }
            GRID_SYNC();
            if constexpr (PH_MASK & 16) lru1_phase(P, l, lds, G);
            GRID_SYNC();
            if constexpr (PH_MASK & 32) attention_phase(P, l, (char*)lds_raw, G);
            GRID_SYNC();
            Mr = last ? MLAT : MTOT;
            if constexpr (PH_MASK & 64) merge_phase(P, l, Mr, G);
            GRID_SYNC();
            gr = pg8::Gemm{(const bf16_t*)(ws + OFF_HBUF), (const bf16_t*)(wb + WB_WOUT), Mr, DM, DM};
            er = pg8::EpiResid{(float*)(ws + OFF_XRES), modl + 5 * DM, 1.0f};
        }
        { pg8::StaticOrder S; S.init(Mr, DM, G, (int)blockIdx.x);
          if constexpr (PH_MASK & 128) pg8::gemm_phase<pg8::EpiResid, pg8::StaticOrder, true, true>(lds, gr, S, er); }
        GRID_SYNC();
    }
    if constexpr (PH_MASK & 256) final_norm_phase(P, G);
}

extern "C" void kernel_launch(void* const* d_in, const int* in_sizes, int n_in, void* d_out, int out_size, void* d_ws, size_t ws_size, hipStream_t stream) {
    static int grid = 0;
    if (grid == 0) {
        if (n_in != 24 || out_size != MLAT * DM || ws_size < WS_NEED) { fprintf(stderr, "kernel_launch: unexpected shapes (n_in %d, out %d, ws %zu, need %zu)\n", n_in, out_size, ws_size, (size_t)WS_NEED); grid = -1; return; }
        int dev = 0, cus = 0, per_cu = 0;
        hipGetDevice(&dev); hipDeviceGetAttribute(&cus, hipDeviceAttributeMultiprocessorCount, dev);
        if (hipFuncSetAttribute((const void*)fwd_megakernel, hipFuncAttributeMaxDynamicSharedMemorySize, LDS_BYTES) != hipSuccess) { fprintf(stderr, "kernel_launch: hipFuncSetAttribute failed\n"); grid = -1; return; }
        if (hipOccupancyMaxActiveBlocksPerMultiprocessor(&per_cu, (const void*)fwd_megakernel, NTHREADS, LDS_BYTES) != hipSuccess || per_cu < 1) { fprintf(stderr, "kernel_launch: occupancy query says %d\n", per_cu); per_cu = 1; (void)hipGetLastError(); }
        grid = cus * 1;
        if (grid % 8 != 0 || grid <= 0) grid = 256;
        fprintf(stderr, "kernel_launch: grid %d (cus %d, per_cu %d)\n", grid, cus, per_cu);
    }
    if (grid < 0) return;
    Params p{};
    for (int i = 0; i < 24; ++i) p.in[i] = (const float*)d_in[i];
    p.out = (float*)d_out; p.ws = (unsigned char*)d_ws;
    if (hipMemsetAsync((unsigned char*)d_ws + OFF_CTL, 0, CTL_BYTES, stream) != hipSuccess) { fprintf(stderr, "kernel_launch: memset of the barrier words failed\n"); return; }
    void* args[] = {&p};
    hipError_t e = hipLaunchCooperativeKernel((const void*)fwd_megakernel, dim3(grid), dim3(NTHREADS), args, LDS_BYTES, stream);
    if (e != hipSuccess) fprintf(stderr, "kernel_launch: cooperative launch failed: %s (grid %d)\n", hipGetErrorString(e), grid);
}
```

```cpp
#include <hip/hip_runtime.h>
#include <hip/hip_bf16.h>
#include <hip/hip_cooperative_groups.h>
#include <cstdio>
#include <cstdint>
#include <cmath>
namespace cg = cooperative_groups;

constexpr int DM = 1024, NBATCH = 8, SEQ = 8192, CTXL = 256, DEPTH = 2;
constexpr int MLAT = NBATCH * SEQ, MCTX = NBATCH * CTXL, MTOT = MLAT + MCTX;
constexpr int DFF = 2816, NFF2 = 2 * DFF, INW = 2048, NMODV = 9, MODW = 9 * DM;
constexpr int KEYS = SEQ + CTXL, NCHUNK = KEYS / 64;
constexpr float EPS = 1e-6f;
constexpr int NTHREADS = 512;
constexpr int LDS_BYTES = 155648;
constexpr int LDS_TAB_OFF = 131072;

constexpr size_t MiB = 1u << 20;
constexpr size_t OFF_MOD = 0;
constexpr size_t OFF_ROPE = 1 * MiB;
constexpr size_t OFF_LW = 1 * MiB + 65536;
constexpr size_t OFF_CSUM = 2 * MiB;
constexpr size_t OFF_CARRY = 7 * MiB;
constexpr size_t OFF_CTL = 9 * MiB + 524288, CTL_BYTES = 65536;
constexpr int LDS_BAR_OFF = 155392;
constexpr size_t OFF_WB = 10 * MiB;
constexpr size_t WB_LAYER = 39 * MiB;
constexpr size_t WB_FFIN = 0, WB_FFIN_SZ = (size_t)NFF2 * DM * 2;
constexpr size_t WB_FFOUT = 2 * WB_FFIN_SZ, WB_FFOUT_SZ = (size_t)DM * DFF * 2;
constexpr size_t WB_WIN = WB_FFOUT + 2 * WB_FFOUT_SZ, WB_WIN_SZ = (size_t)INW * DM * 2;
constexpr size_t WB_WOUT = WB_WIN + WB_WIN_SZ;
static_assert(WB_WOUT + (size_t)DM * DM * 2 == WB_LAYER, "weight map");
constexpr size_t OFF_XRES = 88 * MiB;
constexpr size_t OFF_HBUF = 352 * MiB;
constexpr size_t OFF_R1 = 484 * MiB;
constexpr size_t OFF_MID = OFF_R1;
constexpr size_t OFF_Q = OFF_R1;
constexpr size_t OFF_K = OFF_R1 + 66 * MiB;
constexpr size_t OFF_V = OFF_K + 16 * MiB + 524288;
constexpr size_t OFF_U5 = OFF_R1 + 99 * MiB;
constexpr size_t U5_STRIDE = (size_t)MTOT * 256;
constexpr size_t OFF_S = OFF_R1 + 264 * MiB;
constexpr size_t OFF_PP = OFF_R1 + 330 * MiB;
constexpr size_t OFF_ATT = OFF_R1 + 396 * MiB;
constexpr size_t WS_NEED = OFF_ATT + 66 * MiB;

#define LAS __attribute__((address_space(3)))
typedef unsigned short bf16_t;
typedef float f32x4 __attribute__((ext_vector_type(4)));
typedef float f32x2 __attribute__((ext_vector_type(2)));
typedef unsigned u32x4 __attribute__((ext_vector_type(4)));
typedef unsigned u32x2 __attribute__((ext_vector_type(2)));

struct Params { const float* in[24]; float* out; unsigned char* ws; };

__device__ __forceinline__ unsigned cvt_pk(float lo, float hi) { unsigned r; asm volatile("v_cvt_pk_bf16_f32 %0, %1, %2" : "=v"(r) : "v"(lo), "v"(hi)); return r; }
__device__ __forceinline__ float bf_lo(unsigned w) { return __uint_as_float(w << 16); }
__device__ __forceinline__ float bf_hi(unsigned w) { return __uint_as_float(w & 0xffff0000u); }
__device__ __forceinline__ float wave_sum(float v) {
#pragma unroll
    for (int o = 1; o < 64; o <<= 1) v += __shfl_xor(v, o);
    return v;
}
__device__ __forceinline__ int opaque_tid() { int t = threadIdx.x; asm volatile("" : "+v"(t)); return t; }
__device__ __forceinline__ float sigmoidf_(float z) { return __builtin_amdgcn_rcpf(1.0f + __expf(-z)); }
namespace pg8 {
#define PG8_LAS __attribute__((address_space(3)))
typedef unsigned short bf16_t;
typedef short bf16x8 __attribute__((ext_vector_type(8)));
typedef float f32x4 __attribute__((ext_vector_type(4)));
typedef unsigned u32x4 __attribute__((ext_vector_type(4)));
constexpr int BM = 256, BK = 64, HALF = 128, HTB = HALF * BK * 2  , STAGE_BYTES = 8 * HTB, NXCD = 8, WGM = 8;

__host__ __device__ __forceinline__ int lds_byte(int r, int c) { const int st = (r >> 4) * 2 + (c >> 5), rr = r & 15, cc = c & 31, ob = rr * 64 + cc * 2; return st * 1024 + (ob ^ (((ob >> 9) & 1) << 5)); }
__host__ __device__ __forceinline__ void stage_rc(int b, int& R, int& C) { const int st = b / 1024, sb = b % 1024, swz = sb ^ (((sb >> 9) & 1) << 5); R = (st >> 1) * 16 + swz / 64; C = (st & 1) * 32 + (swz % 64) / 2; }
__host__ __device__ __forceinline__ int perm32(int rho) { const int n = rho >> 4, i = rho & 15; return 8 * (i >> 2) + 4 * n + (i & 3); }

struct Unit { int pm, pn; };
struct Gemm { const bf16_t* A; const bf16_t* Bt; int M, N, K; };

struct StaticOrder {
    int nM, nN, nwg, G, c;
    __host__ __device__ void init(int M, int N, int G_, int c_) { nM = M / BM; nN = N / BM; nwg = nM * nN; G = G_; c = c_; }
    __host__ __device__ bool next(int i, Unit& u) const {
        const long L = (long)i * G + c; if (L >= nwg) return false;
        int wgid = (int)L; { const int q = nwg / NXCD, r = nwg % NXCD, xcd = wgid % NXCD, off = wgid / NXCD; wgid = (xcd < r ? xcd * (q + 1) : r * (q + 1) + (xcd - r) * q) + off; }
        const int nig = WGM * nN, gid = wgid / nig, fm = gid * WGM, gsz = (nM - fm) < WGM ? (nM - fm) : WGM;
        u.pm = fm + ((wgid % nig) % gsz); u.pn = (wgid % nig) / gsz; return true;
    }
    __device__ __forceinline__ void a_ready(const Unit&) const {}
    __device__ __forceinline__ void done(const Unit&) const {}
};
__device__ __forceinline__ unsigned cvt_pk_bf16(float lo, float hi) { unsigned r; asm volatile("v_cvt_pk_bf16_f32 %0, %1, %2" : "=v"(r) : "v"(lo), "v"(hi)); return r; }

struct EpiSwiglu {
    static constexpr bool PERM = false, AFTER_DRAIN = false;
    bf16_t* O;
    __device__ __forceinline__ void operator()(const f32x4 (&acc)[2][2][4][2], const Unit& u, int wr, int wc, int fr, int fq) const {
        const int row0 = u.pm * BM + wr * 64 + fr, col0 = u.pn * 128 + wc * 32 + 8 * fq;
#pragma unroll
        for (int ai = 0; ai < 2; ++ai)
#pragma unroll
            for (int m = 0; m < 4; ++m) {
                bf16_t* rowp = O + (size_t)(row0 + ai * HALF + m * 16) * 2816 + col0;
                float v[8];
#pragma unroll
                for (int n = 0; n < 2; ++n)
#pragma unroll
                    for (int j = 0; j < 4; ++j) { const float g = acc[ai][0][m][n][j], up = acc[ai][1][m][n][j]; v[n * 4 + j] = g * __builtin_amdgcn_rcpf(1.0f + __expf(-g)) * up; }
                u32x4 w; w.x = cvt_pk_bf16(v[0], v[1]); w.y = cvt_pk_bf16(v[2], v[3]); w.z = cvt_pk_bf16(v[4], v[5]); w.w = cvt_pk_bf16(v[6], v[7]);
                *(u32x4*)rowp = w;
            }
    }
};
struct EpiResid {
    static constexpr bool PERM = false, AFTER_DRAIN = false;
    bf16_t* X; const float* Xlat; const float* Xctx; const float* gate; float scale; int first;
    __device__ __forceinline__ void operator()(const f32x4 (&acc)[2][2][4][2], const Unit& u, int wr, int wc, int fr, int fq) const {
        const int v = u.pm < 256 ? (u.pm >> 5) : 8;
        const int row0 = u.pm * BM + wr * 64 + fr, col0 = u.pn * BM + wc * 32 + 4 * fq;
        const float* gp = gate + (size_t)v * 9216 + col0;
        f32x4 gv[2][2];
#pragma unroll
        for (int bj = 0; bj < 2; ++bj)
#pragma unroll
            for (int n = 0; n < 2; ++n) gv[bj][n] = *(const f32x4*)(gp + bj * HALF + n * 16) * scale;
#pragma unroll
        for (int ai = 0; ai < 2; ++ai) {
            bf16_t* rowp = X + (size_t)(row0 + ai * HALF) * 1024 + col0;
            f32x4 xv[4][2][2];
            if (first) {
                const float* rowr = (u.pm < 256 ? Xlat + (size_t)(row0 + ai * HALF) * 1024 : Xctx + (size_t)(row0 + ai * HALF - 65536) * 1024) + col0;
#pragma unroll
                for (int m = 0; m < 4; ++m)
#pragma unroll
                    for (int bj = 0; bj < 2; ++bj)
#pragma unroll
                        for (int n = 0; n < 2; ++n) xv[m][bj][n] = *(const f32x4*)(rowr + (size_t)m * 16 * 1024 + bj * HALF + n * 16);
            } else {
                u32x2 raw[4][2][2];
#pragma unroll
                for (int m = 0; m < 4; ++m)
#pragma unroll
                    for (int bj = 0; bj < 2; ++bj)
#pragma unroll
                        for (int n = 0; n < 2; ++n) raw[m][bj][n] = *(const u32x2*)(rowp + (size_t)m * 16 * 1024 + bj * HALF + n * 16);
#pragma unroll
                for (int m = 0; m < 4; ++m)
#pragma unroll
                    for (int bj = 0; bj < 2; ++bj)
#pragma unroll
                        for (int n = 0; n < 2; ++n) { const u32x2 r = raw[m][bj][n]; xv[m][bj][n] = (f32x4){__uint_as_float(r.x << 16), __uint_as_float(r.x & 0xffff0000u), __uint_as_float(r.y << 16), __uint_as_float(r.y & 0xffff0000u)}; }
            }
#pragma unroll
            for (int m = 0; m < 4; ++m)
#pragma unroll
                for (int bj = 0; bj < 2; ++bj)
#pragma unroll
                    for (int n = 0; n < 2; ++n) { const f32x4 y = xv[m][bj][n] + gv[bj][n] * acc[ai][bj][m][n]; u32x2 w; w.x = cvt_pk_bf16(y[0], y[1]); w.y = cvt_pk_bf16(y[2], y[3]);
                        *(u32x2*)(rowp + (size_t)m * 16 * 1024 + bj * HALF + n * 16) = w; }
        }
    }
};
struct ResidOrder {
    StaticOrder so; int single, pm, pn;
    __device__ __forceinline__ bool next(int i, Unit& u) const { if (single) { if (i > 0) return false; u.pm = pm; u.pn = pn; return true; } return so.next(i, u); }
    __device__ __forceinline__ void a_ready(const Unit&) const {}
    __device__ __forceinline__ void done(const Unit&) const {}
};
struct EpiWin {
    static constexpr bool PERM = false, AFTER_DRAIN = false;
    bf16_t *Q, *K, *V, *U5; const PG8_LAS float* tab; float qscale;
    __device__ __forceinline__ void operator()(const f32x4 (&acc)[2][2][4][2], const Unit& u, int wr, int wc, int fr, int fq) const {
        const int row0 = u.pm * BM + wr * 64 + fr;
        if (u.pn >= 3) {
            bf16_t* base = U5 + (size_t)(u.pn - 3) * ((size_t)67584 * 256) + wc * 32 + 8 * fq;
#pragma unroll
            for (int ai = 0; ai < 2; ++ai)
#pragma unroll
                for (int m = 0; m < 4; ++m) { bf16_t* rowp = base + (size_t)(row0 + ai * HALF + m * 16) * 256;
#pragma unroll
                    for (int bj = 0; bj < 2; ++bj) { const f32x4 v0 = acc[ai][bj][m][0], v1 = acc[ai][bj][m][1];
                        u32x4 w; w.x = cvt_pk_bf16(v0[0], v0[1]); w.y = cvt_pk_bf16(v0[2], v0[3]); w.z = cvt_pk_bf16(v1[0], v1[1]); w.w = cvt_pk_bf16(v1[2], v1[3]);
                        *(u32x4*)(rowp + bj * HALF) = w; } }
            return;
        }
        const int kind = u.pn < 2 ? 0 : (wc < 2 ? 1 : 2);
        const bool latent = u.pm < 256;
        const PG8_LAS float* gsrc = tab + 4096 + (kind == 0 ? 0 : 64);
#pragma unroll
        for (int ai = 0; ai < 2; ++ai)
#pragma unroll
            for (int m = 0; m < 4; ++m) {
                const int row = row0 + ai * HALF + m * 16;
                f32x4 y[2][2];
#pragma unroll
                for (int bj = 0; bj < 2; ++bj)
#pragma unroll
                    for (int n = 0; n < 2; ++n) y[bj][n] = acc[ai][bj][m][n];
                if (kind != 2) {
                    float ss = 0.f;
#pragma unroll
                    for (int bj = 0; bj < 2; ++bj)
#pragma unroll
                        for (int n = 0; n < 2; ++n) { const f32x4 t = y[bj][n]; ss += (t[0] * t[0] + t[1] * t[1]) + (t[2] * t[2] + t[3] * t[3]); }
                    ss += __shfl_xor(ss, 16); ss += __shfl_xor(ss, 32);
                    const float r = 1.0f / sqrtf(ss * (1.0f / 64.0f) + 1e-6f);
#pragma unroll
                    for (int bj = 0; bj < 2; ++bj)
#pragma unroll
                        for (int n = 0; n < 2; ++n) y[bj][n] = y[bj][n] * r * *(const PG8_LAS f32x4*)(gsrc + 32 * bj + 16 * n + 4 * fq);
                    if (latent) {
                        const int s = row & 8191;
#pragma unroll
                        for (int bj = 0; bj < 2; ++bj) { const int pos = bj == 0 ? (s >> 6) : (s & 63);
                            const f32x4 c4 = *(const PG8_LAS f32x4*)(tab + pos * 16 + 4 * fq), s4 = *(const PG8_LAS f32x4*)(tab + 2048 + pos * 16 + 4 * fq);
                            const f32x4 x1 = y[bj][0], x2 = y[bj][1];
                            y[bj][0] = x1 * c4 - x2 * s4; y[bj][1] = x2 * c4 + x1 * s4; }
                    }
                }
                bf16_t* dst;
                if (kind == 0) { dst = Q + (size_t)row * 512 + (u.pn * 4 + wc) * 64;
#pragma unroll
                    for (int bj = 0; bj < 2; ++bj)
#pragma unroll
                        for (int n = 0; n < 2; ++n) y[bj][n] = y[bj][n] * qscale;
                } else {
                    size_t kr;
                    if (latent) kr = (size_t)(row >> 13) * 8448 + 256 + (row & 8191);
                    else { const int rc = row - 65536; kr = (size_t)(rc >> 8) * 8448 + (rc & 255); }
                    dst = (kind == 1 ? K : V) + kr * 128 + (wc & 1) * 64;
                }
#pragma unroll
                for (int bj = 0; bj < 2; ++bj)
#pragma unroll
                    for (int n = 0; n < 2; ++n) { u32x2 w; w.x = cvt_pk_bf16(y[bj][n][0], y[bj][n][1]); w.y = cvt_pk_bf16(y[bj][n][2], y[bj][n][3]);
                        *(u32x2*)(dst + 32 * bj + 16 * n + 4 * fq) = w; }
            }
    }
};
template <class Epi, class Sched, bool ALIGN_EPI = false, bool SP2 = false>
__device__ __forceinline__ void gemm_phase(PG8_LAS unsigned char* lds, const Gemm g, const Sched& S, const Epi& E) {
    const int tid = opaque_tid(), wid = __builtin_amdgcn_readfirstlane(tid >> 6), lane = tid & 63, wr = wid >> 2, wc = wid & 3, fr = lane & 15, fq = lane >> 4;
    const int K = g.K, nt = K / BK;
    unsigned voffA[2], voffB[2];
#pragma unroll
    for (int i = 0; i < 2; ++i) { int R, C; stage_rc(tid * 16 + i * 8192, R, C); const int Rb = Epi::PERM ? ((R & ~31) + perm32(R & 31)) : R;
        voffA[i] = (unsigned)(R * K + C) * 2u; voffB[i] = (unsigned)(Rb * K + C) * 2u; }
    const size_t kstep = (size_t)(BK * 2);
    const size_t hstep = (size_t)HALF * K * 2;
    const size_t tstep = 2 * hstep;
    const unsigned ldsw = (unsigned)wid * 1024u;
    const int aoff = lds_byte(wr * 64 + fr, fq * 8), boff = lds_byte(wc * 32 + fr, fq * 8);
#define PG8_SA(b, h) (((b) * 2 + (h)) * HTB)
#define PG8_SB(b, h) ((4 + (b) * 2 + (h)) * HTB)
#define PG8_STAGE(bufoff, gbase, voff) do { _Pragma("unroll") for (int _i = 0; _i < 2; ++_i) \
        __builtin_amdgcn_global_load_lds((const unsigned*)((const char*)(gbase) + (voff)[_i]), (PG8_LAS unsigned*)(lds + (bufoff) + ldsw + _i * 8192), 16, 0, 0); } while (0)
#define PG8_LDA(dst, b, h) do { _Pragma("unroll") for (int m = 0; m < 4; ++m) _Pragma("unroll") for (int k = 0; k < 2; ++k) dst[m][k] = *(const PG8_LAS bf16x8*)(lds + PG8_SA(b, h) + aoff + m * 2048 + k * 1024); } while (0)
#define PG8_LDB(dst, b, h) do { _Pragma("unroll") for (int n = 0; n < 2; ++n) _Pragma("unroll") for (int k = 0; k < 2; ++k) dst[n][k] = *(const PG8_LAS bf16x8*)(lds + PG8_SB(b, h) + boff + n * 2048 + k * 1024); } while (0)
#define PG8_MMA(ai, bj, At, Bt) do { __builtin_amdgcn_s_setprio(1); _Pragma("unroll") for (int m = 0; m < 4; ++m) _Pragma("unroll") for (int n = 0; n < 2; ++n) _Pragma("unroll") for (int k = 0; k < 2; ++k) \
        acc[ai][bj][m][n] = __builtin_amdgcn_mfma_f32_16x16x32_bf16(Bt[n][k], At[m][k], acc[ai][bj][m][n], 0, 0, 0); __builtin_amdgcn_s_setprio(0); } while (0)
#define PG8_WAIT_V(n) asm volatile("s_waitcnt vmcnt(" #n ")" ::: "memory")
#define PG8_WAIT_L(n) asm volatile("s_waitcnt lgkmcnt(" #n ")" ::: "memory")
#define PG8_BAR __builtin_amdgcn_s_barrier()
#define PG8_SCHED __builtin_amdgcn_sched_barrier(0)
    Unit cur, nxt; int ui = 0;
    if (!S.next(0, cur)) return;
    f32x4 acc[2][2][4][2];
#pragma unroll
    for (int a = 0; a < 2; ++a)
#pragma unroll
        for (int b = 0; b < 2; ++b)
#pragma unroll
            for (int m = 0; m < 4; ++m)
#pragma unroll
                for (int n = 0; n < 2; ++n) acc[a][b][m][n] = (f32x4){0.f, 0.f, 0.f, 0.f};
    bf16x8 At[4][2], B0[2][2], B1[2][2];
    const char* cA = (const char*)g.A + (size_t)cur.pm * tstep; const char* cB = (const char*)g.Bt + (size_t)cur.pn * tstep;
    S.a_ready(cur);
    if constexpr (SP2) {
        PG8_STAGE(PG8_SB(0, 0), cB, voffB); PG8_STAGE(PG8_SB(0, 1), cB + hstep, voffB); PG8_STAGE(PG8_SA(0, 0), cA, voffA); PG8_STAGE(PG8_SA(0, 1), cA + hstep, voffA);
        if (wr == 1) PG8_BAR;
        PG8_WAIT_V(2); PG8_BAR;
        PG8_STAGE(PG8_SB(1, 0), cB + kstep, voffB); PG8_STAGE(PG8_SA(1, 0), cA + kstep, voffA); PG8_STAGE(PG8_SB(1, 1), cB + hstep + kstep, voffB);
        PG8_WAIT_V(6); PG8_BAR;
    } else {
        PG8_STAGE(PG8_SB(0, 0), cB, voffB); PG8_STAGE(PG8_SA(0, 0), cA, voffA); PG8_STAGE(PG8_SB(0, 1), cB + hstep, voffB); PG8_STAGE(PG8_SA(0, 1), cA + hstep, voffA);
        if (wr == 1) PG8_BAR;
        PG8_WAIT_V(4); PG8_BAR;
        PG8_STAGE(PG8_SB(1, 0), cB + kstep, voffB); PG8_STAGE(PG8_SA(1, 0), cA + kstep, voffA); PG8_STAGE(PG8_SB(1, 1), cB + hstep + kstep, voffB);
        PG8_WAIT_V(6); PG8_BAR;
    }
    for (;;) {
        const bool has_next = S.next(ui + 1, nxt);
        const char* nA = has_next ? (const char*)g.A + (size_t)nxt.pm * tstep : cA; const char* nB = has_next ? (const char*)g.Bt + (size_t)nxt.pn * tstep : cB;
        for (int t = 0; t < nt; t += 2) {
            const bool last = (t == nt - 2);
            const char* a1 = cA + (size_t)(t + 1) * kstep;
            const char* a2 = last ? nA : cA + (size_t)(t + 2) * kstep; const char* b2 = last ? nB : cB + (size_t)(t + 2) * kstep;
            const char* a3 = a2 + kstep; const char* b3 = b2 + kstep;
            if (last && has_next) S.a_ready(nxt);
            if constexpr (SP2) {
            PG8_LDB(B0, 0, 0); PG8_LDB(B1, 0, 1); PG8_SCHED; PG8_LDA(At, 0, 0); PG8_STAGE(PG8_SA(1, 1), a1 + hstep, voffA);
            PG8_WAIT_V(8); PG8_WAIT_L(0); PG8_BAR; PG8_MMA(0, 0, At, B0); PG8_MMA(0, 1, At, B1); PG8_BAR; PG8_SCHED;
            PG8_LDA(At, 0, 1); PG8_STAGE(PG8_SB(0, 0), b2, voffB); PG8_STAGE(PG8_SB(0, 1), b2 + hstep, voffB); PG8_STAGE(PG8_SA(0, 0), a2, voffA);
            PG8_WAIT_V(8); PG8_WAIT_L(0); PG8_BAR; PG8_MMA(1, 0, At, B0); PG8_MMA(1, 1, At, B1); PG8_BAR; PG8_SCHED;
            PG8_LDB(B0, 1, 0); PG8_LDB(B1, 1, 1); PG8_SCHED; PG8_LDA(At, 1, 0); PG8_STAGE(PG8_SA(0, 1), a2 + hstep, voffA);
            PG8_WAIT_V(8); PG8_WAIT_L(0); PG8_BAR; PG8_MMA(0, 0, At, B0); PG8_MMA(0, 1, At, B1); PG8_BAR; PG8_SCHED;
            PG8_LDA(At, 1, 1); PG8_STAGE(PG8_SB(1, 0), b3, voffB); PG8_STAGE(PG8_SB(1, 1), b3 + hstep, voffB); PG8_STAGE(PG8_SA(1, 0), a3, voffA);
            PG8_WAIT_V(8); PG8_WAIT_L(0); PG8_BAR; PG8_MMA(1, 0, At, B0); PG8_MMA(1, 1, At, B1); PG8_BAR; PG8_SCHED;
            } else {
            PG8_LDB(B0, 0, 0); PG8_SCHED; PG8_LDA(At, 0, 0); PG8_STAGE(PG8_SA(1, 1), a1 + hstep, voffA);
            PG8_WAIT_L(8); PG8_BAR; PG8_WAIT_L(0); PG8_MMA(0, 0, At, B0); PG8_BAR; PG8_SCHED;
            PG8_LDB(B1, 0, 1); PG8_STAGE(PG8_SB(0, 0), b2, voffB);
            PG8_BAR; PG8_WAIT_L(0); PG8_MMA(0, 1, At, B1); PG8_BAR;
            PG8_LDA(At, 0, 1); PG8_STAGE(PG8_SA(0, 0), a2, voffA);
            PG8_BAR; PG8_WAIT_L(0); PG8_MMA(1, 0, At, B0); PG8_BAR; PG8_SCHED;
            PG8_STAGE(PG8_SB(0, 1), b2 + hstep, voffB);
            PG8_WAIT_V(6); PG8_BAR; PG8_MMA(1, 1, At, B1); PG8_BAR;
            PG8_LDB(B0, 1, 0); PG8_SCHED; PG8_LDA(At, 1, 0); PG8_STAGE(PG8_SA(0, 1), a2 + hstep, voffA);
            PG8_WAIT_L(8); PG8_BAR; PG8_WAIT_L(0); PG8_MMA(0, 0, At, B0); PG8_BAR; PG8_SCHED;
            PG8_LDB(B1, 1, 1); PG8_STAGE(PG8_SB(1, 0), b3, voffB);
            PG8_BAR; PG8_WAIT_L(0); PG8_MMA(0, 1, At, B1); PG8_BAR;
            PG8_LDA(At, 1, 1); PG8_STAGE(PG8_SA(1, 0), a3, voffA);
            PG8_BAR; PG8_WAIT_L(0); PG8_MMA(1, 0, At, B0); PG8_BAR; PG8_SCHED;
            PG8_STAGE(PG8_SB(1, 1), b3 + hstep, voffB);
            PG8_WAIT_V(6); PG8_BAR; PG8_MMA(1, 1, At, B1); PG8_BAR;
            }
        }
        if constexpr (ALIGN_EPI) { if (wr == 0) PG8_BAR; }
        if constexpr (!Epi::AFTER_DRAIN) { E(acc, cur, wr, wc, fr, fq); S.done(cur); }
        if (!has_next) break;
#pragma unroll
        for (int a = 0; a < 2; ++a)
#pragma unroll
            for (int b = 0; b < 2; ++b)
#pragma unroll
                for (int m = 0; m < 4; ++m)
#pragma unroll
                    for (int n = 0; n < 2; ++n) acc[a][b][m][n] = (f32x4){0.f, 0.f, 0.f, 0.f};
        cur = nxt; cA = nA; cB = nB; ++ui;
        if constexpr (ALIGN_EPI) { if (wr == 1) PG8_BAR; }
    }
    PG8_WAIT_V(0);
    if constexpr (!ALIGN_EPI) { if (wr == 0) PG8_BAR; }
    PG8_BAR;
    if constexpr (Epi::AFTER_DRAIN) { E.fused(acc, cur, wr, wc, fr, fq, lds, wid, lane); S.done(cur); }
#undef PG8_SA
#undef PG8_SB
#undef PG8_STAGE
#undef PG8_LDA
#undef PG8_LDB
#undef PG8_MMA
#undef PG8_WAIT_V
#undef PG8_WAIT_L
#undef PG8_BAR
#undef PG8_SCHED
}
}

namespace attn_body {
using bf16=__hip_bfloat16;
using bf16x8=__attribute__((ext_vector_type(8)))short;
using s16x4=__attribute__((ext_vector_type(4)))short;
using f32x16=__attribute__((ext_vector_type(16)))float;
using u32x4=__attribute__((ext_vector_type(4)))unsigned;
constexpr int D=64, QP=512, KP=128, OP=512;
constexpr int NW=8,QBLK=32,QB=QBLK*NW,KVBLK=64;
__device__ __forceinline__ int crow(int r,int hi){return (r&3)+8*(r>>2)+4*hi;}
#define SBAR() __builtin_amdgcn_sched_barrier(0)
#define ATTN_STORE16(p,v) (*(u32x4*)(p)=(v))
constexpr int NSLOT=3, SLOTB=8192;
constexpr int LDS_K=0, LDS_V=NSLOT*SLOTB, LDS_WS=2*NSLOT*SLOTB, LDS_OST=LDS_WS+NW*64*4, LDS_BYTES=LDS_OST+NW*4096;
constexpr float C2=0.125f*1.4426950408889634f;
__device__ __forceinline__ void glds16(const void*gsrc,unsigned lds_dst){unsigned keep;
  asm volatile("s_mov_b32 %0, m0\n\ts_mov_b32 m0, %2\n\ts_nop 0\n\tglobal_load_lds_dwordx4 %1, off\n\ts_mov_b32 m0, %0":"=&s"(keep):"v"(gsrc),"s"(lds_dst):"memory");}
__device__ __forceinline__ float max3f(float a,float b,float c){float r;asm("v_max3_f32 %0, %1, %2, %3":"=v"(r):"v"(a),"v"(b),"v"(c));return r;}
__device__ __forceinline__ float max2f(float a,float b){float r;asm("v_max_f32_e32 %0, %1, %2":"=v"(r):"v"(a),"v"(b));return r;}
__device__ __forceinline__ float fadd_s(float a,float b){float r;asm("v_add_f32_e32 %0, %1, %2":"=v"(r):"v"(a),"v"(b));return r;}
__device__ __forceinline__ float fsub_s(float a,float b){float r;asm("v_sub_f32_e32 %0, %1, %2":"=v"(r):"v"(a),"v"(b));return r;}
typedef float f32x2_t __attribute__((ext_vector_type(2))); typedef __bf16 bf16x2_t __attribute__((ext_vector_type(2)));
__device__ __forceinline__ unsigned cvtpk_s(float lo,float hi){f32x2_t v={lo,hi};bf16x2_t b=__builtin_convertvector(v,bf16x2_t);return __builtin_bit_cast(unsigned,b);}
#define WAIT_BAR(N) asm volatile("s_waitcnt vmcnt(" #N ") lgkmcnt(0)\n\ts_barrier":::"memory")

__device__ __forceinline__ void qkt(f32x16&p0,f32x16&p1,const char*Kslot,const bf16x8*qr,const f32x16&negm,int r32,int hi){
  const char*kb=Kslot+hi*1024+r32*16;
  #pragma unroll
  for(int d0=0;d0<4;++d0){
    const bf16x8 b0=*reinterpret_cast<const bf16x8*>(kb+d0*2048);
    const bf16x8 b1=*reinterpret_cast<const bf16x8*>(kb+d0*2048+512);
    if(d0==0){p0=__builtin_amdgcn_mfma_f32_32x32x16_bf16(b0,qr[0],negm,0,0,0);p1=__builtin_amdgcn_mfma_f32_32x32x16_bf16(b1,qr[0],negm,0,0,0);}
    else{p0=__builtin_amdgcn_mfma_f32_32x32x16_bf16(b0,qr[d0],p0,0,0,0);p1=__builtin_amdgcn_mfma_f32_32x32x16_bf16(b1,qr[d0],p1,0,0,0);}}
}
typedef __attribute__((address_space(3))) const char* lds_cptr;
typedef short v4i16_t __attribute__((ext_vector_type(4)));
__device__ __forceinline__ void kload8(bf16x8*kf,lds_cptr kp){
  kf[0]=*(const __attribute__((address_space(3))) bf16x8*)(kp);      kf[1]=*(const __attribute__((address_space(3))) bf16x8*)(kp+512);
  kf[2]=*(const __attribute__((address_space(3))) bf16x8*)(kp+2048); kf[3]=*(const __attribute__((address_space(3))) bf16x8*)(kp+2560);
  kf[4]=*(const __attribute__((address_space(3))) bf16x8*)(kp+4096); kf[5]=*(const __attribute__((address_space(3))) bf16x8*)(kp+4608);
  kf[6]=*(const __attribute__((address_space(3))) bf16x8*)(kp+6144); kf[7]=*(const __attribute__((address_space(3))) bf16x8*)(kp+6656);
}
__device__ __forceinline__ void kload2(bf16x8*kf,lds_cptr kp,int j){ kf[2*j]=*(const __attribute__((address_space(3))) bf16x8*)(kp+j*2048); kf[2*j+1]=*(const __attribute__((address_space(3))) bf16x8*)(kp+j*2048+512); }
__device__ __forceinline__ s16x4 vtr(lds_cptr p){ return __builtin_bit_cast(s16x4,__builtin_amdgcn_ds_read_tr16_b64_v4i16((__attribute__((address_space(3))) v4i16_t*)p)); }
__device__ __forceinline__ float rowmax(const f32x16&p0,const f32x16&p1){
  float a=max3f(p0[0],p0[1],p1[0]),b=max3f(p0[2],p0[3],p1[1]);a=max3f(a,p1[2],p1[3]);
  #pragma unroll
  for(int r=4;r<16;r+=4){a=max3f(a,p0[r],p0[r+1]);b=max3f(b,p0[r+2],p0[r+3]);a=max3f(a,p1[r],p1[r+1]);b=max3f(b,p1[r+2],p1[r+3]);}
  const float m=max2f(a,b);
  auto rr=__builtin_amdgcn_permlane32_swap(__float_as_uint(m),__float_as_uint(m),false,false);
  return max2f(__uint_as_float(rr[0]),__uint_as_float(rr[1]));
}
__device__ __forceinline__ void pv(f32x16*o,int vb,bf16x8 pa0,bf16x8 pa1,bf16x8 pa2,bf16x8 pa3){
  #pragma unroll
  for(int d0=0;d0<2;++d0){s16x4 lo[4],hi[4];
    #pragma unroll
    for(int ks=0;ks<4;++ks){
      asm volatile("ds_read_b64_tr_b16 %0,%1 offset:%c2":"=&v"(lo[ks]):"v"(vb),"i"(d0*4096+ks*1024):"memory");
      asm volatile("ds_read_b64_tr_b16 %0,%1 offset:%c2":"=&v"(hi[ks]):"v"(vb),"i"(d0*4096+ks*1024+512):"memory");}
    asm volatile("s_waitcnt lgkmcnt(0)":::"memory");SBAR();
    #define PK(k) (bf16x8){lo[k][0],lo[k][1],lo[k][2],lo[k][3],hi[k][0],hi[k][1],hi[k][2],hi[k][3]}
    o[d0]=__builtin_amdgcn_mfma_f32_32x32x16_bf16(pa0,PK(0),o[d0],0,0,0);
    o[d0]=__builtin_amdgcn_mfma_f32_32x32x16_bf16(pa1,PK(1),o[d0],0,0,0);
    o[d0]=__builtin_amdgcn_mfma_f32_32x32x16_bf16(pa2,PK(2),o[d0],0,0,0);
    o[d0]=__builtin_amdgcn_mfma_f32_32x32x16_bf16(pa3,PK(3),o[d0],0,0,0);
    #undef PK
  }
}
template<int THRL> __device__ __forceinline__ void attn_unit(const bf16*Qw0,const bf16*__restrict__ Kh,const bf16*__restrict__ Vh,bf16*Ow0,const int NT,char*shm){
  const int tid=opaque_tid(),lane=tid&63,r32=lane&31,hi=lane>>5; const int wid=__builtin_amdgcn_readfirstlane(tid>>6);
  const bf16*Qw=Qw0+(long)wid*QBLK*QP;
  const unsigned lds0=(unsigned)(uintptr_t)shm;
  float*wsf=(float*)(shm+LDS_WS)+wid*64;
  const bf16*ksrc=Kh+(long)lane*KP+wid*8;
  const bf16*vsrc=Vh+(long)(16*(wid&3)+(lane>>2))*KP+(wid>>2)*32+(lane&3)*8;
  const unsigned kdst=lds0+LDS_K+wid*1024, vdst=lds0+LDS_V+wid*1024;
  #define DMA_K(t,slot) glds16(ksrc+(long)(t)*KVBLK*KP,(unsigned)__builtin_amdgcn_readfirstlane(kdst+(slot)))
  #define DMA_V(t,slot) glds16(vsrc+(long)(t)*KVBLK*KP,(unsigned)__builtin_amdgcn_readfirstlane(vdst+(slot)))
  const int vb0=(int)(lds0+LDS_V)+((lane>>4)&1)*32+(lane&3)*8+(4*hi+((lane&15)>>2))*64;
  const char*Kbase=shm+LDS_K; bf16x8 kf[8];
  const lds_cptr shm3=(lds_cptr)shm; const lds_cptr kp0=shm3+LDS_K+hi*1024+r32*16; const lds_cptr vp0=shm3+LDS_V+((lane>>4)&1)*32+(lane&3)*8+(4*hi+((lane&15)>>2))*64;
  DMA_K(0,0);DMA_V(0,0);DMA_K(1,SLOTB);
  bf16x8 qr[4];
  #pragma unroll
  for(int d0=0;d0<4;++d0)qr[d0]=*reinterpret_cast<const bf16x8*>(&Qw[(long)r32*QP+d0*16+hi*8]);
  float mhat=0.f,l_reg=0.f;f32x16 o[2];o[0]=f32x16{};o[1]=f32x16{};f32x16 negm=f32x16{};asm volatile("":"+v"(negm));
  #define CMASK(P0,P1,t) do{}while(0)
  bool resc=false;
  #define START(P0,P1) do{ const float rm=rowmax(P0,P1); resc=false; \
    { const float dl=rm; mhat=fadd_s(mhat,dl); \
      _Pragma("unroll") for(int r=0;r<16;++r){P0[r]=fsub_s(P0[r],dl);P1[r]=fsub_s(P1[r],dl);} \
      _Pragma("unroll") for(int r=0;r<16;++r)negm[r]=-mhat; asm volatile("":"+v"(negm)); } \
    _Pragma("unroll") for(int r=0;r<16;++r)P0[r]=__builtin_amdgcn_exp2f(P0[r]); }while(0)
  #define RESC() do{ if(resc){ asm volatile("s_waitcnt lgkmcnt(0)":::"memory"); \
      _Pragma("unroll") for(int d_=0;d_<2;++d_) _Pragma("unroll") for(int r=0;r<16;++r)o[d_][r]*=wsf[crow(r,hi)]; } }while(0)
  f32x16 pA0,pA1,pB0,pB1;
  int sl_prev=0,sl_cur=0,sl_next=SLOTB;
  #define ROT() do{sl_prev=sl_cur;sl_cur=sl_next;sl_next=(sl_next==(NSLOT-1)*SLOTB)?0:sl_next+SLOTB;}while(0)
  DMA_K(2,2*SLOTB);
  WAIT_BAR(3);
  qkt(pA0,pA1,Kbase,qr,negm,r32,hi);asm volatile("s_nop 15\n\ts_nop 7":"+v"(pA0),"+v"(pA1));CMASK(pA0,pA1,0);
  START(pA0,pA1);
  _Pragma("unroll") for(int r=0;r<16;++r)pA1[r]=__builtin_amdgcn_exp2f(pA1[r]);
  WAIT_BAR(0);
  DMA_K(3,0);DMA_V(1,SLOTB);
  ROT();
  kload8(kf,kp0+sl_cur);
  WAIT_BAR(2);
  s16x4 vlo[8],vhi[8]; u32x4 pw0,pw1,pw2,pw3;
  #define PKW(P,B) cvtpk_s(P[B],P[B+1])
  #define PAF(k) __builtin_bit_cast(bf16x8,pw##k)
  #define VFR(i) (bf16x8){vlo[i][0],vlo[i][1],vlo[i][2],vlo[i][3],vhi[i][0],vhi[i][1],vhi[i][2],vhi[i][3]}
  #define PIN(x) asm volatile("":"+v"(x))
  #define MX3(a,b,c) __builtin_fmaxf(__builtin_fmaxf((a),(b)),(c))
  #define GAPA(MF,A0,A1,A2,A3,W0,W1,PW) do{ MF; sacc+=A0; sacc+=A1; sacc+=A2; sacc+=A3; PIN(sacc); W0; W1; PIN(PW); SBAR(); }while(0)
  #define EX(v) __builtin_amdgcn_exp2f(v)
  #define GAPB(MF,X,B) do{ MF; X[B]=EX(X[B]); X[B+1]=EX(X[B+1]); X[B+2]=EX(X[B+2]); X[B+3]=EX(X[B+3]); PIN(X); SBAR(); }while(0)
  #define VRD(i) do{ vlo[i]=vtr(vp_+(((i)>>2)*4096+((i)&3)*1024)); vhi[i]=vtr(vp_+(((i)>>2)*4096+((i)&3)*1024+512)); }while(0)
  #define KRD(G,j) do{ if(G){ kload2(kf,kp0+sl_next,j); SBAR(); } }while(0)
  #define STEP(C0,C1,P0,P1,t,GK,GV,GL) do{ SBAR(); \
    const lds_cptr vp_=vp0+sl_prev; \
    VRD(0); SBAR(); float sacc=(P0[0]+P0[1]); \
    GAPA(C0=__builtin_amdgcn_mfma_f32_32x32x16_bf16(kf[0],qr[0],negm,0,0,0), P0[2],P0[3],P0[4],P0[5],     pw0[0]=PKW(P0,0), pw0[1]=PKW(P0,2), pw0); \
    VRD(4); SBAR(); GAPA(C1=__builtin_amdgcn_mfma_f32_32x32x16_bf16(kf[1],qr[0],negm,0,0,0), P0[6],P0[7],P0[8],P0[9],     pw0[2]=PKW(P0,4), pw0[3]=PKW(P0,6), pw0); \
    VRD(1); SBAR(); GAPA(C0=__builtin_amdgcn_mfma_f32_32x32x16_bf16(kf[2],qr[1],C0,0,0,0),   P0[10],P0[11],P0[12],P0[13], pw1[0]=PKW(P0,8), pw1[1]=PKW(P0,10), pw1); \
    VRD(5); SBAR(); GAPA(C1=__builtin_amdgcn_mfma_f32_32x32x16_bf16(kf[3],qr[1],C1,0,0,0),   P0[14],P0[15],P1[0],P1[1],   pw1[2]=PKW(P0,12),pw1[3]=PKW(P0,14), pw1); \
    VRD(2); SBAR(); GAPA(C0=__builtin_amdgcn_mfma_f32_32x32x16_bf16(kf[4],qr[2],C0,0,0,0),   P1[2],P1[3],P1[4],P1[5],     pw2[0]=PKW(P1,0), pw2[1]=PKW(P1,2), pw2); \
    VRD(6); SBAR(); GAPA(C1=__builtin_amdgcn_mfma_f32_32x32x16_bf16(kf[5],qr[2],C1,0,0,0),   P1[6],P1[7],P1[8],P1[9],     pw2[2]=PKW(P1,4), pw2[3]=PKW(P1,6), pw2); \
    VRD(3); SBAR(); GAPA(C0=__builtin_amdgcn_mfma_f32_32x32x16_bf16(kf[6],qr[3],C0,0,0,0),   P1[10],P1[11],P1[12],P1[13], pw3[0]=PKW(P1,8), pw3[1]=PKW(P1,10), pw3); \
    VRD(7); SBAR(); GAPA(C1=__builtin_amdgcn_mfma_f32_32x32x16_bf16(kf[7],qr[3],C1,0,0,0),   P1[14],P1[15],0.f,0.f,       pw3[2]=PKW(P1,12),pw3[3]=PKW(P1,14), pw3); \
    l_reg+=sacc; \
    if(GK){DMA_K((t)+3,sl_cur);} if(GV){DMA_V((t)+1,sl_next);} \
    CMASK(C0,C1,t); \
    { float a=MX3(C0[0],C0[1],C1[0]),b=MX3(C0[2],C0[3],C1[1]); a=MX3(a,C1[2],C1[3]); \
      _Pragma("unroll") for(int r=4;r<16;r+=4){a=MX3(a,C0[r],C0[r+1]);b=MX3(b,C0[r+2],C0[r+3]);a=MX3(a,C1[r],C1[r+1]);b=MX3(b,C1[r+2],C1[r+3]);} \
      float rm=__builtin_fmaxf(a,b); { auto rr=__builtin_amdgcn_permlane32_swap(__float_as_uint(rm),__float_as_uint(rm),false,false); rm=__builtin_fmaxf(__uint_as_float(rr[0]),__uint_as_float(rr[1])); } \
      resc=false; \
      if(__builtin_expect(__any(rm>(float)THRL),0)){ const float dl=__builtin_fmaxf(rm,0.f); mhat+=dl; \
        _Pragma("unroll") for(int r=0;r<16;++r){C0[r]-=dl;C1[r]-=dl;} \
        _Pragma("unroll") for(int r=0;r<16;++r)negm[r]=-mhat; asm volatile("":"+v"(negm)); \
        const float f=__builtin_amdgcn_exp2f(-dl); l_reg*=f; if(hi==0)wsf[r32]=f; resc=true; } } \
    SBAR(); \
    GAPB(o[0]=__builtin_amdgcn_mfma_f32_32x32x16_bf16(PAF(0),VFR(0),o[0],0,0,0), C0,0); \
    GAPB(o[1]=__builtin_amdgcn_mfma_f32_32x32x16_bf16(PAF(0),VFR(4),o[1],0,0,0), C0,4); \
    KRD(GL,0); GAPB(o[0]=__builtin_amdgcn_mfma_f32_32x32x16_bf16(PAF(1),VFR(1),o[0],0,0,0), C0,8); \
    KRD(GL,1); GAPB(o[1]=__builtin_amdgcn_mfma_f32_32x32x16_bf16(PAF(1),VFR(5),o[1],0,0,0), C0,12); \
    KRD(GL,2); GAPB(o[0]=__builtin_amdgcn_mfma_f32_32x32x16_bf16(PAF(2),VFR(2),o[0],0,0,0), C1,0); \
    KRD(GL,3); GAPB(o[1]=__builtin_amdgcn_mfma_f32_32x32x16_bf16(PAF(2),VFR(6),o[1],0,0,0), C1,4); \
    GAPB(o[0]=__builtin_amdgcn_mfma_f32_32x32x16_bf16(PAF(3),VFR(3),o[0],0,0,0), C1,8); \
    GAPB(o[1]=__builtin_amdgcn_mfma_f32_32x32x16_bf16(PAF(3),VFR(7),o[1],0,0,0), C1,12); \
    }while(0)
  int t=1;
  #undef CMASK
  #define CMASK(P0,P1,t) do{}while(0)
  for(;t+5<NT;t+=2){
    STEP(pB0,pB1,pA0,pA1,t,true,true,true);     WAIT_BAR(2); RESC(); ROT();
    STEP(pA0,pA1,pB0,pB1,t+1,true,true,true);   WAIT_BAR(2); RESC(); ROT();
  }
  #undef CMASK
  #define CMASK(P0,P1,t) do{}while(0)
  #define ENDW(tt) do{ if((tt)+3<NT){WAIT_BAR(2);} else if((tt)+2<NT){WAIT_BAR(1);} else {WAIT_BAR(0);} }while(0)
  for(;t+1<NT;t+=2){
    STEP(pB0,pB1,pA0,pA1,t,(t+3<NT),(t+1<NT),(t+1<NT));       ENDW(t);   RESC(); ROT();
    STEP(pA0,pA1,pB0,pB1,t+1,(t+4<NT),(t+2<NT),(t+2<NT));     ENDW(t+1); RESC(); ROT();
  }
  STEP(pB0,pB1,pA0,pA1,NT-1,false,false,false); RESC();
  { float sacc=pB0[0]+pB0[1]; _Pragma("unroll") for(int r=2;r<16;++r)sacc+=pB0[r]; _Pragma("unroll") for(int r=0;r<16;++r)sacc+=pB1[r]; l_reg+=sacc;
    pw0=(u32x4){PKW(pB0,0),PKW(pB0,2),PKW(pB0,4),PKW(pB0,6)};pw1=(u32x4){PKW(pB0,8),PKW(pB0,10),PKW(pB0,12),PKW(pB0,14)};pw2=(u32x4){PKW(pB1,0),PKW(pB1,2),PKW(pB1,4),PKW(pB1,6)};pw3=(u32x4){PKW(pB1,8),PKW(pB1,10),PKW(pB1,12),PKW(pB1,14)};
    SBAR(); pv(o,vb0+sl_cur,PAF(0),PAF(1),PAF(2),PAF(3)); }
  #undef PKW
  #undef PAF
  #undef VFR
  #undef PIN
  #undef MX3
  #undef GAPA
  #undef GAPB
  #undef EX
  #undef VRD
  #undef KRD
  #undef STEP
  #undef ENDW
  {auto rr=__builtin_amdgcn_permlane32_swap(__float_as_uint(l_reg),__float_as_uint(l_reg),false,false);l_reg=__uint_as_float(rr[0])+__uint_as_float(rr[1]);}
  if(hi==0)wsf[32+r32]=l_reg;asm volatile("s_waitcnt lgkmcnt(0)":::"memory");
  float rli[16];
  #pragma unroll
  for(int r=0;r<16;++r)rli[r]=__builtin_amdgcn_rcpf(wsf[32+crow(r,hi)]);
  bf16*Ow=Ow0+(long)wid*QBLK*OP;
  { bf16*stg=(bf16*)(shm+LDS_OST)+wid*2048;
    #pragma unroll
    for(int r=0;r<16;++r){const int orow=crow(r,hi);
      #pragma unroll
      for(int d0=0;d0<2;++d0)stg[orow*64+d0*32+r32]=__float2bfloat16(o[d0][r]*rli[r]);}
    asm volatile("s_waitcnt lgkmcnt(0)":::"memory");
    #pragma unroll
    for(int i=0;i<4;++i){const int row=i*8+(lane>>3),ch=lane&7; const u32x4 v=*(const u32x4*)(stg+row*64+ch*8); ATTN_STORE16(Ow+(long)row*OP+ch*8,v);} }
  asm volatile("s_waitcnt lgkmcnt(0)\n\ts_barrier":::"memory");
  #undef DMA_K
  #undef DMA_V
  #undef CMASK
  #undef START
  #undef RESC
  #undef ROT
}

#undef SBAR
#undef WAIT_BAR
}

typedef short bf16x8_t __attribute__((ext_vector_type(8)));
#define LDS_WAIT() asm volatile("s_waitcnt lgkmcnt(0)" ::: "memory")

__device__ __forceinline__ int inv32(int c) { return 16 * ((c >> 2) & 1) + 4 * (c >> 3) + (c & 3); }
__device__ __forceinline__ int dest_row(int type, int n) {
    if (type == 0) return n;
    if (type == 1) { const int half = n >= DFF ? 1 : 0, j = n - half * DFF, pn = j >> 7, c = j & 127; return pn * 256 + half * 128 + (c & ~31) + inv32(c & 31); }
    if (n < 768) { const int hd = n >> 6, d = n & 63, a = d >> 5, t = (d >> 4) & 1, p = d & 15; return (hd >> 2) * 256 + a * 128 + (hd & 3) * 32 + t * 16 + p; }
    const int pn = n >> 8, c = n & 255, half = c >> 7, c7 = c & 127; return pn * 256 + half * 128 + (c7 & ~31) + inv32(c7 & 31);
}
__device__ __forceinline__ void transpose_item(const float* W, int K, int N, bf16_t* WT, int type, LAS float* scr, int item, int lane) {
    const int nblk = N / 32, kb = item / nblk, nb = item % nblk, k0 = 64 * kb, n0 = 32 * nb;
#pragma unroll 8
    for (int i = 0; i < 32; ++i) { const int kk = 2 * i + (lane >> 5); scr[kk * 33 + (lane & 31)] = W[(size_t)(k0 + kk) * N + n0 + (lane & 31)]; }
    LDS_WAIT(); asm volatile("" ::: "memory");
    const int c = lane & 7;
#pragma unroll
    for (int j = 0; j < 4; ++j) { const int n = (lane >> 3) + 8 * j; const LAS float* s = scr + (8 * c) * 33 + n;
        u32x4 o; o.x = cvt_pk(s[0 * 33], s[1 * 33]); o.y = cvt_pk(s[2 * 33], s[3 * 33]); o.z = cvt_pk(s[4 * 33], s[5 * 33]); o.w = cvt_pk(s[6 * 33], s[7 * 33]);
        *(u32x4*)(WT + (size_t)dest_row(type, n0 + n) * K + k0 + 8 * c) = o; }
    LDS_WAIT(); asm volatile("" ::: "memory");
}

__device__ __forceinline__ void prologue_phase(const Params& P, LAS unsigned char* lds, int G) {
    const int tid = opaque_tid(), lane = tid & 63, wid = __builtin_amdgcn_readfirstlane(tid >> 6), bid = blockIdx.x;
    unsigned char* ws = P.ws;
    {
        LAS float* sc = (LAS float*)lds;
        LAS float* red = (LAS float*)(lds + 36864);
        for (int i = tid; i < 9 * 1024; i += NTHREADS) { const int v = i >> 10, k = i & 1023; const float cv = v < 8 ? P.in[1][v * 1024 + k] : P.in[3][k]; sc[i] = cv / (1.0f + expf(-cv)); }
        __syncthreads();
        float* mod = (float*)(ws + OFF_MOD);
        for (int item = bid; item < 2 * 144; item += G) {
            const int l = item / 144, cgp = item % 144, col = cgp * 64 + lane, kc = wid;
            const float* W = P.in[4] + (size_t)l * 1024 * MODW + col;
            float acc[9];
#pragma unroll
            for (int v = 0; v < 9; ++v) acc[v] = 0.f;
#pragma unroll 8
            for (int k = kc * 128; k < kc * 128 + 128; ++k) { const float w = W[(size_t)k * MODW];
#pragma unroll
                for (int v = 0; v < 9; ++v) acc[v] += sc[v * 1024 + k] * w; }
#pragma unroll
            for (int v = 0; v < 9; ++v) red[(kc * 9 + v) * 64 + lane] = acc[v];
            __syncthreads();
            for (int i = tid; i < 576; i += NTHREADS) { const int v = i >> 6, cc = i & 63; float s = 0.f;
#pragma unroll
                for (int q = 0; q < 8; ++q) s += red[(q * 9 + v) * 64 + cc];
                mod[(size_t)(l * 9 + v) * MODW + cgp * 64 + cc] = s + P.in[5][l * MODW + cgp * 64 + cc]; }
            __syncthreads();
        }
    }
    __syncthreads();
    {
        LAS float* scr = (LAS float*)(lds + wid * 16384);
        const int gw = bid * 8 + wid, NGW = G * 8;
        constexpr int I_FI = 16 * (NFF2 / 32), I_FO = (DFF / 64) * 32, I_WI = 16 * (INW / 32), I_WO = 16 * 32;
        constexpr int PER_L = 2 * I_FI + 2 * I_FO + I_WI + I_WO;
        for (int it = gw; it < DEPTH * PER_L; it += NGW) {
            const int l = it / PER_L; int r = it % PER_L;
            unsigned char* wb = ws + OFF_WB + (size_t)l * WB_LAYER;
            if (r < 2 * I_FI) { const int f = r / I_FI; transpose_item(P.in[7] + (size_t)(l * 2 + f) * DM * NFF2, DM, NFF2, (bf16_t*)(wb + WB_FFIN + f * WB_FFIN_SZ), 1, scr, r % I_FI, lane); continue; } r -= 2 * I_FI;
            if (r < 2 * I_FO) { const int f = r / I_FO; transpose_item(P.in[8] + (size_t)(l * 2 + f) * DFF * DM, DFF, DM, (bf16_t*)(wb + WB_FFOUT + f * WB_FFOUT_SZ), 0, scr, r % I_FO, lane); continue; } r -= 2 * I_FO;
            if (r < I_WI) { transpose_item(P.in[9] + (size_t)l * DM * INW, DM, INW, (bf16_t*)(wb + WB_WIN), 2, scr, r, lane); continue; } r -= I_WI;
            transpose_item(P.in[22] + (size_t)l * DM * DM, DM, DM, (bf16_t*)(wb + WB_WOUT), 0, scr, r, lane);
        }
        bf16_t* LW = (bf16_t*)(ws + OFF_LW);
        const int gt = bid * NTHREADS + tid, NGT = G * NTHREADS;
        for (int i = gt; i < DEPTH * 4 * 256 * 64; i += NGT) {
            const int d = i & 63, c = (i >> 6) & 255, g = (i >> 14) & 3, l = i >> 16, n = c >> 6, e = c & 63;
            const float* src = (g & 1) ? P.in[16] : P.in[14];
            const float v = src[((((size_t)l * 2 + (g >> 1)) * 4 + n) * 64 + d) * 64 + e];
            LW[i] = (bf16_t)(cvt_pk(v, 0.f) & 0xffffu);
        }
        float* rc = (float*)(ws + OFF_ROPE); float* rs = rc + 2048;
        for (int i = gt; i < 2048; i += NGT) { const int pos = i >> 4, p = i & 15; const float inv = powf(10000.0f, -(float)p / 16.0f), ang = (float)pos * inv; rc[i] = cosf(ang); rs[i] = sinf(ang); }
    }
}

__device__ __forceinline__ void norm_phase(const Params& P, int l, int idx, int row_lo, int row_hi, bool first, int wg0, int nwg) {
    const int tid = opaque_tid(), lane = tid & 63, wid = __builtin_amdgcn_readfirstlane(tid >> 6);
    if ((int)blockIdx.x < wg0 || (int)blockIdx.x >= wg0 + nwg) return;
    const int gw = ((int)blockIdx.x - wg0) * 8 + wid, NGW = nwg * 8, per = (row_hi - row_lo + NGW - 1) / NGW;
    const int r0 = row_lo + gw * per, r1 = (r0 + per < row_hi) ? r0 + per : row_hi;
    const float* mod = (const float*)(P.ws + OFF_MOD) + (size_t)l * 9 * MODW;
    const float* gsrc = P.in[6] + (size_t)(l * 3 + idx) * DM;
    const bf16_t* xres = (const bf16_t*)(P.ws + OFF_XRES); bf16_t* hb = (bf16_t*)(P.ws + OFF_HBUF);
    int curv = -1; f32x4 Aa[4], Bb[4];
    for (int row = r0; row < r1; ++row) {
        const int v = row < MLAT ? (row >> 13) : 8;
        if (v != curv) { curv = v;
#pragma unroll
            for (int j = 0; j < 4; ++j) { const int c = 4 * lane + 256 * j; const f32x4 g4 = *(const f32x4*)(gsrc + c), sh = *(const f32x4*)(mod + (size_t)v * MODW + (3 * idx) * DM + c), sc = *(const f32x4*)(mod + (size_t)v * MODW + (3 * idx + 1) * DM + c);
                Aa[j] = g4 * (sc + 1.0f); Bb[j] = sh; } }
        f32x4 x[4]; float ss = 0.f;
        if (first) { const float* xr = row < MLAT ? P.in[0] + (size_t)row * DM : P.in[2] + (size_t)(row - MLAT) * DM;
#pragma unroll
            for (int j = 0; j < 4; ++j) x[j] = *(const f32x4*)(xr + 4 * lane + 256 * j);
        } else {
#pragma unroll
            for (int j = 0; j < 4; ++j) { const u32x2 r = *(const u32x2*)(xres + (size_t)row * DM + 4 * lane + 256 * j); x[j] = (f32x4){bf_lo(r.x), bf_hi(r.x), bf_lo(r.y), bf_hi(r.y)}; }
        }
#pragma unroll
        for (int j = 0; j < 4; ++j) { ss += (x[j][0] * x[j][0] + x[j][1] * x[j][1]) + (x[j][2] * x[j][2] + x[j][3] * x[j][3]); }
        const float rstd = 1.0f / sqrtf(wave_sum(ss) * (1.0f / DM) + EPS);
#pragma unroll
        for (int j = 0; j < 4; ++j) { const f32x4 y = x[j] * rstd * Aa[j] + Bb[j]; u32x2 w; w.x = cvt_pk(y[0], y[1]); w.y = cvt_pk(y[2], y[3]);
            *(u32x2*)(hb + (size_t)row * DM + 4 * lane + 256 * j) = w;
 }
    }
}
__device__ __forceinline__ void final_norm_phase(const Params& P, int G) {
    const int tid = opaque_tid(), lane = tid & 63, wid = __builtin_amdgcn_readfirstlane(tid >> 6);
    const int gw = blockIdx.x * 8 + wid, NGW = G * 8;
    const bf16_t* xres = (const bf16_t*)(P.ws + OFF_XRES);
    f32x4 g4[4];
#pragma unroll
    for (int j = 0; j < 4; ++j) g4[j] = *(const f32x4*)(P.in[23] + 4 * lane + 256 * j);
    for (int row = gw; row < MLAT; row += NGW) {
        f32x4 x[4]; float ss = 0.f;
#pragma unroll
        for (int j = 0; j < 4; ++j) { const u32x2 r = *(const u32x2*)(xres + (size_t)row * DM + 4 * lane + 256 * j); x[j] = (f32x4){bf_lo(r.x), bf_hi(r.x), bf_lo(r.y), bf_hi(r.y)}; ss += (x[j][0] * x[j][0] + x[j][1] * x[j][1]) + (x[j][2] * x[j][2] + x[j][3] * x[j][3]); }
        const float rstd = 1.0f / sqrtf(wave_sum(ss) * (1.0f / DM) + EPS);
#pragma unroll
        for (int j = 0; j < 4; ++j) *(f32x4*)(P.out + (size_t)row * DM + 4 * lane + 256 * j) = x[j] * rstd * g4[j];
    }
}

constexpr int L1_AST = 528;
constexpr int L1_UST = 260;
constexpr int L1_UOFF = 66560;
__device__ __forceinline__ void lru1_phase(const Params& P, int l, LAS unsigned char* lds, int G) {
    const int tid = opaque_tid(), lane = tid & 63, wid = __builtin_amdgcn_readfirstlane(tid >> 6), fr = lane & 15, fq = lane >> 4;
    LAS unsigned char* ldsA = lds; LAS float* ldsU = (LAS float*)(lds + L1_UOFF);
    const bf16_t* Ubuf = (const bf16_t*)(P.ws + OFF_U5);
    float* Sg = (float*)(P.ws + OFF_S); unsigned* PPg = (unsigned*)(P.ws + OFF_PP); float* csum = (float*)(P.ws + OFF_CSUM);
    const bf16_t* LW = (const bf16_t*)(P.ws + OFF_LW) + (size_t)l * 4 * 256 * 64;
    const int ch4 = (tid & 63) * 4, pg = tid >> 6;
    f32x4 cw[4], cbias;
#pragma unroll
    for (int i = 0; i < 4; ++i) cw[i] = *(const f32x4*)(P.in[12] + (size_t)(l * 4 + i) * 256 + ch4);
    cbias = *(const f32x4*)(P.in[13] + (size_t)l * 256 + ch4);
    const int nblk = wid >> 1;
    for (int tile = blockIdx.x; tile < NBATCH * NCHUNK; tile += G) {
        const int b = tile / NCHUNK, cidx = tile % NCHUNK, P0 = cidx * 64; const bool latent = cidx >= 4;
        const int seg_lo = latent ? 256 : 0, seg_hi = latent ? KEYS : 256;
        const int rbase = latent ? b * SEQ - 256 : MLAT + b * CTXL;
        {
            const int pp0 = P0 + pg * 8;
            f32x4 win[11];
#pragma unroll
            for (int i = 0; i < 11; ++i) { const int Pq = pp0 - 2 + i; f32x4 w4 = {0.f, 0.f, 0.f, 0.f};
                if (Pq >= seg_lo && Pq < seg_hi) { const u32x2 raw = *(const u32x2*)(Ubuf + (size_t)(rbase + Pq) * 256 + ch4); w4 = (f32x4){bf_lo(raw.x), bf_hi(raw.x), bf_lo(raw.y), bf_hi(raw.y)}; }
                win[i] = w4; }
#pragma unroll
            for (int q = 0; q < 8; ++q) { f32x4 y = cbias;
#pragma unroll
                for (int i = 0; i < 4; ++i) y = y + cw[i] * win[q + i];
                const int pos = pg * 8 + q;
                u32x2 w; w.x = cvt_pk(y[0], y[1]); w.y = cvt_pk(y[2], y[3]);
                *(LAS u32x2*)(ldsA + pos * L1_AST + ch4 * 2) = w;
                *(LAS f32x4*)(ldsU + pos * L1_UST + ch4) = y; }
        }
        __syncthreads();
#pragma unroll 1
        for (int cc = 0; cc < 2; ++cc) {
            const int c = 32 * wid + 16 * cc + fr;
            const float baf = P.in[15][(l * 2 + 0) * 256 + c], bab = P.in[15][(l * 2 + 1) * 256 + c], bxf = P.in[17][(l * 2 + 0) * 256 + c], bxb = P.in[17][(l * 2 + 1) * 256 + c];
            const float nspf = -8.0f * log1pf(expf(-P.in[18][(l * 2 + 0) * 256 + c])), nspb = -8.0f * log1pf(expf(-P.in[18][(l * 2 + 1) * 256 + c]));
            f32x4 acc[4][4];
            {
                bf16x8_t bw[4][2];
#pragma unroll
                for (int g = 0; g < 4; ++g)
#pragma unroll
                    for (int kk = 0; kk < 2; ++kk) bw[g][kk] = *(const bf16x8_t*)(LW + ((size_t)(g * 256 + c) * 64 + kk * 32 + fq * 8));
#pragma unroll
                for (int m = 0; m < 4; ++m) {
#pragma unroll
                    for (int g = 0; g < 4; ++g) acc[m][g] = (f32x4){0.f, 0.f, 0.f, 0.f};
#pragma unroll
                    for (int kk = 0; kk < 2; ++kk) { const bf16x8_t a = *(const LAS bf16x8_t*)(ldsA + (16 * m + fr) * L1_AST + (64 * nblk + 32 * kk + 8 * fq) * 2);
#pragma unroll
                        for (int g = 0; g < 4; ++g) acc[m][g] = __builtin_amdgcn_mfma_f32_16x16x32_bf16(a, bw[g][kk], acc[m][g], 0, 0, 0); }
                }
            }
#pragma unroll
            for (int m = 0; m < 4; ++m)
#pragma unroll
                for (int j = 0; j < 4; ++j) {
                    const float u = ldsU[(16 * m + 4 * fq + j) * L1_UST + c];
                    {   const float r = sigmoidf_(acc[m][0][j] + baf), ig = sigmoidf_(acc[m][1][j] + bxf);
                        const float la = nspf * r, a = __expf(la), y = 2.0f * la;
                        const float em = (y > -0.1f) ? y * (1.0f + y * (0.5f + y * (0.16666667f + y * 0.041666668f))) : (__expf(y) - 1.0f);
                        acc[m][0][j] = a; acc[m][1][j] = sqrtf(-em) * ig * u; }
                    {   const float r = sigmoidf_(acc[m][2][j] + bab), ig = sigmoidf_(acc[m][3][j] + bxb);
                        const float la = nspb * r, a = __expf(la), y = 2.0f * la;
                        const float em = (y > -0.1f) ? y * (1.0f + y * (0.5f + y * (0.16666667f + y * 0.041666668f))) : (__expf(y) - 1.0f);
                        acc[m][2][j] = a; acc[m][3][j] = sqrtf(-em) * ig * u; }
                }
            f32x4 hf[4], pf[4];
            {
                float cA = 1.f, cH = 0.f;
#pragma unroll
                for (int m = 0; m < 4; ++m) {
                    const f32x4 a = acc[m][0], x = acc[m][1];
                    const float A0 = a[0], H0 = x[0], A1 = A0 * a[1], H1 = a[1] * H0 + x[1], A2 = A1 * a[2], H2 = a[2] * H1 + x[2], A3 = A2 * a[3], H3 = a[3] * H2 + x[3];
                    float TA = A3, TH = H3;
                    float tA = __shfl_up(TA, 16), tH = __shfl_up(TH, 16); if (fq >= 1) { TH = TA * tH + TH; TA = TA * tA; }
                    tA = __shfl_up(TA, 32); tH = __shfl_up(TH, 32); if (fq >= 2) { TH = TA * tH + TH; TA = TA * tA; }
                    float EA = __shfl_up(TA, 16), EH = __shfl_up(TH, 16); if (fq == 0) { EA = 1.f; EH = 0.f; }
                    const float inA = cA * EA, inH = EA * cH + EH;
                    pf[m] = (f32x4){inA * A0, inA * A1, inA * A2, inA * A3};
                    hf[m] = (f32x4){A0 * inH + H0, A1 * inH + H1, A2 * inH + H2, A3 * inH + H3};
                    const float gA = __shfl(TA, fr + 48), gH = __shfl(TH, fr + 48);
                    cH = gA * cH + gH; cA = cA * gA;
                }
                if (fq == 0) { float* cs = csum + ((size_t)(b * NCHUNK + cidx) * 2 + 0) * 512 + c; cs[0] = cA; cs[256] = cH; }
            }
            {
                float cA = 1.f, cH = 0.f;
#pragma unroll
                for (int mm = 0; mm < 4; ++mm) { const int m = 3 - mm;
                    const f32x4 a = acc[m][2], x = acc[m][3];
                    const float A3 = a[3], H3 = x[3], A2 = A3 * a[2], H2 = a[2] * H3 + x[2], A1 = A2 * a[1], H1 = a[1] * H2 + x[1], A0 = A1 * a[0], H0 = a[0] * H1 + x[0];
                    float TA = A0, TH = H0;
                    float tA = __shfl_down(TA, 16), tH = __shfl_down(TH, 16); if (fq <= 2) { TH = TA * tH + TH; TA = TA * tA; }
                    tA = __shfl_down(TA, 32); tH = __shfl_down(TH, 32); if (fq <= 1) { TH = TA * tH + TH; TA = TA * tA; }
                    float EA = __shfl_down(TA, 16), EH = __shfl_down(TH, 16); if (fq == 3) { EA = 1.f; EH = 0.f; }
                    const float inA = cA * EA, inH = EA * cH + EH;
                    const f32x4 pb = (f32x4){inA * A0, inA * A1, inA * A2, inA * A3};
                    const f32x4 hb = (f32x4){A0 * inH + H0, A1 * inH + H1, A2 * inH + H2, A3 * inH + H3};
#pragma unroll
                    for (int j = 0; j < 4; ++j) { const int tk = 16 * m + 4 * fq + j;
                        ldsU[tk * L1_UST + c] = hf[m][j] + hb[j];
                        PPg[(size_t)(rbase + P0 + tk) * 256 + c] = (cvt_pk(pf[m][j], 0.f) & 0xffffu) | (cvt_pk(0.f, pb[j]) & 0xffff0000u); }
                    const float gA = __shfl(TA, fr), gH = __shfl(TH, fr);
                    cH = gA * cH + gH; cA = cA * gA;
                }
                if (fq == 0) { float* cs = csum + ((size_t)(b * NCHUNK + cidx) * 2 + 1) * 512 + c; cs[0] = cA; cs[256] = cH; }
            }
        }
        __syncthreads();
#pragma unroll
        for (int it = 0; it < 8; ++it) { const int idx = it * NTHREADS + tid, r = idx >> 6, c16 = idx & 63; const size_t grow = (size_t)(rbase + P0 + r) * 256 + c16 * 4;
            *(f32x4*)(Sg + grow) = *(const LAS f32x4*)(ldsU + r * L1_UST + c16 * 4);
 }
        __syncthreads();
    }
}
__device__ __forceinline__ void lru2_batch(const Params& P, int b) {
    const int tid = opaque_tid(), dir = tid >> 8, c = tid & 255;
    const float* csum = (const float*)(P.ws + OFF_CSUM); float* carry = (float*)(P.ws + OFF_CARRY);
    float h = 0.f;
#pragma unroll 1
    for (int k0 = 0; k0 < NCHUNK; k0 += 12) {
        float A[12], H[12]; int ci[12];
#pragma unroll
        for (int q = 0; q < 12; ++q) { const int k = k0 + q; ci[q] = dir == 0 ? k : (k < 4 ? 3 - k : 135 - k);
            const float* cs = csum + ((size_t)(b * NCHUNK + ci[q]) * 2 + dir) * 512 + c; A[q] = cs[0]; H[q] = cs[256]; }
#pragma unroll
        for (int q = 0; q < 12; ++q) { carry[((size_t)(b * NCHUNK + ci[q]) * 2 + dir) * 256 + c] = h; h = A[q] * h + H[q]; }
    }
}
__device__ __forceinline__ float gelu_tanh(float x) { const float z = 0.7978845608f * (x + 0.044715f * x * x * x); const float t = 1.0f - 2.0f * __builtin_amdgcn_rcpf(1.0f + __expf(2.0f * z)); return 0.5f * x * (1.0f + t); }
__device__ __forceinline__ void merge_phase(const Params& P, int l, int Mrows, int G) {
    const int tid = opaque_tid(), lane = tid & 63, wid = __builtin_amdgcn_readfirstlane(tid >> 6);
    const int gw = blockIdx.x * 8 + wid, NGW = G * 8, c4 = 4 * lane;
    const bf16_t* U5 = (const bf16_t*)(P.ws + OFF_U5);
    const bf16_t *Gb = U5 + U5_STRIDE, *BGb = U5 + 2 * U5_STRIDE, *CGb = U5 + 3 * U5_STRIDE, *SSb = U5 + 4 * U5_STRIDE;
    const float* Sg = (const float*)(P.ws + OFF_S); const unsigned* PPg = (const unsigned*)(P.ws + OFF_PP); const float* carry = (const float*)(P.ws + OFF_CARRY);
    bf16_t* hb = (bf16_t*)(P.ws + OFF_HBUF); const bf16_t* att = (const bf16_t*)(P.ws + OFF_ATT);
    f32x4 w0 = *(const f32x4*)(P.in[19] + (size_t)(l * 3 + 0) * 256 + c4), w1 = *(const f32x4*)(P.in[19] + (size_t)(l * 3 + 1) * 256 + c4), w2 = *(const f32x4*)(P.in[19] + (size_t)(l * 3 + 2) * 256 + c4);
    f32x4 cb4 = *(const f32x4*)(P.in[20] + (size_t)l * 256 + c4);
    const float* gg = P.in[21] + (size_t)l * 1024;
    const f32x4 ga0 = *(const f32x4*)(gg + 8 * lane), ga1 = *(const f32x4*)(gg + 8 * lane + 4), gl = *(const f32x4*)(gg + 512 + c4), gs = *(const f32x4*)(gg + 768 + c4);
    const int per = (Mrows + NGW - 1) / NGW, r0 = gw * per, r1 = (r0 + per < Mrows) ? r0 + per : Mrows;
    int curc = -1; f32x4 cf = {0.f, 0.f, 0.f, 0.f}, cbk = {0.f, 0.f, 0.f, 0.f};
    f32x4 pm1, p0, pp1;
    auto prodrow = [&](int r) -> f32x4 { const size_t o = (size_t)r * 256 + c4; const u32x2 a = *(const u32x2*)(CGb + o), s2 = *(const u32x2*)(SSb + o);
        return (f32x4){bf_lo(a.x) * bf_lo(s2.x), bf_hi(a.x) * bf_hi(s2.x), bf_lo(a.y) * bf_lo(s2.y), bf_hi(a.y) * bf_hi(s2.y)}; };
    const f32x4 zero4 = {0.f, 0.f, 0.f, 0.f};
    if (r0 < r1) { const int sp = r0 < MLAT ? (r0 & 8191) : ((r0 - MLAT) & 255); pm1 = sp == 0 ? zero4 : prodrow(r0 - 1); p0 = prodrow(r0); }
    for (int row = r0; row < r1; ++row) {
        int b, cidx, sp, slen;
        if (row < MLAT) { b = row >> 13; sp = row & 8191; cidx = 4 + (sp >> 6); slen = SEQ; } else { const int rc = row - MLAT; b = rc >> 8; sp = rc & 255; cidx = sp >> 6; slen = CTXL; }
        const int ckey = b * NCHUNK + cidx;
        if (ckey != curc) { curc = ckey; cf = *(const f32x4*)(carry + ((size_t)ckey * 2 + 0) * 256 + c4); cbk = *(const f32x4*)(carry + ((size_t)ckey * 2 + 1) * 256 + c4); }
        if (sp == 0) { pm1 = zero4; if (row != r0) p0 = prodrow(row); }
        pp1 = (sp + 1 == slen) ? zero4 : prodrow(row + 1);
        {   const size_t o = (size_t)row * 256 + c4;
            const f32x4 S4 = *(const f32x4*)(Sg + o); const u32x4 pp = *(const u32x4*)(PPg + o);
            const u32x2 g2 = *(const u32x2*)(Gb + o), bg2 = *(const u32x2*)(BGb + o);
            const u32x4 at = *(const u32x4*)(att + (size_t)row * 512 + 8 * lane);
            f32x4 hv;
#pragma unroll
            for (int j = 0; j < 4; ++j) hv[j] = S4[j] + bf_lo(pp[j]) * cf[j] + bf_hi(pp[j]) * cbk[j];
            const f32x4 g4 = (f32x4){bf_lo(g2.x), bf_hi(g2.x), bf_lo(g2.y), bf_hi(g2.y)}, bg4 = (f32x4){bf_lo(bg2.x), bf_hi(bg2.x), bf_lo(bg2.y), bf_hi(bg2.y)};
            f32x4 lru, scv;
#pragma unroll
            for (int j = 0; j < 4; ++j) { lru[j] = hv[j] * gelu_tanh(g4[j]); scv[j] = bg4[j] * (w0[j] * pm1[j] + w1[j] * p0[j] + w2[j] * pp1[j] + cb4[j]); }
            float av[8];
#pragma unroll
            for (int j = 0; j < 4; ++j) { av[2 * j] = bf_lo(at[j]); av[2 * j + 1] = bf_hi(at[j]); }
            float ssa = 0.f, ssl = 0.f, sss = 0.f;
#pragma unroll
            for (int j = 0; j < 8; ++j) ssa += av[j] * av[j];
#pragma unroll
            for (int j = 0; j < 4; ++j) { ssl += lru[j] * lru[j]; sss += scv[j] * scv[j]; }
            ssa = wave_sum(ssa); ssl = wave_sum(ssl); sss = wave_sum(sss);
            const float ra = 1.0f / sqrtf(ssa * (1.0f / 512.0f) + EPS), rl = 1.0f / sqrtf(ssl * (1.0f / 256.0f) + EPS), rs = 1.0f / sqrtf(sss * (1.0f / 256.0f) + EPS);
            u32x4 wa; wa.x = cvt_pk(av[0] * ra * ga0[0], av[1] * ra * ga0[1]); wa.y = cvt_pk(av[2] * ra * ga0[2], av[3] * ra * ga0[3]); wa.z = cvt_pk(av[4] * ra * ga1[0], av[5] * ra * ga1[1]); wa.w = cvt_pk(av[6] * ra * ga1[2], av[7] * ra * ga1[3]);
            *(u32x4*)(hb + (size_t)row * DM + 8 * lane) = wa;
            u32x2 wl; wl.x = cvt_pk(lru[0] * rl * gl[0], lru[1] * rl * gl[1]); wl.y = cvt_pk(lru[2] * rl * gl[2], lru[3] * rl * gl[3]);
            *(u32x2*)(hb + (size_t)row * DM + 512 + c4) = wl;
            u32x2 wsv; wsv.x = cvt_pk(scv[0] * rs * gs[0], scv[1] * rs * gs[1]); wsv.y = cvt_pk(scv[2] * rs * gs[2], scv[3] * rs * gs[3]);
            *(u32x2*)(hb + (size_t)row * DM + 768 + c4) = wsv;
        }
        pm1 = p0; p0 = pp1;
    }
}
__device__ __forceinline__ void attention_phase(const Params& P, int l, char* lds, int G) {
    using abf = attn_body::bf16;
    const abf* Q = (const abf*)(P.ws + OFF_Q); const abf* K = (const abf*)(P.ws + OFF_K); const abf* V = (const abf*)(P.ws + OFF_V); abf* O = (abf*)(P.ws + OFF_ATT);
    if (blockIdx.x < NBATCH) lru2_batch(P, blockIdx.x);
    const int nunits = NBATCH * 8 * 32 + ((l + 1 < DEPTH) ? NBATCH * 8 : 0);
    for (int uid = blockIdx.x; uid < nunits; uid += G) {
        int b, h, NT; size_t qrow;
        if (uid < NBATCH * 8 * 32) { b = uid & 7; const int rest = uid >> 3, kvh = rest >> 7, u = rest & 127; h = kvh * 4 + (u >> 5); qrow = (size_t)b * SEQ + (u & 31) * 256; NT = NCHUNK; }
        else { const int v = uid - NBATCH * 8 * 32; b = v & 7; h = v >> 3; qrow = (size_t)MLAT + b * CTXL; NT = 4; }
        const size_t kvoff = (size_t)b * KEYS * 128 + (h >> 2) * 64;
        attn_body::attn_unit<8>(Q + qrow * 512 + h * 64, K + kvoff, V + kvoff, O + qrow * 512 + h * 64, NT, lds);
    }
}

#define XB_TMO      128
#define XB_XCNT(j)  (256  + 64 * (j))
#define XB_XSUB(j)  (1280 + 64 * (j))
#define XB_XGEN(j)  (2304 + 64 * (j))
#define XB_TOP      3328
#define XB_TOPGEN   3392
#define XCD_BAR_WORDS 3456
#define XB_SPIN_CAP (1u << 18)

__device__ __forceinline__ unsigned xb_ld(unsigned* p)              { return __hip_atomic_load(p, __ATOMIC_RELAXED, __HIP_MEMORY_SCOPE_AGENT); }
__device__ __forceinline__ unsigned xb_add(unsigned* p, unsigned v) { return __hip_atomic_fetch_add(p, v, __ATOMIC_RELAXED, __HIP_MEMORY_SCOPE_AGENT); }
__device__ __forceinline__ unsigned xb_xcc_id() { return (unsigned)__builtin_amdgcn_s_getreg((3 << 11) | 20) & 0xFu; }
#define XB_SPIN(cond, bar) do { unsigned _sp = 0; while (cond) { __builtin_amdgcn_s_sleep(1); \
    if ((++_sp & 255u) == 0u) { if (xb_ld(&(bar)[XB_TMO])) break; if (_sp > XB_SPIN_CAP) { atomicAdd(&(bar)[XB_TMO], 1u); break; } } } } while (0)

struct XcdBarrier {
    unsigned* bar; unsigned x;
    volatile LAS unsigned* st;
};

__device__ __forceinline__ XcdBarrier xcd_barrier_post(unsigned* bar, volatile LAS unsigned* st) {
    XcdBarrier b; b.bar = bar; b.x = xb_xcc_id(); b.st = st;
    if (threadIdx.x == 0) (void)xb_add(&bar[XB_XCNT(b.x)], 1u);
    return b;
}
__device__ __forceinline__ void xcd_barrier_complete(unsigned* bar, unsigned x, unsigned& nloc, unsigned& nx) {
    const unsigned G = gridDim.x * gridDim.y * gridDim.z;
    unsigned sum, cnt, mine, sp = 0u;
    for (;;) {
        sum = 0u; cnt = 0u; mine = 0u;
#pragma unroll
        for (unsigned j = 0; j < 16; ++j) { const unsigned c = xb_ld(&bar[XB_XCNT(j)]); sum += c; cnt += (c > 0u) ? 1u : 0u; mine = (j == x) ? c : mine; }
        if (sum == G) break;
        __builtin_amdgcn_s_sleep(1);
        if ((++sp & 255u) == 0u) { if (xb_ld(&bar[XB_TMO])) break; if (sp > XB_SPIN_CAP) { atomicAdd(&bar[XB_TMO], 1u); break; } }
    }
    nloc = mine > 0u ? mine : 1u; nx = cnt > 0u ? cnt : 1u;
}

__device__ __forceinline__ void xcd_barrier(const XcdBarrier& b) {
    asm volatile("s_waitcnt vmcnt(0)" ::: "memory");
    __syncthreads();
    if (threadIdx.x == 0) {
        unsigned* bar = b.bar; unsigned bx_ = b.x; asm volatile("" : "+s"(bx_));
        __builtin_amdgcn_s_waitcnt(0);
        unsigned nloc = b.st[0], nx = b.st[1];
        if (nloc == 0u) { xcd_barrier_complete(bar, bx_, nloc, nx); b.st[0] = nloc; b.st[1] = nx; }
        const unsigned old = xb_add(&bar[XB_XSUB(bx_)], 1u);
        const unsigned gen = old / nloc;
        if (old + 1u == (gen + 1u) * nloc) {
            __builtin_amdgcn_fence(__ATOMIC_RELEASE, "agent");
            asm volatile("s_waitcnt vmcnt(0)" ::: "memory");
            const unsigned og = xb_add(&bar[XB_TOP], 1u);
            const unsigned tg = og / nx;
            if (og + 1u == (tg + 1u) * nx) xb_add(&bar[XB_TOPGEN], 1u);
            else XB_SPIN(xb_ld(&bar[XB_TOPGEN]) == tg, bar);
            __builtin_amdgcn_fence(__ATOMIC_ACQUIRE, "agent");
            xb_add(&bar[XB_XGEN(bx_)], 1u);
            asm volatile("s_waitcnt vmcnt(0)" ::: "memory");
        } else {
            XB_SPIN(xb_ld(&bar[XB_XGEN(bx_)]) == gen, bar);
            __builtin_amdgcn_fence(__ATOMIC_ACQUIRE, "agent");
            asm volatile("s_waitcnt vmcnt(0)" ::: "memory");
        }
    }
    __syncthreads();
}

#ifndef PH_MASK
#define PH_MASK 0x1FF
#endif
__global__ void __launch_bounds__(NTHREADS, 2) fwd_megakernel(Params P) {
    extern __shared__ __attribute__((aligned(16))) unsigned char lds_raw[];
    LAS unsigned char* lds = (LAS unsigned char*)lds_raw;
    cg::grid_group grid = cg::this_grid();
    volatile LAS unsigned* bst = (volatile LAS unsigned*)(lds + LDS_BAR_OFF);
    if (threadIdx.x < 2) bst[threadIdx.x] = 0u;
    __syncthreads();
    const XcdBarrier xbar = xcd_barrier_post((unsigned*)(P.ws + OFF_CTL), bst);
#define GRID_SYNC() xcd_barrier(xbar)
    const int G = gridDim.x;
    unsigned char* ws = P.ws;
    if constexpr (PH_MASK & 1) prologue_phase(P, lds, G);
    grid.sync();
    if constexpr (PH_MASK & 2) norm_phase(P, 0, 0, 0, MTOT, true, 0, G);
    GRID_SYNC();
    for (int step = 0; step < DEPTH * 3; ++step) {
        const int l = step / 3, s3 = step % 3;
        const bool last = (l == DEPTH - 1);
        const int Mn = (last && s3 == 2) ? MLAT : MTOT;
        unsigned char* wb = ws + OFF_WB + (size_t)l * WB_LAYER;
        pg8::Gemm gr; pg8::EpiResid er; int Mr;
        const float* modl = (const float*)(ws + OFF_MOD) + (size_t)l * 9 * MODW;
        if (s3 != 1) {
            const int f = s3 >> 1;
            { pg8::Gemm g{(const bf16_t*)(ws + OFF_HBUF), (const bf16_t*)(wb + WB_FFIN + f * WB_FFIN_SZ), Mn, NFF2, DM};
              pg8::StaticOrder S; S.init(Mn, NFF2, G, (int)blockIdx.x);
              pg8::EpiSwiglu E{(bf16_t*)(ws + OFF_MID)};
              if constexpr (PH_MASK & 4) pg8::gemm_phase<pg8::EpiSwiglu, pg8::StaticOrder, true, true>(lds, g, S, E); }
            GRID_SYNC();
            Mr = Mn;
            gr = pg8::Gemm{(const bf16_t*)(ws + OFF_MID), (const bf16_t*)(wb + WB_FFOUT + f * WB_FFOUT_SZ), Mr, DM, DFF};
            er = pg8::EpiResid{(bf16_t*)(ws + OFF_XRES), P.in[0], P.in[2], modl + (3 * s3 + 2) * DM, 0.5f, step == 0 ? 1 : 0};
        } else {
            { LAS float* tab = (LAS float*)(lds + LDS_TAB_OFF);
              for (int i = opaque_tid(); i < 4096 + 128; i += NTHREADS) tab[i] = i < 4096 ? ((const float*)(ws + OFF_ROPE))[i] : (i < 4160 ? P.in[10][l * 64 + i - 4096] : P.in[11][l * 64 + i - 4160]);
              __syncthreads(); }
            { pg8::Gemm g{(const bf16_t*)(ws + OFF_HBUF), (const bf16_t*)(wb + WB_WIN), MTOT, INW, DM};
              pg8::StaticOrder S; S.init(MTOT, INW, G, (int)blockIdx.x);
              pg8::EpiWin E{(bf16_t*)(ws + OFF_Q), (bf16_t*)(ws + OFF_K), (bf16_t*)(ws + OFF_V), (bf16_t*)(ws + OFF_U5), (const LAS float*)(lds + LDS_TAB_OFF), 0.125f * 1.4426950408889634f};
              if constexpr (PH_MASK & 8) pg8::gemm_phase<pg8::EpiWin, pg8::StaticOrder, true, true>(lds, g, S, E); }
            GRID_SYNC();
            if constexpr (PH_MASK & 16) lru1_phase(P, l, lds, G);
            GRID_SYNC();
            if constexpr (PH_MASK & 32) attention_phase(P, l, (char*)lds_raw, G);
            GRID_SYNC();
            Mr = last ? MLAT : MTOT;
            if constexpr (PH_MASK & 64) merge_phase(P, l, Mr, G);
            GRID_SYNC();
            gr = pg8::Gemm{(const bf16_t*)(ws + OFF_HBUF), (const bf16_t*)(wb + WB_WOUT), Mr, DM, DM};
            er = pg8::EpiResid{(bf16_t*)(ws + OFF_XRES), P.in[0], P.in[2], modl + 5 * DM, 1.0f, 0};
        }
        const bool ctxr = (Mr == MTOT), has_next = step + 1 < DEPTH * 3;
        const int l2 = (step + 1) / 3, s32 = (step + 1) % 3, Mn2 = (l2 == DEPTH - 1 && s32 == 2) ? MLAT : MTOT;
        for (int pass = 0; pass < (ctxr ? 2 : 1); ++pass) {
            pg8::ResidOrder S; S.so.init(MLAT, DM, G, (int)blockIdx.x); S.single = pass; S.pm = 256 + ((int)blockIdx.x >> 2); S.pn = (int)blockIdx.x & 3;
            if (pass == 1 && (int)blockIdx.x >= 32) { if constexpr (PH_MASK & 2) norm_phase(P, l2, s32, 0, MLAT, false, 32, G - 32); }
            else { if constexpr (PH_MASK & 128) pg8::gemm_phase<pg8::EpiResid, pg8::ResidOrder, true, true>(lds, gr, S, er); }
            GRID_SYNC();
        }
        if (has_next) {
            if (ctxr) { if constexpr (PH_MASK & 2) norm_phase(P, l2, s32, MLAT, MTOT, false, 0, G); }
            else { if constexpr (PH_MASK & 2) norm_phase(P, l2, s32, 0, Mn2, false, 0, G); }
            GRID_SYNC();
        }
    }
    if constexpr (PH_MASK & 256) final_norm_phase(P, G);
}

extern "C" void kernel_launch(void* const* d_in, const int* in_sizes, int n_in, void* d_out, int out_size, void* d_ws, size_t ws_size, hipStream_t stream) {
    static int grid = 0;
    if (grid == 0) {
        if (n_in != 24 || out_size != MLAT * DM || ws_size < WS_NEED) { fprintf(stderr, "kernel_launch: unexpected shapes (n_in %d, out %d, ws %zu, need %zu)\n", n_in, out_size, ws_size, (size_t)WS_NEED); grid = -1; return; }
        int dev = 0, cus = 0, per_cu = 0;
        hipGetDevice(&dev); hipDeviceGetAttribute(&cus, hipDeviceAttributeMultiprocessorCount, dev);
        if (hipFuncSetAttribute((const void*)fwd_megakernel, hipFuncAttributeMaxDynamicSharedMemorySize, LDS_BYTES) != hipSuccess) { fprintf(stderr, "kernel_launch: hipFuncSetAttribute failed\n"); grid = -1; return; }
        if (hipOccupancyMaxActiveBlocksPerMultiprocessor(&per_cu, (const void*)fwd_megakernel, NTHREADS, LDS_BYTES) != hipSuccess || per_cu < 1) { fprintf(stderr, "kernel_launch: occupancy query says %d\n", per_cu); per_cu = 1; (void)hipGetLastError(); }
        grid = cus * 1;
        if (grid % 8 != 0 || grid <= 0) grid = 256;
        fprintf(stderr, "kernel_launch: grid %d (cus %d, per_cu %d)\n", grid, cus, per_cu);
    }
    if (grid < 0) return;
    Params p{};
    for (int i = 0; i < 24; ++i) p.in[i] = (const float*)d_in[i];
    p.out = (float*)d_out; p.ws = (unsigned char*)d_ws;
    if (hipMemsetAsync((unsigned char*)d_ws + OFF_CTL, 0, CTL_BYTES, stream) != hipSuccess) { fprintf(stderr, "kernel_launch: memset of the barrier words failed\n"); return; }
    void* args[] = {&p};
    hipError_t e = hipLaunchCooperativeKernel((const void*)fwd_megakernel, dim3(grid), dim3(NTHREADS), args, LDS_BYTES, stream);
    if (e != hipSuccess) fprintf(stderr, "kernel_launch: cooperative launch failed: %s (grid %d)\n", hipGetErrorString(e), grid);
}
```

```cpp
#include <hip/hip_runtime.h>
#include <hip/hip_bf16.h>
#include <hip/hip_cooperative_groups.h>
#include <cstdio>
#include <cstdint>
#include <cmath>
namespace cg = cooperative_groups;

constexpr int DM = 1024, NBATCH = 8, SEQ = 8192, CTXL = 256, DEPTH = 2;
constexpr int MLAT = NBATCH * SEQ, MCTX = NBATCH * CTXL, MTOT = MLAT + MCTX;
constexpr int DFF = 2816, NFF2 = 2 * DFF, INW = 2048, NMODV = 9, MODW = 9 * DM;
constexpr int KEYS = SEQ + CTXL, NCHUNK = KEYS / 64;
constexpr float EPS = 1e-6f;
constexpr int NTHREADS = 512;
constexpr int LDS_BYTES = 155648;
constexpr int LDS_TAB_OFF = 131072;

constexpr size_t MiB = 1u << 20;
constexpr size_t OFF_MOD = 0;
constexpr size_t OFF_ROPE = 1 * MiB;
constexpr size_t OFF_LW = 1 * MiB + 65536;
constexpr size_t OFF_CSUM = 2 * MiB;
constexpr size_t OFF_CARRY = 7 * MiB;
constexpr size_t OFF_CTL = 9 * MiB + 524288, CTL_BYTES = 65536;
constexpr int LDS_BAR_OFF = 155392;
constexpr size_t OFF_WB = 10 * MiB;
constexpr size_t WB_LAYER = 39 * MiB;
constexpr size_t WB_FFIN = 0, WB_FFIN_SZ = (size_t)NFF2 * DM * 2;
constexpr size_t WB_FFOUT = 2 * WB_FFIN_SZ, WB_FFOUT_SZ = (size_t)DM * DFF * 2;
constexpr size_t WB_WIN = WB_FFOUT + 2 * WB_FFOUT_SZ, WB_WIN_SZ = (size_t)INW * DM * 2;
constexpr size_t WB_WOUT = WB_WIN + WB_WIN_SZ;
static_assert(WB_WOUT + (size_t)DM * DM * 2 == WB_LAYER, "weight map");
constexpr size_t OFF_XRES = 88 * MiB;
constexpr size_t OFF_HBUF = 352 * MiB;
constexpr size_t OFF_R1 = 484 * MiB;
constexpr size_t OFF_MID = OFF_R1;
constexpr size_t OFF_Q = OFF_R1;
constexpr size_t OFF_K = OFF_R1 + 66 * MiB;
constexpr size_t OFF_V = OFF_K + 16 * MiB + 524288;
constexpr size_t OFF_U5 = OFF_R1 + 99 * MiB;
constexpr size_t U5_STRIDE = (size_t)MTOT * 256;
constexpr size_t OFF_S = OFF_R1 + 264 * MiB;
constexpr size_t OFF_PP = OFF_R1 + 330 * MiB;
constexpr size_t OFF_ATT = OFF_R1 + 396 * MiB;
constexpr size_t WS_NEED = OFF_ATT + 66 * MiB;

#define LAS __attribute__((address_space(3)))
typedef unsigned short bf16_t;
typedef float f32x4 __attribute__((ext_vector_type(4)));
typedef float f32x2 __attribute__((ext_vector_type(2)));
typedef unsigned u32x4 __attribute__((ext_vector_type(4)));
typedef unsigned u32x2 __attribute__((ext_vector_type(2)));

struct Params { const float* in[24]; float* out; unsigned char* ws; };

__device__ __forceinline__ unsigned cvt_pk(float lo, float hi) { unsigned r; asm volatile("v_cvt_pk_bf16_f32 %0, %1, %2" : "=v"(r) : "v"(lo), "v"(hi)); return r; }
__device__ __forceinline__ float bf_lo(unsigned w) { return __uint_as_float(w << 16); }
__device__ __forceinline__ float bf_hi(unsigned w) { return __uint_as_float(w & 0xffff0000u); }
__device__ __forceinline__ float wave_sum(float v) {
#pragma unroll
    for (int o = 1; o < 64; o <<= 1) v += __shfl_xor(v, o);
    return v;
}
__device__ __forceinline__ int opaque_tid() { int t = threadIdx.x; asm volatile("" : "+v"(t)); return t; }
__device__ __forceinline__ float sigmoidf_(float z) { return __builtin_amdgcn_rcpf(1.0f + __expf(-z)); }
namespace pg8 {
#define PG8_LAS __attribute__((address_space(3)))
typedef unsigned short bf16_t;
typedef short bf16x8 __attribute__((ext_vector_type(8)));
typedef float f32x4 __attribute__((ext_vector_type(4)));
typedef unsigned u32x4 __attribute__((ext_vector_type(4)));
constexpr int BM = 256, BK = 64, HALF = 128, HTB = HALF * BK * 2  , STAGE_BYTES = 8 * HTB, NXCD = 8, WGM = 4;

__host__ __device__ __forceinline__ int lds_byte(int r, int c) { const int st = (r >> 4) * 2 + (c >> 5), rr = r & 15, cc = c & 31, ob = rr * 64 + cc * 2; return st * 1024 + (ob ^ (((ob >> 9) & 1) << 5)); }
__host__ __device__ __forceinline__ void stage_rc(int b, int& R, int& C) { const int st = b / 1024, sb = b % 1024, swz = sb ^ (((sb >> 9) & 1) << 5); R = (st >> 1) * 16 + swz / 64; C = (st & 1) * 32 + (swz % 64) / 2; }
__host__ __device__ __forceinline__ int perm32(int rho) { const int n = rho >> 4, i = rho & 15; return 8 * (i >> 2) + 4 * n + (i & 3); }

struct Unit { int pm, pn; };
struct Gemm { const bf16_t* A; const bf16_t* Bt; int M, N, K; };

struct StaticOrder {
    int nM, nN, nwg, G, c;
    __host__ __device__ void init(int M, int N, int G_, int c_) { nM = M / BM; nN = N / BM; nwg = nM * nN; G = G_; c = c_; }
    __host__ __device__ bool next(int i, Unit& u) const {
        const long L = (long)i * G + c; if (L >= nwg) return false;
        int wgid = (int)L; { const int q = nwg / NXCD, r = nwg % NXCD, xcd = wgid % NXCD, off = wgid / NXCD; wgid = (xcd < r ? xcd * (q + 1) : r * (q + 1) + (xcd - r) * q) + off; }
        const int nig = WGM * nN, gid = wgid / nig, fm = gid * WGM, gsz = (nM - fm) < WGM ? (nM - fm) : WGM;
        u.pm = fm + ((wgid % nig) % gsz); u.pn = (wgid % nig) / gsz; return true;
    }
    __device__ __forceinline__ void a_ready(const Unit&) const {}
    __device__ __forceinline__ void done(const Unit&) const {}
};
__device__ __forceinline__ unsigned cvt_pk_bf16(float lo, float hi) { unsigned r; asm volatile("v_cvt_pk_bf16_f32 %0, %1, %2" : "=v"(r) : "v"(lo), "v"(hi)); return r; }

struct EpiSwiglu {
    static constexpr bool PERM = false, AFTER_DRAIN = false;
    bf16_t* O;
    __device__ __forceinline__ void operator()(const f32x4 (&acc)[2][2][4][2], const Unit& u, int wr, int wc, int fr, int fq) const {
        const int row0 = u.pm * BM + wr * 64 + fr, col0 = u.pn * 128 + wc * 32 + 8 * fq;
#pragma unroll
        for (int ai = 0; ai < 2; ++ai)
#pragma unroll
            for (int m = 0; m < 4; ++m) {
                bf16_t* rowp = O + (size_t)(row0 + ai * HALF + m * 16) * 2816 + col0;
                float v[8];
#pragma unroll
                for (int n = 0; n < 2; ++n)
#pragma unroll
                    for (int j = 0; j < 4; ++j) { const float g = acc[ai][0][m][n][j], up = acc[ai][1][m][n][j]; v[n * 4 + j] = g * __builtin_amdgcn_rcpf(1.0f + __expf(-g)) * up; }
                u32x4 w; w.x = cvt_pk_bf16(v[0], v[1]); w.y = cvt_pk_bf16(v[2], v[3]); w.z = cvt_pk_bf16(v[4], v[5]); w.w = cvt_pk_bf16(v[6], v[7]);
                *(u32x4*)rowp = w;
            }
    }
};
struct EpiResid {
    static constexpr bool PERM = false, AFTER_DRAIN = false;
    bf16_t* X; const float* Xlat; const float* Xctx; const float* gate; float scale; int first;
    __device__ __forceinline__ void operator()(const f32x4 (&acc)[2][2][4][2], const Unit& u, int wr, int wc, int fr, int fq) const {
        const int v = u.pm < 256 ? (u.pm >> 5) : 8;
        const int row0 = u.pm * BM + wr * 64 + fr, col0 = u.pn * BM + wc * 32 + 4 * fq;
        const float* gp = gate + (size_t)v * 9216 + col0;
        f32x4 gv[2][2];
#pragma unroll
        for (int bj = 0; bj < 2; ++bj)
#pragma unroll
            for (int n = 0; n < 2; ++n) gv[bj][n] = *(const f32x4*)(gp + bj * HALF + n * 16) * scale;
#pragma unroll
        for (int ai = 0; ai < 2; ++ai) {
            bf16_t* rowp = X + (size_t)(row0 + ai * HALF) * 1024 + col0;
            f32x4 xv[4][2][2];
            if (first) {
                const float* rowr = (u.pm < 256 ? Xlat + (size_t)(row0 + ai * HALF) * 1024 : Xctx + (size_t)(row0 + ai * HALF - 65536) * 1024) + col0;
#pragma unroll
                for (int m = 0; m < 4; ++m)
#pragma unroll
                    for (int bj = 0; bj < 2; ++bj)
#pragma unroll
                        for (int n = 0; n < 2; ++n) xv[m][bj][n] = *(const f32x4*)(rowr + (size_t)m * 16 * 1024 + bj * HALF + n * 16);
            } else {
                u32x2 raw[4][2][2];
#pragma unroll
                for (int m = 0; m < 4; ++m)
#pragma unroll
                    for (int bj = 0; bj < 2; ++bj)
#pragma unroll
                        for (int n = 0; n < 2; ++n) raw[m][bj][n] = *(const u32x2*)(rowp + (size_t)m * 16 * 1024 + bj * HALF + n * 16);
#pragma unroll
                for (int m = 0; m < 4; ++m)
#pragma unroll
                    for (int bj = 0; bj < 2; ++bj)
#pragma unroll
                        for (int n = 0; n < 2; ++n) { const u32x2 r = raw[m][bj][n]; xv[m][bj][n] = (f32x4){__uint_as_float(r.x << 16), __uint_as_float(r.x & 0xffff0000u), __uint_as_float(r.y << 16), __uint_as_float(r.y & 0xffff0000u)}; }
            }
#pragma unroll
            for (int m = 0; m < 4; ++m)
#pragma unroll
                for (int bj = 0; bj < 2; ++bj)
#pragma unroll
                    for (int n = 0; n < 2; ++n) { const f32x4 y = xv[m][bj][n] + gv[bj][n] * acc[ai][bj][m][n]; u32x2 w; w.x = cvt_pk_bf16(y[0], y[1]); w.y = cvt_pk_bf16(y[2], y[3]);
                        *(u32x2*)(rowp + (size_t)m * 16 * 1024 + bj * HALF + n * 16) = w; }
        }
    }
};
struct ResidOrder {
    StaticOrder so; int single, pm, pn;
    __device__ __forceinline__ bool next(int i, Unit& u) const { if (single) { if (i > 0) return false; u.pm = pm; u.pn = pn; return true; } return so.next(i, u); }
    __device__ __forceinline__ void a_ready(const Unit&) const {}
    __device__ __forceinline__ void done(const Unit&) const {}
};
struct EpiWin {
    static constexpr bool PERM = false, AFTER_DRAIN = false;
    bf16_t *Q, *K, *V, *U5; const PG8_LAS float* tab; float qscale;
    __device__ __forceinline__ void operator()(const f32x4 (&acc)[2][2][4][2], const Unit& u, int wr, int wc, int fr, int fq) const {
        const int row0 = u.pm * BM + wr * 64 + fr;
        if (u.pn >= 3) {
            bf16_t* base = U5 + (size_t)(u.pn - 3) * ((size_t)67584 * 256) + wc * 32 + 8 * fq;
#pragma unroll
            for (int ai = 0; ai < 2; ++ai)
#pragma unroll
                for (int m = 0; m < 4; ++m) { bf16_t* rowp = base + (size_t)(row0 + ai * HALF + m * 16) * 256;
#pragma unroll
                    for (int bj = 0; bj < 2; ++bj) { const f32x4 v0 = acc[ai][bj][m][0], v1 = acc[ai][bj][m][1];
                        u32x4 w; w.x = cvt_pk_bf16(v0[0], v0[1]); w.y = cvt_pk_bf16(v0[2], v0[3]); w.z = cvt_pk_bf16(v1[0], v1[1]); w.w = cvt_pk_bf16(v1[2], v1[3]);
                        *(u32x4*)(rowp + bj * HALF) = w; } }
            return;
        }
        const int kind = u.pn < 2 ? 0 : (wc < 2 ? 1 : 2);
        const bool latent = u.pm < 256;
        const PG8_LAS float* gsrc = tab + 4096 + (kind == 0 ? 0 : 64);
#pragma unroll
        for (int ai = 0; ai < 2; ++ai)
#pragma unroll
            for (int m = 0; m < 4; ++m) {
                const int row = row0 + ai * HALF + m * 16;
                f32x4 y[2][2];
#pragma unroll
                for (int bj = 0; bj < 2; ++bj)
#pragma unroll
                    for (int n = 0; n < 2; ++n) y[bj][n] = acc[ai][bj][m][n];
                if (kind != 2) {
                    float ss = 0.f;
#pragma unroll
                    for (int bj = 0; bj < 2; ++bj)
#pragma unroll
                        for (int n = 0; n < 2; ++n) { const f32x4 t = y[bj][n]; ss += (t[0] * t[0] + t[1] * t[1]) + (t[2] * t[2] + t[3] * t[3]); }
                    ss += __shfl_xor(ss, 16); ss += __shfl_xor(ss, 32);
                    const float r = 1.0f / sqrtf(ss * (1.0f / 64.0f) + 1e-6f);
#pragma unroll
                    for (int bj = 0; bj < 2; ++bj)
#pragma unroll
                        for (int n = 0; n < 2; ++n) y[bj][n] = y[bj][n] * r * *(const PG8_LAS f32x4*)(gsrc + 32 * bj + 16 * n + 4 * fq);
                    if (latent) {
                        const int s = row & 8191;
#pragma unroll
                        for (int bj = 0; bj < 2; ++bj) { const int pos = bj == 0 ? (s >> 6) : (s & 63);
                            const f32x4 c4 = *(const PG8_LAS f32x4*)(tab + pos * 16 + 4 * fq), s4 = *(const PG8_LAS f32x4*)(tab + 2048 + pos * 16 + 4 * fq);
                            const f32x4 x1 = y[bj][0], x2 = y[bj][1];
                            y[bj][0] = x1 * c4 - x2 * s4; y[bj][1] = x2 * c4 + x1 * s4; }
                    }
                }
                bf16_t* dst;
                if (kind == 0) { dst = Q + (size_t)row * 512 + (u.pn * 4 + wc) * 64;
#pragma unroll
                    for (int bj = 0; bj < 2; ++bj)
#pragma unroll
                        for (int n = 0; n < 2; ++n) y[bj][n] = y[bj][n] * qscale;
                } else {
                    size_t kr;
                    if (latent) kr = (size_t)(row >> 13) * 8448 + 256 + (row & 8191);
                    else { const int rc = row - 65536; kr = (size_t)(rc >> 8) * 8448 + (rc & 255); }
                    dst = (kind == 1 ? K : V) + kr * 128 + (wc & 1) * 64;
                }
#pragma unroll
                for (int bj = 0; bj < 2; ++bj)
#pragma unroll
                    for (int n = 0; n < 2; ++n) { u32x2 w; w.x = cvt_pk_bf16(y[bj][n][0], y[bj][n][1]); w.y = cvt_pk_bf16(y[bj][n][2], y[bj][n][3]);
                        *(u32x2*)(dst + 32 * bj + 16 * n + 4 * fq) = w; }
            }
    }
};
template <class Epi, class Sched, bool ALIGN_EPI = false, bool SP2 = false>
__device__ __forceinline__ void gemm_phase(PG8_LAS unsigned char* lds, const Gemm g, const Sched& S, const Epi& E) {
    const int tid = opaque_tid(), wid = __builtin_amdgcn_readfirstlane(tid >> 6), lane = tid & 63, wr = wid >> 2, wc = wid & 3, fr = lane & 15, fq = lane >> 4;
    const int K = g.K, nt = K / BK;
    unsigned voffA[2], voffB[2];
#pragma unroll
    for (int i = 0; i < 2; ++i) { int R, C; stage_rc(tid * 16 + i * 8192, R, C); const int Rb = Epi::PERM ? ((R & ~31) + perm32(R & 31)) : R;
        voffA[i] = (unsigned)(R * K + C) * 2u; voffB[i] = (unsigned)(Rb * K + C) * 2u; }
    const size_t kstep = (size_t)(BK * 2);
    const size_t hstep = (size_t)HALF * K * 2;
    const size_t tstep = 2 * hstep;
    const unsigned ldsw = (unsigned)wid * 1024u;
    const int aoff = lds_byte(wr * 64 + fr, fq * 8), boff = lds_byte(wc * 32 + fr, fq * 8);
#define PG8_SA(b, h) (((b) * 2 + (h)) * HTB)
#define PG8_SB(b, h) ((4 + (b) * 2 + (h)) * HTB)
#define PG8_STAGE(bufoff, gbase, voff) do { _Pragma("unroll") for (int _i = 0; _i < 2; ++_i) \
        __builtin_amdgcn_global_load_lds((const unsigned*)((const char*)(gbase) + (voff)[_i]), (PG8_LAS unsigned*)(lds + (bufoff) + ldsw + _i * 8192), 16, 0, 0); } while (0)
#define PG8_LDA(dst, b, h) do { _Pragma("unroll") for (int m = 0; m < 4; ++m) _Pragma("unroll") for (int k = 0; k < 2; ++k) dst[m][k] = *(const PG8_LAS bf16x8*)(lds + PG8_SA(b, h) + aoff + m * 2048 + k * 1024); } while (0)
#define PG8_LDB(dst, b, h) do { _Pragma("unroll") for (int n = 0; n < 2; ++n) _Pragma("unroll") for (int k = 0; k < 2; ++k) dst[n][k] = *(const PG8_LAS bf16x8*)(lds + PG8_SB(b, h) + boff + n * 2048 + k * 1024); } while (0)
#define PG8_MMA(ai, bj, At, Bt) do { __builtin_amdgcn_s_setprio(1); _Pragma("unroll") for (int m = 0; m < 4; ++m) _Pragma("unroll") for (int n = 0; n < 2; ++n) _Pragma("unroll") for (int k = 0; k < 2; ++k) \
        acc[ai][bj][m][n] = __builtin_amdgcn_mfma_f32_16x16x32_bf16(Bt[n][k], At[m][k], acc[ai][bj][m][n], 0, 0, 0); __builtin_amdgcn_s_setprio(0); } while (0)
#define PG8_WAIT_V(n) asm volatile("s_waitcnt vmcnt(" #n ")" ::: "memory")
#define PG8_WAIT_L(n) asm volatile("s_waitcnt lgkmcnt(" #n ")" ::: "memory")
#define PG8_BAR __builtin_amdgcn_s_barrier()
#define PG8_SCHED __builtin_amdgcn_sched_barrier(0)
    Unit cur, nxt; int ui = 0;
    if (!S.next(0, cur)) return;
    f32x4 acc[2][2][4][2];
#pragma unroll
    for (int a = 0; a < 2; ++a)
#pragma unroll
        for (int b = 0; b < 2; ++b)
#pragma unroll
            for (int m = 0; m < 4; ++m)
#pragma unroll
                for (int n = 0; n < 2; ++n) acc[a][b][m][n] = (f32x4){0.f, 0.f, 0.f, 0.f};
    bf16x8 At[4][2], B0[2][2], B1[2][2];
    const char* cA = (const char*)g.A + (size_t)cur.pm * tstep; const char* cB = (const char*)g.Bt + (size_t)cur.pn * tstep;
    S.a_ready(cur);
    if constexpr (SP2) {
        PG8_STAGE(PG8_SB(0, 0), cB, voffB); PG8_STAGE(PG8_SB(0, 1), cB + hstep, voffB); PG8_STAGE(PG8_SA(0, 0), cA, voffA); PG8_STAGE(PG8_SA(0, 1), cA + hstep, voffA);
        if (wr == 1) PG8_BAR;
        PG8_WAIT_V(2); PG8_BAR;
        PG8_STAGE(PG8_SB(1, 0), cB + kstep, voffB); PG8_STAGE(PG8_SA(1, 0), cA + kstep, voffA); PG8_STAGE(PG8_SB(1, 1), cB + hstep + kstep, voffB);
        PG8_WAIT_V(6); PG8_BAR;
    } else {
        PG8_STAGE(PG8_SB(0, 0), cB, voffB); PG8_STAGE(PG8_SA(0, 0), cA, voffA); PG8_STAGE(PG8_SB(0, 1), cB + hstep, voffB); PG8_STAGE(PG8_SA(0, 1), cA + hstep, voffA);
        if (wr == 1) PG8_BAR;
        PG8_WAIT_V(4); PG8_BAR;
        PG8_STAGE(PG8_SB(1, 0), cB + kstep, voffB); PG8_STAGE(PG8_SA(1, 0), cA + kstep, voffA); PG8_STAGE(PG8_SB(1, 1), cB + hstep + kstep, voffB);
        PG8_WAIT_V(6); PG8_BAR;
    }
    for (;;) {
        const bool has_next = S.next(ui + 1, nxt);
        const char* nA = has_next ? (const char*)g.A + (size_t)nxt.pm * tstep : cA; const char* nB = has_next ? (const char*)g.Bt + (size_t)nxt.pn * tstep : cB;
        for (int t = 0; t < nt; t += 2) {
            const bool last = (t == nt - 2);
            const char* a1 = cA + (size_t)(t + 1) * kstep;
            const char* a2 = last ? nA : cA + (size_t)(t + 2) * kstep; const char* b2 = last ? nB : cB + (size_t)(t + 2) * kstep;
            const char* a3 = a2 + kstep; const char* b3 = b2 + kstep;
            if (last && has_next) S.a_ready(nxt);
            if constexpr (SP2) {
            PG8_LDB(B0, 0, 0); PG8_LDB(B1, 0, 1); PG8_SCHED; PG8_LDA(At, 0, 0); PG8_STAGE(PG8_SA(1, 1), a1 + hstep, voffA);
            PG8_WAIT_V(8); PG8_WAIT_L(0); PG8_BAR; PG8_MMA(0, 0, At, B0); PG8_MMA(0, 1, At, B1); PG8_BAR; PG8_SCHED;
            PG8_LDA(At, 0, 1); PG8_STAGE(PG8_SB(0, 0), b2, voffB); PG8_STAGE(PG8_SB(0, 1), b2 + hstep, voffB); PG8_STAGE(PG8_SA(0, 0), a2, voffA);
            PG8_WAIT_V(8); PG8_WAIT_L(0); PG8_BAR; PG8_MMA(1, 0, At, B0); PG8_MMA(1, 1, At, B1); PG8_BAR; PG8_SCHED;
            PG8_LDB(B0, 1, 0); PG8_LDB(B1, 1, 1); PG8_SCHED; PG8_LDA(At, 1, 0); PG8_STAGE(PG8_SA(0, 1), a2 + hstep, voffA);
            PG8_WAIT_V(8); PG8_WAIT_L(0); PG8_BAR; PG8_MMA(0, 0, At, B0); PG8_MMA(0, 1, At, B1); PG8_BAR; PG8_SCHED;
            PG8_LDA(At, 1, 1); PG8_STAGE(PG8_SB(1, 0), b3, voffB); PG8_STAGE(PG8_SB(1, 1), b3 + hstep, voffB); PG8_STAGE(PG8_SA(1, 0), a3, voffA);
            PG8_WAIT_V(8); PG8_WAIT_L(0); PG8_BAR; PG8_MMA(1, 0, At, B0); PG8_MMA(1, 1, At, B1); PG8_BAR; PG8_SCHED;
            } else {
            PG8_LDB(B0, 0, 0); PG8_SCHED; PG8_LDA(At, 0, 0); PG8_STAGE(PG8_SA(1, 1), a1 + hstep, voffA);
            PG8_WAIT_L(8); PG8_BAR; PG8_WAIT_L(0); PG8_MMA(0, 0, At, B0); PG8_BAR; PG8_SCHED;
            PG8_LDB(B1, 0, 1); PG8_STAGE(PG8_SB(0, 0), b2, voffB);
            PG8_BAR; PG8_WAIT_L(0); PG8_MMA(0, 1, At, B1); PG8_BAR;
            PG8_LDA(At, 0, 1); PG8_STAGE(PG8_SA(0, 0), a2, voffA);
            PG8_BAR; PG8_WAIT_L(0); PG8_MMA(1, 0, At, B0); PG8_BAR; PG8_SCHED;
            PG8_STAGE(PG8_SB(0, 1), b2 + hstep, voffB);
            PG8_WAIT_V(6); PG8_BAR; PG8_MMA(1, 1, At, B1); PG8_BAR;
            PG8_LDB(B0, 1, 0); PG8_SCHED; PG8_LDA(At, 1, 0); PG8_STAGE(PG8_SA(0, 1), a2 + hstep, voffA);
            PG8_WAIT_L(8); PG8_BAR; PG8_WAIT_L(0); PG8_MMA(0, 0, At, B0); PG8_BAR; PG8_SCHED;
            PG8_LDB(B1, 1, 1); PG8_STAGE(PG8_SB(1, 0), b3, voffB);
            PG8_BAR; PG8_WAIT_L(0); PG8_MMA(0, 1, At, B1); PG8_BAR;
            PG8_LDA(At, 1, 1); PG8_STAGE(PG8_SA(1, 0), a3, voffA);
            PG8_BAR; PG8_WAIT_L(0); PG8_MMA(1, 0, At, B0); PG8_BAR; PG8_SCHED;
            PG8_STAGE(PG8_SB(1, 1), b3 + hstep, voffB);
            PG8_WAIT_V(6); PG8_BAR; PG8_MMA(1, 1, At, B1); PG8_BAR;
            }
        }
        if constexpr (ALIGN_EPI) { if (wr == 0) PG8_BAR; }
        if constexpr (!Epi::AFTER_DRAIN) { E(acc, cur, wr, wc, fr, fq); S.done(cur); }
        if (!has_next) break;
#pragma unroll
        for (int a = 0; a < 2; ++a)
#pragma unroll
            for (int b = 0; b < 2; ++b)
#pragma unroll
                for (int m = 0; m < 4; ++m)
#pragma unroll
                    for (int n = 0; n < 2; ++n) acc[a][b][m][n] = (f32x4){0.f, 0.f, 0.f, 0.f};
        cur = nxt; cA = nA; cB = nB; ++ui;
        if constexpr (ALIGN_EPI) { if (wr == 1) PG8_BAR; }
    }
    PG8_WAIT_V(0);
    if constexpr (!ALIGN_EPI) { if (wr == 0) PG8_BAR; }
    PG8_BAR;
    if constexpr (Epi::AFTER_DRAIN) { E.fused(acc, cur, wr, wc, fr, fq, lds, wid, lane); S.done(cur); }
#undef PG8_SA
#undef PG8_SB
#undef PG8_STAGE
#undef PG8_LDA
#undef PG8_LDB
#undef PG8_MMA
#undef PG8_WAIT_V
#undef PG8_WAIT_L
#undef PG8_BAR
#undef PG8_SCHED
}
}

namespace attn_body {
using bf16=__hip_bfloat16;
using bf16x8=__attribute__((ext_vector_type(8)))short;
using s16x4=__attribute__((ext_vector_type(4)))short;
using f32x16=__attribute__((ext_vector_type(16)))float;
using u32x4=__attribute__((ext_vector_type(4)))unsigned;
constexpr int D=64, QP=512, KP=128, OP=512;
constexpr int NW=8,QBLK=32,QB=QBLK*NW,KVBLK=64;
__device__ __forceinline__ int crow(int r,int hi){return (r&3)+8*(r>>2)+4*hi;}
#define SBAR() __builtin_amdgcn_sched_barrier(0)
#define ATTN_STORE16(p,v) (*(u32x4*)(p)=(v))
constexpr int NSLOT=3, SLOTB=8192;
constexpr int LDS_K=0, LDS_V=NSLOT*SLOTB, LDS_WS=2*NSLOT*SLOTB, LDS_OST=LDS_WS+NW*64*4, LDS_BYTES=LDS_OST+NW*4096;
constexpr float C2=0.125f*1.4426950408889634f;
__device__ __forceinline__ void glds16(const void*gsrc,unsigned lds_dst){unsigned keep;
  asm volatile("s_mov_b32 %0, m0\n\ts_mov_b32 m0, %2\n\ts_nop 0\n\tglobal_load_lds_dwordx4 %1, off\n\ts_mov_b32 m0, %0":"=&s"(keep):"v"(gsrc),"s"(lds_dst):"memory");}
__device__ __forceinline__ float max3f(float a,float b,float c){float r;asm("v_max3_f32 %0, %1, %2, %3":"=v"(r):"v"(a),"v"(b),"v"(c));return r;}
__device__ __forceinline__ float max2f(float a,float b){float r;asm("v_max_f32_e32 %0, %1, %2":"=v"(r):"v"(a),"v"(b));return r;}
__device__ __forceinline__ float fadd_s(float a,float b){float r;asm("v_add_f32_e32 %0, %1, %2":"=v"(r):"v"(a),"v"(b));return r;}
__device__ __forceinline__ float fsub_s(float a,float b){float r;asm("v_sub_f32_e32 %0, %1, %2":"=v"(r):"v"(a),"v"(b));return r;}
typedef float f32x2_t __attribute__((ext_vector_type(2))); typedef __bf16 bf16x2_t __attribute__((ext_vector_type(2)));
__device__ __forceinline__ unsigned cvtpk_s(float lo,float hi){f32x2_t v={lo,hi};bf16x2_t b=__builtin_convertvector(v,bf16x2_t);return __builtin_bit_cast(unsigned,b);}
#define WAIT_BAR(N) asm volatile("s_waitcnt vmcnt(" #N ") lgkmcnt(0)\n\ts_barrier":::"memory")

__device__ __forceinline__ void qkt(f32x16&p0,f32x16&p1,const char*Kslot,const bf16x8*qr,const f32x16&negm,int r32,int hi){
  const char*kb=Kslot+hi*1024+r32*16;
  #pragma unroll
  for(int d0=0;d0<4;++d0){
    const bf16x8 b0=*reinterpret_cast<const bf16x8*>(kb+d0*2048);
    const bf16x8 b1=*reinterpret_cast<const bf16x8*>(kb+d0*2048+512);
    if(d0==0){p0=__builtin_amdgcn_mfma_f32_32x32x16_bf16(b0,qr[0],negm,0,0,0);p1=__builtin_amdgcn_mfma_f32_32x32x16_bf16(b1,qr[0],negm,0,0,0);}
    else{p0=__builtin_amdgcn_mfma_f32_32x32x16_bf16(b0,qr[d0],p0,0,0,0);p1=__builtin_amdgcn_mfma_f32_32x32x16_bf16(b1,qr[d0],p1,0,0,0);}}
}
typedef __attribute__((address_space(3))) const char* lds_cptr;
typedef short v4i16_t __attribute__((ext_vector_type(4)));
__device__ __forceinline__ void kload8(bf16x8*kf,lds_cptr kp){
  kf[0]=*(const __attribute__((address_space(3))) bf16x8*)(kp);      kf[1]=*(const __attribute__((address_space(3))) bf16x8*)(kp+512);
  kf[2]=*(const __attribute__((address_space(3))) bf16x8*)(kp+2048); kf[3]=*(const __attribute__((address_space(3))) bf16x8*)(kp+2560);
  kf[4]=*(const __attribute__((address_space(3))) bf16x8*)(kp+4096); kf[5]=*(const __attribute__((address_space(3))) bf16x8*)(kp+4608);
  kf[6]=*(const __attribute__((address_space(3))) bf16x8*)(kp+6144); kf[7]=*(const __attribute__((address_space(3))) bf16x8*)(kp+6656);
}
__device__ __forceinline__ void kload2(bf16x8*kf,lds_cptr kp,int j){ kf[2*j]=*(const __attribute__((address_space(3))) bf16x8*)(kp+j*2048); kf[2*j+1]=*(const __attribute__((address_space(3))) bf16x8*)(kp+j*2048+512); }
__device__ __forceinline__ s16x4 vtr(lds_cptr p){ return __builtin_bit_cast(s16x4,__builtin_amdgcn_ds_read_tr16_b64_v4i16((__attribute__((address_space(3))) v4i16_t*)p)); }
__device__ __forceinline__ float rowmax(const f32x16&p0,const f32x16&p1){
  float a=max3f(p0[0],p0[1],p1[0]),b=max3f(p0[2],p0[3],p1[1]);a=max3f(a,p1[2],p1[3]);
  #pragma unroll
  for(int r=4;r<16;r+=4){a=max3f(a,p0[r],p0[r+1]);b=max3f(b,p0[r+2],p0[r+3]);a=max3f(a,p1[r],p1[r+1]);b=max3f(b,p1[r+2],p1[r+3]);}
  const float m=max2f(a,b);
  auto rr=__builtin_amdgcn_permlane32_swap(__float_as_uint(m),__float_as_uint(m),false,false);
  return max2f(__uint_as_float(rr[0]),__uint_as_float(rr[1]));
}
__device__ __forceinline__ void pv(f32x16*o,int vb,bf16x8 pa0,bf16x8 pa1,bf16x8 pa2,bf16x8 pa3){
  #pragma unroll
  for(int d0=0;d0<2;++d0){s16x4 lo[4],hi[4];
    #pragma unroll
    for(int ks=0;ks<4;++ks){
      asm volatile("ds_read_b64_tr_b16 %0,%1 offset:%c2":"=&v"(lo[ks]):"v"(vb),"i"(d0*4096+ks*1024):"memory");
      asm volatile("ds_read_b64_tr_b16 %0,%1 offset:%c2":"=&v"(hi[ks]):"v"(vb),"i"(d0*4096+ks*1024+512):"memory");}
    asm volatile("s_waitcnt lgkmcnt(0)":::"memory");SBAR();
    #define PK(k) (bf16x8){lo[k][0],lo[k][1],lo[k][2],lo[k][3],hi[k][0],hi[k][1],hi[k][2],hi[k][3]}
    o[d0]=__builtin_amdgcn_mfma_f32_32x32x16_bf16(pa0,PK(0),o[d0],0,0,0);
    o[d0]=__builtin_amdgcn_mfma_f32_32x32x16_bf16(pa1,PK(1),o[d0],0,0,0);
    o[d0]=__builtin_amdgcn_mfma_f32_32x32x16_bf16(pa2,PK(2),o[d0],0,0,0);
    o[d0]=__builtin_amdgcn_mfma_f32_32x32x16_bf16(pa3,PK(3),o[d0],0,0,0);
    #undef PK
  }
}
template<int THRL> __device__ __forceinline__ void attn_unit(const bf16*Qw0,const bf16*__restrict__ Kh,const bf16*__restrict__ Vh,bf16*Ow0,const int NT,char*shm){
  const int tid=opaque_tid(),lane=tid&63,r32=lane&31,hi=lane>>5; const int wid=__builtin_amdgcn_readfirstlane(tid>>6);
  const bf16*Qw=Qw0+(long)wid*QBLK*QP;
  const unsigned lds0=(unsigned)(uintptr_t)shm;
  float*wsf=(float*)(shm+LDS_WS)+wid*64;
  const bf16*ksrc=Kh+(long)lane*KP+wid*8;
  const bf16*vsrc=Vh+(long)(16*(wid&3)+(lane>>2))*KP+(wid>>2)*32+(lane&3)*8;
  const unsigned kdst=lds0+LDS_K+wid*1024, vdst=lds0+LDS_V+wid*1024;
  #define DMA_K(t,slot) glds16(ksrc+(long)(t)*KVBLK*KP,(unsigned)__builtin_amdgcn_readfirstlane(kdst+(slot)))
  #define DMA_V(t,slot) glds16(vsrc+(long)(t)*KVBLK*KP,(unsigned)__builtin_amdgcn_readfirstlane(vdst+(slot)))
  const int vb0=(int)(lds0+LDS_V)+((lane>>4)&1)*32+(lane&3)*8+(4*hi+((lane&15)>>2))*64;
  const char*Kbase=shm+LDS_K; bf16x8 kf[8];
  const lds_cptr shm3=(lds_cptr)shm; const lds_cptr kp0=shm3+LDS_K+hi*1024+r32*16; const lds_cptr vp0=shm3+LDS_V+((lane>>4)&1)*32+(lane&3)*8+(4*hi+((lane&15)>>2))*64;
  DMA_K(0,0);DMA_V(0,0);DMA_K(1,SLOTB);
  bf16x8 qr[4];
  #pragma unroll
  for(int d0=0;d0<4;++d0)qr[d0]=*reinterpret_cast<const bf16x8*>(&Qw[(long)r32*QP+d0*16+hi*8]);
  float mhat=0.f,l_reg=0.f;f32x16 o[2];o[0]=f32x16{};o[1]=f32x16{};f32x16 negm=f32x16{};asm volatile("":"+v"(negm));
  #define CMASK(P0,P1,t) do{}while(0)
  bool resc=false;
  #define START(P0,P1) do{ const float rm=rowmax(P0,P1); resc=false; \
    { const float dl=rm; mhat=fadd_s(mhat,dl); \
      _Pragma("unroll") for(int r=0;r<16;++r){P0[r]=fsub_s(P0[r],dl);P1[r]=fsub_s(P1[r],dl);} \
      _Pragma("unroll") for(int r=0;r<16;++r)negm[r]=-mhat; asm volatile("":"+v"(negm)); } \
    _Pragma("unroll") for(int r=0;r<16;++r)P0[r]=__builtin_amdgcn_exp2f(P0[r]); }while(0)
  #define RESC() do{ if(resc){ asm volatile("s_waitcnt lgkmcnt(0)":::"memory"); \
      _Pragma("unroll") for(int d_=0;d_<2;++d_) _Pragma("unroll") for(int r=0;r<16;++r)o[d_][r]*=wsf[crow(r,hi)]; } }while(0)
  f32x16 pA0,pA1,pB0,pB1;
  int sl_prev=0,sl_cur=0,sl_next=SLOTB;
  #define ROT() do{sl_prev=sl_cur;sl_cur=sl_next;sl_next=(sl_next==(NSLOT-1)*SLOTB)?0:sl_next+SLOTB;}while(0)
  DMA_K(2,2*SLOTB);
  WAIT_BAR(3);
  qkt(pA0,pA1,Kbase,qr,negm,r32,hi);asm volatile("s_nop 15\n\ts_nop 7":"+v"(pA0),"+v"(pA1));CMASK(pA0,pA1,0);
  START(pA0,pA1);
  _Pragma("unroll") for(int r=0;r<16;++r)pA1[r]=__builtin_amdgcn_exp2f(pA1[r]);
  WAIT_BAR(0);
  DMA_K(3,0);DMA_V(1,SLOTB);
  ROT();
  kload8(kf,kp0+sl_cur);
  WAIT_BAR(2);
  s16x4 vlo[8],vhi[8]; u32x4 pw0,pw1,pw2,pw3;
  #define PKW(P,B) cvtpk_s(P[B],P[B+1])
  #define PAF(k) __builtin_bit_cast(bf16x8,pw##k)
  #define VFR(i) (bf16x8){vlo[i][0],vlo[i][1],vlo[i][2],vlo[i][3],vhi[i][0],vhi[i][1],vhi[i][2],vhi[i][3]}
  #define PIN(x) asm volatile("":"+v"(x))
  #define MX3(a,b,c) __builtin_fmaxf(__builtin_fmaxf((a),(b)),(c))
  #define GAPA(MF,A0,A1,A2,A3,W0,W1,PW) do{ MF; sacc+=A0; sacc+=A1; sacc+=A2; sacc+=A3; PIN(sacc); W0; W1; PIN(PW); SBAR(); }while(0)
  #define EX(v) __builtin_amdgcn_exp2f(v)
  #define GAPB(MF,X,B) do{ MF; X[B]=EX(X[B]); X[B+1]=EX(X[B+1]); X[B+2]=EX(X[B+2]); X[B+3]=EX(X[B+3]); PIN(X); SBAR(); }while(0)
  #define VRD(i) do{ vlo[i]=vtr(vp_+(((i)>>2)*4096+((i)&3)*1024)); vhi[i]=vtr(vp_+(((i)>>2)*4096+((i)&3)*1024+512)); }while(0)
  #define KRD(G,j) do{ if(G){ kload2(kf,kp0+sl_next,j); SBAR(); } }while(0)
  #define STEP(C0,C1,P0,P1,t,GK,GV,GL) do{ SBAR(); \
    const lds_cptr vp_=vp0+sl_prev; \
    VRD(0); SBAR(); float sacc=(P0[0]+P0[1]); \
    GAPA(C0=__builtin_amdgcn_mfma_f32_32x32x16_bf16(kf[0],qr[0],negm,0,0,0), P0[2],P0[3],P0[4],P0[5],     pw0[0]=PKW(P0,0), pw0[1]=PKW(P0,2), pw0); \
    VRD(4); SBAR(); GAPA(C1=__builtin_amdgcn_mfma_f32_32x32x16_bf16(kf[1],qr[0],negm,0,0,0), P0[6],P0[7],P0[8],P0[9],     pw0[2]=PKW(P0,4), pw0[3]=PKW(P0,6), pw0); \
    VRD(1); SBAR(); GAPA(C0=__builtin_amdgcn_mfma_f32_32x32x16_bf16(kf[2],qr[1],C0,0,0,0),   P0[10],P0[11],P0[12],P0[13], pw1[0]=PKW(P0,8), pw1[1]=PKW(P0,10), pw1); \
    VRD(5); SBAR(); GAPA(C1=__builtin_amdgcn_mfma_f32_32x32x16_bf16(kf[3],qr[1],C1,0,0,0),   P0[14],P0[15],P1[0],P1[1],   pw1[2]=PKW(P0,12),pw1[3]=PKW(P0,14), pw1); \
    VRD(2); SBAR(); GAPA(C0=__builtin_amdgcn_mfma_f32_32x32x16_bf16(kf[4],qr[2],C0,0,0,0),   P1[2],P1[3],P1[4],P1[5],     pw2[0]=PKW(P1,0), pw2[1]=PKW(P1,2), pw2); \
    VRD(6); SBAR(); GAPA(C1=__builtin_amdgcn_mfma_f32_32x32x16_bf16(kf[5],qr[2],C1,0,0,0),   P1[6],P1[7],P1[8],P1[9],     pw2[2]=PKW(P1,4), pw2[3]=PKW(P1,6), pw2); \
    VRD(3); SBAR(); GAPA(C0=__builtin_amdgcn_mfma_f32_32x32x16_bf16(kf[6],qr[3],C0,0,0,0),   P1[10],P1[11],P1[12],P1[13], pw3[0]=PKW(P1,8), pw3[1]=PKW(P1,10), pw3); \
    VRD(7); SBAR(); GAPA(C1=__builtin_amdgcn_mfma_f32_32x32x16_bf16(kf[7],qr[3],C1,0,0,0),   P1[14],P1[15],0.f,0.f,       pw3[2]=PKW(P1,12),pw3[3]=PKW(P1,14), pw3); \
    l_reg+=sacc; \
    if(GK){DMA_K((t)+3,sl_cur);} if(GV){DMA_V((t)+1,sl_next);} \
    CMASK(C0,C1,t); \
    { float a=MX3(C0[0],C0[1],C1[0]),b=MX3(C0[2],C0[3],C1[1]); a=MX3(a,C1[2],C1[3]); \
      _Pragma("unroll") for(int r=4;r<16;r+=4){a=MX3(a,C0[r],C0[r+1]);b=MX3(b,C0[r+2],C0[r+3]);a=MX3(a,C1[r],C1[r+1]);b=MX3(b,C1[r+2],C1[r+3]);} \
      float rm=__builtin_fmaxf(a,b); { auto rr=__builtin_amdgcn_permlane32_swap(__float_as_uint(rm),__float_as_uint(rm),false,false); rm=__builtin_fmaxf(__uint_as_float(rr[0]),__uint_as_float(rr[1])); } \
      resc=false; \
      if(__builtin_expect(__any(rm>(float)THRL),0)){ const float dl=__builtin_fmaxf(rm,0.f); mhat+=dl; \
        _Pragma("unroll") for(int r=0;r<16;++r){C0[r]-=dl;C1[r]-=dl;} \
        _Pragma("unroll") for(int r=0;r<16;++r)negm[r]=-mhat; asm volatile("":"+v"(negm)); \
        const float f=__builtin_amdgcn_exp2f(-dl); l_reg*=f; if(hi==0)wsf[r32]=f; resc=true; } } \
    SBAR(); \
    GAPB(o[0]=__builtin_amdgcn_mfma_f32_32x32x16_bf16(PAF(0),VFR(0),o[0],0,0,0), C0,0); \
    GAPB(o[1]=__builtin_amdgcn_mfma_f32_32x32x16_bf16(PAF(0),VFR(4),o[1],0,0,0), C0,4); \
    KRD(GL,0); GAPB(o[0]=__builtin_amdgcn_mfma_f32_32x32x16_bf16(PAF(1),VFR(1),o[0],0,0,0), C0,8); \
    KRD(GL,1); GAPB(o[1]=__builtin_amdgcn_mfma_f32_32x32x16_bf16(PAF(1),VFR(5),o[1],0,0,0), C0,12); \
    KRD(GL,2); GAPB(o[0]=__builtin_amdgcn_mfma_f32_32x32x16_bf16(PAF(2),VFR(2),o[0],0,0,0), C1,0); \
    KRD(GL,3); GAPB(o[1]=__builtin_amdgcn_mfma_f32_32x32x16_bf16(PAF(2),VFR(6),o[1],0,0,0), C1,4); \
    GAPB(o[0]=__builtin_amdgcn_mfma_f32_32x32x16_bf16(PAF(3),VFR(3),o[0],0,0,0), C1,8); \
    GAPB(o[1]=__builtin_amdgcn_mfma_f32_32x32x16_bf16(PAF(3),VFR(7),o[1],0,0,0), C1,12); \
    }while(0)
  int t=1;
  #undef CMASK
  #define CMASK(P0,P1,t) do{}while(0)
  for(;t+5<NT;t+=2){
    STEP(pB0,pB1,pA0,pA1,t,true,true,true);     WAIT_BAR(2); RESC(); ROT();
    STEP(pA0,pA1,pB0,pB1,t+1,true,true,true);   WAIT_BAR(2); RESC(); ROT();
  }
  #undef CMASK
  #define CMASK(P0,P1,t) do{}while(0)
  #define ENDW(tt) do{ if((tt)+3<NT){WAIT_BAR(2);} else if((tt)+2<NT){WAIT_BAR(1);} else {WAIT_BAR(0);} }while(0)
  for(;t+1<NT;t+=2){
    STEP(pB0,pB1,pA0,pA1,t,(t+3<NT),(t+1<NT),(t+1<NT));       ENDW(t);   RESC(); ROT();
    STEP(pA0,pA1,pB0,pB1,t+1,(t+4<NT),(t+2<NT),(t+2<NT));     ENDW(t+1); RESC(); ROT();
  }
  STEP(pB0,pB1,pA0,pA1,NT-1,false,false,false); RESC();
  { float sacc=pB0[0]+pB0[1]; _Pragma("unroll") for(int r=2;r<16;++r)sacc+=pB0[r]; _Pragma("unroll") for(int r=0;r<16;++r)sacc+=pB1[r]; l_reg+=sacc;
    pw0=(u32x4){PKW(pB0,0),PKW(pB0,2),PKW(pB0,4),PKW(pB0,6)};pw1=(u32x4){PKW(pB0,8),PKW(pB0,10),PKW(pB0,12),PKW(pB0,14)};pw2=(u32x4){PKW(pB1,0),PKW(pB1,2),PKW(pB1,4),PKW(pB1,6)};pw3=(u32x4){PKW(pB1,8),PKW(pB1,10),PKW(pB1,12),PKW(pB1,14)};
    SBAR(); pv(o,vb0+sl_cur,PAF(0),PAF(1),PAF(2),PAF(3)); }
  #undef PKW
  #undef PAF
  #undef VFR
  #undef PIN
  #undef MX3
  #undef GAPA
  #undef GAPB
  #undef EX
  #undef VRD
  #undef KRD
  #undef STEP
  #undef ENDW
  {auto rr=__builtin_amdgcn_permlane32_swap(__float_as_uint(l_reg),__float_as_uint(l_reg),false,false);l_reg=__uint_as_float(rr[0])+__uint_as_float(rr[1]);}
  if(hi==0)wsf[32+r32]=l_reg;asm volatile("s_waitcnt lgkmcnt(0)":::"memory");
  float rli[16];
  #pragma unroll
  for(int r=0;r<16;++r)rli[r]=__builtin_amdgcn_rcpf(wsf[32+crow(r,hi)]);
  bf16*Ow=Ow0+(long)wid*QBLK*OP;
  { bf16*stg=(bf16*)(shm+LDS_OST)+wid*2048;
    #pragma unroll
    for(int r=0;r<16;++r){const int orow=crow(r,hi);
      #pragma unroll
      for(int d0=0;d0<2;++d0)stg[orow*64+d0*32+r32]=__float2bfloat16(o[d0][r]*rli[r]);}
    asm volatile("s_waitcnt lgkmcnt(0)":::"memory");
    #pragma unroll
    for(int i=0;i<4;++i){const int row=i*8+(lane>>3),ch=lane&7; const u32x4 v=*(const u32x4*)(stg+row*64+ch*8); ATTN_STORE16(Ow+(long)row*OP+ch*8,v);} }
  asm volatile("s_waitcnt lgkmcnt(0)\n\ts_barrier":::"memory");
  #undef DMA_K
  #undef DMA_V
  #undef CMASK
  #undef START
  #undef RESC
  #undef ROT
}

#undef SBAR
#undef WAIT_BAR
}

typedef short bf16x8_t __attribute__((ext_vector_type(8)));
#define LDS_WAIT() asm volatile("s_waitcnt lgkmcnt(0)" ::: "memory")

__device__ __forceinline__ int inv32(int c) { return 16 * ((c >> 2) & 1) + 4 * (c >> 3) + (c & 3); }
__device__ __forceinline__ int dest_row(int type, int n) {
    if (type == 0) return n;
    if (type == 1) { const int half = n >= DFF ? 1 : 0, j = n - half * DFF, pn = j >> 7, c = j & 127; return pn * 256 + half * 128 + (c & ~31) + inv32(c & 31); }
    if (n < 768) { const int hd = n >> 6, d = n & 63, a = d >> 5, t = (d >> 4) & 1, p = d & 15; return (hd >> 2) * 256 + a * 128 + (hd & 3) * 32 + t * 16 + p; }
    const int pn = n >> 8, c = n & 255, half = c >> 7, c7 = c & 127; return pn * 256 + half * 128 + (c7 & ~31) + inv32(c7 & 31);
}
__device__ __forceinline__ void transpose_item(const float* W, int K, int N, bf16_t* WT, int type, LAS float* scr, int item, int lane) {
    const int nblk = N / 32, kb = item / nblk, nb = item % nblk, k0 = 64 * kb, n0 = 32 * nb;
#pragma unroll
    for (int h = 0; h < 2; ++h) { float wv[16];
#pragma unroll
        for (int i = 0; i < 16; ++i) wv[i] = W[(size_t)(k0 + 2 * (16 * h + i) + (lane >> 5)) * N + n0 + (lane & 31)];
#pragma unroll
        for (int i = 0; i < 16; ++i) scr[(2 * (16 * h + i) + (lane >> 5)) * 33 + (lane & 31)] = wv[i]; }
    LDS_WAIT(); asm volatile("" ::: "memory");
    const int c = lane & 7;
#pragma unroll
    for (int j = 0; j < 4; ++j) { const int n = (lane >> 3) + 8 * j; const LAS float* s = scr + (8 * c) * 33 + n;
        u32x4 o; o.x = cvt_pk(s[0 * 33], s[1 * 33]); o.y = cvt_pk(s[2 * 33], s[3 * 33]); o.z = cvt_pk(s[4 * 33], s[5 * 33]); o.w = cvt_pk(s[6 * 33], s[7 * 33]);
        *(u32x4*)(WT + (size_t)dest_row(type, n0 + n) * K + k0 + 8 * c) = o; }
    LDS_WAIT(); asm volatile("" ::: "memory");
}

__device__ __forceinline__ void prologue_phase(const Params& P, LAS unsigned char* lds, int G) {
    const int tid = opaque_tid(), lane = tid & 63, wid = __builtin_amdgcn_readfirstlane(tid >> 6), bid = blockIdx.x;
    unsigned char* ws = P.ws;
    {
        LAS float* sc = (LAS float*)lds;
        LAS float* red = (LAS float*)(lds + 36864);
        for (int i = tid; i < 9 * 1024; i += NTHREADS) { const int v = i >> 10, k = i & 1023; const float cv = v < 8 ? P.in[1][v * 1024 + k] : P.in[3][k]; sc[i] = cv / (1.0f + expf(-cv)); }
        __syncthreads();
        float* mod = (float*)(ws + OFF_MOD);
        for (int item = bid; item < 2 * 144; item += G) {
            const int l = item / 144, cgp = item % 144, col = cgp * 64 + lane, kc = wid;
            const float* W = P.in[4] + (size_t)l * 1024 * MODW + col;
            float acc[9];
#pragma unroll
            for (int v = 0; v < 9; ++v) acc[v] = 0.f;
#pragma unroll 1
            for (int k0 = kc * 128; k0 < kc * 128 + 128; k0 += 16) { float wv[16];
#pragma unroll
                for (int q = 0; q < 16; ++q) wv[q] = W[(size_t)(k0 + q) * MODW];
#pragma unroll
                for (int q = 0; q < 16; ++q)
#pragma unroll
                    for (int v = 0; v < 9; ++v) acc[v] += sc[v * 1024 + k0 + q] * wv[q]; }
#pragma unroll
            for (int v = 0; v < 9; ++v) red[(kc * 9 + v) * 64 + lane] = acc[v];
            __syncthreads();
            for (int i = tid; i < 576; i += NTHREADS) { const int v = i >> 6, cc = i & 63; float s = 0.f;
#pragma unroll
                for (int q = 0; q < 8; ++q) s += red[(q * 9 + v) * 64 + cc];
                mod[(size_t)(l * 9 + v) * MODW + cgp * 64 + cc] = s + P.in[5][l * MODW + cgp * 64 + cc]; }
            __syncthreads();
        }
    }
    __syncthreads();
    {
        LAS float* scr = (LAS float*)(lds + wid * 16384);
        const int gw = bid * 8 + wid, NGW = G * 8;
        constexpr int I_FI = 16 * (NFF2 / 32), I_FO = (DFF / 64) * 32, I_WI = 16 * (INW / 32), I_WO = 16 * 32;
        constexpr int PER_L = 2 * I_FI + 2 * I_FO + I_WI + I_WO;
        for (int it = gw; it < DEPTH * PER_L; it += NGW) {
            const int l = it / PER_L; int r = it % PER_L;
            unsigned char* wb = ws + OFF_WB + (size_t)l * WB_LAYER;
            if (r < 2 * I_FI) { const int f = r / I_FI; transpose_item(P.in[7] + (size_t)(l * 2 + f) * DM * NFF2, DM, NFF2, (bf16_t*)(wb + WB_FFIN + f * WB_FFIN_SZ), 1, scr, r % I_FI, lane); continue; } r -= 2 * I_FI;
            if (r < 2 * I_FO) { const int f = r / I_FO; transpose_item(P.in[8] + (size_t)(l * 2 + f) * DFF * DM, DFF, DM, (bf16_t*)(wb + WB_FFOUT + f * WB_FFOUT_SZ), 0, scr, r % I_FO, lane); continue; } r -= 2 * I_FO;
            if (r < I_WI) { transpose_item(P.in[9] + (size_t)l * DM * INW, DM, INW, (bf16_t*)(wb + WB_WIN), 2, scr, r, lane); continue; } r -= I_WI;
            transpose_item(P.in[22] + (size_t)l * DM * DM, DM, DM, (bf16_t*)(wb + WB_WOUT), 0, scr, r, lane);
        }
        bf16_t* LW = (bf16_t*)(ws + OFF_LW);
        const int gt = bid * NTHREADS + tid, NGT = G * NTHREADS;
        for (int i = gt; i < DEPTH * 4 * 256 * 64; i += NGT) {
            const int d = i & 63, c = (i >> 6) & 255, g = (i >> 14) & 3, l = i >> 16, n = c >> 6, e = c & 63;
            const float* src = (g & 1) ? P.in[16] : P.in[14];
            const float v = src[((((size_t)l * 2 + (g >> 1)) * 4 + n) * 64 + d) * 64 + e];
            LW[i] = (bf16_t)(cvt_pk(v, 0.f) & 0xffffu);
        }
        float* rc = (float*)(ws + OFF_ROPE); float* rs = rc + 2048;
        for (int i = gt; i < 2048; i += NGT) { const int pos = i >> 4, p = i & 15; const float inv = powf(10000.0f, -(float)p / 16.0f), ang = (float)pos * inv; rc[i] = cosf(ang); rs[i] = sinf(ang); }
    }
}

__device__ __forceinline__ void norm_phase(const Params& P, int l, int idx, int row_lo, int row_hi, bool first, int wg0, int nwg) {
    const int tid = opaque_tid(), lane = tid & 63, wid = __builtin_amdgcn_readfirstlane(tid >> 6);
    if ((int)blockIdx.x < wg0 || (int)blockIdx.x >= wg0 + nwg) return;
    const int gw = ((int)blockIdx.x - wg0) * 8 + wid, NGW = nwg * 8, per = (row_hi - row_lo + NGW - 1) / NGW;
    const int r0 = row_lo + gw * per, r1 = (r0 + per < row_hi) ? r0 + per : row_hi;
    const float* mod = (const float*)(P.ws + OFF_MOD) + (size_t)l * 9 * MODW;
    const float* gsrc = P.in[6] + (size_t)(l * 3 + idx) * DM;
    const bf16_t* xres = (const bf16_t*)(P.ws + OFF_XRES); bf16_t* hb = (bf16_t*)(P.ws + OFF_HBUF);
    int curv = -1; f32x4 Aa[4], Bb[4];
    for (int row = r0; row < r1; ++row) {
        const int v = row < MLAT ? (row >> 13) : 8;
        if (v != curv) { curv = v;
#pragma unroll
            for (int j = 0; j < 4; ++j) { const int c = 4 * lane + 256 * j; const f32x4 g4 = *(const f32x4*)(gsrc + c), sh = *(const f32x4*)(mod + (size_t)v * MODW + (3 * idx) * DM + c), sc = *(const f32x4*)(mod + (size_t)v * MODW + (3 * idx + 1) * DM + c);
                Aa[j] = g4 * (sc + 1.0f); Bb[j] = sh; } }
        f32x4 x[4]; float ss = 0.f;
        if (first) { const float* xr = row < MLAT ? P.in[0] + (size_t)row * DM : P.in[2] + (size_t)(row - MLAT) * DM;
#pragma unroll
            for (int j = 0; j < 4; ++j) x[j] = *(const f32x4*)(xr + 4 * lane + 256 * j);
        } else {
#pragma unroll
            for (int j = 0; j < 4; ++j) { const u32x2 r = *(const u32x2*)(xres + (size_t)row * DM + 4 * lane + 256 * j); x[j] = (f32x4){bf_lo(r.x), bf_hi(r.x), bf_lo(r.y), bf_hi(r.y)}; }
        }
#pragma unroll
        for (int j = 0; j < 4; ++j) { ss += (x[j][0] * x[j][0] + x[j][1] * x[j][1]) + (x[j][2] * x[j][2] + x[j][3] * x[j][3]); }
        const float rstd = 1.0f / sqrtf(wave_sum(ss) * (1.0f / DM) + EPS);
#pragma unroll
        for (int j = 0; j < 4; ++j) { const f32x4 y = x[j] * rstd * Aa[j] + Bb[j]; u32x2 w; w.x = cvt_pk(y[0], y[1]); w.y = cvt_pk(y[2], y[3]);
            *(u32x2*)(hb + (size_t)row * DM + 4 * lane + 256 * j) = w;
 }
    }
}
__device__ __forceinline__ void final_norm_phase(const Params& P, int G) {
    const int tid = opaque_tid(), lane = tid & 63, wid = __builtin_amdgcn_readfirstlane(tid >> 6);
    const int gw = blockIdx.x * 8 + wid, NGW = G * 8;
    const bf16_t* xres = (const bf16_t*)(P.ws + OFF_XRES);
    f32x4 g4[4];
#pragma unroll
    for (int j = 0; j < 4; ++j) g4[j] = *(const f32x4*)(P.in[23] + 4 * lane + 256 * j);
    for (int row = gw; row < MLAT; row += NGW) {
        f32x4 x[4]; float ss = 0.f;
#pragma unroll
        for (int j = 0; j < 4; ++j) { const u32x2 r = *(const u32x2*)(xres + (size_t)row * DM + 4 * lane + 256 * j); x[j] = (f32x4){bf_lo(r.x), bf_hi(r.x), bf_lo(r.y), bf_hi(r.y)}; ss += (x[j][0] * x[j][0] + x[j][1] * x[j][1]) + (x[j][2] * x[j][2] + x[j][3] * x[j][3]); }
        const float rstd = 1.0f / sqrtf(wave_sum(ss) * (1.0f / DM) + EPS);
#pragma unroll
        for (int j = 0; j < 4; ++j) *(f32x4*)(P.out + (size_t)row * DM + 4 * lane + 256 * j) = x[j] * rstd * g4[j];
    }
}

constexpr int L1_AST = 528;
constexpr int L1_UST = 260;
constexpr int L1_UOFF = 66560;
__device__ __forceinline__ void lru1_phase(const Params& P, int l, LAS unsigned char* lds, int G) {
    const int tid = opaque_tid(), lane = tid & 63, wid = __builtin_amdgcn_readfirstlane(tid >> 6), fr = lane & 15, fq = lane >> 4;
    LAS unsigned char* ldsA = lds; LAS float* ldsU = (LAS float*)(lds + L1_UOFF);
    const bf16_t* Ubuf = (const bf16_t*)(P.ws + OFF_U5);
    float* Sg = (float*)(P.ws + OFF_S); unsigned* PPg = (unsigned*)(P.ws + OFF_PP); float* csum = (float*)(P.ws + OFF_CSUM);
    const bf16_t* LW = (const bf16_t*)(P.ws + OFF_LW) + (size_t)l * 4 * 256 * 64;
    const int ch4 = (tid & 63) * 4, pg = tid >> 6;
    f32x4 cw[4], cbias;
#pragma unroll
    for (int i = 0; i < 4; ++i) cw[i] = *(const f32x4*)(P.in[12] + (size_t)(l * 4 + i) * 256 + ch4);
    cbias = *(const f32x4*)(P.in[13] + (size_t)l * 256 + ch4);
    const int nblk = wid >> 1;
    for (int tile = blockIdx.x; tile < NBATCH * NCHUNK; tile += G) {
        const int b = tile / NCHUNK, cidx = tile % NCHUNK, P0 = cidx * 64; const bool latent = cidx >= 4;
        const int seg_lo = latent ? 256 : 0, seg_hi = latent ? KEYS : 256;
        const int rbase = latent ? b * SEQ - 256 : MLAT + b * CTXL;
        {
            const int pp0 = P0 + pg * 8;
            f32x4 win[11];
#pragma unroll
            for (int i = 0; i < 11; ++i) { const int Pq = pp0 - 2 + i; f32x4 w4 = {0.f, 0.f, 0.f, 0.f};
                if (Pq >= seg_lo && Pq < seg_hi) { const u32x2 raw = *(const u32x2*)(Ubuf + (size_t)(rbase + Pq) * 256 + ch4); w4 = (f32x4){bf_lo(raw.x), bf_hi(raw.x), bf_lo(raw.y), bf_hi(raw.y)}; }
                win[i] = w4; }
#pragma unroll
            for (int q = 0; q < 8; ++q) { f32x4 y = cbias;
#pragma unroll
                for (int i = 0; i < 4; ++i) y = y + cw[i] * win[q + i];
                const int pos = pg * 8 + q;
                u32x2 w; w.x = cvt_pk(y[0], y[1]); w.y = cvt_pk(y[2], y[3]);
                *(LAS u32x2*)(ldsA + pos * L1_AST + ch4 * 2) = w;
                *(LAS f32x4*)(ldsU + pos * L1_UST + ch4) = y; }
        }
        __syncthreads();
#pragma unroll 1
        for (int cc = 0; cc < 2; ++cc) {
            const int c = 32 * wid + 16 * cc + fr;
            const float baf = P.in[15][(l * 2 + 0) * 256 + c], bab = P.in[15][(l * 2 + 1) * 256 + c], bxf = P.in[17][(l * 2 + 0) * 256 + c], bxb = P.in[17][(l * 2 + 1) * 256 + c];
            const float nspf = -8.0f * log1pf(expf(-P.in[18][(l * 2 + 0) * 256 + c])), nspb = -8.0f * log1pf(expf(-P.in[18][(l * 2 + 1) * 256 + c]));
            f32x4 acc[4][4];
            {
                bf16x8_t bw[4][2];
#pragma unroll
                for (int g = 0; g < 4; ++g)
#pragma unroll
                    for (int kk = 0; kk < 2; ++kk) bw[g][kk] = *(const bf16x8_t*)(LW + ((size_t)(g * 256 + c) * 64 + kk * 32 + fq * 8));
#pragma unroll
                for (int m = 0; m < 4; ++m) {
#pragma unroll
                    for (int g = 0; g < 4; ++g) acc[m][g] = (f32x4){0.f, 0.f, 0.f, 0.f};
#pragma unroll
                    for (int kk = 0; kk < 2; ++kk) { const bf16x8_t a = *(const LAS bf16x8_t*)(ldsA + (16 * m + fr) * L1_AST + (64 * nblk + 32 * kk + 8 * fq) * 2);
#pragma unroll
                        for (int g = 0; g < 4; ++g) acc[m][g] = __builtin_amdgcn_mfma_f32_16x16x32_bf16(a, bw[g][kk], acc[m][g], 0, 0, 0); }
                }
            }
#pragma unroll
            for (int m = 0; m < 4; ++m)
#pragma unroll
                for (int j = 0; j < 4; ++j) {
                    const float u = ldsU[(16 * m + 4 * fq + j) * L1_UST + c];
                    {   const float r = sigmoidf_(acc[m][0][j] + baf), ig = sigmoidf_(acc[m][1][j] + bxf);
                        const float la = nspf * r, a = __expf(la), y = 2.0f * la;
                        const float em = (y > -0.1f) ? y * (1.0f + y * (0.5f + y * (0.16666667f + y * 0.041666668f))) : (__expf(y) - 1.0f);
                        acc[m][0][j] = a; acc[m][1][j] = sqrtf(-em) * ig * u; }
                    {   const float r = sigmoidf_(acc[m][2][j] + bab), ig = sigmoidf_(acc[m][3][j] + bxb);
                        const float la = nspb * r, a = __expf(la), y = 2.0f * la;
                        const float em = (y > -0.1f) ? y * (1.0f + y * (0.5f + y * (0.16666667f + y * 0.041666668f))) : (__expf(y) - 1.0f);
                        acc[m][2][j] = a; acc[m][3][j] = sqrtf(-em) * ig * u; }
                }
            f32x4 hf[4], pf[4];
            {
                float cA = 1.f, cH = 0.f;
#pragma unroll
                for (int m = 0; m < 4; ++m) {
                    const f32x4 a = acc[m][0], x = acc[m][1];
                    const float A0 = a[0], H0 = x[0], A1 = A0 * a[1], H1 = a[1] * H0 + x[1], A2 = A1 * a[2], H2 = a[2] * H1 + x[2], A3 = A2 * a[3], H3 = a[3] * H2 + x[3];
                    float TA = A3, TH = H3;
                    float tA = __shfl_up(TA, 16), tH = __shfl_up(TH, 16); if (fq >= 1) { TH = TA * tH + TH; TA = TA * tA; }
                    tA = __shfl_up(TA, 32); tH = __shfl_up(TH, 32); if (fq >= 2) { TH = TA * tH + TH; TA = TA * tA; }
                    float EA = __shfl_up(TA, 16), EH = __shfl_up(TH, 16); if (fq == 0) { EA = 1.f; EH = 0.f; }
                    const float inA = cA * EA, inH = EA * cH + EH;
                    pf[m] = (f32x4){inA * A0, inA * A1, inA * A2, inA * A3};
                    hf[m] = (f32x4){A0 * inH + H0, A1 * inH + H1, A2 * inH + H2, A3 * inH + H3};
                    const float gA = __shfl(TA, fr + 48), gH = __shfl(TH, fr + 48);
                    cH = gA * cH + gH; cA = cA * gA;
                }
                if (fq == 0) { float* cs = csum + ((size_t)(b * NCHUNK + cidx) * 2 + 0) * 512 + c; cs[0] = cA; cs[256] = cH; }
            }
            {
                float cA = 1.f, cH = 0.f;
#pragma unroll
                for (int mm = 0; mm < 4; ++mm) { const int m = 3 - mm;
                    const f32x4 a = acc[m][2], x = acc[m][3];
                    const float A3 = a[3], H3 = x[3], A2 = A3 * a[2], H2 = a[2] * H3 + x[2], A1 = A2 * a[1], H1 = a[1] * H2 + x[1], A0 = A1 * a[0], H0 = a[0] * H1 + x[0];
                    float TA = A0, TH = H0;
                    float tA = __shfl_down(TA, 16), tH = __shfl_down(TH, 16); if (fq <= 2) { TH = TA * tH + TH; TA = TA * tA; }
                    tA = __shfl_down(TA, 32); tH = __shfl_down(TH, 32); if (fq <= 1) { TH = TA * tH + TH; TA = TA * tA; }
                    float EA = __shfl_down(TA, 16), EH = __shfl_down(TH, 16); if (fq == 3) { EA = 1.f; EH = 0.f; }
                    const float inA = cA * EA, inH = EA * cH + EH;
                    const f32x4 pb = (f32x4){inA * A0, inA * A1, inA * A2, inA * A3};
                    const f32x4 hb = (f32x4){A0 * inH + H0, A1 * inH + H1, A2 * inH + H2, A3 * inH + H3};
#pragma unroll
                    for (int j = 0; j < 4; ++j) { const int tk = 16 * m + 4 * fq + j;
                        ldsU[tk * L1_UST + c] = hf[m][j] + hb[j];
                        PPg[(size_t)(rbase + P0 + tk) * 256 + c] = (cvt_pk(pf[m][j], 0.f) & 0xffffu) | (cvt_pk(0.f, pb[j]) & 0xffff0000u); }
                    const float gA = __shfl(TA, fr), gH = __shfl(TH, fr);
                    cH = gA * cH + gH; cA = cA * gA;
                }
                if (fq == 0) { float* cs = csum + ((size_t)(b * NCHUNK + cidx) * 2 + 1) * 512 + c; cs[0] = cA; cs[256] = cH; }
            }
        }
        __syncthreads();
#pragma unroll
        for (int it = 0; it < 8; ++it) { const int idx = it * NTHREADS + tid, r = idx >> 6, c16 = idx & 63; const size_t grow = (size_t)(rbase + P0 + r) * 256 + c16 * 4;
            *(f32x4*)(Sg + grow) = *(const LAS f32x4*)(ldsU + r * L1_UST + c16 * 4);
 }
        __syncthreads();
    }
}
__device__ __forceinline__ void lru2_batch(const Params& P, int b) {
    const int tid = opaque_tid(), dir = tid >> 8, c = tid & 255;
    const float* csum = (const float*)(P.ws + OFF_CSUM); float* carry = (float*)(P.ws + OFF_CARRY);
    float h = 0.f;
#pragma unroll 1
    for (int k0 = 0; k0 < NCHUNK; k0 += 33) {
        float A[33], H[33]; int ci[33];
#pragma unroll
        for (int q = 0; q < 33; ++q) { const int k = k0 + q; ci[q] = dir == 0 ? k : (k < 4 ? 3 - k : 135 - k);
            const float* cs = csum + ((size_t)(b * NCHUNK + ci[q]) * 2 + dir) * 512 + c; A[q] = cs[0]; H[q] = cs[256]; }
#pragma unroll
        for (int q = 0; q < 33; ++q) { carry[((size_t)(b * NCHUNK + ci[q]) * 2 + dir) * 256 + c] = h; h = A[q] * h + H[q]; }
    }
}
__device__ __forceinline__ float gelu_tanh(float x) { const float z = 0.7978845608f * (x + 0.044715f * x * x * x); const float t = 1.0f - 2.0f * __builtin_amdgcn_rcpf(1.0f + __expf(2.0f * z)); return 0.5f * x * (1.0f + t); }
__device__ __forceinline__ void merge_phase(const Params& P, int l, int Mrows, int G) {
    const int tid = opaque_tid(), lane = tid & 63, wid = __builtin_amdgcn_readfirstlane(tid >> 6);
    const int gw = blockIdx.x * 8 + wid, NGW = G * 8, c4 = 4 * lane;
    const bf16_t* U5 = (const bf16_t*)(P.ws + OFF_U5);
    const bf16_t *Gb = U5 + U5_STRIDE, *BGb = U5 + 2 * U5_STRIDE, *CGb = U5 + 3 * U5_STRIDE, *SSb = U5 + 4 * U5_STRIDE;
    const float* Sg = (const float*)(P.ws + OFF_S); const unsigned* PPg = (const unsigned*)(P.ws + OFF_PP); const float* carry = (const float*)(P.ws + OFF_CARRY);
    bf16_t* hb = (bf16_t*)(P.ws + OFF_HBUF); const bf16_t* att = (const bf16_t*)(P.ws + OFF_ATT);
    f32x4 w0 = *(const f32x4*)(P.in[19] + (size_t)(l * 3 + 0) * 256 + c4), w1 = *(const f32x4*)(P.in[19] + (size_t)(l * 3 + 1) * 256 + c4), w2 = *(const f32x4*)(P.in[19] + (size_t)(l * 3 + 2) * 256 + c4);
    f32x4 cb4 = *(const f32x4*)(P.in[20] + (size_t)l * 256 + c4);
    const float* gg = P.in[21] + (size_t)l * 1024;
    const f32x4 ga0 = *(const f32x4*)(gg + 8 * lane), ga1 = *(const f32x4*)(gg + 8 * lane + 4), gl = *(const f32x4*)(gg + 512 + c4), gs = *(const f32x4*)(gg + 768 + c4);
    const int per = (Mrows + NGW - 1) / NGW, r0 = gw * per, r1 = (r0 + per < Mrows) ? r0 + per : Mrows;
    int curc = -1; f32x4 cf = {0.f, 0.f, 0.f, 0.f}, cbk = {0.f, 0.f, 0.f, 0.f};
    f32x4 pm1, p0, pp1;
    auto prodrow = [&](int r) -> f32x4 { const size_t o = (size_t)r * 256 + c4; const u32x2 a = *(const u32x2*)(CGb + o), s2 = *(const u32x2*)(SSb + o);
        return (f32x4){bf_lo(a.x) * bf_lo(s2.x), bf_hi(a.x) * bf_hi(s2.x), bf_lo(a.y) * bf_lo(s2.y), bf_hi(a.y) * bf_hi(s2.y)}; };
    const f32x4 zero4 = {0.f, 0.f, 0.f, 0.f};
    if (r0 < r1) { const int sp = r0 < MLAT ? (r0 & 8191) : ((r0 - MLAT) & 255); pm1 = sp == 0 ? zero4 : prodrow(r0 - 1); p0 = prodrow(r0); }
    for (int row = r0; row < r1; ++row) {
        int b, cidx, sp, slen;
        if (row < MLAT) { b = row >> 13; sp = row & 8191; cidx = 4 + (sp >> 6); slen = SEQ; } else { const int rc = row - MLAT; b = rc >> 8; sp = rc & 255; cidx = sp >> 6; slen = CTXL; }
        const int ckey = b * NCHUNK + cidx;
        if (ckey != curc) { curc = ckey; cf = *(const f32x4*)(carry + ((size_t)ckey * 2 + 0) * 256 + c4); cbk = *(const f32x4*)(carry + ((size_t)ckey * 2 + 1) * 256 + c4); }
        if (sp == 0) { pm1 = zero4; if (row != r0) p0 = prodrow(row); }
        pp1 = (sp + 1 == slen) ? zero4 : prodrow(row + 1);
        {   const size_t o = (size_t)row * 256 + c4;
            const f32x4 S4 = *(const f32x4*)(Sg + o); const u32x4 pp = *(const u32x4*)(PPg + o);
            const u32x2 g2 = *(const u32x2*)(Gb + o), bg2 = *(const u32x2*)(BGb + o);
            const u32x4 at = *(const u32x4*)(att + (size_t)row * 512 + 8 * lane);
            f32x4 hv;
#pragma unroll
            for (int j = 0; j < 4; ++j) hv[j] = S4[j] + bf_lo(pp[j]) * cf[j] + bf_hi(pp[j]) * cbk[j];
            const f32x4 g4 = (f32x4){bf_lo(g2.x), bf_hi(g2.x), bf_lo(g2.y), bf_hi(g2.y)}, bg4 = (f32x4){bf_lo(bg2.x), bf_hi(bg2.x), bf_lo(bg2.y), bf_hi(bg2.y)};
            f32x4 lru, scv;
#pragma unroll
            for (int j = 0; j < 4; ++j) { lru[j] = hv[j] * gelu_tanh(g4[j]); scv[j] = bg4[j] * (w0[j] * pm1[j] + w1[j] * p0[j] + w2[j] * pp1[j] + cb4[j]); }
            float av[8];
#pragma unroll
            for (int j = 0; j < 4; ++j) { av[2 * j] = bf_lo(at[j]); av[2 * j + 1] = bf_hi(at[j]); }
            float ssa = 0.f, ssl = 0.f, sss = 0.f;
#pragma unroll
            for (int j = 0; j < 8; ++j) ssa += av[j] * av[j];
#pragma unroll
            for (int j = 0; j < 4; ++j) { ssl += lru[j] * lru[j]; sss += scv[j] * scv[j]; }
            ssa = wave_sum(ssa); ssl = wave_sum(ssl); sss = wave_sum(sss);
            const float ra = 1.0f / sqrtf(ssa * (1.0f / 512.0f) + EPS), rl = 1.0f / sqrtf(ssl * (1.0f / 256.0f) + EPS), rs = 1.0f / sqrtf(sss * (1.0f / 256.0f) + EPS);
            u32x4 wa; wa.x = cvt_pk(av[0] * ra * ga0[0], av[1] * ra * ga0[1]); wa.y = cvt_pk(av[2] * ra * ga0[2], av[3] * ra * ga0[3]); wa.z = cvt_pk(av[4] * ra * ga1[0], av[5] * ra * ga1[1]); wa.w = cvt_pk(av[6] * ra * ga1[2], av[7] * ra * ga1[3]);
            *(u32x4*)(hb + (size_t)row * DM + 8 * lane) = wa;
            u32x2 wl; wl.x = cvt_pk(lru[0] * rl * gl[0], lru[1] * rl * gl[1]); wl.y = cvt_pk(lru[2] * rl * gl[2], lru[3] * rl * gl[3]);
            *(u32x2*)(hb + (size_t)row * DM + 512 + c4) = wl;
            u32x2 wsv; wsv.x = cvt_pk(scv[0] * rs * gs[0], scv[1] * rs * gs[1]); wsv.y = cvt_pk(scv[2] * rs * gs[2], scv[3] * rs * gs[3]);
            *(u32x2*)(hb + (size_t)row * DM + 768 + c4) = wsv;
        }
        pm1 = p0; p0 = pp1;
    }
}
__device__ __forceinline__ void attention_phase(const Params& P, int l, char* lds, int G) {
    using abf = attn_body::bf16;
    const abf* Q = (const abf*)(P.ws + OFF_Q); const abf* K = (const abf*)(P.ws + OFF_K); const abf* V = (const abf*)(P.ws + OFF_V); abf* O = (abf*)(P.ws + OFF_ATT);
    if (blockIdx.x < NBATCH) lru2_batch(P, blockIdx.x);
    const int nunits = NBATCH * 8 * 32 + ((l + 1 < DEPTH) ? NBATCH * 8 : 0);
    for (int uid = blockIdx.x; uid < nunits; uid += G) {
        int b, h, NT; size_t qrow;
        if (uid < NBATCH * 8 * 32) { b = uid & 7; const int rest = uid >> 3, kvh = rest >> 7, u = rest & 127; h = kvh * 4 + (u >> 5); qrow = (size_t)b * SEQ + (u & 31) * 256; NT = NCHUNK; }
        else { const int v = uid - NBATCH * 8 * 32; b = v & 7; h = v >> 3; qrow = (size_t)MLAT + b * CTXL; NT = 4; }
        const size_t kvoff = (size_t)b * KEYS * 128 + (h >> 2) * 64;
        attn_body::attn_unit<8>(Q + qrow * 512 + h * 64, K + kvoff, V + kvoff, O + qrow * 512 + h * 64, NT, lds);
    }
}

#define XB_TMO      128
#define XB_XCNT(j)  (256  + 64 * (j))
#define XB_XSUB(j)  (1280 + 64 * (j))
#define XB_XGEN(j)  (2304 + 64 * (j))
#define XB_TOP      3328
#define XB_TOPGEN   3392
#define XCD_BAR_WORDS 3456
#define XB_SPIN_CAP (1u << 18)

__device__ __forceinline__ unsigned xb_ld(unsigned* p)              { return __hip_atomic_load(p, __ATOMIC_RELAXED, __HIP_MEMORY_SCOPE_AGENT); }
__device__ __forceinline__ unsigned xb_add(unsigned* p, unsigned v) { return __hip_atomic_fetch_add(p, v, __ATOMIC_RELAXED, __HIP_MEMORY_SCOPE_AGENT); }
__device__ __forceinline__ unsigned xb_xcc_id() { return (unsigned)__builtin_amdgcn_s_getreg((3 << 11) | 20) & 0xFu; }
#define XB_SPIN(cond, bar) do { unsigned _sp = 0; while (cond) { __builtin_amdgcn_s_sleep(1); \
    if ((++_sp & 255u) == 0u) { if (xb_ld(&(bar)[XB_TMO])) break; if (_sp > XB_SPIN_CAP) { atomicAdd(&(bar)[XB_TMO], 1u); break; } } } } while (0)

struct XcdBarrier {
    unsigned* bar; unsigned x;
    volatile LAS unsigned* st;
};

__device__ __forceinline__ XcdBarrier xcd_barrier_post(unsigned* bar, volatile LAS unsigned* st) {
    XcdBarrier b; b.bar = bar; b.x = xb_xcc_id(); b.st = st;
    if (threadIdx.x == 0) (void)xb_add(&bar[XB_XCNT(b.x)], 1u);
    return b;
}
__device__ __forceinline__ void xcd_barrier_complete(unsigned* bar, unsigned x, unsigned& nloc, unsigned& nx) {
    const unsigned G = gridDim.x * gridDim.y * gridDim.z;
    unsigned sum, cnt, mine, sp = 0u;
    for (;;) {
        sum = 0u; cnt = 0u; mine = 0u;
#pragma unroll
        for (unsigned j = 0; j < 16; ++j) { const unsigned c = xb_ld(&bar[XB_XCNT(j)]); sum += c; cnt += (c > 0u) ? 1u : 0u; mine = (j == x) ? c : mine; }
        if (sum == G) break;
        __builtin_amdgcn_s_sleep(1);
        if ((++sp & 255u) == 0u) { if (xb_ld(&bar[XB_TMO])) break; if (sp > XB_SPIN_CAP) { atomicAdd(&bar[XB_TMO], 1u); break; } }
    }
    nloc = mine > 0u ? mine : 1u; nx = cnt > 0u ? cnt : 1u;
}

__device__ __forceinline__ void xcd_barrier(const XcdBarrier& b) {
    asm volatile("s_waitcnt vmcnt(0)" ::: "memory");
    __syncthreads();
    if (threadIdx.x == 0) {
        unsigned* bar = b.bar; unsigned bx_ = b.x; asm volatile("" : "+s"(bx_));
        __builtin_amdgcn_s_waitcnt(0);
        unsigned nloc = b.st[0], nx = b.st[1];
        if (nloc == 0u) { xcd_barrier_complete(bar, bx_, nloc, nx); b.st[0] = nloc; b.st[1] = nx; }
        const unsigned old = xb_add(&bar[XB_XSUB(bx_)], 1u);
        const unsigned gen = old / nloc;
        if (old + 1u == (gen + 1u) * nloc) {
            __builtin_amdgcn_fence(__ATOMIC_RELEASE, "agent");
            asm volatile("s_waitcnt vmcnt(0)" ::: "memory");
            const unsigned og = xb_add(&bar[XB_TOP], 1u);
            const unsigned tg = og / nx;
            if (og + 1u == (tg + 1u) * nx) xb_add(&bar[XB_TOPGEN], 1u);
            else XB_SPIN(xb_ld(&bar[XB_TOPGEN]) == tg, bar);
            __builtin_amdgcn_fence(__ATOMIC_ACQUIRE, "agent");
            xb_add(&bar[XB_XGEN(bx_)], 1u);
            asm volatile("s_waitcnt vmcnt(0)" ::: "memory");
        } else {
            XB_SPIN(xb_ld(&bar[XB_XGEN(bx_)]) == gen, bar);
            __builtin_amdgcn_fence(__ATOMIC_ACQUIRE, "agent");
            asm volatile("s_waitcnt vmcnt(0)" ::: "memory");
        }
    }
    __syncthreads();
}

#ifndef PH_MASK
#define PH_MASK 0x1FF
#endif
__global__ void __launch_bounds__(NTHREADS, 2) fwd_megakernel(Params P) {
    extern __shared__ __attribute__((aligned(16))) unsigned char lds_raw[];
    LAS unsigned char* lds = (LAS unsigned char*)lds_raw;
    cg::grid_group grid = cg::this_grid();
    volatile LAS unsigned* bst = (volatile LAS unsigned*)(lds + LDS_BAR_OFF);
    if (threadIdx.x < 2) bst[threadIdx.x] = 0u;
    __syncthreads();
    const XcdBarrier xbar = xcd_barrier_post((unsigned*)(P.ws + OFF_CTL), bst);
#define GRID_SYNC() xcd_barrier(xbar)
    const int G = gridDim.x;
    unsigned char* ws = P.ws;
    if constexpr (PH_MASK & 1) prologue_phase(P, lds, G);
    grid.sync();
    if constexpr (PH_MASK & 2) norm_phase(P, 0, 0, 0, MTOT, true, 0, G);
    GRID_SYNC();
    for (int step = 0; step < DEPTH * 3; ++step) {
        const int l = step / 3, s3 = step % 3;
        const bool last = (l == DEPTH - 1);
        const int Mn = (last && s3 == 2) ? MLAT : MTOT;
        unsigned char* wb = ws + OFF_WB + (size_t)l * WB_LAYER;
        pg8::Gemm gr; pg8::EpiResid er; int Mr;
        const float* modl = (const float*)(ws + OFF_MOD) + (size_t)l * 9 * MODW;
        if (s3 != 1) {
            const int f = s3 >> 1;
            { pg8::Gemm g{(const bf16_t*)(ws + OFF_HBUF), (const bf16_t*)(wb + WB_FFIN + f * WB_FFIN_SZ), Mn, NFF2, DM};
              pg8::StaticOrder S; S.init(Mn, NFF2, G, (int)blockIdx.x);
              pg8::EpiSwiglu E{(bf16_t*)(ws + OFF_MID)};
              if constexpr (PH_MASK & 4) pg8::gemm_phase<pg8::EpiSwiglu, pg8::StaticOrder, true, true>(lds, g, S, E); }
            GRID_SYNC();
            Mr = Mn;
            gr = pg8::Gemm{(const bf16_t*)(ws + OFF_MID), (const bf16_t*)(wb + WB_FFOUT + f * WB_FFOUT_SZ), Mr, DM, DFF};
            er = pg8::EpiResid{(bf16_t*)(ws + OFF_XRES), P.in[0], P.in[2], modl + (3 * s3 + 2) * DM, 0.5f, step == 0 ? 1 : 0};
        } else {
            { LAS float* tab = (LAS float*)(lds + LDS_TAB_OFF);
              for (int i = opaque_tid(); i < 4096 + 128; i += NTHREADS) tab[i] = i < 4096 ? ((const float*)(ws + OFF_ROPE))[i] : (i < 4160 ? P.in[10][l * 64 + i - 4096] : P.in[11][l * 64 + i - 4160]);
              __syncthreads(); }
            { pg8::Gemm g{(const bf16_t*)(ws + OFF_HBUF), (const bf16_t*)(wb + WB_WIN), MTOT, INW, DM};
              pg8::StaticOrder S; S.init(MTOT, INW, G, (int)blockIdx.x);
              pg8::EpiWin E{(bf16_t*)(ws + OFF_Q), (bf16_t*)(ws + OFF_K), (bf16_t*)(ws + OFF_V), (bf16_t*)(ws + OFF_U5), (const LAS float*)(lds + LDS_TAB_OFF), 0.125f * 1.4426950408889634f};
              if constexpr (PH_MASK & 8) pg8::gemm_phase<pg8::EpiWin, pg8::StaticOrder, true, true>(lds, g, S, E); }
            GRID_SYNC();
            if constexpr (PH_MASK & 16) lru1_phase(P, l, lds, G);
            GRID_SYNC();
            if constexpr (PH_MASK & 32) attention_phase(P, l, (char*)lds_raw, G);
            GRID_SYNC();
            Mr = last ? MLAT : MTOT;
            if constexpr (PH_MASK & 64) merge_phase(P, l, Mr, G);
            GRID_SYNC();
            gr = pg8::Gemm{(const bf16_t*)(ws + OFF_HBUF), (const bf16_t*)(wb + WB_WOUT), Mr, DM, DM};
            er = pg8::EpiResid{(bf16_t*)(ws + OFF_XRES), P.in[0], P.in[2], modl + 5 * DM, 1.0f, 0};
        }
        const bool ctxr = (Mr == MTOT), has_next = step + 1 < DEPTH * 3;
        const int l2 = (step + 1) / 3, s32 = (step + 1) % 3, Mn2 = (l2 == DEPTH - 1 && s32 == 2) ? MLAT : MTOT;
        for (int pass = 0; pass < (ctxr ? 2 : 1); ++pass) {
            pg8::ResidOrder S; S.so.init(MLAT, DM, G, (int)blockIdx.x); S.single = pass; S.pm = 256 + ((int)blockIdx.x >> 2); S.pn = (int)blockIdx.x & 3;
            if (pass == 1 && (int)blockIdx.x >= 32) { if constexpr (PH_MASK & 2) norm_phase(P, l2, s32, 0, MLAT, false, 32, G - 32); }
            else { if constexpr (PH_MASK & 128) pg8::gemm_phase<pg8::EpiResid, pg8::ResidOrder, true, true>(lds, gr, S, er); }
            GRID_SYNC();
        }
        if (has_next) {
            if (ctxr) { if constexpr (PH_MASK & 2) norm_phase(P, l2, s32, MLAT, MTOT, false, 0, G); }
            else { if constexpr (PH_MASK & 2) norm_phase(P, l2, s32, 0, Mn2, false, 0, G); }
            GRID_SYNC();
        }
    }
    if constexpr (PH_MASK & 256) final_norm_phase(P, G);
}

extern "C" void kernel_launch(void* const* d_in, const int* in_sizes, int n_in, void* d_out, int out_size, void* d_ws, size_t ws_size, hipStream_t stream) {
    static int grid = 0;
    if (grid == 0) {
        if (n_in != 24 || out_size != MLAT * DM || ws_size < WS_NEED) { fprintf(stderr, "kernel_launch: unexpected shapes (n_in %d, out %d, ws %zu, need %zu)\n", n_in, out_size, ws_size, (size_t)WS_NEED); grid = -1; return; }
        int dev = 0, cus = 0, per_cu = 0;
        hipGetDevice(&dev); hipDeviceGetAttribute(&cus, hipDeviceAttributeMultiprocessorCount, dev);
        if (hipFuncSetAttribute((const void*)fwd_megakernel, hipFuncAttributeMaxDynamicSharedMemorySize, LDS_BYTES) != hipSuccess) { fprintf(stderr, "kernel_launch: hipFuncSetAttribute failed\n"); grid = -1; return; }
        if (hipOccupancyMaxActiveBlocksPerMultiprocessor(&per_cu, (const void*)fwd_megakernel, NTHREADS, LDS_BYTES) != hipSuccess || per_cu < 1) { fprintf(stderr, "kernel_launch: occupancy query says %d\n", per_cu); per_cu = 1; (void)hipGetLastError(); }
        grid = cus * 1;
        if (grid % 8 != 0 || grid <= 0) grid = 256;
        fprintf(stderr, "kernel_launch: grid %d (cus %d, per_cu %d)\n", grid, cus, per_cu);
    }
    if (grid < 0) return;
    Params p{};
    for (int i = 0; i < 24; ++i) p.in[i] = (const float*)d_in[i];
    p.out = (float*)d_out; p.ws = (unsigned char*)d_ws;
    if (hipMemsetAsync((unsigned char*)d_ws + OFF_CTL, 0, CTL_BYTES, stream) != hipSuccess) { fprintf(stderr, "kernel_launch: memset of the barrier words failed\n"); return; }
    void* args[] = {&p};
    hipError_t e = hipLaunchCooperativeKernel((const void*)fwd_megakernel, dim3(grid), dim3(NTHREADS), args, LDS_BYTES, stream);
    if (e != hipSuccess) fprintf(stderr, "kernel_launch: cooperative launch failed: %s (grid %d)\n", hipGetErrorString(e), grid);
}
```

```cpp
#include <hip/hip_runtime.h>
#include <hip/hip_bf16.h>
#include <hip/hip_cooperative_groups.h>
#include <cstdio>
#include <cstdint>
#include <cmath>
namespace cg = cooperative_groups;

constexpr int DM = 1024, NBATCH = 8, SEQ = 8192, CTXL = 256, DEPTH = 2;
constexpr int MLAT = NBATCH * SEQ, MCTX = NBATCH * CTXL, MTOT = MLAT + MCTX;
constexpr int DFF = 2816, NFF2 = 2 * DFF, INW = 2048, NMODV = 9, MODW = 9 * DM;
constexpr int KEYS = SEQ + CTXL, NCHUNK = KEYS / 64;
constexpr float EPS = 1e-6f;
constexpr int NTHREADS = 512;
constexpr int LDS_BYTES = 155648;
constexpr int LDS_TAB_OFF = 131072;

constexpr size_t MiB = 1u << 20;
constexpr size_t OFF_MOD = 0;
constexpr size_t OFF_ROPE = 1 * MiB;
constexpr size_t OFF_LW = 1 * MiB + 65536;
constexpr size_t OFF_CSUM = 2 * MiB;
constexpr size_t OFF_CARRY = 7 * MiB;
constexpr size_t OFF_CTL = 9 * MiB + 524288, CTL_BYTES = 65536;
constexpr int LDS_BAR_OFF = 155392;
constexpr size_t OFF_WB = 10 * MiB;
constexpr size_t WB_LAYER = 39 * MiB;
constexpr size_t WB_FFIN = 0, WB_FFIN_SZ = (size_t)NFF2 * DM * 2;
constexpr size_t WB_FFOUT = 2 * WB_FFIN_SZ, WB_FFOUT_SZ = (size_t)DM * DFF * 2;
constexpr size_t WB_WIN = WB_FFOUT + 2 * WB_FFOUT_SZ, WB_WIN_SZ = (size_t)INW * DM * 2;
constexpr size_t WB_WOUT = WB_WIN + WB_WIN_SZ;
static_assert(WB_WOUT + (size_t)DM * DM * 2 == WB_LAYER, "weight map");
constexpr size_t OFF_XRES = 88 * MiB;
constexpr size_t OFF_HBUF = 352 * MiB;
constexpr size_t OFF_R1 = 484 * MiB;
constexpr size_t OFF_MID = OFF_R1;
constexpr size_t OFF_Q = OFF_R1;
constexpr size_t OFF_K = OFF_R1 + 66 * MiB;
constexpr size_t OFF_V = OFF_K + 16 * MiB + 524288;
constexpr size_t OFF_U5 = OFF_R1 + 99 * MiB;
constexpr size_t U5_STRIDE = (size_t)MTOT * 256;
constexpr size_t OFF_S = OFF_R1 + 264 * MiB;
constexpr size_t OFF_PP = OFF_R1 + 330 * MiB;
constexpr size_t OFF_ATT = OFF_R1 + 396 * MiB;
constexpr size_t WS_NEED = OFF_ATT + 66 * MiB;

#define LAS __attribute__((address_space(3)))
typedef unsigned short bf16_t;
typedef float f32x4 __attribute__((ext_vector_type(4)));
typedef float f32x2 __attribute__((ext_vector_type(2)));
typedef unsigned u32x4 __attribute__((ext_vector_type(4)));
typedef unsigned u32x2 __attribute__((ext_vector_type(2)));

struct Params { const float* in[24]; float* out; unsigned char* ws; };

__device__ __forceinline__ unsigned cvt_pk(float lo, float hi) { unsigned r; asm volatile("v_cvt_pk_bf16_f32 %0, %1, %2" : "=v"(r) : "v"(lo), "v"(hi)); return r; }
__device__ __forceinline__ float bf_lo(unsigned w) { return __uint_as_float(w << 16); }
__device__ __forceinline__ float bf_hi(unsigned w) { return __uint_as_float(w & 0xffff0000u); }
__device__ __forceinline__ float wave_sum(float v) {
#pragma unroll
    for (int o = 1; o < 64; o <<= 1) v += __shfl_xor(v, o);
    return v;
}
__device__ __forceinline__ int opaque_tid() { int t = threadIdx.x; asm volatile("" : "+v"(t)); return t; }
__device__ __forceinline__ float sigmoidf_(float z) { return __builtin_amdgcn_rcpf(1.0f + __expf(-z)); }
namespace pg8 {
#define PG8_LAS __attribute__((address_space(3)))
typedef unsigned short bf16_t;
typedef short bf16x8 __attribute__((ext_vector_type(8)));
typedef float f32x4 __attribute__((ext_vector_type(4)));
typedef unsigned u32x4 __attribute__((ext_vector_type(4)));
constexpr int BM = 256, BK = 64, HALF = 128, HTB = HALF * BK * 2  , STAGE_BYTES = 8 * HTB, NXCD = 8, WGM = 4;

__host__ __device__ __forceinline__ int lds_byte(int r, int c) { const int st = (r >> 4) * 2 + (c >> 5), rr = r & 15, cc = c & 31, ob = rr * 64 + cc * 2; return st * 1024 + (ob ^ (((ob >> 9) & 1) << 5)); }
__host__ __device__ __forceinline__ void stage_rc(int b, int& R, int& C) { const int st = b / 1024, sb = b % 1024, swz = sb ^ (((sb >> 9) & 1) << 5); R = (st >> 1) * 16 + swz / 64; C = (st & 1) * 32 + (swz % 64) / 2; }
__host__ __device__ __forceinline__ int perm32(int rho) { const int n = rho >> 4, i = rho & 15; return 8 * (i >> 2) + 4 * n + (i & 3); }

struct Unit { int pm, pn; };
struct Gemm { const bf16_t* A; const bf16_t* Bt; int M, N, K; };

struct StaticOrder {
    int nM, nN, nwg, G, c;
    __host__ __device__ void init(int M, int N, int G_, int c_) { nM = M / BM; nN = N / BM; nwg = nM * nN; G = G_; c = c_; }
    __host__ __device__ bool next(int i, Unit& u) const {
        const long L = (long)i * G + c; if (L >= nwg) return false;
        int wgid = (int)L; { const int q = nwg / NXCD, r = nwg % NXCD, xcd = wgid % NXCD, off = wgid / NXCD; wgid = (xcd < r ? xcd * (q + 1) : r * (q + 1) + (xcd - r) * q) + off; }
        const int nig = WGM * nN, gid = wgid / nig, fm = gid * WGM, gsz = (nM - fm) < WGM ? (nM - fm) : WGM;
        u.pm = fm + ((wgid % nig) % gsz); u.pn = (wgid % nig) / gsz; return true;
    }
    __device__ __forceinline__ void a_ready(const Unit&) const {}
    __device__ __forceinline__ void done(const Unit&) const {}
};
__device__ __forceinline__ unsigned cvt_pk_bf16(float lo, float hi) { unsigned r; asm volatile("v_cvt_pk_bf16_f32 %0, %1, %2" : "=v"(r) : "v"(lo), "v"(hi)); return r; }

struct EpiSwiglu {
    static constexpr bool PERM = false, AFTER_DRAIN = false;
    bf16_t* O;
    __device__ __forceinline__ void operator()(const f32x4 (&acc)[2][2][4][2], const Unit& u, int wr, int wc, int fr, int fq) const {
        const int row0 = u.pm * BM + wr * 64 + fr, col0 = u.pn * 128 + wc * 32 + 8 * fq;
#pragma unroll
        for (int ai = 0; ai < 2; ++ai)
#pragma unroll
            for (int m = 0; m < 4; ++m) {
                bf16_t* rowp = O + (size_t)(row0 + ai * HALF + m * 16) * 2816 + col0;
                float v[8];
#pragma unroll
                for (int n = 0; n < 2; ++n)
#pragma unroll
                    for (int j = 0; j < 4; ++j) { const float g = acc[ai][0][m][n][j], up = acc[ai][1][m][n][j]; v[n * 4 + j] = g * __builtin_amdgcn_rcpf(1.0f + __expf(-g)) * up; }
                u32x4 w; w.x = cvt_pk_bf16(v[0], v[1]); w.y = cvt_pk_bf16(v[2], v[3]); w.z = cvt_pk_bf16(v[4], v[5]); w.w = cvt_pk_bf16(v[6], v[7]);
                *(u32x4*)rowp = w;
            }
    }
};
struct EpiResid {
    static constexpr bool PERM = false, AFTER_DRAIN = false;
    bf16_t* X; const float* Xlat; const float* Xctx; const float* gate; float scale; int first;
    __device__ __forceinline__ void operator()(const f32x4 (&acc)[2][2][4][2], const Unit& u, int wr, int wc, int fr, int fq) const {
        const int v = u.pm < 256 ? (u.pm >> 5) : 8;
        const int row0 = u.pm * BM + wr * 64 + fr, col0 = u.pn * BM + wc * 32 + 8 * fq;
        const float* gp = gate + (size_t)v * 9216 + col0;
        f32x4 gv[2][2];
#pragma unroll
        for (int bj = 0; bj < 2; ++bj)
#pragma unroll
            for (int n = 0; n < 2; ++n) gv[bj][n] = *(const f32x4*)(gp + bj * HALF + n * 4) * scale;
#pragma unroll
        for (int ai = 0; ai < 2; ++ai) {
            bf16_t* rowp = X + (size_t)(row0 + ai * HALF) * 1024 + col0;
            f32x4 xv[4][2][2];
            if (first) {
                const float* rowr = (u.pm < 256 ? Xlat + (size_t)(row0 + ai * HALF) * 1024 : Xctx + (size_t)(row0 + ai * HALF - 65536) * 1024) + col0;
#pragma unroll
                for (int m = 0; m < 4; ++m)
#pragma unroll
                    for (int bj = 0; bj < 2; ++bj)
#pragma unroll
                        for (int n = 0; n < 2; ++n) xv[m][bj][n] = *(const f32x4*)(rowr + (size_t)m * 16 * 1024 + bj * HALF + n * 4);
            } else {
                u32x4 raw[4][2];
#pragma unroll
                for (int m = 0; m < 4; ++m)
#pragma unroll
                    for (int bj = 0; bj < 2; ++bj) raw[m][bj] = *(const u32x4*)(rowp + (size_t)m * 16 * 1024 + bj * HALF);
#pragma unroll
                for (int m = 0; m < 4; ++m)
#pragma unroll
                    for (int bj = 0; bj < 2; ++bj) { const u32x4 r = raw[m][bj];
                        xv[m][bj][0] = (f32x4){__uint_as_float(r.x << 16), __uint_as_float(r.x & 0xffff0000u), __uint_as_float(r.y << 16), __uint_as_float(r.y & 0xffff0000u)};
                        xv[m][bj][1] = (f32x4){__uint_as_float(r.z << 16), __uint_as_float(r.z & 0xffff0000u), __uint_as_float(r.w << 16), __uint_as_float(r.w & 0xffff0000u)}; }
            }
#pragma unroll
            for (int m = 0; m < 4; ++m)
#pragma unroll
                for (int bj = 0; bj < 2; ++bj) { const f32x4 y0 = xv[m][bj][0] + gv[bj][0] * acc[ai][bj][m][0], y1 = xv[m][bj][1] + gv[bj][1] * acc[ai][bj][m][1];
                    u32x4 w; w.x = cvt_pk_bf16(y0[0], y0[1]); w.y = cvt_pk_bf16(y0[2], y0[3]); w.z = cvt_pk_bf16(y1[0], y1[1]); w.w = cvt_pk_bf16(y1[2], y1[3]);
                    *(u32x4*)(rowp + (size_t)m * 16 * 1024 + bj * HALF) = w; }
        }
    }
};
struct ResidOrder {
    StaticOrder so; int single, pm, pn;
    __device__ __forceinline__ bool next(int i, Unit& u) const { if (single) { if (i > 0) return false; u.pm = pm; u.pn = pn; return true; } return so.next(i, u); }
    __device__ __forceinline__ void a_ready(const Unit&) const {}
    __device__ __forceinline__ void done(const Unit&) const {}
};
struct EpiWin {
    static constexpr bool PERM = false, AFTER_DRAIN = false;
    bf16_t *Q, *K, *V, *U5; const PG8_LAS float* tab; float qscale;
    __device__ __forceinline__ void operator()(const f32x4 (&acc)[2][2][4][2], const Unit& u, int wr, int wc, int fr, int fq) const {
        const int row0 = u.pm * BM + wr * 64 + fr;
        if (u.pn >= 3) {
            bf16_t* base = U5 + (size_t)(u.pn - 3) * ((size_t)67584 * 256) + wc * 32 + 8 * fq;
#pragma unroll
            for (int ai = 0; ai < 2; ++ai)
#pragma unroll
                for (int m = 0; m < 4; ++m) { bf16_t* rowp = base + (size_t)(row0 + ai * HALF + m * 16) * 256;
#pragma unroll
                    for (int bj = 0; bj < 2; ++bj) { const f32x4 v0 = acc[ai][bj][m][0], v1 = acc[ai][bj][m][1];
                        u32x4 w; w.x = cvt_pk_bf16(v0[0], v0[1]); w.y = cvt_pk_bf16(v0[2], v0[3]); w.z = cvt_pk_bf16(v1[0], v1[1]); w.w = cvt_pk_bf16(v1[2], v1[3]);
                        *(u32x4*)(rowp + bj * HALF) = w; } }
            return;
        }
        const int kind = u.pn < 2 ? 0 : (wc < 2 ? 1 : 2);
        const bool latent = u.pm < 256;
        const PG8_LAS float* gsrc = tab + 4096 + (kind == 0 ? 0 : 64);
#pragma unroll
        for (int ai = 0; ai < 2; ++ai)
#pragma unroll
            for (int m = 0; m < 4; ++m) {
                const int row = row0 + ai * HALF + m * 16;
                f32x4 y[2][2];
#pragma unroll
                for (int bj = 0; bj < 2; ++bj)
#pragma unroll
                    for (int n = 0; n < 2; ++n) y[bj][n] = acc[ai][bj][m][n];
                if (kind != 2) {
                    float ss = 0.f;
#pragma unroll
                    for (int bj = 0; bj < 2; ++bj)
#pragma unroll
                        for (int n = 0; n < 2; ++n) { const f32x4 t = y[bj][n]; ss += (t[0] * t[0] + t[1] * t[1]) + (t[2] * t[2] + t[3] * t[3]); }
                    ss += __shfl_xor(ss, 16); ss += __shfl_xor(ss, 32);
                    const float r = 1.0f / sqrtf(ss * (1.0f / 64.0f) + 1e-6f);
#pragma unroll
                    for (int bj = 0; bj < 2; ++bj)
#pragma unroll
                        for (int n = 0; n < 2; ++n) y[bj][n] = y[bj][n] * r * *(const PG8_LAS f32x4*)(gsrc + 32 * bj + 16 * n + 4 * fq);
                    if (latent) {
                        const int s = row & 8191;
#pragma unroll
                        for (int bj = 0; bj < 2; ++bj) { const int pos = bj == 0 ? (s >> 6) : (s & 63);
                            const f32x4 c4 = *(const PG8_LAS f32x4*)(tab + pos * 16 + 4 * fq), s4 = *(const PG8_LAS f32x4*)(tab + 2048 + pos * 16 + 4 * fq);
                            const f32x4 x1 = y[bj][0], x2 = y[bj][1];
                            y[bj][0] = x1 * c4 - x2 * s4; y[bj][1] = x2 * c4 + x1 * s4; }
                    }
                }
                bf16_t* dst;
                if (kind == 0) { dst = Q + (size_t)row * 512 + (u.pn * 4 + wc) * 64;
#pragma unroll
                    for (int bj = 0; bj < 2; ++bj)
#pragma unroll
                        for (int n = 0; n < 2; ++n) y[bj][n] = y[bj][n] * qscale;
                } else {
                    size_t kr;
                    if (latent) kr = (size_t)(row >> 13) * 8448 + 256 + (row & 8191);
                    else { const int rc = row - 65536; kr = (size_t)(rc >> 8) * 8448 + (rc & 255); }
                    dst = (kind == 1 ? K : V) + kr * 128 + (wc & 1) * 64;
                }
                if (kind != 2) {
#pragma unroll
                    for (int bj = 0; bj < 2; ++bj) { u32x4 w; w.x = cvt_pk_bf16(y[bj][0][0], y[bj][0][1]); w.y = cvt_pk_bf16(y[bj][0][2], y[bj][0][3]); w.z = cvt_pk_bf16(y[bj][1][0], y[bj][1][1]); w.w = cvt_pk_bf16(y[bj][1][2], y[bj][1][3]);
                        *(u32x4*)(dst + 32 * bj + 8 * fq) = w; }
                } else {
#pragma unroll
                    for (int bj = 0; bj < 2; ++bj)
#pragma unroll
                        for (int n = 0; n < 2; ++n) { u32x2 w; w.x = cvt_pk_bf16(y[bj][n][0], y[bj][n][1]); w.y = cvt_pk_bf16(y[bj][n][2], y[bj][n][3]);
                            *(u32x2*)(dst + 32 * bj + 16 * n + 4 * fq) = w; }
                }
            }
    }
};
template <class Epi, class Sched, bool ALIGN_EPI = false, bool SP2 = false>
__device__ __forceinline__ void gemm_phase(PG8_LAS unsigned char* lds, const Gemm g, const Sched& S, const Epi& E) {
    const int tid = opaque_tid(), wid = __builtin_amdgcn_readfirstlane(tid >> 6), lane = tid & 63, wr = wid >> 2, wc = wid & 3, fr = lane & 15, fq = lane >> 4;
    const int K = g.K, nt = K / BK;
    unsigned voffA[2], voffB[2];
#pragma unroll
    for (int i = 0; i < 2; ++i) { int R, C; stage_rc(tid * 16 + i * 8192, R, C); const int Rb = Epi::PERM ? ((R & ~31) + perm32(R & 31)) : R;
        voffA[i] = (unsigned)(R * K + C) * 2u; voffB[i] = (unsigned)(Rb * K + C) * 2u; }
    const size_t kstep = (size_t)(BK * 2);
    const size_t hstep = (size_t)HALF * K * 2;
    const size_t tstep = 2 * hstep;
    const unsigned ldsw = (unsigned)wid * 1024u;
    const int aoff = lds_byte(wr * 64 + fr, fq * 8), boff = lds_byte(wc * 32 + fr, fq * 8);
#define PG8_SA(b, h) (((b) * 2 + (h)) * HTB)
#define PG8_SB(b, h) ((4 + (b) * 2 + (h)) * HTB)
#define PG8_STAGE(bufoff, gbase, voff) do { _Pragma("unroll") for (int _i = 0; _i < 2; ++_i) \
        __builtin_amdgcn_global_load_lds((const unsigned*)((const char*)(gbase) + (voff)[_i]), (PG8_LAS unsigned*)(lds + (bufoff) + ldsw + _i * 8192), 16, 0, 0); } while (0)
#define PG8_LDA(dst, b, h) do { _Pragma("unroll") for (int m = 0; m < 4; ++m) _Pragma("unroll") for (int k = 0; k < 2; ++k) dst[m][k] = *(const PG8_LAS bf16x8*)(lds + PG8_SA(b, h) + aoff + m * 2048 + k * 1024); } while (0)
#define PG8_LDB(dst, b, h) do { _Pragma("unroll") for (int n = 0; n < 2; ++n) _Pragma("unroll") for (int k = 0; k < 2; ++k) dst[n][k] = *(const PG8_LAS bf16x8*)(lds + PG8_SB(b, h) + boff + n * 2048 + k * 1024); } while (0)
#define PG8_MMA(ai, bj, At, Bt) do { __builtin_amdgcn_s_setprio(1); _Pragma("unroll") for (int m = 0; m < 4; ++m) _Pragma("unroll") for (int n = 0; n < 2; ++n) _Pragma("unroll") for (int k = 0; k < 2; ++k) \
        acc[ai][bj][m][n] = __builtin_amdgcn_mfma_f32_16x16x32_bf16(Bt[n][k], At[m][k], acc[ai][bj][m][n], 0, 0, 0); __builtin_amdgcn_s_setprio(0); } while (0)
#define PG8_WAIT_V(n) asm volatile("s_waitcnt vmcnt(" #n ")" ::: "memory")
#define PG8_WAIT_L(n) asm volatile("s_waitcnt lgkmcnt(" #n ")" ::: "memory")
#define PG8_BAR __builtin_amdgcn_s_barrier()
#define PG8_SCHED __builtin_amdgcn_sched_barrier(0)
    Unit cur, nxt; int ui = 0;
    if (!S.next(0, cur)) return;
    f32x4 acc[2][2][4][2];
#pragma unroll
    for (int a = 0; a < 2; ++a)
#pragma unroll
        for (int b = 0; b < 2; ++b)
#pragma unroll
            for (int m = 0; m < 4; ++m)
#pragma unroll
                for (int n = 0; n < 2; ++n) acc[a][b][m][n] = (f32x4){0.f, 0.f, 0.f, 0.f};
    bf16x8 At[4][2], B0[2][2], B1[2][2];
    const char* cA = (const char*)g.A + (size_t)cur.pm * tstep; const char* cB = (const char*)g.Bt + (size_t)cur.pn * tstep;
    S.a_ready(cur);
    if constexpr (SP2) {
        PG8_STAGE(PG8_SB(0, 0), cB, voffB); PG8_STAGE(PG8_SB(0, 1), cB + hstep, voffB); PG8_STAGE(PG8_SA(0, 0), cA, voffA); PG8_STAGE(PG8_SA(0, 1), cA + hstep, voffA);
        if (wr == 1) PG8_BAR;
        PG8_WAIT_V(2); PG8_BAR;
        PG8_STAGE(PG8_SB(1, 0), cB + kstep, voffB); PG8_STAGE(PG8_SA(1, 0), cA + kstep, voffA); PG8_STAGE(PG8_SB(1, 1), cB + hstep + kstep, voffB);
        PG8_WAIT_V(6); PG8_BAR;
    } else {
        PG8_STAGE(PG8_SB(0, 0), cB, voffB); PG8_STAGE(PG8_SA(0, 0), cA, voffA); PG8_STAGE(PG8_SB(0, 1), cB + hstep, voffB); PG8_STAGE(PG8_SA(0, 1), cA + hstep, voffA);
        if (wr == 1) PG8_BAR;
        PG8_WAIT_V(4); PG8_BAR;
        PG8_STAGE(PG8_SB(1, 0), cB + kstep, voffB); PG8_STAGE(PG8_SA(1, 0), cA + kstep, voffA); PG8_STAGE(PG8_SB(1, 1), cB + hstep + kstep, voffB);
        PG8_WAIT_V(6); PG8_BAR;
    }
    for (;;) {
        const bool has_next = S.next(ui + 1, nxt);
        const char* nA = has_next ? (const char*)g.A + (size_t)nxt.pm * tstep : cA; const char* nB = has_next ? (const char*)g.Bt + (size_t)nxt.pn * tstep : cB;
        for (int t = 0; t < nt; t += 2) {
            const bool last = (t == nt - 2);
            const char* a1 = cA + (size_t)(t + 1) * kstep;
            const char* a2 = last ? nA : cA + (size_t)(t + 2) * kstep; const char* b2 = last ? nB : cB + (size_t)(t + 2) * kstep;
            const char* a3 = a2 + kstep; const char* b3 = b2 + kstep;
            if (last && has_next) S.a_ready(nxt);
            if constexpr (SP2) {
            PG8_LDB(B0, 0, 0); PG8_LDB(B1, 0, 1); PG8_SCHED; PG8_LDA(At, 0, 0); PG8_STAGE(PG8_SA(1, 1), a1 + hstep, voffA);
            PG8_WAIT_V(8); PG8_WAIT_L(0); PG8_BAR; PG8_MMA(0, 0, At, B0); PG8_MMA(0, 1, At, B1); PG8_BAR; PG8_SCHED;
            PG8_LDA(At, 0, 1); PG8_STAGE(PG8_SB(0, 0), b2, voffB); PG8_STAGE(PG8_SB(0, 1), b2 + hstep, voffB); PG8_STAGE(PG8_SA(0, 0), a2, voffA);
            PG8_WAIT_V(8); PG8_WAIT_L(0); PG8_BAR; PG8_MMA(1, 0, At, B0); PG8_MMA(1, 1, At, B1); PG8_BAR; PG8_SCHED;
            PG8_LDB(B0, 1, 0); PG8_LDB(B1, 1, 1); PG8_SCHED; PG8_LDA(At, 1, 0); PG8_STAGE(PG8_SA(0, 1), a2 + hstep, voffA);
            PG8_WAIT_V(8); PG8_WAIT_L(0); PG8_BAR; PG8_MMA(0, 0, At, B0); PG8_MMA(0, 1, At, B1); PG8_BAR; PG8_SCHED;
            PG8_LDA(At, 1, 1); PG8_STAGE(PG8_SB(1, 0), b3, voffB); PG8_STAGE(PG8_SB(1, 1), b3 + hstep, voffB); PG8_STAGE(PG8_SA(1, 0), a3, voffA);
            PG8_WAIT_V(8); PG8_WAIT_L(0); PG8_BAR; PG8_MMA(1, 0, At, B0); PG8_MMA(1, 1, At, B1); PG8_BAR; PG8_SCHED;
            } else {
            PG8_LDB(B0, 0, 0); PG8_SCHED; PG8_LDA(At, 0, 0); PG8_STAGE(PG8_SA(1, 1), a1 + hstep, voffA);
            PG8_WAIT_L(8); PG8_BAR; PG8_WAIT_L(0); PG8_MMA(0, 0, At, B0); PG8_BAR; PG8_SCHED;
            PG8_LDB(B1, 0, 1); PG8_STAGE(PG8_SB(0, 0), b2, voffB);
            PG8_BAR; PG8_WAIT_L(0); PG8_MMA(0, 1, At, B1); PG8_BAR;
            PG8_LDA(At, 0, 1); PG8_STAGE(PG8_SA(0, 0), a2, voffA);
            PG8_BAR; PG8_WAIT_L(0); PG8_MMA(1, 0, At, B0); PG8_BAR; PG8_SCHED;
            PG8_STAGE(PG8_SB(0, 1), b2 + hstep, voffB);
            PG8_WAIT_V(6); PG8_BAR; PG8_MMA(1, 1, At, B1); PG8_BAR;
            PG8_LDB(B0, 1, 0); PG8_SCHED; PG8_LDA(At, 1, 0); PG8_STAGE(PG8_SA(0, 1), a2 + hstep, voffA);
            PG8_WAIT_L(8); PG8_BAR; PG8_WAIT_L(0); PG8_MMA(0, 0, At, B0); PG8_BAR; PG8_SCHED;
            PG8_LDB(B1, 1, 1); PG8_STAGE(PG8_SB(1, 0), b3, voffB);
            PG8_BAR; PG8_WAIT_L(0); PG8_MMA(0, 1, At, B1); PG8_BAR;
            PG8_LDA(At, 1, 1); PG8_STAGE(PG8_SA(1, 0), a3, voffA);
            PG8_BAR; PG8_WAIT_L(0); PG8_MMA(1, 0, At, B0); PG8_BAR; PG8_SCHED;
            PG8_STAGE(PG8_SB(1, 1), b3 + hstep, voffB);
            PG8_WAIT_V(6); PG8_BAR; PG8_MMA(1, 1, At, B1); PG8_BAR;
            }
        }
        if constexpr (ALIGN_EPI) { if (wr == 0) PG8_BAR; }
        if constexpr (!Epi::AFTER_DRAIN) { E(acc, cur, wr, wc, fr, fq); S.done(cur); }
        if (!has_next) break;
#pragma unroll
        for (int a = 0; a < 2; ++a)
#pragma unroll
            for (int b = 0; b < 2; ++b)
#pragma unroll
                for (int m = 0; m < 4; ++m)
#pragma unroll
                    for (int n = 0; n < 2; ++n) acc[a][b][m][n] = (f32x4){0.f, 0.f, 0.f, 0.f};
        cur = nxt; cA = nA; cB = nB; ++ui;
        if constexpr (ALIGN_EPI) { if (wr == 1) PG8_BAR; }
    }
    PG8_WAIT_V(0);
    if constexpr (!ALIGN_EPI) { if (wr == 0) PG8_BAR; }
    PG8_BAR;
    if constexpr (Epi::AFTER_DRAIN) { E.fused(acc, cur, wr, wc, fr, fq, lds, wid, lane); S.done(cur); }
#undef PG8_SA
#undef PG8_SB
#undef PG8_STAGE
#undef PG8_LDA
#undef PG8_LDB
#undef PG8_MMA
#undef PG8_WAIT_V
#undef PG8_WAIT_L
#undef PG8_BAR
#undef PG8_SCHED
}
}

namespace attn_body {
using bf16=__hip_bfloat16;
using bf16x8=__attribute__((ext_vector_type(8)))short;
using s16x4=__attribute__((ext_vector_type(4)))short;
using f32x16=__attribute__((ext_vector_type(16)))float;
using u32x4=__attribute__((ext_vector_type(4)))unsigned;
constexpr int D=64, QP=512, KP=128, OP=512;
constexpr int NW=8,QBLK=32,QB=QBLK*NW,KVBLK=64;
__device__ __forceinline__ int crow(int r,int hi){return (r&3)+8*(r>>2)+4*hi;}
#define SBAR() __builtin_amdgcn_sched_barrier(0)
#define ATTN_STORE16(p,v) (*(u32x4*)(p)=(v))
constexpr int NSLOT=3, SLOTB=8192;
constexpr int LDS_K=0, LDS_V=NSLOT*SLOTB, LDS_WS=2*NSLOT*SLOTB, LDS_OST=LDS_WS+NW*64*4, LDS_BYTES=LDS_OST+NW*4096;
constexpr float C2=0.125f*1.4426950408889634f;
__device__ __forceinline__ void glds16(const void*gsrc,unsigned lds_dst){unsigned keep;
  asm volatile("s_mov_b32 %0, m0\n\ts_mov_b32 m0, %2\n\ts_nop 0\n\tglobal_load_lds_dwordx4 %1, off\n\ts_mov_b32 m0, %0":"=&s"(keep):"v"(gsrc),"s"(lds_dst):"memory");}
__device__ __forceinline__ float max3f(float a,float b,float c){float r;asm("v_max3_f32 %0, %1, %2, %3":"=v"(r):"v"(a),"v"(b),"v"(c));return r;}
__device__ __forceinline__ float max2f(float a,float b){float r;asm("v_max_f32_e32 %0, %1, %2":"=v"(r):"v"(a),"v"(b));return r;}
__device__ __forceinline__ float fadd_s(float a,float b){float r;asm("v_add_f32_e32 %0, %1, %2":"=v"(r):"v"(a),"v"(b));return r;}
__device__ __forceinline__ float fsub_s(float a,float b){float r;asm("v_sub_f32_e32 %0, %1, %2":"=v"(r):"v"(a),"v"(b));return r;}
typedef float f32x2_t __attribute__((ext_vector_type(2))); typedef __bf16 bf16x2_t __attribute__((ext_vector_type(2)));
__device__ __forceinline__ unsigned cvtpk_s(float lo,float hi){f32x2_t v={lo,hi};bf16x2_t b=__builtin_convertvector(v,bf16x2_t);return __builtin_bit_cast(unsigned,b);}
#define WAIT_BAR(N) asm volatile("s_waitcnt vmcnt(" #N ") lgkmcnt(0)\n\ts_barrier":::"memory")

__device__ __forceinline__ void qkt(f32x16&p0,f32x16&p1,const char*Kslot,const bf16x8*qr,const f32x16&negm,int r32,int hi){
  const char*kb=Kslot+hi*1024+r32*16;
  #pragma unroll
  for(int d0=0;d0<4;++d0){
    const bf16x8 b0=*reinterpret_cast<const bf16x8*>(kb+d0*2048);
    const bf16x8 b1=*reinterpret_cast<const bf16x8*>(kb+d0*2048+512);
    if(d0==0){p0=__builtin_amdgcn_mfma_f32_32x32x16_bf16(b0,qr[0],negm,0,0,0);p1=__builtin_amdgcn_mfma_f32_32x32x16_bf16(b1,qr[0],negm,0,0,0);}
    else{p0=__builtin_amdgcn_mfma_f32_32x32x16_bf16(b0,qr[d0],p0,0,0,0);p1=__builtin_amdgcn_mfma_f32_32x32x16_bf16(b1,qr[d0],p1,0,0,0);}}
}
typedef __attribute__((address_space(3))) const char* lds_cptr;
typedef short v4i16_t __attribute__((ext_vector_type(4)));
__device__ __forceinline__ void kload8(bf16x8*kf,lds_cptr kp){
  kf[0]=*(const __attribute__((address_space(3))) bf16x8*)(kp);      kf[1]=*(const __attribute__((address_space(3))) bf16x8*)(kp+512);
  kf[2]=*(const __attribute__((address_space(3))) bf16x8*)(kp+2048); kf[3]=*(const __attribute__((address_space(3))) bf16x8*)(kp+2560);
  kf[4]=*(const __attribute__((address_space(3))) bf16x8*)(kp+4096); kf[5]=*(const __attribute__((address_space(3))) bf16x8*)(kp+4608);
  kf[6]=*(const __attribute__((address_space(3))) bf16x8*)(kp+6144); kf[7]=*(const __attribute__((address_space(3))) bf16x8*)(kp+6656);
}
__device__ __forceinline__ void kload2(bf16x8*kf,lds_cptr kp,int j){ kf[2*j]=*(const __attribute__((address_space(3))) bf16x8*)(kp+j*2048); kf[2*j+1]=*(const __attribute__((address_space(3))) bf16x8*)(kp+j*2048+512); }
__device__ __forceinline__ s16x4 vtr(lds_cptr p){ return __builtin_bit_cast(s16x4,__builtin_amdgcn_ds_read_tr16_b64_v4i16((__attribute__((address_space(3))) v4i16_t*)p)); }
__device__ __forceinline__ float rowmax(const f32x16&p0,const f32x16&p1){
  float a=max3f(p0[0],p0[1],p1[0]),b=max3f(p0[2],p0[3],p1[1]);a=max3f(a,p1[2],p1[3]);
  #pragma unroll
  for(int r=4;r<16;r+=4){a=max3f(a,p0[r],p0[r+1]);b=max3f(b,p0[r+2],p0[r+3]);a=max3f(a,p1[r],p1[r+1]);b=max3f(b,p1[r+2],p1[r+3]);}
  const float m=max2f(a,b);
  auto rr=__builtin_amdgcn_permlane32_swap(__float_as_uint(m),__float_as_uint(m),false,false);
  return max2f(__uint_as_float(rr[0]),__uint_as_float(rr[1]));
}
__device__ __forceinline__ void pv(f32x16*o,int vb,bf16x8 pa0,bf16x8 pa1,bf16x8 pa2,bf16x8 pa3){
  #pragma unroll
  for(int d0=0;d0<2;++d0){s16x4 lo[4],hi[4];
    #pragma unroll
    for(int ks=0;ks<4;++ks){
      asm volatile("ds_read_b64_tr_b16 %0,%1 offset:%c2":"=&v"(lo[ks]):"v"(vb),"i"(d0*4096+ks*1024):"memory");
      asm volatile("ds_read_b64_tr_b16 %0,%1 offset:%c2":"=&v"(hi[ks]):"v"(vb),"i"(d0*4096+ks*1024+512):"memory");}
    asm volatile("s_waitcnt lgkmcnt(0)":::"memory");SBAR();
    #define PK(k) (bf16x8){lo[k][0],lo[k][1],lo[k][2],lo[k][3],hi[k][0],hi[k][1],hi[k][2],hi[k][3]}
    o[d0]=__builtin_amdgcn_mfma_f32_32x32x16_bf16(pa0,PK(0),o[d0],0,0,0);
    o[d0]=__builtin_amdgcn_mfma_f32_32x32x16_bf16(pa1,PK(1),o[d0],0,0,0);
    o[d0]=__builtin_amdgcn_mfma_f32_32x32x16_bf16(pa2,PK(2),o[d0],0,0,0);
    o[d0]=__builtin_amdgcn_mfma_f32_32x32x16_bf16(pa3,PK(3),o[d0],0,0,0);
    #undef PK
  }
}
template<int THRL> __device__ __forceinline__ void attn_unit(const bf16*Qw0,const bf16*__restrict__ Kh,const bf16*__restrict__ Vh,bf16*Ow0,const int NT,char*shm){
  const int tid=opaque_tid(),lane=tid&63,r32=lane&31,hi=lane>>5; const int wid=__builtin_amdgcn_readfirstlane(tid>>6);
  const bf16*Qw=Qw0+(long)wid*QBLK*QP;
  const unsigned lds0=(unsigned)(uintptr_t)shm;
  float*wsf=(float*)(shm+LDS_WS)+wid*64;
  const bf16*ksrc=Kh+(long)lane*KP+wid*8;
  const bf16*vsrc=Vh+(long)(16*(wid&3)+(lane>>2))*KP+(wid>>2)*32+(lane&3)*8;
  const unsigned kdst=lds0+LDS_K+wid*1024, vdst=lds0+LDS_V+wid*1024;
  #define DMA_K(t,slot) glds16(ksrc+(long)(t)*KVBLK*KP,(unsigned)__builtin_amdgcn_readfirstlane(kdst+(slot)))
  #define DMA_V(t,slot) glds16(vsrc+(long)(t)*KVBLK*KP,(unsigned)__builtin_amdgcn_readfirstlane(vdst+(slot)))
  const int vb0=(int)(lds0+LDS_V)+((lane>>4)&1)*32+(lane&3)*8+(4*hi+((lane&15)>>2))*64;
  const char*Kbase=shm+LDS_K; bf16x8 kf[8];
  const lds_cptr shm3=(lds_cptr)shm; const lds_cptr kp0=shm3+LDS_K+hi*1024+r32*16; const lds_cptr vp0=shm3+LDS_V+((lane>>4)&1)*32+(lane&3)*8+(4*hi+((lane&15)>>2))*64;
  DMA_K(0,0);DMA_V(0,0);DMA_K(1,SLOTB);
  bf16x8 qr[4];
  #pragma unroll
  for(int d0=0;d0<4;++d0)qr[d0]=*reinterpret_cast<const bf16x8*>(&Qw[(long)r32*QP+d0*16+hi*8]);
  float mhat=0.f,l_reg=0.f;f32x16 o[2];o[0]=f32x16{};o[1]=f32x16{};f32x16 negm=f32x16{};asm volatile("":"+v"(negm));
  #define CMASK(P0,P1,t) do{}while(0)
  bool resc=false;
  #define START(P0,P1) do{ const float rm=rowmax(P0,P1); resc=false; \
    { const float dl=rm; mhat=fadd_s(mhat,dl); \
      _Pragma("unroll") for(int r=0;r<16;++r){P0[r]=fsub_s(P0[r],dl);P1[r]=fsub_s(P1[r],dl);} \
      _Pragma("unroll") for(int r=0;r<16;++r)negm[r]=-mhat; asm volatile("":"+v"(negm)); } \
    _Pragma("unroll") for(int r=0;r<16;++r)P0[r]=__builtin_amdgcn_exp2f(P0[r]); }while(0)
  #define RESC() do{ if(resc){ asm volatile("s_waitcnt lgkmcnt(0)":::"memory"); \
      _Pragma("unroll") for(int d_=0;d_<2;++d_) _Pragma("unroll") for(int r=0;r<16;++r)o[d_][r]*=wsf[crow(r,hi)]; } }while(0)
  f32x16 pA0,pA1,pB0,pB1;
  int sl_prev=0,sl_cur=0,sl_next=SLOTB;
  #define ROT() do{sl_prev=sl_cur;sl_cur=sl_next;sl_next=(sl_next==(NSLOT-1)*SLOTB)?0:sl_next+SLOTB;}while(0)
  DMA_K(2,2*SLOTB);
  WAIT_BAR(3);
  qkt(pA0,pA1,Kbase,qr,negm,r32,hi);asm volatile("s_nop 15\n\ts_nop 7":"+v"(pA0),"+v"(pA1));CMASK(pA0,pA1,0);
  START(pA0,pA1);
  _Pragma("unroll") for(int r=0;r<16;++r)pA1[r]=__builtin_amdgcn_exp2f(pA1[r]);
  WAIT_BAR(0);
  DMA_K(3,0);DMA_V(1,SLOTB);
  ROT();
  kload8(kf,kp0+sl_cur);
  WAIT_BAR(2);
  s16x4 vlo[8],vhi[8]; u32x4 pw0,pw1,pw2,pw3;
  #define PKW(P,B) cvtpk_s(P[B],P[B+1])
  #define PAF(k) __builtin_bit_cast(bf16x8,pw##k)
  #define VFR(i) (bf16x8){vlo[i][0],vlo[i][1],vlo[i][2],vlo[i][3],vhi[i][0],vhi[i][1],vhi[i][2],vhi[i][3]}
  #define PIN(x) asm volatile("":"+v"(x))
  #define MX3(a,b,c) __builtin_fmaxf(__builtin_fmaxf((a),(b)),(c))
  #define GAPA(MF,A0,A1,A2,A3,W0,W1,PW) do{ MF; sacc+=A0; sacc+=A1; sacc+=A2; sacc+=A3; PIN(sacc); W0; W1; PIN(PW); SBAR(); }while(0)
  #define EX(v) __builtin_amdgcn_exp2f(v)
  #define GAPB(MF,X,B) do{ MF; X[B]=EX(X[B]); X[B+1]=EX(X[B+1]); X[B+2]=EX(X[B+2]); X[B+3]=EX(X[B+3]); PIN(X); SBAR(); }while(0)
  #define VRD(i) do{ vlo[i]=vtr(vp_+(((i)>>2)*4096+((i)&3)*1024)); vhi[i]=vtr(vp_+(((i)>>2)*4096+((i)&3)*1024+512)); }while(0)
  #define KRD(G,j) do{ if(G){ kload2(kf,kp0+sl_next,j); SBAR(); } }while(0)
  #define STEP(C0,C1,P0,P1,t,GK,GV,GL) do{ SBAR(); \
    const lds_cptr vp_=vp0+sl_prev; \
    VRD(0); SBAR(); float sacc=(P0[0]+P0[1]); \
    GAPA(C0=__builtin_amdgcn_mfma_f32_32x32x16_bf16(kf[0],qr[0],negm,0,0,0), P0[2],P0[3],P0[4],P0[5],     pw0[0]=PKW(P0,0), pw0[1]=PKW(P0,2), pw0); \
    VRD(4); SBAR(); GAPA(C1=__builtin_amdgcn_mfma_f32_32x32x16_bf16(kf[1],qr[0],negm,0,0,0), P0[6],P0[7],P0[8],P0[9],     pw0[2]=PKW(P0,4), pw0[3]=PKW(P0,6), pw0); \
    VRD(1); SBAR(); GAPA(C0=__builtin_amdgcn_mfma_f32_32x32x16_bf16(kf[2],qr[1],C0,0,0,0),   P0[10],P0[11],P0[12],P0[13], pw1[0]=PKW(P0,8), pw1[1]=PKW(P0,10), pw1); \
    VRD(5); SBAR(); GAPA(C1=__builtin_amdgcn_mfma_f32_32x32x16_bf16(kf[3],qr[1],C1,0,0,0),   P0[14],P0[15],P1[0],P1[1],   pw1[2]=PKW(P0,12),pw1[3]=PKW(P0,14), pw1); \
    VRD(2); SBAR(); GAPA(C0=__builtin_amdgcn_mfma_f32_32x32x16_bf16(kf[4],qr[2],C0,0,0,0),   P1[2],P1[3],P1[4],P1[5],     pw2[0]=PKW(P1,0), pw2[1]=PKW(P1,2), pw2); \
    VRD(6); SBAR(); GAPA(C1=__builtin_amdgcn_mfma_f32_32x32x16_bf16(kf[5],qr[2],C1,0,0,0),   P1[6],P1[7],P1[8],P1[9],     pw2[2]=PKW(P1,4), pw2[3]=PKW(P1,6), pw2); \
    VRD(3); SBAR(); GAPA(C0=__builtin_amdgcn_mfma_f32_32x32x16_bf16(kf[6],qr[3],C0,0,0,0),   P1[10],P1[11],P1[12],P1[13], pw3[0]=PKW(P1,8), pw3[1]=PKW(P1,10), pw3); \
    VRD(7); SBAR(); GAPA(C1=__builtin_amdgcn_mfma_f32_32x32x16_bf16(kf[7],qr[3],C1,0,0,0),   P1[14],P1[15],0.f,0.f,       pw3[2]=PKW(P1,12),pw3[3]=PKW(P1,14), pw3); \
    l_reg+=sacc; \
    if(GK){DMA_K((t)+3,sl_cur);} if(GV){DMA_V((t)+1,sl_next);} \
    CMASK(C0,C1,t); \
    { float a=MX3(C0[0],C0[1],C1[0]),b=MX3(C0[2],C0[3],C1[1]); a=MX3(a,C1[2],C1[3]); \
      _Pragma("unroll") for(int r=4;r<16;r+=4){a=MX3(a,C0[r],C0[r+1]);b=MX3(b,C0[r+2],C0[r+3]);a=MX3(a,C1[r],C1[r+1]);b=MX3(b,C1[r+2],C1[r+3]);} \
      float rm=__builtin_fmaxf(a,b); { auto rr=__builtin_amdgcn_permlane32_swap(__float_as_uint(rm),__float_as_uint(rm),false,false); rm=__builtin_fmaxf(__uint_as_float(rr[0]),__uint_as_float(rr[1])); } \
      resc=false; \
      if(__builtin_expect(__any(rm>(float)THRL),0)){ const float dl=__builtin_fmaxf(rm,0.f); mhat+=dl; \
        _Pragma("unroll") for(int r=0;r<16;++r){C0[r]-=dl;C1[r]-=dl;} \
        _Pragma("unroll") for(int r=0;r<16;++r)negm[r]=-mhat; asm volatile("":"+v"(negm)); \
        const float f=__builtin_amdgcn_exp2f(-dl); l_reg*=f; if(hi==0)wsf[r32]=f; resc=true; } } \
    SBAR(); \
    GAPB(o[0]=__builtin_amdgcn_mfma_f32_32x32x16_bf16(PAF(0),VFR(0),o[0],0,0,0), C0,0); \
    GAPB(o[1]=__builtin_amdgcn_mfma_f32_32x32x16_bf16(PAF(0),VFR(4),o[1],0,0,0), C0,4); \
    KRD(GL,0); GAPB(o[0]=__builtin_amdgcn_mfma_f32_32x32x16_bf16(PAF(1),VFR(1),o[0],0,0,0), C0,8); \
    KRD(GL,1); GAPB(o[1]=__builtin_amdgcn_mfma_f32_32x32x16_bf16(PAF(1),VFR(5),o[1],0,0,0), C0,12); \
    KRD(GL,2); GAPB(o[0]=__builtin_amdgcn_mfma_f32_32x32x16_bf16(PAF(2),VFR(2),o[0],0,0,0), C1,0); \
    KRD(GL,3); GAPB(o[1]=__builtin_amdgcn_mfma_f32_32x32x16_bf16(PAF(2),VFR(6),o[1],0,0,0), C1,4); \
    GAPB(o[0]=__builtin_amdgcn_mfma_f32_32x32x16_bf16(PAF(3),VFR(3),o[0],0,0,0), C1,8); \
    GAPB(o[1]=__builtin_amdgcn_mfma_f32_32x32x16_bf16(PAF(3),VFR(7),o[1],0,0,0), C1,12); \
    }while(0)
  int t=1;
  #undef CMASK
  #define CMASK(P0,P1,t) do{}while(0)
  for(;t+5<NT;t+=2){
    STEP(pB0,pB1,pA0,pA1,t,true,true,true);     WAIT_BAR(2); RESC(); ROT();
    STEP(pA0,pA1,pB0,pB1,t+1,true,true,true);   WAIT_BAR(2); RESC(); ROT();
  }
  #undef CMASK
  #define CMASK(P0,P1,t) do{}while(0)
  #define ENDW(tt) do{ if((tt)+3<NT){WAIT_BAR(2);} else if((tt)+2<NT){WAIT_BAR(1);} else {WAIT_BAR(0);} }while(0)
  for(;t+1<NT;t+=2){
    STEP(pB0,pB1,pA0,pA1,t,(t+3<NT),(t+1<NT),(t+1<NT));       ENDW(t);   RESC(); ROT();
    STEP(pA0,pA1,pB0,pB1,t+1,(t+4<NT),(t+2<NT),(t+2<NT));     ENDW(t+1); RESC(); ROT();
  }
  STEP(pB0,pB1,pA0,pA1,NT-1,false,false,false); RESC();
  { float sacc=pB0[0]+pB0[1]; _Pragma("unroll") for(int r=2;r<16;++r)sacc+=pB0[r]; _Pragma("unroll") for(int r=0;r<16;++r)sacc+=pB1[r]; l_reg+=sacc;
    pw0=(u32x4){PKW(pB0,0),PKW(pB0,2),PKW(pB0,4),PKW(pB0,6)};pw1=(u32x4){PKW(pB0,8),PKW(pB0,10),PKW(pB0,12),PKW(pB0,14)};pw2=(u32x4){PKW(pB1,0),PKW(pB1,2),PKW(pB1,4),PKW(pB1,6)};pw3=(u32x4){PKW(pB1,8),PKW(pB1,10),PKW(pB1,12),PKW(pB1,14)};
    SBAR(); pv(o,vb0+sl_cur,PAF(0),PAF(1),PAF(2),PAF(3)); }
  #undef PKW
  #undef PAF
  #undef VFR
  #undef PIN
  #undef MX3
  #undef GAPA
  #undef GAPB
  #undef EX
  #undef VRD
  #undef KRD
  #undef STEP
  #undef ENDW
  {auto rr=__builtin_amdgcn_permlane32_swap(__float_as_uint(l_reg),__float_as_uint(l_reg),false,false);l_reg=__uint_as_float(rr[0])+__uint_as_float(rr[1]);}
  if(hi==0)wsf[32+r32]=l_reg;asm volatile("s_waitcnt lgkmcnt(0)":::"memory");
  float rli[16];
  #pragma unroll
  for(int r=0;r<16;++r)rli[r]=__builtin_amdgcn_rcpf(wsf[32+crow(r,hi)]);
  bf16*Ow=Ow0+(long)wid*QBLK*OP;
  { bf16*stg=(bf16*)(shm+LDS_OST)+wid*2048;
    #pragma unroll
    for(int r=0;r<16;++r){const int orow=crow(r,hi);
      #pragma unroll
      for(int d0=0;d0<2;++d0)stg[orow*64+d0*32+r32]=__float2bfloat16(o[d0][r]*rli[r]);}
    asm volatile("s_waitcnt lgkmcnt(0)":::"memory");
    #pragma unroll
    for(int i=0;i<4;++i){const int row=i*8+(lane>>3),ch=lane&7; const u32x4 v=*(const u32x4*)(stg+row*64+ch*8); ATTN_STORE16(Ow+(long)row*OP+ch*8,v);} }
  asm volatile("s_waitcnt lgkmcnt(0)\n\ts_barrier":::"memory");
  #undef DMA_K
  #undef DMA_V
  #undef CMASK
  #undef START
  #undef RESC
  #undef ROT
}

#undef SBAR
#undef WAIT_BAR
}

typedef short bf16x8_t __attribute__((ext_vector_type(8)));
#define LDS_WAIT() asm volatile("s_waitcnt lgkmcnt(0)" ::: "memory")

__device__ __forceinline__ int inv32(int c) { return 16 * ((c >> 2) & 1) + 4 * (c >> 3) + (c & 3); }
__device__ __forceinline__ int dest_row(int type, int n) {
    if (type == 0) return n;
    if (type == 3) return (n & ~31) + inv32(n & 31);
    if (type == 1) { const int half = n >= DFF ? 1 : 0, j = n - half * DFF, pn = j >> 7, c = j & 127; return pn * 256 + half * 128 + (c & ~31) + inv32(c & 31); }
    if (n < 768) { const int hd = n >> 6, d = n & 63, a = d >> 5, t = (d >> 4) & 1, p = d & 15; return (hd >> 2) * 256 + a * 128 + (hd & 3) * 32 + t * 16 + p; }
    const int pn = n >> 8, c = n & 255, half = c >> 7, c7 = c & 127; return pn * 256 + half * 128 + (c7 & ~31) + inv32(c7 & 31);
}
__device__ __forceinline__ void transpose_item(const float* W, int K, int N, bf16_t* WT, int type, LAS float* scr, int item, int lane) {
    const int nblk = N / 32, kb = item / nblk, nb = item % nblk, k0 = 64 * kb, n0 = 32 * nb;
#pragma unroll
    for (int h = 0; h < 2; ++h) { float wv[16];
#pragma unroll
        for (int i = 0; i < 16; ++i) wv[i] = W[(size_t)(k0 + 2 * (16 * h + i) + (lane >> 5)) * N + n0 + (lane & 31)];
#pragma unroll
        for (int i = 0; i < 16; ++i) scr[(2 * (16 * h + i) + (lane >> 5)) * 33 + (lane & 31)] = wv[i]; }
    LDS_WAIT(); asm volatile("" ::: "memory");
    const int c = lane & 7;
#pragma unroll
    for (int j = 0; j < 4; ++j) { const int n = (lane >> 3) + 8 * j; const LAS float* s = scr + (8 * c) * 33 + n;
        u32x4 o; o.x = cvt_pk(s[0 * 33], s[1 * 33]); o.y = cvt_pk(s[2 * 33], s[3 * 33]); o.z = cvt_pk(s[4 * 33], s[5 * 33]); o.w = cvt_pk(s[6 * 33], s[7 * 33]);
        *(u32x4*)(WT + (size_t)dest_row(type, n0 + n) * K + k0 + 8 * c) = o; }
    LDS_WAIT(); asm volatile("" ::: "memory");
}

__device__ __forceinline__ void prologue_phase(const Params& P, LAS unsigned char* lds, int G) {
    const int tid = opaque_tid(), lane = tid & 63, wid = __builtin_amdgcn_readfirstlane(tid >> 6), bid = blockIdx.x;
    unsigned char* ws = P.ws;
    {
        LAS float* sc = (LAS float*)lds;
        LAS float* red = (LAS float*)(lds + 36864);
        for (int i = tid; i < 9 * 1024; i += NTHREADS) { const int v = i >> 10, k = i & 1023; const float cv = v < 8 ? P.in[1][v * 1024 + k] : P.in[3][k]; sc[i] = cv / (1.0f + expf(-cv)); }
        __syncthreads();
        float* mod = (float*)(ws + OFF_MOD);
        for (int item = bid; item < 2 * 144; item += G) {
            const int l = item / 144, cgp = item % 144, col = cgp * 64 + lane, kc = wid;
            const float* W = P.in[4] + (size_t)l * 1024 * MODW + col;
            float acc[9];
#pragma unroll
            for (int v = 0; v < 9; ++v) acc[v] = 0.f;
#pragma unroll 1
            for (int k0 = kc * 128; k0 < kc * 128 + 128; k0 += 16) { float wv[16];
#pragma unroll
                for (int q = 0; q < 16; ++q) wv[q] = W[(size_t)(k0 + q) * MODW];
#pragma unroll
                for (int q = 0; q < 16; ++q)
#pragma unroll
                    for (int v = 0; v < 9; ++v) acc[v] += sc[v * 1024 + k0 + q] * wv[q]; }
#pragma unroll
            for (int v = 0; v < 9; ++v) red[(kc * 9 + v) * 64 + lane] = acc[v];
            __syncthreads();
            for (int i = tid; i < 576; i += NTHREADS) { const int v = i >> 6, cc = i & 63; float s = 0.f;
#pragma unroll
                for (int q = 0; q < 8; ++q) s += red[(q * 9 + v) * 64 + cc];
                mod[(size_t)(l * 9 + v) * MODW + cgp * 64 + cc] = s + P.in[5][l * MODW + cgp * 64 + cc]; }
            __syncthreads();
        }
    }
    __syncthreads();
    {
        LAS float* scr = (LAS float*)(lds + wid * 16384);
        const int gw = bid * 8 + wid, NGW = G * 8;
        constexpr int I_FI = 16 * (NFF2 / 32), I_FO = (DFF / 64) * 32, I_WI = 16 * (INW / 32), I_WO = 16 * 32;
        constexpr int PER_L = 2 * I_FI + 2 * I_FO + I_WI + I_WO;
        for (int it = gw; it < DEPTH * PER_L; it += NGW) {
            const int l = it / PER_L; int r = it % PER_L;
            unsigned char* wb = ws + OFF_WB + (size_t)l * WB_LAYER;
            if (r < 2 * I_FI) { const int f = r / I_FI; transpose_item(P.in[7] + (size_t)(l * 2 + f) * DM * NFF2, DM, NFF2, (bf16_t*)(wb + WB_FFIN + f * WB_FFIN_SZ), 1, scr, r % I_FI, lane); continue; } r -= 2 * I_FI;
            if (r < 2 * I_FO) { const int f = r / I_FO; transpose_item(P.in[8] + (size_t)(l * 2 + f) * DFF * DM, DFF, DM, (bf16_t*)(wb + WB_FFOUT + f * WB_FFOUT_SZ), 3, scr, r % I_FO, lane); continue; } r -= 2 * I_FO;
            if (r < I_WI) { transpose_item(P.in[9] + (size_t)l * DM * INW, DM, INW, (bf16_t*)(wb + WB_WIN), 2, scr, r, lane); continue; } r -= I_WI;
            transpose_item(P.in[22] + (size_t)l * DM * DM, DM, DM, (bf16_t*)(wb + WB_WOUT), 3, scr, r, lane);
        }
        bf16_t* LW = (bf16_t*)(ws + OFF_LW);
        const int gt = bid * NTHREADS + tid, NGT = G * NTHREADS;
        for (int i = gt; i < DEPTH * 4 * 256 * 64; i += NGT) {
            const int d = i & 63, c = (i >> 6) & 255, g = (i >> 14) & 3, l = i >> 16, n = c >> 6, e = c & 63;
            const float* src = (g & 1) ? P.in[16] : P.in[14];
            const float v = src[((((size_t)l * 2 + (g >> 1)) * 4 + n) * 64 + d) * 64 + e];
            LW[i] = (bf16_t)(cvt_pk(v, 0.f) & 0xffffu);
        }
        float* rc = (float*)(ws + OFF_ROPE); float* rs = rc + 2048;
        for (int i = gt; i < 2048; i += NGT) { const int pos = i >> 4, p = i & 15; const float inv = powf(10000.0f, -(float)p / 16.0f), ang = (float)pos * inv; rc[i] = cosf(ang); rs[i] = sinf(ang); }
    }
}

__device__ __forceinline__ void norm_phase(const Params& P, int l, int idx, int row_lo, int row_hi, bool first, int wg0, int nwg) {
    const int tid = opaque_tid(), lane = tid & 63, wid = __builtin_amdgcn_readfirstlane(tid >> 6);
    if ((int)blockIdx.x < wg0 || (int)blockIdx.x >= wg0 + nwg) return;
    const int gw = ((int)blockIdx.x - wg0) * 8 + wid, NGW = nwg * 8, per = (row_hi - row_lo + NGW - 1) / NGW;
    const int r0 = row_lo + gw * per, r1 = (r0 + per < row_hi) ? r0 + per : row_hi;
    const float* mod = (const float*)(P.ws + OFF_MOD) + (size_t)l * 9 * MODW;
    const float* gsrc = P.in[6] + (size_t)(l * 3 + idx) * DM;
    const bf16_t* xres = (const bf16_t*)(P.ws + OFF_XRES); bf16_t* hb = (bf16_t*)(P.ws + OFF_HBUF);
    int curv = -1; f32x4 Aa[4], Bb[4];
    for (int row = r0; row < r1; ++row) {
        const int v = row < MLAT ? (row >> 13) : 8;
        if (v != curv) { curv = v;
#pragma unroll
            for (int j = 0; j < 4; ++j) { const int c = 4 * lane + 256 * j; const f32x4 g4 = *(const f32x4*)(gsrc + c), sh = *(const f32x4*)(mod + (size_t)v * MODW + (3 * idx) * DM + c), sc = *(const f32x4*)(mod + (size_t)v * MODW + (3 * idx + 1) * DM + c);
                Aa[j] = g4 * (sc + 1.0f); Bb[j] = sh; } }
        f32x4 x[4]; float ss = 0.f;
        if (first) { const float* xr = row < MLAT ? P.in[0] + (size_t)row * DM : P.in[2] + (size_t)(row - MLAT) * DM;
#pragma unroll
            for (int j = 0; j < 4; ++j) x[j] = *(const f32x4*)(xr + 4 * lane + 256 * j);
        } else {
#pragma unroll
            for (int j = 0; j < 4; ++j) { const u32x2 r = *(const u32x2*)(xres + (size_t)row * DM + 4 * lane + 256 * j); x[j] = (f32x4){bf_lo(r.x), bf_hi(r.x), bf_lo(r.y), bf_hi(r.y)}; }
        }
#pragma unroll
        for (int j = 0; j < 4; ++j) { ss += (x[j][0] * x[j][0] + x[j][1] * x[j][1]) + (x[j][2] * x[j][2] + x[j][3] * x[j][3]); }
        const float rstd = 1.0f / sqrtf(wave_sum(ss) * (1.0f / DM) + EPS);
#pragma unroll
        for (int j = 0; j < 4; ++j) { const f32x4 y = x[j] * rstd * Aa[j] + Bb[j]; u32x2 w; w.x = cvt_pk(y[0], y[1]); w.y = cvt_pk(y[2], y[3]);
            *(u32x2*)(hb + (size_t)row * DM + 4 * lane + 256 * j) = w;
 }
    }
}
__device__ __forceinline__ void final_norm_phase(const Params& P, int G) {
    const int tid = opaque_tid(), lane = tid & 63, wid = __builtin_amdgcn_readfirstlane(tid >> 6);
    const int gw = blockIdx.x * 8 + wid, NGW = G * 8;
    const bf16_t* xres = (const bf16_t*)(P.ws + OFF_XRES);
    f32x4 g4[4];
#pragma unroll
    for (int j = 0; j < 4; ++j) g4[j] = *(const f32x4*)(P.in[23] + 4 * lane + 256 * j);
    for (int row = gw; row < MLAT; row += NGW) {
        f32x4 x[4]; float ss = 0.f;
#pragma unroll
        for (int j = 0; j < 4; ++j) { const u32x2 r = *(const u32x2*)(xres + (size_t)row * DM + 4 * lane + 256 * j); x[j] = (f32x4){bf_lo(r.x), bf_hi(r.x), bf_lo(r.y), bf_hi(r.y)}; ss += (x[j][0] * x[j][0] + x[j][1] * x[j][1]) + (x[j][2] * x[j][2] + x[j][3] * x[j][3]); }
        const float rstd = 1.0f / sqrtf(wave_sum(ss) * (1.0f / DM) + EPS);
#pragma unroll
        for (int j = 0; j < 4; ++j) *(f32x4*)(P.out + (size_t)row * DM + 4 * lane + 256 * j) = x[j] * rstd * g4[j];
    }
}

constexpr int L1_AST = 528;
constexpr int L1_UST = 260;
constexpr int L1_UOFF = 66560;
__device__ __forceinline__ void lru1_phase(const Params& P, int l, LAS unsigned char* lds, int G) {
    const int tid = opaque_tid(), lane = tid & 63, wid = __builtin_amdgcn_readfirstlane(tid >> 6), fr = lane & 15, fq = lane >> 4;
    LAS unsigned char* ldsA = lds; LAS float* ldsU = (LAS float*)(lds + L1_UOFF);
    const bf16_t* Ubuf = (const bf16_t*)(P.ws + OFF_U5);
    float* Sg = (float*)(P.ws + OFF_S); unsigned* PPg = (unsigned*)(P.ws + OFF_PP); float* csum = (float*)(P.ws + OFF_CSUM);
    const bf16_t* LW = (const bf16_t*)(P.ws + OFF_LW) + (size_t)l * 4 * 256 * 64;
    const int ch4 = (tid & 63) * 4, pg = tid >> 6;
    f32x4 cw[4], cbias;
#pragma unroll
    for (int i = 0; i < 4; ++i) cw[i] = *(const f32x4*)(P.in[12] + (size_t)(l * 4 + i) * 256 + ch4);
    cbias = *(const f32x4*)(P.in[13] + (size_t)l * 256 + ch4);
    const int nblk = wid >> 1;
    for (int tile = blockIdx.x; tile < NBATCH * NCHUNK; tile += G) {
        const int b = tile / NCHUNK, cidx = tile % NCHUNK, P0 = cidx * 64; const bool latent = cidx >= 4;
        const int seg_lo = latent ? 256 : 0, seg_hi = latent ? KEYS : 256;
        const int rbase = latent ? b * SEQ - 256 : MLAT + b * CTXL;
        {
            const int pp0 = P0 + pg * 8;
            f32x4 win[11];
#pragma unroll
            for (int i = 0; i < 11; ++i) { const int Pq = pp0 - 2 + i; f32x4 w4 = {0.f, 0.f, 0.f, 0.f};
                if (Pq >= seg_lo && Pq < seg_hi) { const u32x2 raw = *(const u32x2*)(Ubuf + (size_t)(rbase + Pq) * 256 + ch4); w4 = (f32x4){bf_lo(raw.x), bf_hi(raw.x), bf_lo(raw.y), bf_hi(raw.y)}; }
                win[i] = w4; }
#pragma unroll
            for (int q = 0; q < 8; ++q) { f32x4 y = cbias;
#pragma unroll
                for (int i = 0; i < 4; ++i) y = y + cw[i] * win[q + i];
                const int pos = pg * 8 + q;
                u32x2 w; w.x = cvt_pk(y[0], y[1]); w.y = cvt_pk(y[2], y[3]);
                *(LAS u32x2*)(ldsA + pos * L1_AST + ch4 * 2) = w;
                *(LAS f32x4*)(ldsU + pos * L1_UST + ch4) = y; }
        }
        __syncthreads();
#pragma unroll 1
        for (int cc = 0; cc < 2; ++cc) {
            const int c = 32 * wid + 16 * cc + fr;
            const float baf = P.in[15][(l * 2 + 0) * 256 + c], bab = P.in[15][(l * 2 + 1) * 256 + c], bxf = P.in[17][(l * 2 + 0) * 256 + c], bxb = P.in[17][(l * 2 + 1) * 256 + c];
            const float nspf = -8.0f * log1pf(expf(-P.in[18][(l * 2 + 0) * 256 + c])), nspb = -8.0f * log1pf(expf(-P.in[18][(l * 2 + 1) * 256 + c]));
            f32x4 acc[4][4];
            {
                bf16x8_t bw[4][2];
#pragma unroll
                for (int g = 0; g < 4; ++g)
#pragma unroll
                    for (int kk = 0; kk < 2; ++kk) bw[g][kk] = *(const bf16x8_t*)(LW + ((size_t)(g * 256 + c) * 64 + kk * 32 + fq * 8));
#pragma unroll
                for (int m = 0; m < 4; ++m) {
#pragma unroll
                    for (int g = 0; g < 4; ++g) acc[m][g] = (f32x4){0.f, 0.f, 0.f, 0.f};
#pragma unroll
                    for (int kk = 0; kk < 2; ++kk) { const bf16x8_t a = *(const LAS bf16x8_t*)(ldsA + (16 * m + fr) * L1_AST + (64 * nblk + 32 * kk + 8 * fq) * 2);
#pragma unroll
                        for (int g = 0; g < 4; ++g) acc[m][g] = __builtin_amdgcn_mfma_f32_16x16x32_bf16(a, bw[g][kk], acc[m][g], 0, 0, 0); }
                }
            }
#pragma unroll
            for (int m = 0; m < 4; ++m)
#pragma unroll
                for (int j = 0; j < 4; ++j) {
                    const float u = ldsU[(16 * m + 4 * fq + j) * L1_UST + c];
                    {   const float r = sigmoidf_(acc[m][0][j] + baf), ig = sigmoidf_(acc[m][1][j] + bxf);
                        const float la = nspf * r, a = __expf(la), y = 2.0f * la;
                        const float em = (y > -0.1f) ? y * (1.0f + y * (0.5f + y * (0.16666667f + y * 0.041666668f))) : (__expf(y) - 1.0f);
                        acc[m][0][j] = a; acc[m][1][j] = sqrtf(-em) * ig * u; }
                    {   const float r = sigmoidf_(acc[m][2][j] + bab), ig = sigmoidf_(acc[m][3][j] + bxb);
                        const float la = nspb * r, a = __expf(la), y = 2.0f * la;
                        const float em = (y > -0.1f) ? y * (1.0f + y * (0.5f + y * (0.16666667f + y * 0.041666668f))) : (__expf(y) - 1.0f);
                        acc[m][2][j] = a; acc[m][3][j] = sqrtf(-em) * ig * u; }
                }
            f32x4 hf[4], pf[4];
            {
                float cA = 1.f, cH = 0.f;
#pragma unroll
                for (int m = 0; m < 4; ++m) {
                    const f32x4 a = acc[m][0], x = acc[m][1];
                    const float A0 = a[0], H0 = x[0], A1 = A0 * a[1], H1 = a[1] * H0 + x[1], A2 = A1 * a[2], H2 = a[2] * H1 + x[2], A3 = A2 * a[3], H3 = a[3] * H2 + x[3];
                    float TA = A3, TH = H3;
                    float tA = __shfl_up(TA, 16), tH = __shfl_up(TH, 16); if (fq >= 1) { TH = TA * tH + TH; TA = TA * tA; }
                    tA = __shfl_up(TA, 32); tH = __shfl_up(TH, 32); if (fq >= 2) { TH = TA * tH + TH; TA = TA * tA; }
                    float EA = __shfl_up(TA, 16), EH = __shfl_up(TH, 16); if (fq == 0) { EA = 1.f; EH = 0.f; }
                    const float inA = cA * EA, inH = EA * cH + EH;
                    pf[m] = (f32x4){inA * A0, inA * A1, inA * A2, inA * A3};
                    hf[m] = (f32x4){A0 * inH + H0, A1 * inH + H1, A2 * inH + H2, A3 * inH + H3};
                    const float gA = __shfl(TA, fr + 48), gH = __shfl(TH, fr + 48);
                    cH = gA * cH + gH; cA = cA * gA;
                }
                if (fq == 0) { float* cs = csum + ((size_t)(b * NCHUNK + cidx) * 2 + 0) * 512 + c; cs[0] = cA; cs[256] = cH; }
            }
            {
                float cA = 1.f, cH = 0.f;
#pragma unroll
                for (int mm = 0; mm < 4; ++mm) { const int m = 3 - mm;
                    const f32x4 a = acc[m][2], x = acc[m][3];
                    const float A3 = a[3], H3 = x[3], A2 = A3 * a[2], H2 = a[2] * H3 + x[2], A1 = A2 * a[1], H1 = a[1] * H2 + x[1], A0 = A1 * a[0], H0 = a[0] * H1 + x[0];
                    float TA = A0, TH = H0;
                    float tA = __shfl_down(TA, 16), tH = __shfl_down(TH, 16); if (fq <= 2) { TH = TA * tH + TH; TA = TA * tA; }
                    tA = __shfl_down(TA, 32); tH = __shfl_down(TH, 32); if (fq <= 1) { TH = TA * tH + TH; TA = TA * tA; }
                    float EA = __shfl_down(TA, 16), EH = __shfl_down(TH, 16); if (fq == 3) { EA = 1.f; EH = 0.f; }
                    const float inA = cA * EA, inH = EA * cH + EH;
                    const f32x4 pb = (f32x4){inA * A0, inA * A1, inA * A2, inA * A3};
                    const f32x4 hb = (f32x4){A0 * inH + H0, A1 * inH + H1, A2 * inH + H2, A3 * inH + H3};
#pragma unroll
                    for (int j = 0; j < 4; ++j) { const int tk = 16 * m + 4 * fq + j;
                        ldsU[tk * L1_UST + c] = hf[m][j] + hb[j];
                        PPg[(size_t)(rbase + P0 + tk) * 256 + c] = (cvt_pk(pf[m][j], 0.f) & 0xffffu) | (cvt_pk(0.f, pb[j]) & 0xffff0000u); }
                    const float gA = __shfl(TA, fr), gH = __shfl(TH, fr);
                    cH = gA * cH + gH; cA = cA * gA;
                }
                if (fq == 0) { float* cs = csum + ((size_t)(b * NCHUNK + cidx) * 2 + 1) * 512 + c; cs[0] = cA; cs[256] = cH; }
            }
        }
        __syncthreads();
#pragma unroll
        for (int it = 0; it < 8; ++it) { const int idx = it * NTHREADS + tid, r = idx >> 6, c16 = idx & 63; const size_t grow = (size_t)(rbase + P0 + r) * 256 + c16 * 4;
            *(f32x4*)(Sg + grow) = *(const LAS f32x4*)(ldsU + r * L1_UST + c16 * 4);
 }
        __syncthreads();
    }
}
__device__ __forceinline__ void lru2_batch(const Params& P, int b) {
    const int tid = opaque_tid(), dir = tid >> 8, c = tid & 255;
    const float* csum = (const float*)(P.ws + OFF_CSUM); float* carry = (float*)(P.ws + OFF_CARRY);
    float h = 0.f;
#pragma unroll 1
    for (int k0 = 0; k0 < NCHUNK; k0 += 33) {
        float A[33], H[33]; int ci[33];
#pragma unroll
        for (int q = 0; q < 33; ++q) { const int k = k0 + q; ci[q] = dir == 0 ? k : (k < 4 ? 3 - k : 135 - k);
            const float* cs = csum + ((size_t)(b * NCHUNK + ci[q]) * 2 + dir) * 512 + c; A[q] = cs[0]; H[q] = cs[256]; }
#pragma unroll
        for (int q = 0; q < 33; ++q) { carry[((size_t)(b * NCHUNK + ci[q]) * 2 + dir) * 256 + c] = h; h = A[q] * h + H[q]; }
    }
}
__device__ __forceinline__ float gelu_tanh(float x) { const float z = 0.7978845608f * (x + 0.044715f * x * x * x); const float t = 1.0f - 2.0f * __builtin_amdgcn_rcpf(1.0f + __expf(2.0f * z)); return 0.5f * x * (1.0f + t); }
__device__ __forceinline__ void merge_phase(const Params& P, int l, int Mrows, int G) {
    const int tid = opaque_tid(), lane = tid & 63, wid = __builtin_amdgcn_readfirstlane(tid >> 6);
    const int gw = blockIdx.x * 8 + wid, NGW = G * 8, c4 = 4 * lane;
    const bf16_t* U5 = (const bf16_t*)(P.ws + OFF_U5);
    const bf16_t *Gb = U5 + U5_STRIDE, *BGb = U5 + 2 * U5_STRIDE, *CGb = U5 + 3 * U5_STRIDE, *SSb = U5 + 4 * U5_STRIDE;
    const float* Sg = (const float*)(P.ws + OFF_S); const unsigned* PPg = (const unsigned*)(P.ws + OFF_PP); const float* carry = (const float*)(P.ws + OFF_CARRY);
    bf16_t* hb = (bf16_t*)(P.ws + OFF_HBUF); const bf16_t* att = (const bf16_t*)(P.ws + OFF_ATT);
    f32x4 w0 = *(const f32x4*)(P.in[19] + (size_t)(l * 3 + 0) * 256 + c4), w1 = *(const f32x4*)(P.in[19] + (size_t)(l * 3 + 1) * 256 + c4), w2 = *(const f32x4*)(P.in[19] + (size_t)(l * 3 + 2) * 256 + c4);
    f32x4 cb4 = *(const f32x4*)(P.in[20] + (size_t)l * 256 + c4);
    const float* gg = P.in[21] + (size_t)l * 1024;
    const f32x4 ga0 = *(const f32x4*)(gg + 8 * lane), ga1 = *(const f32x4*)(gg + 8 * lane + 4), gl = *(const f32x4*)(gg + 512 + c4), gs = *(const f32x4*)(gg + 768 + c4);
    const int per = (Mrows + NGW - 1) / NGW, r0 = gw * per, r1 = (r0 + per < Mrows) ? r0 + per : Mrows;
    int curc = -1; f32x4 cf = {0.f, 0.f, 0.f, 0.f}, cbk = {0.f, 0.f, 0.f, 0.f};
    f32x4 pm1, p0, pp1;
    auto prodrow = [&](int r) -> f32x4 { const size_t o = (size_t)r * 256 + c4; const u32x2 a = *(const u32x2*)(CGb + o), s2 = *(const u32x2*)(SSb + o);
        return (f32x4){bf_lo(a.x) * bf_lo(s2.x), bf_hi(a.x) * bf_hi(s2.x), bf_lo(a.y) * bf_lo(s2.y), bf_hi(a.y) * bf_hi(s2.y)}; };
    const f32x4 zero4 = {0.f, 0.f, 0.f, 0.f};
    if (r0 < r1) { const int sp = r0 < MLAT ? (r0 & 8191) : ((r0 - MLAT) & 255); pm1 = sp == 0 ? zero4 : prodrow(r0 - 1); p0 = prodrow(r0); }
    for (int row = r0; row < r1; ++row) {
        int b, cidx, sp, slen;
        if (row < MLAT) { b = row >> 13; sp = row & 8191; cidx = 4 + (sp >> 6); slen = SEQ; } else { const int rc = row - MLAT; b = rc >> 8; sp = rc & 255; cidx = sp >> 6; slen = CTXL; }
        const int ckey = b * NCHUNK + cidx;
        if (ckey != curc) { curc = ckey; cf = *(const f32x4*)(carry + ((size_t)ckey * 2 + 0) * 256 + c4); cbk = *(const f32x4*)(carry + ((size_t)ckey * 2 + 1) * 256 + c4); }
        if (sp == 0) { pm1 = zero4; if (row != r0) p0 = prodrow(row); }
        pp1 = (sp + 1 == slen) ? zero4 : prodrow(row + 1);
        {   const size_t o = (size_t)row * 256 + c4;
            const f32x4 S4 = *(const f32x4*)(Sg + o); const u32x4 pp = *(const u32x4*)(PPg + o);
            const u32x2 g2 = *(const u32x2*)(Gb + o), bg2 = *(const u32x2*)(BGb + o);
            const u32x4 at = *(const u32x4*)(att + (size_t)row * 512 + 8 * lane);
            f32x4 hv;
#pragma unroll
            for (int j = 0; j < 4; ++j) hv[j] = S4[j] + bf_lo(pp[j]) * cf[j] + bf_hi(pp[j]) * cbk[j];
            const f32x4 g4 = (f32x4){bf_lo(g2.x), bf_hi(g2.x), bf_lo(g2.y), bf_hi(g2.y)}, bg4 = (f32x4){bf_lo(bg2.x), bf_hi(bg2.x), bf_lo(bg2.y), bf_hi(bg2.y)};
            f32x4 lru, scv;
#pragma unroll
            for (int j = 0; j < 4; ++j) { lru[j] = hv[j] * gelu_tanh(g4[j]); scv[j] = bg4[j] * (w0[j] * pm1[j] + w1[j] * p0[j] + w2[j] * pp1[j] + cb4[j]); }
            float av[8];
#pragma unroll
            for (int j = 0; j < 4; ++j) { av[2 * j] = bf_lo(at[j]); av[2 * j + 1] = bf_hi(at[j]); }
            float ssa = 0.f, ssl = 0.f, sss = 0.f;
#pragma unroll
            for (int j = 0; j < 8; ++j) ssa += av[j] * av[j];
#pragma unroll
            for (int j = 0; j < 4; ++j) { ssl += lru[j] * lru[j]; sss += scv[j] * scv[j]; }
            ssa = wave_sum(ssa); ssl = wave_sum(ssl); sss = wave_sum(sss);
            const float ra = 1.0f / sqrtf(ssa * (1.0f / 512.0f) + EPS), rl = 1.0f / sqrtf(ssl * (1.0f / 256.0f) + EPS), rs = 1.0f / sqrtf(sss * (1.0f / 256.0f) + EPS);
            u32x4 wa; wa.x = cvt_pk(av[0] * ra * ga0[0], av[1] * ra * ga0[1]); wa.y = cvt_pk(av[2] * ra * ga0[2], av[3] * ra * ga0[3]); wa.z = cvt_pk(av[4] * ra * ga1[0], av[5] * ra * ga1[1]); wa.w = cvt_pk(av[6] * ra * ga1[2], av[7] * ra * ga1[3]);
            *(u32x4*)(hb + (size_t)row * DM + 8 * lane) = wa;
            u32x2 wl; wl.x = cvt_pk(lru[0] * rl * gl[0], lru[1] * rl * gl[1]); wl.y = cvt_pk(lru[2] * rl * gl[2], lru[3] * rl * gl[3]);
            *(u32x2*)(hb + (size_t)row * DM + 512 + c4) = wl;
            u32x2 wsv; wsv.x = cvt_pk(scv[0] * rs * gs[0], scv[1] * rs * gs[1]); wsv.y = cvt_pk(scv[2] * rs * gs[2], scv[3] * rs * gs[3]);
            *(u32x2*)(hb + (size_t)row * DM + 768 + c4) = wsv;
        }
        pm1 = p0; p0 = pp1;
    }
}
__device__ __forceinline__ void attention_phase(const Params& P, int l, char* lds, int G) {
    using abf = attn_body::bf16;
    const abf* Q = (const abf*)(P.ws + OFF_Q); const abf* K = (const abf*)(P.ws + OFF_K); const abf* V = (const abf*)(P.ws + OFF_V); abf* O = (abf*)(P.ws + OFF_ATT);
    if (blockIdx.x < NBATCH) lru2_batch(P, blockIdx.x);
    const int nunits = NBATCH * 8 * 32 + ((l + 1 < DEPTH) ? NBATCH * 8 : 0);
    for (int uid = blockIdx.x; uid < nunits; uid += G) {
        int b, h, NT; size_t qrow;
        if (uid < NBATCH * 8 * 32) { b = uid & 7; const int rest = uid >> 3, kvh = rest >> 7, u = rest & 127; h = kvh * 4 + (u >> 5); qrow = (size_t)b * SEQ + (u & 31) * 256; NT = NCHUNK; }
        else { const int v = uid - NBATCH * 8 * 32; b = v & 7; h = v >> 3; qrow = (size_t)MLAT + b * CTXL; NT = 4; }
        const size_t kvoff = (size_t)b * KEYS * 128 + (h >> 2) * 64;
        attn_body::attn_unit<8>(Q + qrow * 512 + h * 64, K + kvoff, V + kvoff, O + qrow * 512 + h * 64, NT, lds);
    }
}

#define XB_TMO      128
#define XB_XCNT(j)  (256  + 64 * (j))
#define XB_XSUB(j)  (1280 + 64 * (j))
#define XB_XGEN(j)  (2304 + 64 * (j))
#define XB_TOP      3328
#define XB_TOPGEN   3392
#define XCD_BAR_WORDS 3456
#define XB_SPIN_CAP (1u << 18)

__device__ __forceinline__ unsigned xb_ld(unsigned* p)              { return __hip_atomic_load(p, __ATOMIC_RELAXED, __HIP_MEMORY_SCOPE_AGENT); }
__device__ __forceinline__ unsigned xb_add(unsigned* p, unsigned v) { return __hip_atomic_fetch_add(p, v, __ATOMIC_RELAXED, __HIP_MEMORY_SCOPE_AGENT); }
__device__ __forceinline__ unsigned xb_xcc_id() { return (unsigned)__builtin_amdgcn_s_getreg((3 << 11) | 20) & 0xFu; }
#define XB_SPIN(cond, bar) do { unsigned _sp = 0; while (cond) { __builtin_amdgcn_s_sleep(1); \
    if ((++_sp & 255u) == 0u) { if (xb_ld(&(bar)[XB_TMO])) break; if (_sp > XB_SPIN_CAP) { atomicAdd(&(bar)[XB_TMO], 1u); break; } } } } while (0)

struct XcdBarrier {
    unsigned* bar; unsigned x;
    volatile LAS unsigned* st;
};

__device__ __forceinline__ XcdBarrier xcd_barrier_post(unsigned* bar, volatile LAS unsigned* st) {
    XcdBarrier b; b.bar = bar; b.x = xb_xcc_id(); b.st = st;
    if (threadIdx.x == 0) (void)xb_add(&bar[XB_XCNT(b.x)], 1u);
    return b;
}
__device__ __forceinline__ void xcd_barrier_complete(unsigned* bar, unsigned x, unsigned& nloc, unsigned& nx) {
    const unsigned G = gridDim.x * gridDim.y * gridDim.z;
    unsigned sum, cnt, mine, sp = 0u;
    for (;;) {
        sum = 0u; cnt = 0u; mine = 0u;
#pragma unroll
        for (unsigned j = 0; j < 16; ++j) { const unsigned c = xb_ld(&bar[XB_XCNT(j)]); sum += c; cnt += (c > 0u) ? 1u : 0u; mine = (j == x) ? c : mine; }
        if (sum == G) break;
        __builtin_amdgcn_s_sleep(1);
        if ((++sp & 255u) == 0u) { if (xb_ld(&bar[XB_TMO])) break; if (sp > XB_SPIN_CAP) { atomicAdd(&bar[XB_TMO], 1u); break; } }
    }
    nloc = mine > 0u ? mine : 1u; nx = cnt > 0u ? cnt : 1u;
}

__device__ __forceinline__ void xcd_barrier(const XcdBarrier& b) {
    asm volatile("s_waitcnt vmcnt(0)" ::: "memory");
    __syncthreads();
    if (threadIdx.x == 0) {
        unsigned* bar = b.bar; unsigned bx_ = b.x; asm volatile("" : "+s"(bx_));
        __builtin_amdgcn_s_waitcnt(0);
        unsigned nloc = b.st[0], nx = b.st[1];
        if (nloc == 0u) { xcd_barrier_complete(bar, bx_, nloc, nx); b.st[0] = nloc; b.st[1] = nx; }
        const unsigned old = xb_add(&bar[XB_XSUB(bx_)], 1u);
        const unsigned gen = old / nloc;
        if (old + 1u == (gen + 1u) * nloc) {
            __builtin_amdgcn_fence(__ATOMIC_RELEASE, "agent");
            asm volatile("s_waitcnt vmcnt(0)" ::: "memory");
            const unsigned og = xb_add(&bar[XB_TOP], 1u);
            const unsigned tg = og / nx;
            if (og + 1u == (tg + 1u) * nx) xb_add(&bar[XB_TOPGEN], 1u);
            else XB_SPIN(xb_ld(&bar[XB_TOPGEN]) == tg, bar);
            __builtin_amdgcn_fence(__ATOMIC_ACQUIRE, "agent");
            xb_add(&bar[XB_XGEN(bx_)], 1u);
            asm volatile("s_waitcnt vmcnt(0)" ::: "memory");
        } else {
            XB_SPIN(xb_ld(&bar[XB_XGEN(bx_)]) == gen, bar);
            __builtin_amdgcn_fence(__ATOMIC_ACQUIRE, "agent");
            asm volatile("s_waitcnt vmcnt(0)" ::: "memory");
        }
    }
    __syncthreads();
}

#ifndef PH_MASK
#define PH_MASK 0x1FF
#endif
__global__ void __launch_bounds__(NTHREADS, 2) fwd_megakernel(Params P) {
    extern __shared__ __attribute__((aligned(16))) unsigned char lds_raw[];
    LAS unsigned char* lds = (LAS unsigned char*)lds_raw;
    cg::grid_group grid = cg::this_grid();
    volatile LAS unsigned* bst = (volatile LAS unsigned*)(lds + LDS_BAR_OFF);
    if (threadIdx.x < 2) bst[threadIdx.x] = 0u;
    __syncthreads();
    const XcdBarrier xbar = xcd_barrier_post((unsigned*)(P.ws + OFF_CTL), bst);
#define GRID_SYNC() xcd_barrier(xbar)
    const int G = gridDim.x;
    unsigned char* ws = P.ws;
    if constexpr (PH_MASK & 1) prologue_phase(P, lds, G);
    grid.sync();
    if constexpr (PH_MASK & 2) norm_phase(P, 0, 0, 0, MTOT, true, 0, G);
    GRID_SYNC();
    for (int step = 0; step < DEPTH * 3; ++step) {
        const int l = step / 3, s3 = step % 3;
        const bool last = (l == DEPTH - 1);
        const int Mn = (last && s3 == 2) ? MLAT : MTOT;
        unsigned char* wb = ws + OFF_WB + (size_t)l * WB_LAYER;
        pg8::Gemm gr; pg8::EpiResid er; int Mr;
        const float* modl = (const float*)(ws + OFF_MOD) + (size_t)l * 9 * MODW;
        if (s3 != 1) {
            const int f = s3 >> 1;
            { pg8::Gemm g{(const bf16_t*)(ws + OFF_HBUF), (const bf16_t*)(wb + WB_FFIN + f * WB_FFIN_SZ), Mn, NFF2, DM};
              pg8::StaticOrder S; S.init(Mn, NFF2, G, (int)blockIdx.x);
              pg8::EpiSwiglu E{(bf16_t*)(ws + OFF_MID)};
              if constexpr (PH_MASK & 4) pg8::gemm_phase<pg8::EpiSwiglu, pg8::StaticOrder, true, true>(lds, g, S, E); }
            GRID_SYNC();
            Mr = Mn;
            gr = pg8::Gemm{(const bf16_t*)(ws + OFF_MID), (const bf16_t*)(wb + WB_FFOUT + f * WB_FFOUT_SZ), Mr, DM, DFF};
            er = pg8::EpiResid{(bf16_t*)(ws + OFF_XRES), P.in[0], P.in[2], modl + (3 * s3 + 2) * DM, 0.5f, step == 0 ? 1 : 0};
        } else {
            { LAS float* tab = (LAS float*)(lds + LDS_TAB_OFF);
              for (int i = opaque_tid(); i < 4096 + 128; i += NTHREADS) tab[i] = i < 4096 ? ((const float*)(ws + OFF_ROPE))[i] : (i < 4160 ? P.in[10][l * 64 + i - 4096] : P.in[11][l * 64 + i - 4160]);
              __syncthreads(); }
            { pg8::Gemm g{(const bf16_t*)(ws + OFF_HBUF), (const bf16_t*)(wb + WB_WIN), MTOT, INW, DM};
              pg8::StaticOrder S; S.init(MTOT, INW, G, (int)blockIdx.x);
              pg8::EpiWin E{(bf16_t*)(ws + OFF_Q), (bf16_t*)(ws + OFF_K), (bf16_t*)(ws + OFF_V), (bf16_t*)(ws + OFF_U5), (const LAS float*)(lds + LDS_TAB_OFF), 0.125f * 1.4426950408889634f};
              if constexpr (PH_MASK & 8) pg8::gemm_phase<pg8::EpiWin, pg8::StaticOrder, true, true>(lds, g, S, E); }
            GRID_SYNC();
            if constexpr (PH_MASK & 16) lru1_phase(P, l, lds, G);
            GRID_SYNC();
            if constexpr (PH_MASK & 32) attention_phase(P, l, (char*)lds_raw, G);
            GRID_SYNC();
            Mr = last ? MLAT : MTOT;
            if constexpr (PH_MASK & 64) merge_phase(P, l, Mr, G);
            GRID_SYNC();
            gr = pg8::Gemm{(const bf16_t*)(ws + OFF_HBUF), (const bf16_t*)(wb + WB_WOUT), Mr, DM, DM};
            er = pg8::EpiResid{(bf16_t*)(ws + OFF_XRES), P.in[0], P.in[2], modl + 5 * DM, 1.0f, 0};
        }
        const bool ctxr = (Mr == MTOT), has_next = step + 1 < DEPTH * 3;
        const int l2 = (step + 1) / 3, s32 = (step + 1) % 3, Mn2 = (l2 == DEPTH - 1 && s32 == 2) ? MLAT : MTOT;
        for (int pass = 0; pass < (ctxr ? 2 : 1); ++pass) {
            pg8::ResidOrder S; S.so.init(MLAT, DM, G, (int)blockIdx.x); S.single = pass; S.pm = 256 + ((int)blockIdx.x >> 2); S.pn = (int)blockIdx.x & 3;
            if (pass == 1 && (int)blockIdx.x >= 32) { if constexpr (PH_MASK & 2) norm_phase(P, l2, s32, 0, MLAT, false, 32, G - 32); }
            else { if constexpr (PH_MASK & 128) pg8::gemm_phase<pg8::EpiResid, pg8::ResidOrder, true, true>(lds, gr, S, er); }
            GRID_SYNC();
        }
        if (has_next) {
            if (ctxr) { if constexpr (PH_MASK & 2) norm_phase(P, l2, s32, MLAT, MTOT, false, 0, G); }
            else { if constexpr (PH_MASK & 2) norm_phase(P, l2, s32, 0, Mn2, false, 0, G); }
            GRID_SYNC();
        }
    }
    if constexpr (PH_MASK & 256) final_norm_phase(P, G);
}

extern "C" void kernel_launch(void* const* d_in, const int* in_sizes, int n_in, void* d_out, int out_size, void* d_ws, size_t ws_size, hipStream_t stream) {
    static int grid = 0;
    if (grid == 0) {
        if (n_in != 24 || out_size != MLAT * DM || ws_size < WS_NEED) { fprintf(stderr, "kernel_launch: unexpected shapes (n_in %d, out %d, ws %zu, need %zu)\n", n_in, out_size, ws_size, (size_t)WS_NEED); grid = -1; return; }
        int dev = 0, cus = 0, per_cu = 0;
        hipGetDevice(&dev); hipDeviceGetAttribute(&cus, hipDeviceAttributeMultiprocessorCount, dev);
        if (hipFuncSetAttribute((const void*)fwd_megakernel, hipFuncAttributeMaxDynamicSharedMemorySize, LDS_BYTES) != hipSuccess) { fprintf(stderr, "kernel_launch: hipFuncSetAttribute failed\n"); grid = -1; return; }
        if (hipOccupancyMaxActiveBlocksPerMultiprocessor(&per_cu, (const void*)fwd_megakernel, NTHREADS, LDS_BYTES) != hipSuccess || per_cu < 1) { fprintf(stderr, "kernel_launch: occupancy query says %d\n", per_cu); per_cu = 1; (void)hipGetLastError(); }
        grid = cus * 1;
        if (grid % 8 != 0 || grid <= 0) grid = 256;
        fprintf(stderr, "kernel_launch: grid %d (cus %d, per_cu %d)\n", grid, cus, per_cu);
    }
    if (grid < 0) return;
    Params p{};
    for (int i = 0; i < 24; ++i) p.in[i] = (const float*)d_in[i];
    p.out = (float*)d_out; p.ws = (unsigned char*)d_ws;
    if (hipMemsetAsync((unsigned char*)d_ws + OFF_CTL, 0, CTL_BYTES, stream) != hipSuccess) { fprintf(stderr, "kernel_launch: memset of the barrier words failed\n"); return; }
    void* args[] = {&p};
    hipError_t e = hipLaunchCooperativeKernel((const void*)fwd_megakernel, dim3(grid), dim3(NTHREADS), args, LDS_BYTES, stream);
    if (e != hipSuccess) fprintf(stderr, "kernel_launch: cooperative launch failed: %s (grid %d)\n", hipGetErrorString(e), grid);
}
```

```cpp
#include <hip/hip_runtime.h>
#include <hip/hip_bf16.h>
#include <hip/hip_cooperative_groups.h>
#include <cstdio>
#include <cstdint>
#include <cmath>
namespace cg = cooperative_groups;

constexpr int DM = 1024, NBATCH = 8, SEQ = 8192, CTXL = 256, DEPTH = 2;
constexpr int MLAT = NBATCH * SEQ, MCTX = NBATCH * CTXL, MTOT = MLAT + MCTX;
constexpr int DFF = 2816, NFF2 = 2 * DFF, INW = 2048, NMODV = 9, MODW = 9 * DM;
constexpr int KEYS = SEQ + CTXL, NCHUNK = KEYS / 64;
constexpr float EPS = 1e-6f;
constexpr int NTHREADS = 512;
constexpr int LDS_BYTES = 155648;
constexpr int LDS_TAB_OFF = 131072;

constexpr size_t MiB = 1u << 20;
constexpr size_t OFF_MOD = 0;
constexpr size_t OFF_ROPE = 1 * MiB;
constexpr size_t OFF_LW = 1 * MiB + 65536;
constexpr size_t OFF_CSUM = 2 * MiB;
constexpr size_t OFF_CARRY = 7 * MiB;
constexpr size_t OFF_CTL = 9 * MiB + 524288, CTL_BYTES = 65536;
constexpr int LDS_BAR_OFF = 155392;
constexpr size_t OFF_WB = 10 * MiB;
constexpr size_t WB_LAYER = 39 * MiB;
constexpr size_t WB_FFIN = 0, WB_FFIN_SZ = (size_t)NFF2 * DM * 2;
constexpr size_t WB_FFOUT = 2 * WB_FFIN_SZ, WB_FFOUT_SZ = (size_t)DM * DFF * 2;
constexpr size_t WB_WIN = WB_FFOUT + 2 * WB_FFOUT_SZ, WB_WIN_SZ = (size_t)INW * DM * 2;
constexpr size_t WB_WOUT = WB_WIN + WB_WIN_SZ;
static_assert(WB_WOUT + (size_t)DM * DM * 2 == WB_LAYER, "weight map");
constexpr size_t OFF_XRES = 88 * MiB;
constexpr size_t OFF_HBUF = 352 * MiB;
constexpr size_t OFF_R1 = 484 * MiB;
constexpr size_t OFF_MID = OFF_R1;
constexpr size_t OFF_Q = OFF_R1;
constexpr size_t OFF_K = OFF_R1 + 66 * MiB;
constexpr size_t OFF_V = OFF_K + 16 * MiB + 524288;
constexpr size_t OFF_U5 = OFF_R1 + 99 * MiB;
constexpr size_t U5_STRIDE = (size_t)MTOT * 256;
constexpr size_t OFF_S = OFF_R1 + 264 * MiB;
constexpr size_t OFF_PP = OFF_R1 + 330 * MiB;
constexpr size_t OFF_ATT = OFF_R1 + 396 * MiB;
constexpr size_t WS_NEED = OFF_ATT + 66 * MiB;

#define LAS __attribute__((address_space(3)))
typedef unsigned short bf16_t;
typedef float f32x4 __attribute__((ext_vector_type(4)));
typedef float f32x2 __attribute__((ext_vector_type(2)));
typedef unsigned u32x4 __attribute__((ext_vector_type(4)));
typedef unsigned u32x2 __attribute__((ext_vector_type(2)));

struct Params { const float* in[24]; float* out; unsigned char* ws; };

__device__ __forceinline__ unsigned cvt_pk(float lo, float hi) { unsigned r; asm volatile("v_cvt_pk_bf16_f32 %0, %1, %2" : "=v"(r) : "v"(lo), "v"(hi)); return r; }
__device__ __forceinline__ float bf_lo(unsigned w) { return __uint_as_float(w << 16); }
__device__ __forceinline__ float bf_hi(unsigned w) { return __uint_as_float(w & 0xffff0000u); }
__device__ __forceinline__ float wave_sum(float v) {
#pragma unroll
    for (int o = 1; o < 64; o <<= 1) v += __shfl_xor(v, o);
    return v;
}
__device__ __forceinline__ int opaque_tid() { int t = threadIdx.x; asm volatile("" : "+v"(t)); return t; }
__device__ __forceinline__ float sigmoidf_(float z) { return __builtin_amdgcn_rcpf(1.0f + __expf(-z)); }
namespace pg8 {
#define PG8_LAS __attribute__((address_space(3)))
typedef unsigned short bf16_t;
typedef short bf16x8 __attribute__((ext_vector_type(8)));
typedef float f32x4 __attribute__((ext_vector_type(4)));
typedef unsigned u32x4 __attribute__((ext_vector_type(4)));
constexpr int BM = 256, BK = 64, HALF = 128, HTB = HALF * BK * 2  , STAGE_BYTES = 8 * HTB, NXCD = 8, WGM = 4;

__host__ __device__ __forceinline__ int lds_byte(int r, int c) { const int st = (r >> 4) * 2 + (c >> 5), rr = r & 15, cc = c & 31, ob = rr * 64 + cc * 2; return st * 1024 + (ob ^ (((ob >> 9) & 1) << 5)); }
__host__ __device__ __forceinline__ void stage_rc(int b, int& R, int& C) { const int st = b / 1024, sb = b % 1024, swz = sb ^ (((sb >> 9) & 1) << 5); R = (st >> 1) * 16 + swz / 64; C = (st & 1) * 32 + (swz % 64) / 2; }
__host__ __device__ __forceinline__ int perm32(int rho) { const int n = rho >> 4, i = rho & 15; return 8 * (i >> 2) + 4 * n + (i & 3); }

struct Unit { int pm, pn; };
struct Gemm { const bf16_t* A; const bf16_t* Bt; int M, N, K; };

struct StaticOrder {
    int nM, nN, nwg, G, c;
    __host__ __device__ void init(int M, int N, int G_, int c_) { nM = M / BM; nN = N / BM; nwg = nM * nN; G = G_; c = c_; }
    __host__ __device__ bool next(int i, Unit& u) const {
        const long L = (long)i * G + c; if (L >= nwg) return false;
        int wgid = (int)L; { const int q = nwg / NXCD, r = nwg % NXCD, xcd = wgid % NXCD, off = wgid / NXCD; wgid = (xcd < r ? xcd * (q + 1) : r * (q + 1) + (xcd - r) * q) + off; }
        const int nig = WGM * nN, gid = wgid / nig, fm = gid * WGM, gsz = (nM - fm) < WGM ? (nM - fm) : WGM;
        u.pm = fm + ((wgid % nig) % gsz); u.pn = (wgid % nig) / gsz; return true;
    }
    __device__ __forceinline__ void a_ready(const Unit&) const {}
    __device__ __forceinline__ void done(const Unit&) const {}
};
__device__ __forceinline__ unsigned cvt_pk_bf16(float lo, float hi) { unsigned r; asm volatile("v_cvt_pk_bf16_f32 %0, %1, %2" : "=v"(r) : "v"(lo), "v"(hi)); return r; }

struct EpiSwiglu {
    static constexpr bool PERM = false, AFTER_DRAIN = false;
    bf16_t* O;
    __device__ __forceinline__ void operator()(const f32x4 (&acc)[2][2][4][2], const Unit& u, int wr, int wc, int fr, int fq) const {
        const int row0 = u.pm * BM + wr * 64 + fr, col0 = u.pn * 128 + wc * 32 + 8 * fq;
#pragma unroll
        for (int ai = 0; ai < 2; ++ai)
#pragma unroll
            for (int m = 0; m < 4; ++m) {
                bf16_t* rowp = O + (size_t)(row0 + ai * HALF + m * 16) * 2816 + col0;
                float v[8];
#pragma unroll
                for (int n = 0; n < 2; ++n)
#pragma unroll
                    for (int j = 0; j < 4; ++j) { const float g = acc[ai][0][m][n][j], up = acc[ai][1][m][n][j]; v[n * 4 + j] = g * __builtin_amdgcn_rcpf(1.0f + __expf(-g)) * up; }
                u32x4 w; w.x = cvt_pk_bf16(v[0], v[1]); w.y = cvt_pk_bf16(v[2], v[3]); w.z = cvt_pk_bf16(v[4], v[5]); w.w = cvt_pk_bf16(v[6], v[7]);
                *(u32x4*)rowp = w;
            }
    }
};
struct EpiResid {
    static constexpr bool PERM = false, AFTER_DRAIN = false;
    bf16_t* X; const float* Xlat; const float* Xctx; const float* gate; float scale; int first;
    __device__ __forceinline__ void operator()(const f32x4 (&acc)[2][2][4][2], const Unit& u, int wr, int wc, int fr, int fq) const {
        const int v = u.pm < 256 ? (u.pm >> 5) : 8;
        const int row0 = u.pm * BM + wr * 64 + fr, col0 = u.pn * BM + wc * 32 + 8 * fq;
        const float* gp = gate + (size_t)v * 9216 + col0;
        f32x4 gv[2][2];
#pragma unroll
        for (int bj = 0; bj < 2; ++bj)
#pragma unroll
            for (int n = 0; n < 2; ++n) gv[bj][n] = *(const f32x4*)(gp + bj * HALF + n * 4) * scale;
#pragma unroll
        for (int ai = 0; ai < 2; ++ai) {
            bf16_t* rowp = X + (size_t)(row0 + ai * HALF) * 1024 + col0;
            f32x4 xv[4][2][2];
            if (first) {
                const float* rowr = (u.pm < 256 ? Xlat + (size_t)(row0 + ai * HALF) * 1024 : Xctx + (size_t)(row0 + ai * HALF - 65536) * 1024) + col0;
#pragma unroll
                for (int m = 0; m < 4; ++m)
#pragma unroll
                    for (int bj = 0; bj < 2; ++bj)
#pragma unroll
                        for (int n = 0; n < 2; ++n) xv[m][bj][n] = *(const f32x4*)(rowr + (size_t)m * 16 * 1024 + bj * HALF + n * 4);
            } else {
                u32x4 raw[4][2];
#pragma unroll
                for (int m = 0; m < 4; ++m)
#pragma unroll
                    for (int bj = 0; bj < 2; ++bj) raw[m][bj] = *(const u32x4*)(rowp + (size_t)m * 16 * 1024 + bj * HALF);
#pragma unroll
                for (int m = 0; m < 4; ++m)
#pragma unroll
                    for (int bj = 0; bj < 2; ++bj) { const u32x4 r = raw[m][bj];
                        xv[m][bj][0] = (f32x4){__uint_as_float(r.x << 16), __uint_as_float(r.x & 0xffff0000u), __uint_as_float(r.y << 16), __uint_as_float(r.y & 0xffff0000u)};
                        xv[m][bj][1] = (f32x4){__uint_as_float(r.z << 16), __uint_as_float(r.z & 0xffff0000u), __uint_as_float(r.w << 16), __uint_as_float(r.w & 0xffff0000u)}; }
            }
#pragma unroll
            for (int m = 0; m < 4; ++m)
#pragma unroll
                for (int bj = 0; bj < 2; ++bj) { const f32x4 y0 = xv[m][bj][0] + gv[bj][0] * acc[ai][bj][m][0], y1 = xv[m][bj][1] + gv[bj][1] * acc[ai][bj][m][1];
                    u32x4 w; w.x = cvt_pk_bf16(y0[0], y0[1]); w.y = cvt_pk_bf16(y0[2], y0[3]); w.z = cvt_pk_bf16(y1[0], y1[1]); w.w = cvt_pk_bf16(y1[2], y1[3]);
                    *(u32x4*)(rowp + (size_t)m * 16 * 1024 + bj * HALF) = w; }
        }
    }
};
struct ResidOrder {
    StaticOrder so; int single, pm, pn;
    __device__ __forceinline__ bool next(int i, Unit& u) const { if (single) { if (i > 0) return false; u.pm = pm; u.pn = pn; return true; } return so.next(i, u); }
    __device__ __forceinline__ void a_ready(const Unit&) const {}
    __device__ __forceinline__ void done(const Unit&) const {}
};
struct EpiWin {
    static constexpr bool PERM = false, AFTER_DRAIN = false;
    bf16_t *Q, *K, *V, *U5; const PG8_LAS float* tab; float qscale;
    __device__ __forceinline__ void operator()(const f32x4 (&acc)[2][2][4][2], const Unit& u, int wr, int wc, int fr, int fq) const {
        const int row0 = u.pm * BM + wr * 64 + fr;
        if (u.pn >= 3) {
            bf16_t* base = U5 + (size_t)(u.pn - 3) * ((size_t)67584 * 256) + wc * 32 + 8 * fq;
#pragma unroll
            for (int ai = 0; ai < 2; ++ai)
#pragma unroll
                for (int m = 0; m < 4; ++m) { bf16_t* rowp = base + (size_t)(row0 + ai * HALF + m * 16) * 256;
#pragma unroll
                    for (int bj = 0; bj < 2; ++bj) { const f32x4 v0 = acc[ai][bj][m][0], v1 = acc[ai][bj][m][1];
                        u32x4 w; w.x = cvt_pk_bf16(v0[0], v0[1]); w.y = cvt_pk_bf16(v0[2], v0[3]); w.z = cvt_pk_bf16(v1[0], v1[1]); w.w = cvt_pk_bf16(v1[2], v1[3]);
                        *(u32x4*)(rowp + bj * HALF) = w; } }
            return;
        }
        const int kind = u.pn < 2 ? 0 : (wc < 2 ? 1 : 2);
        const bool latent = u.pm < 256;
        const PG8_LAS float* gsrc = tab + 4096 + (kind == 0 ? 0 : 64);
#pragma unroll
        for (int ai = 0; ai < 2; ++ai)
#pragma unroll
            for (int m = 0; m < 4; ++m) {
                const int row = row0 + ai * HALF + m * 16;
                f32x4 y[2][2];
#pragma unroll
                for (int bj = 0; bj < 2; ++bj)
#pragma unroll
                    for (int n = 0; n < 2; ++n) y[bj][n] = acc[ai][bj][m][n];
                if (kind != 2) {
                    float ss = 0.f;
#pragma unroll
                    for (int bj = 0; bj < 2; ++bj)
#pragma unroll
                        for (int n = 0; n < 2; ++n) { const f32x4 t = y[bj][n]; ss += (t[0] * t[0] + t[1] * t[1]) + (t[2] * t[2] + t[3] * t[3]); }
                    ss += __shfl_xor(ss, 16); ss += __shfl_xor(ss, 32);
                    const float r = 1.0f / sqrtf(ss * (1.0f / 64.0f) + 1e-6f);
#pragma unroll
                    for (int bj = 0; bj < 2; ++bj)
#pragma unroll
                        for (int n = 0; n < 2; ++n) y[bj][n] = y[bj][n] * r * *(const PG8_LAS f32x4*)(gsrc + 32 * bj + 16 * n + 4 * fq);
                    if (latent) {
                        const int s = row & 8191;
#pragma unroll
                        for (int bj = 0; bj < 2; ++bj) { const int pos = bj == 0 ? (s >> 6) : (s & 63);
                            const f32x4 c4 = *(const PG8_LAS f32x4*)(tab + pos * 16 + 4 * fq), s4 = *(const PG8_LAS f32x4*)(tab + 2048 + pos * 16 + 4 * fq);
                            const f32x4 x1 = y[bj][0], x2 = y[bj][1];
                            y[bj][0] = x1 * c4 - x2 * s4; y[bj][1] = x2 * c4 + x1 * s4; }
                    }
                }
                bf16_t* dst;
                if (kind == 0) { dst = Q + (size_t)row * 512 + (u.pn * 4 + wc) * 64;
#pragma unroll
                    for (int bj = 0; bj < 2; ++bj)
#pragma unroll
                        for (int n = 0; n < 2; ++n) y[bj][n] = y[bj][n] * qscale;
                } else {
                    size_t kr;
                    if (latent) kr = (size_t)(row >> 13) * 8448 + 256 + (row & 8191);
                    else { const int rc = row - 65536; kr = (size_t)(rc >> 8) * 8448 + (rc & 255); }
                    dst = (kind == 1 ? K : V) + kr * 128 + (wc & 1) * 64;
                }
                if (kind != 2) {
#pragma unroll
                    for (int bj = 0; bj < 2; ++bj) { u32x4 w; w.x = cvt_pk_bf16(y[bj][0][0], y[bj][0][1]); w.y = cvt_pk_bf16(y[bj][0][2], y[bj][0][3]); w.z = cvt_pk_bf16(y[bj][1][0], y[bj][1][1]); w.w = cvt_pk_bf16(y[bj][1][2], y[bj][1][3]);
                        *(u32x4*)(dst + 32 * bj + 8 * fq) = w; }
                } else {
#pragma unroll
                    for (int bj = 0; bj < 2; ++bj)
#pragma unroll
                        for (int n = 0; n < 2; ++n) { u32x2 w; w.x = cvt_pk_bf16(y[bj][n][0], y[bj][n][1]); w.y = cvt_pk_bf16(y[bj][n][2], y[bj][n][3]);
                            *(u32x2*)(dst + 32 * bj + 16 * n + 4 * fq) = w; }
                }
            }
    }
};
template <class Epi, class Sched, bool ALIGN_EPI = false, bool SP2 = false>
__device__ __forceinline__ void gemm_phase(PG8_LAS unsigned char* lds, const Gemm g, const Sched& S, const Epi& E) {
    const int tid = opaque_tid(), wid = __builtin_amdgcn_readfirstlane(tid >> 6), lane = tid & 63, wr = wid >> 2, wc = wid & 3, fr = lane & 15, fq = lane >> 4;
    const int K = g.K, nt = K / BK;
    unsigned voffA[2], voffB[2];
#pragma unroll
    for (int i = 0; i < 2; ++i) { int R, C; stage_rc(tid * 16 + i * 8192, R, C); const int Rb = Epi::PERM ? ((R & ~31) + perm32(R & 31)) : R;
        voffA[i] = (unsigned)(R * K + C) * 2u; voffB[i] = (unsigned)(Rb * K + C) * 2u; }
    const size_t kstep = (size_t)(BK * 2);
    const size_t hstep = (size_t)HALF * K * 2;
    const size_t tstep = 2 * hstep;
    const unsigned ldsw = (unsigned)wid * 1024u;
    const int aoff = lds_byte(wr * 64 + fr, fq * 8), boff = lds_byte(wc * 32 + fr, fq * 8);
#define PG8_SA(b, h) (((b) * 2 + (h)) * HTB)
#define PG8_SB(b, h) ((4 + (b) * 2 + (h)) * HTB)
#define PG8_STAGE(bufoff, gbase, voff) do { _Pragma("unroll") for (int _i = 0; _i < 2; ++_i) \
        __builtin_amdgcn_global_load_lds((const unsigned*)((const char*)(gbase) + (voff)[_i]), (PG8_LAS unsigned*)(lds + (bufoff) + ldsw + _i * 8192), 16, 0, 0); } while (0)
#define PG8_LDA(dst, b, h) do { _Pragma("unroll") for (int m = 0; m < 4; ++m) _Pragma("unroll") for (int k = 0; k < 2; ++k) dst[m][k] = *(const PG8_LAS bf16x8*)(lds + PG8_SA(b, h) + aoff + m * 2048 + k * 1024); } while (0)
#define PG8_LDB(dst, b, h) do { _Pragma("unroll") for (int n = 0; n < 2; ++n) _Pragma("unroll") for (int k = 0; k < 2; ++k) dst[n][k] = *(const PG8_LAS bf16x8*)(lds + PG8_SB(b, h) + boff + n * 2048 + k * 1024); } while (0)
#define PG8_MMA(ai, bj, At, Bt) do { __builtin_amdgcn_s_setprio(1); _Pragma("unroll") for (int m = 0; m < 4; ++m) _Pragma("unroll") for (int n = 0; n < 2; ++n) _Pragma("unroll") for (int k = 0; k < 2; ++k) \
        acc[ai][bj][m][n] = __builtin_amdgcn_mfma_f32_16x16x32_bf16(Bt[n][k], At[m][k], acc[ai][bj][m][n], 0, 0, 0); __builtin_amdgcn_s_setprio(0); } while (0)
#define PG8_WAIT_V(n) asm volatile("s_waitcnt vmcnt(" #n ")" ::: "memory")
#define PG8_WAIT_L(n) asm volatile("s_waitcnt lgkmcnt(" #n ")" ::: "memory")
#define PG8_BAR __builtin_amdgcn_s_barrier()
#define PG8_SCHED __builtin_amdgcn_sched_barrier(0)
    Unit cur, nxt; int ui = 0;
    if (!S.next(0, cur)) return;
    f32x4 acc[2][2][4][2];
#pragma unroll
    for (int a = 0; a < 2; ++a)
#pragma unroll
        for (int b = 0; b < 2; ++b)
#pragma unroll
            for (int m = 0; m < 4; ++m)
#pragma unroll
                for (int n = 0; n < 2; ++n) acc[a][b][m][n] = (f32x4){0.f, 0.f, 0.f, 0.f};
    bf16x8 At[4][2], B0[2][2], B1[2][2];
    const char* cA = (const char*)g.A + (size_t)cur.pm * tstep; const char* cB = (const char*)g.Bt + (size_t)cur.pn * tstep;
    S.a_ready(cur);
    if constexpr (SP2) {
        PG8_STAGE(PG8_SB(0, 0), cB, voffB); PG8_STAGE(PG8_SB(0, 1), cB + hstep, voffB); PG8_STAGE(PG8_SA(0, 0), cA, voffA); PG8_STAGE(PG8_SA(0, 1), cA + hstep, voffA);
        if (wr == 1) PG8_BAR;
        PG8_WAIT_V(2); PG8_BAR;
        PG8_STAGE(PG8_SB(1, 0), cB + kstep, voffB); PG8_STAGE(PG8_SA(1, 0), cA + kstep, voffA); PG8_STAGE(PG8_SB(1, 1), cB + hstep + kstep, voffB);
        PG8_WAIT_V(6); PG8_BAR;
    } else {
        PG8_STAGE(PG8_SB(0, 0), cB, voffB); PG8_STAGE(PG8_SA(0, 0), cA, voffA); PG8_STAGE(PG8_SB(0, 1), cB + hstep, voffB); PG8_STAGE(PG8_SA(0, 1), cA + hstep, voffA);
        if (wr == 1) PG8_BAR;
        PG8_WAIT_V(4); PG8_BAR;
        PG8_STAGE(PG8_SB(1, 0), cB + kstep, voffB); PG8_STAGE(PG8_SA(1, 0), cA + kstep, voffA); PG8_STAGE(PG8_SB(1, 1), cB + hstep + kstep, voffB);
        PG8_WAIT_V(6); PG8_BAR;
    }
    for (;;) {
        const bool has_next = S.next(ui + 1, nxt);
        const char* nA = has_next ? (const char*)g.A + (size_t)nxt.pm * tstep : cA; const char* nB = has_next ? (const char*)g.Bt + (size_t)nxt.pn * tstep : cB;
        for (int t = 0; t < nt; t += 2) {
            const bool last = (t == nt - 2);
            const char* a1 = cA + (size_t)(t + 1) * kstep;
            const char* a2 = last ? nA : cA + (size_t)(t + 2) * kstep; const char* b2 = last ? nB : cB + (size_t)(t + 2) * kstep;
            const char* a3 = a2 + kstep; const char* b3 = b2 + kstep;
            if (last && has_next) S.a_ready(nxt);
            if constexpr (SP2) {
            PG8_LDB(B0, 0, 0); PG8_LDB(B1, 0, 1); PG8_SCHED; PG8_LDA(At, 0, 0); PG8_STAGE(PG8_SA(1, 1), a1 + hstep, voffA);
            PG8_WAIT_V(8); PG8_WAIT_L(0); PG8_BAR; PG8_MMA(0, 0, At, B0); PG8_MMA(0, 1, At, B1); PG8_BAR; PG8_SCHED;
            PG8_LDA(At, 0, 1); PG8_STAGE(PG8_SB(0, 0), b2, voffB); PG8_STAGE(PG8_SB(0, 1), b2 + hstep, voffB); PG8_STAGE(PG8_SA(0, 0), a2, voffA);
            PG8_WAIT_V(8); PG8_WAIT_L(0); PG8_BAR; PG8_MMA(1, 0, At, B0); PG8_MMA(1, 1, At, B1); PG8_BAR; PG8_SCHED;
            PG8_LDB(B0, 1, 0); PG8_LDB(B1, 1, 1); PG8_SCHED; PG8_LDA(At, 1, 0); PG8_STAGE(PG8_SA(0, 1), a2 + hstep, voffA);
            PG8_WAIT_V(8); PG8_WAIT_L(0); PG8_BAR; PG8_MMA(0, 0, At, B0); PG8_MMA(0, 1, At, B1); PG8_BAR; PG8_SCHED;
            PG8_LDA(At, 1, 1); PG8_STAGE(PG8_SB(1, 0), b3, voffB); PG8_STAGE(PG8_SB(1, 1), b3 + hstep, voffB); PG8_STAGE(PG8_SA(1, 0), a3, voffA);
            PG8_WAIT_V(8); PG8_WAIT_L(0); PG8_BAR; PG8_MMA(1, 0, At, B0); PG8_MMA(1, 1, At, B1); PG8_BAR; PG8_SCHED;
            } else {
            PG8_LDB(B0, 0, 0); PG8_SCHED; PG8_LDA(At, 0, 0); PG8_STAGE(PG8_SA(1, 1), a1 + hstep, voffA);
            PG8_WAIT_L(8); PG8_BAR; PG8_WAIT_L(0); PG8_MMA(0, 0, At, B0); PG8_BAR; PG8_SCHED;
            PG8_LDB(B1, 0, 1); PG8_STAGE(PG8_SB(0, 0), b2, voffB);
            PG8_BAR; PG8_WAIT_L(0); PG8_MMA(0, 1, At, B1); PG8_BAR;
            PG8_LDA(At, 0, 1); PG8_STAGE(PG8_SA(0, 0), a2, voffA);
            PG8_BAR; PG8_WAIT_L(0); PG8_MMA(1, 0, At, B0); PG8_BAR; PG8_SCHED;
            PG8_STAGE(PG8_SB(0, 1), b2 + hstep, voffB);
            PG8_WAIT_V(6); PG8_BAR; PG8_MMA(1, 1, At, B1); PG8_BAR;
            PG8_LDB(B0, 1, 0); PG8_SCHED; PG8_LDA(At, 1, 0); PG8_STAGE(PG8_SA(0, 1), a2 + hstep, voffA);
            PG8_WAIT_L(8); PG8_BAR; PG8_WAIT_L(0); PG8_MMA(0, 0, At, B0); PG8_BAR; PG8_SCHED;
            PG8_LDB(B1, 1, 1); PG8_STAGE(PG8_SB(1, 0), b3, voffB);
            PG8_BAR; PG8_WAIT_L(0); PG8_MMA(0, 1, At, B1); PG8_BAR;
            PG8_LDA(At, 1, 1); PG8_STAGE(PG8_SA(1, 0), a3, voffA);
            PG8_BAR; PG8_WAIT_L(0); PG8_MMA(1, 0, At, B0); PG8_BAR; PG8_SCHED;
            PG8_STAGE(PG8_SB(1, 1), b3 + hstep, voffB);
            PG8_WAIT_V(6); PG8_BAR; PG8_MMA(1, 1, At, B1); PG8_BAR;
            }
        }
        if constexpr (ALIGN_EPI) { if (wr == 0) PG8_BAR; }
        if constexpr (!Epi::AFTER_DRAIN) { E(acc, cur, wr, wc, fr, fq); S.done(cur); }
        if (!has_next) break;
#pragma unroll
        for (int a = 0; a < 2; ++a)
#pragma unroll
            for (int b = 0; b < 2; ++b)
#pragma unroll
                for (int m = 0; m < 4; ++m)
#pragma unroll
                    for (int n = 0; n < 2; ++n) acc[a][b][m][n] = (f32x4){0.f, 0.f, 0.f, 0.f};
        cur = nxt; cA = nA; cB = nB; ++ui;
        if constexpr (ALIGN_EPI) { if (wr == 1) PG8_BAR; }
    }
    PG8_WAIT_V(0);
    if constexpr (!ALIGN_EPI) { if (wr == 0) PG8_BAR; }
    PG8_BAR;
    if constexpr (Epi::AFTER_DRAIN) { E.fused(acc, cur, wr, wc, fr, fq, lds, wid, lane); S.done(cur); }
#undef PG8_SA
#undef PG8_SB
#undef PG8_STAGE
#undef PG8_LDA
#undef PG8_LDB
#undef PG8_MMA
#undef PG8_WAIT_V
#undef PG8_WAIT_L
#undef PG8_BAR
#undef PG8_SCHED
}
}

namespace attn_body {
using bf16=__hip_bfloat16;
using bf16x8=__attribute__((ext_vector_type(8)))short;
using s16x4=__attribute__((ext_vector_type(4)))short;
using f32x16=__attribute__((ext_vector_type(16)))float;
using u32x4=__attribute__((ext_vector_type(4)))unsigned;
constexpr int D=64, QP=512, KP=128, OP=512;
constexpr int NW=8,QBLK=32,QB=QBLK*NW,KVBLK=64;
__device__ __forceinline__ int crow(int r,int hi){return (r&3)+8*(r>>2)+4*hi;}
#define SBAR() __builtin_amdgcn_sched_barrier(0)
#define ATTN_STORE16(p,v) (*(u32x4*)(p)=(v))
constexpr int NSLOT=3, SLOTB=8192;
constexpr int LDS_K=0, LDS_V=NSLOT*SLOTB, LDS_WS=2*NSLOT*SLOTB, LDS_OST=LDS_WS+NW*64*4, LDS_BYTES=LDS_OST+NW*4096;
constexpr float C2=0.125f*1.4426950408889634f;
__device__ __forceinline__ void glds16(const void*gsrc,unsigned lds_dst){unsigned keep;
  asm volatile("s_mov_b32 %0, m0\n\ts_mov_b32 m0, %2\n\ts_nop 0\n\tglobal_load_lds_dwordx4 %1, off\n\ts_mov_b32 m0, %0":"=&s"(keep):"v"(gsrc),"s"(lds_dst):"memory");}
__device__ __forceinline__ float max3f(float a,float b,float c){float r;asm("v_max3_f32 %0, %1, %2, %3":"=v"(r):"v"(a),"v"(b),"v"(c));return r;}
__device__ __forceinline__ float max2f(float a,float b){float r;asm("v_max_f32_e32 %0, %1, %2":"=v"(r):"v"(a),"v"(b));return r;}
__device__ __forceinline__ float fadd_s(float a,float b){float r;asm("v_add_f32_e32 %0, %1, %2":"=v"(r):"v"(a),"v"(b));return r;}
__device__ __forceinline__ float fsub_s(float a,float b){float r;asm("v_sub_f32_e32 %0, %1, %2":"=v"(r):"v"(a),"v"(b));return r;}
typedef float f32x2_t __attribute__((ext_vector_type(2))); typedef __bf16 bf16x2_t __attribute__((ext_vector_type(2)));
__device__ __forceinline__ unsigned cvtpk_s(float lo,float hi){f32x2_t v={lo,hi};bf16x2_t b=__builtin_convertvector(v,bf16x2_t);return __builtin_bit_cast(unsigned,b);}
#define WAIT_BAR(N) asm volatile("s_waitcnt vmcnt(" #N ") lgkmcnt(0)\n\ts_barrier":::"memory")

__device__ __forceinline__ void qkt(f32x16&p0,f32x16&p1,const char*Kslot,const bf16x8*qr,const f32x16&negm,int r32,int hi){
  const char*kb=Kslot+hi*1024+r32*16;
  #pragma unroll
  for(int d0=0;d0<4;++d0){
    const bf16x8 b0=*reinterpret_cast<const bf16x8*>(kb+d0*2048);
    const bf16x8 b1=*reinterpret_cast<const bf16x8*>(kb+d0*2048+512);
    if(d0==0){p0=__builtin_amdgcn_mfma_f32_32x32x16_bf16(b0,qr[0],negm,0,0,0);p1=__builtin_amdgcn_mfma_f32_32x32x16_bf16(b1,qr[0],negm,0,0,0);}
    else{p0=__builtin_amdgcn_mfma_f32_32x32x16_bf16(b0,qr[d0],p0,0,0,0);p1=__builtin_amdgcn_mfma_f32_32x32x16_bf16(b1,qr[d0],p1,0,0,0);}}
}
typedef __attribute__((address_space(3))) const char* lds_cptr;
typedef short v4i16_t __attribute__((ext_vector_type(4)));
__device__ __forceinline__ void kload8(bf16x8*kf,lds_cptr kp){
  kf[0]=*(const __attribute__((address_space(3))) bf16x8*)(kp);      kf[1]=*(const __attribute__((address_space(3))) bf16x8*)(kp+512);
  kf[2]=*(const __attribute__((address_space(3))) bf16x8*)(kp+2048); kf[3]=*(const __attribute__((address_space(3))) bf16x8*)(kp+2560);
  kf[4]=*(const __attribute__((address_space(3))) bf16x8*)(kp+4096); kf[5]=*(const __attribute__((address_space(3))) bf16x8*)(kp+4608);
  kf[6]=*(const __attribute__((address_space(3))) bf16x8*)(kp+6144); kf[7]=*(const __attribute__((address_space(3))) bf16x8*)(kp+6656);
}
__device__ __forceinline__ void kload2(bf16x8*kf,lds_cptr kp,int j){ kf[2*j]=*(const __attribute__((address_space(3))) bf16x8*)(kp+j*2048); kf[2*j+1]=*(const __attribute__((address_space(3))) bf16x8*)(kp+j*2048+512); }
__device__ __forceinline__ s16x4 vtr(lds_cptr p){ return __builtin_bit_cast(s16x4,__builtin_amdgcn_ds_read_tr16_b64_v4i16((__attribute__((address_space(3))) v4i16_t*)p)); }
__device__ __forceinline__ float rowmax(const f32x16&p0,const f32x16&p1){
  float a=max3f(p0[0],p0[1],p1[0]),b=max3f(p0[2],p0[3],p1[1]);a=max3f(a,p1[2],p1[3]);
  #pragma unroll
  for(int r=4;r<16;r+=4){a=max3f(a,p0[r],p0[r+1]);b=max3f(b,p0[r+2],p0[r+3]);a=max3f(a,p1[r],p1[r+1]);b=max3f(b,p1[r+2],p1[r+3]);}
  const float m=max2f(a,b);
  auto rr=__builtin_amdgcn_permlane32_swap(__float_as_uint(m),__float_as_uint(m),false,false);
  return max2f(__uint_as_float(rr[0]),__uint_as_float(rr[1]));
}
__device__ __forceinline__ void pv(f32x16*o,int vb,bf16x8 pa0,bf16x8 pa1,bf16x8 pa2,bf16x8 pa3){
  #pragma unroll
  for(int d0=0;d0<2;++d0){s16x4 lo[4],hi[4];
    #pragma unroll
    for(int ks=0;ks<4;++ks){
      asm volatile("ds_read_b64_tr_b16 %0,%1 offset:%c2":"=&v"(lo[ks]):"v"(vb),"i"(d0*4096+ks*1024):"memory");
      asm volatile("ds_read_b64_tr_b16 %0,%1 offset:%c2":"=&v"(hi[ks]):"v"(vb),"i"(d0*4096+ks*1024+512):"memory");}
    asm volatile("s_waitcnt lgkmcnt(0)":::"memory");SBAR();
    #define PK(k) (bf16x8){lo[k][0],lo[k][1],lo[k][2],lo[k][3],hi[k][0],hi[k][1],hi[k][2],hi[k][3]}
    o[d0]=__builtin_amdgcn_mfma_f32_32x32x16_bf16(pa0,PK(0),o[d0],0,0,0);
    o[d0]=__builtin_amdgcn_mfma_f32_32x32x16_bf16(pa1,PK(1),o[d0],0,0,0);
    o[d0]=__builtin_amdgcn_mfma_f32_32x32x16_bf16(pa2,PK(2),o[d0],0,0,0);
    o[d0]=__builtin_amdgcn_mfma_f32_32x32x16_bf16(pa3,PK(3),o[d0],0,0,0);
    #undef PK
  }
}
template<int THRL> __device__ __forceinline__ void attn_unit(const bf16*Qw0,const bf16*__restrict__ Kh,const bf16*__restrict__ Vh,bf16*Ow0,const int NT,char*shm){
  const int tid=opaque_tid(),lane=tid&63,r32=lane&31,hi=lane>>5; const int wid=__builtin_amdgcn_readfirstlane(tid>>6);
  const bf16*Qw=Qw0+(long)wid*QBLK*QP;
  const unsigned lds0=(unsigned)(uintptr_t)shm;
  float*wsf=(float*)(shm+LDS_WS)+wid*64;
  const bf16*ksrc=Kh+(long)lane*KP+wid*8;
  const bf16*vsrc=Vh+(long)(16*(wid&3)+(lane>>2))*KP+(wid>>2)*32+(lane&3)*8;
  const unsigned kdst=lds0+LDS_K+wid*1024, vdst=lds0+LDS_V+wid*1024;
  #define DMA_K(t,slot) glds16(ksrc+(long)(t)*KVBLK*KP,(unsigned)__builtin_amdgcn_readfirstlane(kdst+(slot)))
  #define DMA_V(t,slot) glds16(vsrc+(long)(t)*KVBLK*KP,(unsigned)__builtin_amdgcn_readfirstlane(vdst+(slot)))
  const int vb0=(int)(lds0+LDS_V)+((lane>>4)&1)*32+(lane&3)*8+(4*hi+((lane&15)>>2))*64;
  const char*Kbase=shm+LDS_K; bf16x8 kf[8];
  const lds_cptr shm3=(lds_cptr)shm; const lds_cptr kp0=shm3+LDS_K+hi*1024+r32*16; const lds_cptr vp0=shm3+LDS_V+((lane>>4)&1)*32+(lane&3)*8+(4*hi+((lane&15)>>2))*64;
  DMA_K(0,0);DMA_V(0,0);DMA_K(1,SLOTB);
  bf16x8 qr[4];
  #pragma unroll
  for(int d0=0;d0<4;++d0)qr[d0]=*reinterpret_cast<const bf16x8*>(&Qw[(long)r32*QP+d0*16+hi*8]);
  float mhat=0.f,l_reg=0.f;f32x16 o[2];o[0]=f32x16{};o[1]=f32x16{};f32x16 negm=f32x16{};asm volatile("":"+v"(negm));
  #define CMASK(P0,P1,t) do{}while(0)
  bool resc=false;
  #define START(P0,P1) do{ const float rm=rowmax(P0,P1); resc=false; \
    { const float dl=rm; mhat=fadd_s(mhat,dl); \
      _Pragma("unroll") for(int r=0;r<16;++r){P0[r]=fsub_s(P0[r],dl);P1[r]=fsub_s(P1[r],dl);} \
      _Pragma("unroll") for(int r=0;r<16;++r)negm[r]=-mhat; asm volatile("":"+v"(negm)); } \
    _Pragma("unroll") for(int r=0;r<16;++r)P0[r]=__builtin_amdgcn_exp2f(P0[r]); }while(0)
  #define RESC() do{ if(resc){ asm volatile("s_waitcnt lgkmcnt(0)":::"memory"); \
      _Pragma("unroll") for(int d_=0;d_<2;++d_) _Pragma("unroll") for(int r=0;r<16;++r)o[d_][r]*=wsf[crow(r,hi)]; } }while(0)
  f32x16 pA0,pA1,pB0,pB1;
  int sl_prev=0,sl_cur=0,sl_next=SLOTB;
  #define ROT() do{sl_prev=sl_cur;sl_cur=sl_next;sl_next=(sl_next==(NSLOT-1)*SLOTB)?0:sl_next+SLOTB;}while(0)
  DMA_K(2,2*SLOTB);
  WAIT_BAR(3);
  qkt(pA0,pA1,Kbase,qr,negm,r32,hi);asm volatile("s_nop 15\n\ts_nop 7":"+v"(pA0),"+v"(pA1));CMASK(pA0,pA1,0);
  START(pA0,pA1);
  _Pragma("unroll") for(int r=0;r<16;++r)pA1[r]=__builtin_amdgcn_exp2f(pA1[r]);
  WAIT_BAR(0);
  DMA_K(3,0);DMA_V(1,SLOTB);
  ROT();
  kload8(kf,kp0+sl_cur);
  WAIT_BAR(2);
  s16x4 vlo[8],vhi[8]; u32x4 pw0,pw1,pw2,pw3;
  #define PKW(P,B) cvtpk_s(P[B],P[B+1])
  #define PAF(k) __builtin_bit_cast(bf16x8,pw##k)
  #define VFR(i) (bf16x8){vlo[i][0],vlo[i][1],vlo[i][2],vlo[i][3],vhi[i][0],vhi[i][1],vhi[i][2],vhi[i][3]}
  #define PIN(x) asm volatile("":"+v"(x))
  #define MX3(a,b,c) __builtin_fmaxf(__builtin_fmaxf((a),(b)),(c))
  #define GAPA(MF,A0,A1,A2,A3,W0,W1,PW) do{ MF; sacc+=A0; sacc+=A1; sacc+=A2; sacc+=A3; PIN(sacc); W0; W1; PIN(PW); SBAR(); }while(0)
  #define EX(v) __builtin_amdgcn_exp2f(v)
  #define GAPB(MF,X,B) do{ MF; X[B]=EX(X[B]); X[B+1]=EX(X[B+1]); X[B+2]=EX(X[B+2]); X[B+3]=EX(X[B+3]); PIN(X); SBAR(); }while(0)
  #define VRD(i) do{ vlo[i]=vtr(vp_+(((i)>>2)*4096+((i)&3)*1024)); vhi[i]=vtr(vp_+(((i)>>2)*4096+((i)&3)*1024+512)); }while(0)
  #define KRD(G,j) do{ if(G){ kload2(kf,kp0+sl_next,j); SBAR(); } }while(0)
  #define STEP(C0,C1,P0,P1,t,GK,GV,GL) do{ SBAR(); \
    const lds_cptr vp_=vp0+sl_prev; \
    VRD(0); SBAR(); float sacc=(P0[0]+P0[1]); \
    GAPA(C0=__builtin_amdgcn_mfma_f32_32x32x16_bf16(kf[0],qr[0],negm,0,0,0), P0[2],P0[3],P0[4],P0[5],     pw0[0]=PKW(P0,0), pw0[1]=PKW(P0,2), pw0); \
    VRD(4); SBAR(); GAPA(C1=__builtin_amdgcn_mfma_f32_32x32x16_bf16(kf[1],qr[0],negm,0,0,0), P0[6],P0[7],P0[8],P0[9],     pw0[2]=PKW(P0,4), pw0[3]=PKW(P0,6), pw0); \
    VRD(1); SBAR(); GAPA(C0=__builtin_amdgcn_mfma_f32_32x32x16_bf16(kf[2],qr[1],C0,0,0,0),   P0[10],P0[11],P0[12],P0[13], pw1[0]=PKW(P0,8), pw1[1]=PKW(P0,10), pw1); \
    VRD(5); SBAR(); GAPA(C1=__builtin_amdgcn_mfma_f32_32x32x16_bf16(kf[3],qr[1],C1,0,0,0),   P0[14],P0[15],P1[0],P1[1],   pw1[2]=PKW(P0,12),pw1[3]=PKW(P0,14), pw1); \
    VRD(2); SBAR(); GAPA(C0=__builtin_amdgcn_mfma_f32_32x32x16_bf16(kf[4],qr[2],C0,0,0,0),   P1[2],P1[3],P1[4],P1[5],     pw2[0]=PKW(P1,0), pw2[1]=PKW(P1,2), pw2); \
    VRD(6); SBAR(); GAPA(C1=__builtin_amdgcn_mfma_f32_32x32x16_bf16(kf[5],qr[2],C1,0,0,0),   P1[6],P1[7],P1[8],P1[9],     pw2[2]=PKW(P1,4), pw2[3]=PKW(P1,6), pw2); \
    VRD(3); SBAR(); GAPA(C0=__builtin_amdgcn_mfma_f32_32x32x16_bf16(kf[6],qr[3],C0,0,0,0),   P1[10],P1[11],P1[12],P1[13], pw3[0]=PKW(P1,8), pw3[1]=PKW(P1,10), pw3); \
    VRD(7); SBAR(); GAPA(C1=__builtin_amdgcn_mfma_f32_32x32x16_bf16(kf[7],qr[3],C1,0,0,0),   P1[14],P1[15],0.f,0.f,       pw3[2]=PKW(P1,12),pw3[3]=PKW(P1,14), pw3); \
    l_reg+=sacc; \
    if(GK){DMA_K((t)+3,sl_cur);} if(GV){DMA_V((t)+1,sl_next);} \
    CMASK(C0,C1,t); \
    { float a=MX3(C0[0],C0[1],C1[0]),b=MX3(C0[2],C0[3],C1[1]); a=MX3(a,C1[2],C1[3]); \
      _Pragma("unroll") for(int r=4;r<16;r+=4){a=MX3(a,C0[r],C0[r+1]);b=MX3(b,C0[r+2],C0[r+3]);a=MX3(a,C1[r],C1[r+1]);b=MX3(b,C1[r+2],C1[r+3]);} \
      float rm=__builtin_fmaxf(a,b); { auto rr=__builtin_amdgcn_permlane32_swap(__float_as_uint(rm),__float_as_uint(rm),false,false); rm=__builtin_fmaxf(__uint_as_float(rr[0]),__uint_as_float(rr[1])); } \
      resc=false; \
      if(__builtin_expect(__any(rm>(float)THRL),0)){ const float dl=__builtin_fmaxf(rm,0.f); mhat+=dl; \
        _Pragma("unroll") for(int r=0;r<16;++r){C0[r]-=dl;C1[r]-=dl;} \
        _Pragma("unroll") for(int r=0;r<16;++r)negm[r]=-mhat; asm volatile("":"+v"(negm)); \
        const float f=__builtin_amdgcn_exp2f(-dl); l_reg*=f; if(hi==0)wsf[r32]=f; resc=true; } } \
    SBAR(); \
    GAPB(o[0]=__builtin_amdgcn_mfma_f32_32x32x16_bf16(PAF(0),VFR(0),o[0],0,0,0), C0,0); \
    GAPB(o[1]=__builtin_amdgcn_mfma_f32_32x32x16_bf16(PAF(0),VFR(4),o[1],0,0,0), C0,4); \
    KRD(GL,0); GAPB(o[0]=__builtin_amdgcn_mfma_f32_32x32x16_bf16(PAF(1),VFR(1),o[0],0,0,0), C0,8); \
    KRD(GL,1); GAPB(o[1]=__builtin_amdgcn_mfma_f32_32x32x16_bf16(PAF(1),VFR(5),o[1],0,0,0), C0,12); \
    KRD(GL,2); GAPB(o[0]=__builtin_amdgcn_mfma_f32_32x32x16_bf16(PAF(2),VFR(2),o[0],0,0,0), C1,0); \
    KRD(GL,3); GAPB(o[1]=__builtin_amdgcn_mfma_f32_32x32x16_bf16(PAF(2),VFR(6),o[1],0,0,0), C1,4); \
    GAPB(o[0]=__builtin_amdgcn_mfma_f32_32x32x16_bf16(PAF(3),VFR(3),o[0],0,0,0), C1,8); \
    GAPB(o[1]=__builtin_amdgcn_mfma_f32_32x32x16_bf16(PAF(3),VFR(7),o[1],0,0,0), C1,12); \
    }while(0)
  int t=1;
  #undef CMASK
  #define CMASK(P0,P1,t) do{}while(0)
  for(;t+5<NT;t+=2){
    STEP(pB0,pB1,pA0,pA1,t,true,true,true);     WAIT_BAR(2); RESC(); ROT();
    STEP(pA0,pA1,pB0,pB1,t+1,true,true,true);   WAIT_BAR(2); RESC(); ROT();
  }
  #undef CMASK
  #define CMASK(P0,P1,t) do{}while(0)
  #define ENDW(tt) do{ if((tt)+3<NT){WAIT_BAR(2);} else if((tt)+2<NT){WAIT_BAR(1);} else {WAIT_BAR(0);} }while(0)
  for(;t+1<NT;t+=2){
    STEP(pB0,pB1,pA0,pA1,t,(t+3<NT),(t+1<NT),(t+1<NT));       ENDW(t);   RESC(); ROT();
    STEP(pA0,pA1,pB0,pB1,t+1,(t+4<NT),(t+2<NT),(t+2<NT));     ENDW(t+1); RESC(); ROT();
  }
  STEP(pB0,pB1,pA0,pA1,NT-1,false,false,false); RESC();
  { float sacc=pB0[0]+pB0[1]; _Pragma("unroll") for(int r=2;r<16;++r)sacc+=pB0[r]; _Pragma("unroll") for(int r=0;r<16;++r)sacc+=pB1[r]; l_reg+=sacc;
    pw0=(u32x4){PKW(pB0,0),PKW(pB0,2),PKW(pB0,4),PKW(pB0,6)};pw1=(u32x4){PKW(pB0,8),PKW(pB0,10),PKW(pB0,12),PKW(pB0,14)};pw2=(u32x4){PKW(pB1,0),PKW(pB1,2),PKW(pB1,4),PKW(pB1,6)};pw3=(u32x4){PKW(pB1,8),PKW(pB1,10),PKW(pB1,12),PKW(pB1,14)};
    SBAR(); pv(o,vb0+sl_cur,PAF(0),PAF(1),PAF(2),PAF(3)); }
  #undef PKW
  #undef PAF
  #undef VFR
  #undef PIN
  #undef MX3
  #undef GAPA
  #undef GAPB
  #undef EX
  #undef VRD
  #undef KRD
  #undef STEP
  #undef ENDW
  {auto rr=__builtin_amdgcn_permlane32_swap(__float_as_uint(l_reg),__float_as_uint(l_reg),false,false);l_reg=__uint_as_float(rr[0])+__uint_as_float(rr[1]);}
  if(hi==0)wsf[32+r32]=l_reg;asm volatile("s_waitcnt lgkmcnt(0)":::"memory");
  float rli[16];
  #pragma unroll
  for(int r=0;r<16;++r)rli[r]=__builtin_amdgcn_rcpf(wsf[32+crow(r,hi)]);
  bf16*Ow=Ow0+(long)wid*QBLK*OP;
  { bf16*stg=(bf16*)(shm+LDS_OST)+wid*2048;
    #pragma unroll
    for(int r=0;r<16;++r){const int orow=crow(r,hi);
      #pragma unroll
      for(int d0=0;d0<2;++d0)stg[orow*64+d0*32+r32]=__float2bfloat16(o[d0][r]*rli[r]);}
    asm volatile("s_waitcnt lgkmcnt(0)":::"memory");
    #pragma unroll
    for(int i=0;i<4;++i){const int row=i*8+(lane>>3),ch=lane&7; const u32x4 v=*(const u32x4*)(stg+row*64+ch*8); ATTN_STORE16(Ow+(long)row*OP+ch*8,v);} }
  asm volatile("s_waitcnt lgkmcnt(0)\n\ts_barrier":::"memory");
  #undef DMA_K
  #undef DMA_V
  #undef CMASK
  #undef START
  #undef RESC
  #undef ROT
}

#undef SBAR
#undef WAIT_BAR
}

typedef short bf16x8_t __attribute__((ext_vector_type(8)));
#define LDS_WAIT() asm volatile("s_waitcnt lgkmcnt(0)" ::: "memory")

__device__ __forceinline__ int inv32(int c) { return 16 * ((c >> 2) & 1) + 4 * (c >> 3) + (c & 3); }
__device__ __forceinline__ int dest_row(int type, int n) {
    if (type == 0) return n;
    if (type == 3) return (n & ~31) + inv32(n & 31);
    if (type == 1) { const int half = n >= DFF ? 1 : 0, j = n - half * DFF, pn = j >> 7, c = j & 127; return pn * 256 + half * 128 + (c & ~31) + inv32(c & 31); }
    if (n < 768) { const int hd = n >> 6, d = n & 63, a = d >> 5, t = (d >> 4) & 1, p = d & 15; return (hd >> 2) * 256 + a * 128 + (hd & 3) * 32 + t * 16 + p; }
    const int pn = n >> 8, c = n & 255, half = c >> 7, c7 = c & 127; return pn * 256 + half * 128 + (c7 & ~31) + inv32(c7 & 31);
}
__device__ __forceinline__ void transpose_item(const float* W, int K, int N, bf16_t* WT, int type, LAS float* scr, int item, int lane) {
    const int nblk = N / 32, kb = item / nblk, nb = item % nblk, k0 = 64 * kb, n0 = 32 * nb;
#pragma unroll
    for (int h = 0; h < 2; ++h) { float wv[16];
#pragma unroll
        for (int i = 0; i < 16; ++i) wv[i] = W[(size_t)(k0 + 2 * (16 * h + i) + (lane >> 5)) * N + n0 + (lane & 31)];
#pragma unroll
        for (int i = 0; i < 16; ++i) scr[(2 * (16 * h + i) + (lane >> 5)) * 33 + (lane & 31)] = wv[i]; }
    LDS_WAIT(); asm volatile("" ::: "memory");
    const int c = lane & 7;
#pragma unroll
    for (int j = 0; j < 4; ++j) { const int n = (lane >> 3) + 8 * j; const LAS float* s = scr + (8 * c) * 33 + n;
        u32x4 o; o.x = cvt_pk(s[0 * 33], s[1 * 33]); o.y = cvt_pk(s[2 * 33], s[3 * 33]); o.z = cvt_pk(s[4 * 33], s[5 * 33]); o.w = cvt_pk(s[6 * 33], s[7 * 33]);
        *(u32x4*)(WT + (size_t)dest_row(type, n0 + n) * K + k0 + 8 * c) = o; }
    LDS_WAIT(); asm volatile("" ::: "memory");
}

__device__ __forceinline__ void prologue_phase(const Params& P, LAS unsigned char* lds, int G) {
    const int tid = opaque_tid(), lane = tid & 63, wid = __builtin_amdgcn_readfirstlane(tid >> 6), bid = blockIdx.x;
    unsigned char* ws = P.ws;
    {
        LAS float* sc = (LAS float*)lds;
        LAS float* red = (LAS float*)(lds + 36864);
        for (int i = tid; i < 9 * 1024; i += NTHREADS) { const int v = i >> 10, k = i & 1023; const float cv = v < 8 ? P.in[1][v * 1024 + k] : P.in[3][k]; sc[i] = cv / (1.0f + expf(-cv)); }
        __syncthreads();
        float* mod = (float*)(ws + OFF_MOD);
        for (int item = bid; item < 2 * 144; item += G) {
            const int l = item / 144, cgp = item % 144, col = cgp * 64 + lane, kc = wid;
            const float* W = P.in[4] + (size_t)l * 1024 * MODW + col;
            float acc[9];
#pragma unroll
            for (int v = 0; v < 9; ++v) acc[v] = 0.f;
#pragma unroll 1
            for (int k0 = kc * 128; k0 < kc * 128 + 128; k0 += 16) { float wv[16];
#pragma unroll
                for (int q = 0; q < 16; ++q) wv[q] = W[(size_t)(k0 + q) * MODW];
#pragma unroll
                for (int q = 0; q < 16; ++q)
#pragma unroll
                    for (int v = 0; v < 9; ++v) acc[v] += sc[v * 1024 + k0 + q] * wv[q]; }
#pragma unroll
            for (int v = 0; v < 9; ++v) red[(kc * 9 + v) * 64 + lane] = acc[v];
            __syncthreads();
            for (int i = tid; i < 576; i += NTHREADS) { const int v = i >> 6, cc = i & 63; float s = 0.f;
#pragma unroll
                for (int q = 0; q < 8; ++q) s += red[(q * 9 + v) * 64 + cc];
                mod[(size_t)(l * 9 + v) * MODW + cgp * 64 + cc] = s + P.in[5][l * MODW + cgp * 64 + cc]; }
            __syncthreads();
        }
    }
    __syncthreads();
    {
        LAS float* scr = (LAS float*)(lds + wid * 16384);
        const int gw = bid * 8 + wid, NGW = G * 8;
        constexpr int I_FI = 16 * (NFF2 / 32), I_FO = (DFF / 64) * 32, I_WI = 16 * (INW / 32), I_WO = 16 * 32;
        constexpr int PER_L = 2 * I_FI + 2 * I_FO + I_WI + I_WO;
        for (int it = gw; it < DEPTH * PER_L; it += NGW) {
            const int l = it / PER_L; int r = it % PER_L;
            unsigned char* wb = ws + OFF_WB + (size_t)l * WB_LAYER;
            if (r < 2 * I_FI) { const int f = r / I_FI; transpose_item(P.in[7] + (size_t)(l * 2 + f) * DM * NFF2, DM, NFF2, (bf16_t*)(wb + WB_FFIN + f * WB_FFIN_SZ), 1, scr, r % I_FI, lane); continue; } r -= 2 * I_FI;
            if (r < 2 * I_FO) { const int f = r / I_FO; transpose_item(P.in[8] + (size_t)(l * 2 + f) * DFF * DM, DFF, DM, (bf16_t*)(wb + WB_FFOUT + f * WB_FFOUT_SZ), 3, scr, r % I_FO, lane); continue; } r -= 2 * I_FO;
            if (r < I_WI) { transpose_item(P.in[9] + (size_t)l * DM * INW, DM, INW, (bf16_t*)(wb + WB_WIN), 2, scr, r, lane); continue; } r -= I_WI;
            transpose_item(P.in[22] + (size_t)l * DM * DM, DM, DM, (bf16_t*)(wb + WB_WOUT), 3, scr, r, lane);
        }
        bf16_t* LW = (bf16_t*)(ws + OFF_LW);
        const int gt = bid * NTHREADS + tid, NGT = G * NTHREADS;
        for (int i = gt; i < DEPTH * 4 * 256 * 64; i += NGT) {
            const int d = i & 63, c = (i >> 6) & 255, g = (i >> 14) & 3, l = i >> 16, n = c >> 6, e = c & 63;
            const float* src = (g & 1) ? P.in[16] : P.in[14];
            const float v = src[((((size_t)l * 2 + (g >> 1)) * 4 + n) * 64 + d) * 64 + e];
            LW[i] = (bf16_t)(cvt_pk(v, 0.f) & 0xffffu);
        }
        float* rc = (float*)(ws + OFF_ROPE); float* rs = rc + 2048;
        for (int i = gt; i < 2048; i += NGT) { const int pos = i >> 4, p = i & 15; const float inv = powf(10000.0f, -(float)p / 16.0f), ang = (float)pos * inv; rc[i] = cosf(ang); rs[i] = sinf(ang); }
    }
}

__device__ __forceinline__ void norm_phase(const Params& P, int l, int idx, int row_lo, int row_hi, bool first, int wg0, int nwg) {
    const int tid = opaque_tid(), lane = tid & 63, wid = __builtin_amdgcn_readfirstlane(tid >> 6);
    if ((int)blockIdx.x < wg0 || (int)blockIdx.x >= wg0 + nwg) return;
    const int gw = ((int)blockIdx.x - wg0) * 8 + wid, NGW = nwg * 8, per = (row_hi - row_lo + NGW - 1) / NGW;
    const int r0 = row_lo + gw * per, r1 = (r0 + per < row_hi) ? r0 + per : row_hi;
    const float* mod = (const float*)(P.ws + OFF_MOD) + (size_t)l * 9 * MODW;
    const float* gsrc = P.in[6] + (size_t)(l * 3 + idx) * DM;
    const bf16_t* xres = (const bf16_t*)(P.ws + OFF_XRES); bf16_t* hb = (bf16_t*)(P.ws + OFF_HBUF);
    int curv = -1; f32x4 Aa[4], Bb[4];
    for (int row = r0; row < r1; ++row) {
        const int v = row < MLAT ? (row >> 13) : 8;
        if (v != curv) { curv = v;
#pragma unroll
            for (int j = 0; j < 4; ++j) { const int c = 4 * lane + 256 * j; const f32x4 g4 = *(const f32x4*)(gsrc + c), sh = *(const f32x4*)(mod + (size_t)v * MODW + (3 * idx) * DM + c), sc = *(const f32x4*)(mod + (size_t)v * MODW + (3 * idx + 1) * DM + c);
                Aa[j] = g4 * (sc + 1.0f); Bb[j] = sh; } }
        f32x4 x[4]; float ss = 0.f;
        if (first) { const float* xr = row < MLAT ? P.in[0] + (size_t)row * DM : P.in[2] + (size_t)(row - MLAT) * DM;
#pragma unroll
            for (int j = 0; j < 4; ++j) x[j] = *(const f32x4*)(xr + 4 * lane + 256 * j);
        } else {
#pragma unroll
            for (int j = 0; j < 4; ++j) { const u32x2 r = *(const u32x2*)(xres + (size_t)row * DM + 4 * lane + 256 * j); x[j] = (f32x4){bf_lo(r.x), bf_hi(r.x), bf_lo(r.y), bf_hi(r.y)}; }
        }
#pragma unroll
        for (int j = 0; j < 4; ++j) { ss += (x[j][0] * x[j][0] + x[j][1] * x[j][1]) + (x[j][2] * x[j][2] + x[j][3] * x[j][3]); }
        const float rstd = 1.0f / sqrtf(wave_sum(ss) * (1.0f / DM) + EPS);
#pragma unroll
        for (int j = 0; j < 4; ++j) { const f32x4 y = x[j] * rstd * Aa[j] + Bb[j]; u32x2 w; w.x = cvt_pk(y[0], y[1]); w.y = cvt_pk(y[2], y[3]);
            *(u32x2*)(hb + (size_t)row * DM + 4 * lane + 256 * j) = w;
 }
    }
}
__device__ __forceinline__ void final_norm_phase(const Params& P, int G) {
    const int tid = opaque_tid(), lane = tid & 63, wid = __builtin_amdgcn_readfirstlane(tid >> 6);
    const int gw = blockIdx.x * 8 + wid, NGW = G * 8;
    const bf16_t* xres = (const bf16_t*)(P.ws + OFF_XRES);
    f32x4 g4[4];
#pragma unroll
    for (int j = 0; j < 4; ++j) g4[j] = *(const f32x4*)(P.in[23] + 4 * lane + 256 * j);
    for (int row = gw; row < MLAT; row += NGW) {
        f32x4 x[4]; float ss = 0.f;
#pragma unroll
        for (int j = 0; j < 4; ++j) { const u32x2 r = *(const u32x2*)(xres + (size_t)row * DM + 4 * lane + 256 * j); x[j] = (f32x4){bf_lo(r.x), bf_hi(r.x), bf_lo(r.y), bf_hi(r.y)}; ss += (x[j][0] * x[j][0] + x[j][1] * x[j][1]) + (x[j][2] * x[j][2] + x[j][3] * x[j][3]); }
        const float rstd = 1.0f / sqrtf(wave_sum(ss) * (1.0f / DM) + EPS);
#pragma unroll
        for (int j = 0; j < 4; ++j) *(f32x4*)(P.out + (size_t)row * DM + 4 * lane + 256 * j) = x[j] * rstd * g4[j];
    }
}

constexpr int L1_AST = 528;
constexpr int L1_UST = 260;
constexpr int L1_UOFF = 66560;
__device__ __forceinline__ void lru1_phase(const Params& P, int l, LAS unsigned char* lds, int G) {
    const int tid = opaque_tid(), lane = tid & 63, wid = __builtin_amdgcn_readfirstlane(tid >> 6), fr = lane & 15, fq = lane >> 4;
    LAS unsigned char* ldsA = lds; LAS float* ldsU = (LAS float*)(lds + L1_UOFF);
    const bf16_t* Ubuf = (const bf16_t*)(P.ws + OFF_U5);
    float* Sg = (float*)(P.ws + OFF_S); unsigned* PPg = (unsigned*)(P.ws + OFF_PP); float* csum = (float*)(P.ws + OFF_CSUM);
    const bf16_t* LW = (const bf16_t*)(P.ws + OFF_LW) + (size_t)l * 4 * 256 * 64;
    const int ch4 = (tid & 63) * 4, pg = tid >> 6;
    f32x4 cw[4], cbias;
#pragma unroll
    for (int i = 0; i < 4; ++i) cw[i] = *(const f32x4*)(P.in[12] + (size_t)(l * 4 + i) * 256 + ch4);
    cbias = *(const f32x4*)(P.in[13] + (size_t)l * 256 + ch4);
    const int nblk = wid >> 1;
    for (int tile = blockIdx.x; tile < NBATCH * NCHUNK; tile += G) {
        const int b = tile / NCHUNK, cidx = tile % NCHUNK, P0 = cidx * 64; const bool latent = cidx >= 4;
        const int seg_lo = latent ? 256 : 0, seg_hi = latent ? KEYS : 256;
        const int rbase = latent ? b * SEQ - 256 : MLAT + b * CTXL;
        {
            const int pp0 = P0 + pg * 8;
            f32x4 win[11];
#pragma unroll
            for (int i = 0; i < 11; ++i) { const int Pq = pp0 - 2 + i; f32x4 w4 = {0.f, 0.f, 0.f, 0.f};
                if (Pq >= seg_lo && Pq < seg_hi) { const u32x2 raw = *(const u32x2*)(Ubuf + (size_t)(rbase + Pq) * 256 + ch4); w4 = (f32x4){bf_lo(raw.x), bf_hi(raw.x), bf_lo(raw.y), bf_hi(raw.y)}; }
                win[i] = w4; }
#pragma unroll
            for (int q = 0; q < 8; ++q) { f32x4 y = cbias;
#pragma unroll
                for (int i = 0; i < 4; ++i) y = y + cw[i] * win[q + i];
                const int pos = pg * 8 + q;
                u32x2 w; w.x = cvt_pk(y[0], y[1]); w.y = cvt_pk(y[2], y[3]);
                *(LAS u32x2*)(ldsA + pos * L1_AST + ch4 * 2) = w;
                *(LAS f32x4*)(ldsU + pos * L1_UST + ch4) = y; }
        }
        __syncthreads();
#pragma unroll 1
        for (int cc = 0; cc < 2; ++cc) {
            const int c = 32 * wid + 16 * cc + fr;
            const float baf = P.in[15][(l * 2 + 0) * 256 + c], bab = P.in[15][(l * 2 + 1) * 256 + c], bxf = P.in[17][(l * 2 + 0) * 256 + c], bxb = P.in[17][(l * 2 + 1) * 256 + c];
            const float nspf = -8.0f * log1pf(expf(-P.in[18][(l * 2 + 0) * 256 + c])), nspb = -8.0f * log1pf(expf(-P.in[18][(l * 2 + 1) * 256 + c]));
            f32x4 acc[4][4];
            {
                bf16x8_t bw[4][2];
#pragma unroll
                for (int g = 0; g < 4; ++g)
#pragma unroll
                    for (int kk = 0; kk < 2; ++kk) bw[g][kk] = *(const bf16x8_t*)(LW + ((size_t)(g * 256 + c) * 64 + kk * 32 + fq * 8));
#pragma unroll
                for (int m = 0; m < 4; ++m) {
#pragma unroll
                    for (int g = 0; g < 4; ++g) acc[m][g] = (f32x4){0.f, 0.f, 0.f, 0.f};
#pragma unroll
                    for (int kk = 0; kk < 2; ++kk) { const bf16x8_t a = *(const LAS bf16x8_t*)(ldsA + (16 * m + fr) * L1_AST + (64 * nblk + 32 * kk + 8 * fq) * 2);
#pragma unroll
                        for (int g = 0; g < 4; ++g) acc[m][g] = __builtin_amdgcn_mfma_f32_16x16x32_bf16(a, bw[g][kk], acc[m][g], 0, 0, 0); }
                }
            }
#pragma unroll
            for (int m = 0; m < 4; ++m)
#pragma unroll
                for (int j = 0; j < 4; ++j) {
                    const float u = ldsU[(16 * m + 4 * fq + j) * L1_UST + c];
                    {   const float r = sigmoidf_(acc[m][0][j] + baf), ig = sigmoidf_(acc[m][1][j] + bxf);
                        const float la = nspf * r, a = __expf(la);
                        acc[m][0][j] = a; acc[m][1][j] = __builtin_amdgcn_sqrtf((1.0f - a) * (1.0f + a)) * ig * u; }
                    {   const float r = sigmoidf_(acc[m][2][j] + bab), ig = sigmoidf_(acc[m][3][j] + bxb);
                        const float la = nspb * r, a = __expf(la);
                        acc[m][2][j] = a; acc[m][3][j] = __builtin_amdgcn_sqrtf((1.0f - a) * (1.0f + a)) * ig * u; }
                }
            f32x4 hf[4], pf[4];
            {
                float cA = 1.f, cH = 0.f;
#pragma unroll
                for (int m = 0; m < 4; ++m) {
                    const f32x4 a = acc[m][0], x = acc[m][1];
                    const float A0 = a[0], H0 = x[0], A1 = A0 * a[1], H1 = a[1] * H0 + x[1], A2 = A1 * a[2], H2 = a[2] * H1 + x[2], A3 = A2 * a[3], H3 = a[3] * H2 + x[3];
                    float TA = A3, TH = H3;
                    float tA = __shfl_up(TA, 16), tH = __shfl_up(TH, 16); if (fq >= 1) { TH = TA * tH + TH; TA = TA * tA; }
                    tA = __shfl_up(TA, 32); tH = __shfl_up(TH, 32); if (fq >= 2) { TH = TA * tH + TH; TA = TA * tA; }
                    float EA = __shfl_up(TA, 16), EH = __shfl_up(TH, 16); if (fq == 0) { EA = 1.f; EH = 0.f; }
                    const float inA = cA * EA, inH = EA * cH + EH;
                    pf[m] = (f32x4){inA * A0, inA * A1, inA * A2, inA * A3};
                    hf[m] = (f32x4){A0 * inH + H0, A1 * inH + H1, A2 * inH + H2, A3 * inH + H3};
                    const float gA = __shfl(TA, fr + 48), gH = __shfl(TH, fr + 48);
                    cH = gA * cH + gH; cA = cA * gA;
                }
                if (fq == 0) { float* cs = csum + ((size_t)(b * NCHUNK + cidx) * 2 + 0) * 512 + c; cs[0] = cA; cs[256] = cH; }
            }
            {
                float cA = 1.f, cH = 0.f;
#pragma unroll
                for (int mm = 0; mm < 4; ++mm) { const int m = 3 - mm;
                    const f32x4 a = acc[m][2], x = acc[m][3];
                    const float A3 = a[3], H3 = x[3], A2 = A3 * a[2], H2 = a[2] * H3 + x[2], A1 = A2 * a[1], H1 = a[1] * H2 + x[1], A0 = A1 * a[0], H0 = a[0] * H1 + x[0];
                    float TA = A0, TH = H0;
                    float tA = __shfl_down(TA, 16), tH = __shfl_down(TH, 16); if (fq <= 2) { TH = TA * tH + TH; TA = TA * tA; }
                    tA = __shfl_down(TA, 32); tH = __shfl_down(TH, 32); if (fq <= 1) { TH = TA * tH + TH; TA = TA * tA; }
                    float EA = __shfl_down(TA, 16), EH = __shfl_down(TH, 16); if (fq == 3) { EA = 1.f; EH = 0.f; }
                    const float inA = cA * EA, inH = EA * cH + EH;
                    const f32x4 pb = (f32x4){inA * A0, inA * A1, inA * A2, inA * A3};
                    const f32x4 hb = (f32x4){A0 * inH + H0, A1 * inH + H1, A2 * inH + H2, A3 * inH + H3};
#pragma unroll
                    for (int j = 0; j < 4; ++j) { const int tk = 16 * m + 4 * fq + j;
                        ldsU[tk * L1_UST + c] = hf[m][j] + hb[j];
                        PPg[(size_t)(rbase + P0 + tk) * 256 + c] = (cvt_pk(pf[m][j], 0.f) & 0xffffu) | (cvt_pk(0.f, pb[j]) & 0xffff0000u); }
                    const float gA = __shfl(TA, fr), gH = __shfl(TH, fr);
                    cH = gA * cH + gH; cA = cA * gA;
                }
                if (fq == 0) { float* cs = csum + ((size_t)(b * NCHUNK + cidx) * 2 + 1) * 512 + c; cs[0] = cA; cs[256] = cH; }
            }
        }
        __syncthreads();
#pragma unroll
        for (int it = 0; it < 8; ++it) { const int idx = it * NTHREADS + tid, r = idx >> 6, c16 = idx & 63; const size_t grow = (size_t)(rbase + P0 + r) * 256 + c16 * 4;
            *(f32x4*)(Sg + grow) = *(const LAS f32x4*)(ldsU + r * L1_UST + c16 * 4);
 }
        __syncthreads();
    }
}
__device__ __forceinline__ void lru2_batch(const Params& P, int b) {
    const int tid = opaque_tid(), dir = tid >> 8, c = tid & 255;
    const float* csum = (const float*)(P.ws + OFF_CSUM); float* carry = (float*)(P.ws + OFF_CARRY);
    float h = 0.f;
#pragma unroll 1
    for (int k0 = 0; k0 < NCHUNK; k0 += 33) {
        float A[33], H[33]; int ci[33];
#pragma unroll
        for (int q = 0; q < 33; ++q) { const int k = k0 + q; ci[q] = dir == 0 ? k : (k < 4 ? 3 - k : 135 - k);
            const float* cs = csum + ((size_t)(b * NCHUNK + ci[q]) * 2 + dir) * 512 + c; A[q] = cs[0]; H[q] = cs[256]; }
#pragma unroll
        for (int q = 0; q < 33; ++q) { carry[((size_t)(b * NCHUNK + ci[q]) * 2 + dir) * 256 + c] = h; h = A[q] * h + H[q]; }
    }
}
__device__ __forceinline__ float gelu_tanh(float x) { const float z = 0.7978845608f * (x + 0.044715f * x * x * x); const float t = 1.0f - 2.0f * __builtin_amdgcn_rcpf(1.0f + __expf(2.0f * z)); return 0.5f * x * (1.0f + t); }
__device__ __forceinline__ void merge_phase(const Params& P, int l, int Mrows, int G) {
    const int tid = opaque_tid(), lane = tid & 63, wid = __builtin_amdgcn_readfirstlane(tid >> 6);
    const int gw = blockIdx.x * 8 + wid, NGW = G * 8, c4 = 4 * lane;
    const bf16_t* U5 = (const bf16_t*)(P.ws + OFF_U5);
    const bf16_t *Gb = U5 + U5_STRIDE, *BGb = U5 + 2 * U5_STRIDE, *CGb = U5 + 3 * U5_STRIDE, *SSb = U5 + 4 * U5_STRIDE;
    const float* Sg = (const float*)(P.ws + OFF_S); const unsigned* PPg = (const unsigned*)(P.ws + OFF_PP); const float* carry = (const float*)(P.ws + OFF_CARRY);
    bf16_t* hb = (bf16_t*)(P.ws + OFF_HBUF); const bf16_t* att = (const bf16_t*)(P.ws + OFF_ATT);
    f32x4 w0 = *(const f32x4*)(P.in[19] + (size_t)(l * 3 + 0) * 256 + c4), w1 = *(const f32x4*)(P.in[19] + (size_t)(l * 3 + 1) * 256 + c4), w2 = *(const f32x4*)(P.in[19] + (size_t)(l * 3 + 2) * 256 + c4);
    f32x4 cb4 = *(const f32x4*)(P.in[20] + (size_t)l * 256 + c4);
    const float* gg = P.in[21] + (size_t)l * 1024;
    const f32x4 ga0 = *(const f32x4*)(gg + 8 * lane), ga1 = *(const f32x4*)(gg + 8 * lane + 4), gl = *(const f32x4*)(gg + 512 + c4), gs = *(const f32x4*)(gg + 768 + c4);
    const int per = (Mrows + NGW - 1) / NGW, r0 = gw * per, r1 = (r0 + per < Mrows) ? r0 + per : Mrows;
    int curc = -1; f32x4 cf = {0.f, 0.f, 0.f, 0.f}, cbk = {0.f, 0.f, 0.f, 0.f};
    f32x4 pm1, p0, pp1;
    auto prodrow = [&](int r) -> f32x4 { const size_t o = (size_t)r * 256 + c4; const u32x2 a = *(const u32x2*)(CGb + o), s2 = *(const u32x2*)(SSb + o);
        return (f32x4){bf_lo(a.x) * bf_lo(s2.x), bf_hi(a.x) * bf_hi(s2.x), bf_lo(a.y) * bf_lo(s2.y), bf_hi(a.y) * bf_hi(s2.y)}; };
    const f32x4 zero4 = {0.f, 0.f, 0.f, 0.f};
    if (r0 < r1) { const int sp = r0 < MLAT ? (r0 & 8191) : ((r0 - MLAT) & 255); pm1 = sp == 0 ? zero4 : prodrow(r0 - 1); p0 = prodrow(r0); }
    for (int row = r0; row < r1; ++row) {
        int b, cidx, sp, slen;
        if (row < MLAT) { b = row >> 13; sp = row & 8191; cidx = 4 + (sp >> 6); slen = SEQ; } else { const int rc = row - MLAT; b = rc >> 8; sp = rc & 255; cidx = sp >> 6; slen = CTXL; }
        const int ckey = b * NCHUNK + cidx;
        if (ckey != curc) { curc = ckey; cf = *(const f32x4*)(carry + ((size_t)ckey * 2 + 0) * 256 + c4); cbk = *(const f32x4*)(carry + ((size_t)ckey * 2 + 1) * 256 + c4); }
        if (sp == 0) { pm1 = zero4; if (row != r0) p0 = prodrow(row); }
        pp1 = (sp + 1 == slen) ? zero4 : prodrow(row + 1);
        {   const size_t o = (size_t)row * 256 + c4;
            const f32x4 S4 = *(const f32x4*)(Sg + o); const u32x4 pp = *(const u32x4*)(PPg + o);
            const u32x2 g2 = *(const u32x2*)(Gb + o), bg2 = *(const u32x2*)(BGb + o);
            const u32x4 at = *(const u32x4*)(att + (size_t)row * 512 + 8 * lane);
            f32x4 hv;
#pragma unroll
            for (int j = 0; j < 4; ++j) hv[j] = S4[j] + bf_lo(pp[j]) * cf[j] + bf_hi(pp[j]) * cbk[j];
            const f32x4 g4 = (f32x4){bf_lo(g2.x), bf_hi(g2.x), bf_lo(g2.y), bf_hi(g2.y)}, bg4 = (f32x4){bf_lo(bg2.x), bf_hi(bg2.x), bf_lo(bg2.y), bf_hi(bg2.y)};
            f32x4 lru, scv;
#pragma unroll
            for (int j = 0; j < 4; ++j) { lru[j] = hv[j] * gelu_tanh(g4[j]); scv[j] = bg4[j] * (w0[j] * pm1[j] + w1[j] * p0[j] + w2[j] * pp1[j] + cb4[j]); }
            float av[8];
#pragma unroll
            for (int j = 0; j < 4; ++j) { av[2 * j] = bf_lo(at[j]); av[2 * j + 1] = bf_hi(at[j]); }
            float ssa = 0.f, ssl = 0.f, sss = 0.f;
#pragma unroll
            for (int j = 0; j < 8; ++j) ssa += av[j] * av[j];
#pragma unroll
            for (int j = 0; j < 4; ++j) { ssl += lru[j] * lru[j]; sss += scv[j] * scv[j]; }
            ssa = wave_sum(ssa); ssl = wave_sum(ssl); sss = wave_sum(sss);
            const float ra = 1.0f / sqrtf(ssa * (1.0f / 512.0f) + EPS), rl = 1.0f / sqrtf(ssl * (1.0f / 256.0f) + EPS), rs = 1.0f / sqrtf(sss * (1.0f / 256.0f) + EPS);
            u32x4 wa; wa.x = cvt_pk(av[0] * ra * ga0[0], av[1] * ra * ga0[1]); wa.y = cvt_pk(av[2] * ra * ga0[2], av[3] * ra * ga0[3]); wa.z = cvt_pk(av[4] * ra * ga1[0], av[5] * ra * ga1[1]); wa.w = cvt_pk(av[6] * ra * ga1[2], av[7] * ra * ga1[3]);
            *(u32x4*)(hb + (size_t)row * DM + 8 * lane) = wa;
            u32x2 wl; wl.x = cvt_pk(lru[0] * rl * gl[0], lru[1] * rl * gl[1]); wl.y = cvt_pk(lru[2] * rl * gl[2], lru[3] * rl * gl[3]);
            *(u32x2*)(hb + (size_t)row * DM + 512 + c4) = wl;
            u32x2 wsv; wsv.x = cvt_pk(scv[0] * rs * gs[0], scv[1] * rs * gs[1]); wsv.y = cvt_pk(scv[2] * rs * gs[2], scv[3] * rs * gs[3]);
            *(u32x2*)(hb + (size_t)row * DM + 768 + c4) = wsv;
        }
        pm1 = p0; p0 = pp1;
    }
}
__device__ __forceinline__ void attention_phase(const Params& P, int l, char* lds, int G) {
    using abf = attn_body::bf16;
    const abf* Q = (const abf*)(P.ws + OFF_Q); const abf* K = (const abf*)(P.ws + OFF_K); const abf* V = (const abf*)(P.ws + OFF_V); abf* O = (abf*)(P.ws + OFF_ATT);
    if (blockIdx.x < NBATCH) lru2_batch(P, blockIdx.x);
    const int nunits = NBATCH * 8 * 32 + ((l + 1 < DEPTH) ? NBATCH * 8 : 0);
    for (int uid = blockIdx.x; uid < nunits; uid += G) {
        int b, h, NT; size_t qrow;
        if (uid < NBATCH * 8 * 32) { b = uid & 7; const int rest = uid >> 3, kvh = rest >> 7, u = rest & 127; h = kvh * 4 + (u >> 5); qrow = (size_t)b * SEQ + (u & 31) * 256; NT = NCHUNK; }
        else { const int v = uid - NBATCH * 8 * 32; b = v & 7; h = v >> 3; qrow = (size_t)MLAT + b * CTXL; NT = 4; }
        const size_t kvoff = (size_t)b * KEYS * 128 + (h >> 2) * 64;
        attn_body::attn_unit<8>(Q + qrow * 512 + h * 64, K + kvoff, V + kvoff, O + qrow * 512 + h * 64, NT, lds);
    }
}

#define XB_TMO      128
#define XB_XCNT(j)  (256  + 64 * (j))
#define XB_XSUB(j)  (1280 + 64 * (j))
#define XB_XGEN(j)  (2304 + 64 * (j))
#define XB_TOP      3328
#define XB_TOPGEN   3392
#define XCD_BAR_WORDS 3456
#define XB_SPIN_CAP (1u << 18)

__device__ __forceinline__ unsigned xb_ld(unsigned* p)              { return __hip_atomic_load(p, __ATOMIC_RELAXED, __HIP_MEMORY_SCOPE_AGENT); }
__device__ __forceinline__ unsigned xb_add(unsigned* p, unsigned v) { return __hip_atomic_fetch_add(p, v, __ATOMIC_RELAXED, __HIP_MEMORY_SCOPE_AGENT); }
__device__ __forceinline__ unsigned xb_xcc_id() { return (unsigned)__builtin_amdgcn_s_getreg((3 << 11) | 20) & 0xFu; }
#define XB_SPIN(cond, bar) do { unsigned _sp = 0; while (cond) { __builtin_amdgcn_s_sleep(1); \
    if ((++_sp & 255u) == 0u) { if (xb_ld(&(bar)[XB_TMO])) break; if (_sp > XB_SPIN_CAP) { atomicAdd(&(bar)[XB_TMO], 1u); break; } } } } while (0)

struct XcdBarrier {
    unsigned* bar; unsigned x;
    volatile LAS unsigned* st;
};

__device__ __forceinline__ XcdBarrier xcd_barrier_post(unsigned* bar, volatile LAS unsigned* st) {
    XcdBarrier b; b.bar = bar; b.x = xb_xcc_id(); b.st = st;
    if (threadIdx.x == 0) (void)xb_add(&bar[XB_XCNT(b.x)], 1u);
    return b;
}
__device__ __forceinline__ void xcd_barrier_complete(unsigned* bar, unsigned x, unsigned& nloc, unsigned& nx) {
    const unsigned G = gridDim.x * gridDim.y * gridDim.z;
    unsigned sum, cnt, mine, sp = 0u;
    for (;;) {
        sum = 0u; cnt = 0u; mine = 0u;
#pragma unroll
        for (unsigned j = 0; j < 16; ++j) { const unsigned c = xb_ld(&bar[XB_XCNT(j)]); sum += c; cnt += (c > 0u) ? 1u : 0u; mine = (j == x) ? c : mine; }
        if (sum == G) break;
        __builtin_amdgcn_s_sleep(1);
        if ((++sp & 255u) == 0u) { if (xb_ld(&bar[XB_TMO])) break; if (sp > XB_SPIN_CAP) { atomicAdd(&bar[XB_TMO], 1u); break; } }
    }
    nloc = mine > 0u ? mine : 1u; nx = cnt > 0u ? cnt : 1u;
}

__device__ __forceinline__ void xcd_barrier(const XcdBarrier& b) {
    asm volatile("s_waitcnt vmcnt(0)" ::: "memory");
    __syncthreads();
    if (threadIdx.x == 0) {
        unsigned* bar = b.bar; unsigned bx_ = b.x; asm volatile("" : "+s"(bx_));
        __builtin_amdgcn_s_waitcnt(0);
        unsigned nloc = b.st[0], nx = b.st[1];
        if (nloc == 0u) { xcd_barrier_complete(bar, bx_, nloc, nx); b.st[0] = nloc; b.st[1] = nx; }
        const unsigned old = xb_add(&bar[XB_XSUB(bx_)], 1u);
        const unsigned gen = old / nloc;
        if (old + 1u == (gen + 1u) * nloc) {
            __builtin_amdgcn_fence(__ATOMIC_RELEASE, "agent");
            asm volatile("s_waitcnt vmcnt(0)" ::: "memory");
            const unsigned og = xb_add(&bar[XB_TOP], 1u);
            const unsigned tg = og / nx;
            if (og + 1u == (tg + 1u) * nx) xb_add(&bar[XB_TOPGEN], 1u);
            else XB_SPIN(xb_ld(&bar[XB_TOPGEN]) == tg, bar);
            __builtin_amdgcn_fence(__ATOMIC_ACQUIRE, "agent");
            xb_add(&bar[XB_XGEN(bx_)], 1u);
            asm volatile("s_waitcnt vmcnt(0)" ::: "memory");
        } else {
            XB_SPIN(xb_ld(&bar[XB_XGEN(bx_)]) == gen, bar);
            __builtin_amdgcn_fence(__ATOMIC_ACQUIRE, "agent");
            asm volatile("s_waitcnt vmcnt(0)" ::: "memory");
        }
    }
    __syncthreads();
}

#ifndef PH_MASK
#define PH_MASK 0x1FF
#endif
__global__ void __launch_bounds__(NTHREADS, 2) fwd_megakernel(Params P) {
    extern __shared__ __attribute__((aligned(16))) unsigned char lds_raw[];
    LAS unsigned char* lds = (LAS unsigned char*)lds_raw;
    cg::grid_group grid = cg::this_grid();
    volatile LAS unsigned* bst = (volatile LAS unsigned*)(lds + LDS_BAR_OFF);
    if (threadIdx.x < 2) bst[threadIdx.x] = 0u;
    __syncthreads();
    const XcdBarrier xbar = xcd_barrier_post((unsigned*)(P.ws + OFF_CTL), bst);
#define GRID_SYNC() xcd_barrier(xbar)
    const int G = gridDim.x;
    unsigned char* ws = P.ws;
    if constexpr (PH_MASK & 1) prologue_phase(P, lds, G);
    grid.sync();
    if constexpr (PH_MASK & 2) norm_phase(P, 0, 0, 0, MTOT, true, 0, G);
    GRID_SYNC();
    for (int step = 0; step < DEPTH * 3; ++step) {
        const int l = step / 3, s3 = step % 3;
        const bool last = (l == DEPTH - 1);
        const int Mn = (last && s3 == 2) ? MLAT : MTOT;
        unsigned char* wb = ws + OFF_WB + (size_t)l * WB_LAYER;
        pg8::Gemm gr; pg8::EpiResid er; int Mr;
        const float* modl = (const float*)(ws + OFF_MOD) + (size_t)l * 9 * MODW;
        if (s3 != 1) {
            const int f = s3 >> 1;
            { pg8::Gemm g{(const bf16_t*)(ws + OFF_HBUF), (const bf16_t*)(wb + WB_FFIN + f * WB_FFIN_SZ), Mn, NFF2, DM};
              pg8::StaticOrder S; S.init(Mn, NFF2, G, (int)blockIdx.x);
              pg8::EpiSwiglu E{(bf16_t*)(ws + OFF_MID)};
              if constexpr (PH_MASK & 4) pg8::gemm_phase<pg8::EpiSwiglu, pg8::StaticOrder, true, true>(lds, g, S, E); }
            GRID_SYNC();
            Mr = Mn;
            gr = pg8::Gemm{(const bf16_t*)(ws + OFF_MID), (const bf16_t*)(wb + WB_FFOUT + f * WB_FFOUT_SZ), Mr, DM, DFF};
            er = pg8::EpiResid{(bf16_t*)(ws + OFF_XRES), P.in[0], P.in[2], modl + (3 * s3 + 2) * DM, 0.5f, step == 0 ? 1 : 0};
        } else {
            { LAS float* tab = (LAS float*)(lds + LDS_TAB_OFF);
              for (int i = opaque_tid(); i < 4096 + 128; i += NTHREADS) tab[i] = i < 4096 ? ((const float*)(ws + OFF_ROPE))[i] : (i < 4160 ? P.in[10][l * 64 + i - 4096] : P.in[11][l * 64 + i - 4160]);
              __syncthreads(); }
            { pg8::Gemm g{(const bf16_t*)(ws + OFF_HBUF), (const bf16_t*)(wb + WB_WIN), MTOT, INW, DM};
              pg8::StaticOrder S; S.init(MTOT, INW, G, (int)blockIdx.x);
              pg8::EpiWin E{(bf16_t*)(ws + OFF_Q), (bf16_t*)(ws + OFF_K), (bf16_t*)(ws + OFF_V), (bf16_t*)(ws + OFF_U5), (const LAS float*)(lds + LDS_TAB_OFF), 0.125f * 1.4426950408889634f};
              if constexpr (PH_MASK & 8) pg8::gemm_phase<pg8::EpiWin, pg8::StaticOrder, true, true>(lds, g, S, E); }
            GRID_SYNC();
            if constexpr (PH_MASK & 16) lru1_phase(P, l, lds, G);
            GRID_SYNC();
            if constexpr (PH_MASK & 32) attention_phase(P, l, (char*)lds_raw, G);
            GRID_SYNC();
            Mr = last ? MLAT : MTOT;
            if constexpr (PH_MASK & 64) merge_phase(P, l, Mr, G);
            GRID_SYNC();
            gr = pg8::Gemm{(const bf16_t*)(ws + OFF_HBUF), (const bf16_t*)(wb + WB_WOUT), Mr, DM, DM};
            er = pg8::EpiResid{(bf16_t*)(ws + OFF_XRES), P.in[0], P.in[2], modl + 5 * DM, 1.0f, 0};
        }
        const bool ctxr = (Mr == MTOT), has_next = step + 1 < DEPTH * 3;
        const int l2 = (step + 1) / 3, s32 = (step + 1) % 3, Mn2 = (l2 == DEPTH - 1 && s32 == 2) ? MLAT : MTOT;
        for (int pass = 0; pass < (ctxr ? 2 : 1); ++pass) {
            pg8::ResidOrder S; S.so.init(MLAT, DM, G, (int)blockIdx.x); S.single = pass; S.pm = 256 + ((int)blockIdx.x >> 2); S.pn = (int)blockIdx.x & 3;
            if (pass == 1 && (int)blockIdx.x >= 32) { if constexpr (PH_MASK & 2) norm_phase(P, l2, s32, 0, MLAT, false, 32, G - 32); }
            else { if constexpr (PH_MASK & 128) pg8::gemm_phase<pg8::EpiResid, pg8::ResidOrder, true, true>(lds, gr, S, er); }
            GRID_SYNC();
        }
        if (has_next) {
            if (ctxr) { if constexpr (PH_MASK & 2) norm_phase(P, l2, s32, MLAT, MTOT, false, 0, G); }
            else { if constexpr (PH_MASK & 2) norm_phase(P, l2, s32, 0, Mn2, false, 0, G); }
            GRID_SYNC();
        }
    }
    if constexpr (PH_MASK & 256) final_norm_phase(P, G);
}

extern "C" void kernel_launch(void* const* d_in, const int* in_sizes, int n_in, void* d_out, int out_size, void* d_ws, size_t ws_size, hipStream_t stream) {
    static int grid = 0;
    if (grid == 0) {
        if (n_in != 24 || out_size != MLAT * DM || ws_size < WS_NEED) { fprintf(stderr, "kernel_launch: unexpected shapes (n_in %d, out %d, ws %zu, need %zu)\n", n_in, out_size, ws_size, (size_t)WS_NEED); grid = -1; return; }
        int dev = 0, cus = 0, per_cu = 0;
        hipGetDevice(&dev); hipDeviceGetAttribute(&cus, hipDeviceAttributeMultiprocessorCount, dev);
        if (hipFuncSetAttribute((const void*)fwd_megakernel, hipFuncAttributeMaxDynamicSharedMemorySize, LDS_BYTES) != hipSuccess) { fprintf(stderr, "kernel_launch: hipFuncSetAttribute failed\n"); grid = -1; return; }
        if (hipOccupancyMaxActiveBlocksPerMultiprocessor(&per_cu, (const void*)fwd_megakernel, NTHREADS, LDS_BYTES) != hipSuccess || per_cu < 1) { fprintf(stderr, "kernel_launch: occupancy query says %d\n", per_cu); per_cu = 1; (void)hipGetLastError(); }
        grid = cus * 1;
        if (grid % 8 != 0 || grid <= 0) grid = 256;
        fprintf(stderr, "kernel_launch: grid %d (cus %d, per_cu %d)\n", grid, cus, per_cu);
    }
    if (grid < 0) return;
    Params p{};
    for (int i = 0; i < 24; ++i) p.in[i] = (const float*)d_in[i];
    p.out = (float*)d_out; p.ws = (unsigned char*)d_ws;
    if (hipMemsetAsync((unsigned char*)d_ws + OFF_CTL, 0, CTL_BYTES, stream) != hipSuccess) { fprintf(stderr, "kernel_launch: memset of the barrier words failed\n"); return; }
    void* args[] = {&p};
    hipError_t e = hipLaunchCooperativeKernel((const void*)fwd_megakernel, dim3(grid), dim3(NTHREADS), args, LDS_BYTES, stream);
    if (e != hipSuccess) fprintf(stderr, "kernel_launch: cooperative launch failed: %s (grid %d)\n", hipGetErrorString(e), grid);
}
```

```cpp
#include <hip/hip_runtime.h>
#include <hip/hip_bf16.h>
#include <hip/hip_cooperative_groups.h>
#include <cstdio>
#include <cstdint>
#include <cmath>
namespace cg = cooperative_groups;

constexpr int DM = 1024, NBATCH = 8, SEQ = 8192, CTXL = 256, DEPTH = 2;
constexpr int MLAT = NBATCH * SEQ, MCTX = NBATCH * CTXL, MTOT = MLAT + MCTX;
constexpr int DFF = 2816, NFF2 = 2 * DFF, INW = 2048, NMODV = 9, MODW = 9 * DM;
constexpr int KEYS = SEQ + CTXL, NCHUNK = KEYS / 64;
constexpr float EPS = 1e-6f;
constexpr int NTHREADS = 512;
constexpr int LDS_BYTES = 155648;
constexpr int LDS_TAB_OFF = 131072;

constexpr size_t MiB = 1u << 20;
constexpr size_t OFF_MOD = 0;
constexpr size_t OFF_ROPE = 1 * MiB;
constexpr size_t OFF_LW = 1 * MiB + 65536;
constexpr size_t OFF_CSUM = 2 * MiB;
constexpr size_t OFF_CARRY = 7 * MiB;
constexpr size_t OFF_CTL = 9 * MiB + 524288, CTL_BYTES = 65536;
constexpr int LDS_BAR_OFF = 155392;
constexpr size_t OFF_WB = 10 * MiB;
constexpr size_t WB_LAYER = 39 * MiB;
constexpr size_t WB_FFIN = 0, WB_FFIN_SZ = (size_t)NFF2 * DM * 2;
constexpr size_t WB_FFOUT = 2 * WB_FFIN_SZ, WB_FFOUT_SZ = (size_t)DM * DFF * 2;
constexpr size_t WB_WIN = WB_FFOUT + 2 * WB_FFOUT_SZ, WB_WIN_SZ = (size_t)INW * DM * 2;
constexpr size_t WB_WOUT = WB_WIN + WB_WIN_SZ;
static_assert(WB_WOUT + (size_t)DM * DM * 2 == WB_LAYER, "weight map");
constexpr size_t OFF_XRES = 88 * MiB;
constexpr size_t OFF_HBUF = 352 * MiB;
constexpr size_t OFF_R1 = 484 * MiB;
constexpr size_t OFF_MID = OFF_R1;
constexpr size_t OFF_Q = OFF_R1;
constexpr size_t OFF_K = OFF_R1 + 66 * MiB;
constexpr size_t OFF_V = OFF_K + 16 * MiB + 524288;
constexpr size_t OFF_U5 = OFF_R1 + 99 * MiB;
constexpr size_t U5_STRIDE = (size_t)MTOT * 256;
constexpr size_t OFF_S = OFF_R1 + 264 * MiB;
constexpr size_t OFF_PP = OFF_R1 + 330 * MiB;
constexpr size_t OFF_ATT = OFF_R1 + 396 * MiB;
constexpr size_t WS_NEED = OFF_ATT + 66 * MiB;

#define LAS __attribute__((address_space(3)))
typedef unsigned short bf16_t;
typedef float f32x4 __attribute__((ext_vector_type(4)));
typedef float f32x2 __attribute__((ext_vector_type(2)));
typedef unsigned u32x4 __attribute__((ext_vector_type(4)));
typedef unsigned u32x2 __attribute__((ext_vector_type(2)));

struct Params { const float* in[24]; float* out; unsigned char* ws; };

__device__ __forceinline__ unsigned cvt_pk(float lo, float hi) { unsigned r; asm volatile("v_cvt_pk_bf16_f32 %0, %1, %2" : "=v"(r) : "v"(lo), "v"(hi)); return r; }
__device__ __forceinline__ float bf_lo(unsigned w) { return __uint_as_float(w << 16); }
__device__ __forceinline__ float bf_hi(unsigned w) { return __uint_as_float(w & 0xffff0000u); }
#define DPP_F(v, ctrl) __int_as_float(__builtin_amdgcn_mov_dpp(__float_as_int(v), (ctrl), 0xF, 0xF, true))
__device__ __forceinline__ float wave_sum(float v) {
    v += DPP_F(v, 0xB1);
    v += DPP_F(v, 0x4E);
    v += DPP_F(v, 0x141);
    v += DPP_F(v, 0x140);
    v += __shfl_xor(v, 16); v += __shfl_xor(v, 32);
    return v;
}
__device__ __forceinline__ int opaque_tid() { int t = threadIdx.x; asm volatile("" : "+v"(t)); return t; }
__device__ __forceinline__ float sigmoidf_(float z) { return __builtin_amdgcn_rcpf(1.0f + __expf(-z)); }
namespace pg8 {
#define PG8_LAS __attribute__((address_space(3)))
typedef unsigned short bf16_t;
typedef short bf16x8 __attribute__((ext_vector_type(8)));
typedef float f32x4 __attribute__((ext_vector_type(4)));
typedef unsigned u32x4 __attribute__((ext_vector_type(4)));
constexpr int BM = 256, BK = 64, HALF = 128, HTB = HALF * BK * 2  , STAGE_BYTES = 8 * HTB, NXCD = 8, WGM = 4;

__host__ __device__ __forceinline__ int lds_byte(int r, int c) { const int st = (r >> 4) * 2 + (c >> 5), rr = r & 15, cc = c & 31, ob = rr * 64 + cc * 2; return st * 1024 + (ob ^ (((ob >> 9) & 1) << 5)); }
__host__ __device__ __forceinline__ void stage_rc(int b, int& R, int& C) { const int st = b / 1024, sb = b % 1024, swz = sb ^ (((sb >> 9) & 1) << 5); R = (st >> 1) * 16 + swz / 64; C = (st & 1) * 32 + (swz % 64) / 2; }
__host__ __device__ __forceinline__ int perm32(int rho) { const int n = rho >> 4, i = rho & 15; return 8 * (i >> 2) + 4 * n + (i & 3); }

struct Unit { int pm, pn; };
struct Gemm { const bf16_t* A; const bf16_t* Bt; int M, N, K; };

struct StaticOrder {
    int nM, nN, nwg, G, c;
    __host__ __device__ void init(int M, int N, int G_, int c_) { nM = M / BM; nN = N / BM; nwg = nM * nN; G = G_; c = c_; }
    __host__ __device__ bool next(int i, Unit& u) const {
        const long L = (long)i * G + c; if (L >= nwg) return false;
        int wgid = (int)L; { const int q = nwg / NXCD, r = nwg % NXCD, xcd = wgid % NXCD, off = wgid / NXCD; wgid = (xcd < r ? xcd * (q + 1) : r * (q + 1) + (xcd - r) * q) + off; }
        const int nig = WGM * nN, gid = wgid / nig, fm = gid * WGM, gsz = (nM - fm) < WGM ? (nM - fm) : WGM;
        u.pm = fm + ((wgid % nig) % gsz); u.pn = (wgid % nig) / gsz; return true;
    }
    __device__ __forceinline__ void a_ready(const Unit&) const {}
    __device__ __forceinline__ void done(const Unit&) const {}
};
__device__ __forceinline__ unsigned cvt_pk_bf16(float lo, float hi) { unsigned r; asm volatile("v_cvt_pk_bf16_f32 %0, %1, %2" : "=v"(r) : "v"(lo), "v"(hi)); return r; }

struct EpiSwiglu {
    static constexpr bool PERM = false, AFTER_DRAIN = false;
    bf16_t* O;
    __device__ __forceinline__ void operator()(const f32x4 (&acc)[2][2][4][2], const Unit& u, int wr, int wc, int fr, int fq) const {
        const int row0 = u.pm * BM + wr * 64 + fr, col0 = u.pn * 128 + wc * 32 + 8 * fq;
#pragma unroll
        for (int ai = 0; ai < 2; ++ai)
#pragma unroll
            for (int m = 0; m < 4; ++m) {
                bf16_t* rowp = O + (size_t)(row0 + ai * HALF + m * 16) * 2816 + col0;
                float v[8];
#pragma unroll
                for (int n = 0; n < 2; ++n)
#pragma unroll
                    for (int j = 0; j < 4; ++j) { const float g = acc[ai][0][m][n][j], up = acc[ai][1][m][n][j]; v[n * 4 + j] = g * __builtin_amdgcn_rcpf(1.0f + __expf(-g)) * up; }
                u32x4 w; w.x = cvt_pk_bf16(v[0], v[1]); w.y = cvt_pk_bf16(v[2], v[3]); w.z = cvt_pk_bf16(v[4], v[5]); w.w = cvt_pk_bf16(v[6], v[7]);
                *(u32x4*)rowp = w;
            }
    }
};
struct EpiResid {
    static constexpr bool PERM = false, AFTER_DRAIN = false;
    bf16_t* X; const float* Xlat; const float* Xctx; const float* gate; float scale; int first;
    __device__ __forceinline__ void operator()(const f32x4 (&acc)[2][2][4][2], const Unit& u, int wr, int wc, int fr, int fq) const {
        const int v = u.pm < 256 ? (u.pm >> 5) : 8;
        const int row0 = u.pm * BM + wr * 64 + fr, col0 = u.pn * BM + wc * 32 + 8 * fq;
        const float* gp = gate + (size_t)v * 9216 + col0;
        f32x4 gv[2][2];
#pragma unroll
        for (int bj = 0; bj < 2; ++bj)
#pragma unroll
            for (int n = 0; n < 2; ++n) gv[bj][n] = *(const f32x4*)(gp + bj * HALF + n * 4) * scale;
#pragma unroll
        for (int ai = 0; ai < 2; ++ai) {
            bf16_t* rowp = X + (size_t)(row0 + ai * HALF) * 1024 + col0;
            f32x4 xv[4][2][2];
            if (first) {
                const float* rowr = (u.pm < 256 ? Xlat + (size_t)(row0 + ai * HALF) * 1024 : Xctx + (size_t)(row0 + ai * HALF - 65536) * 1024) + col0;
#pragma unroll
                for (int m = 0; m < 4; ++m)
#pragma unroll
                    for (int bj = 0; bj < 2; ++bj)
#pragma unroll
                        for (int n = 0; n < 2; ++n) xv[m][bj][n] = *(const f32x4*)(rowr + (size_t)m * 16 * 1024 + bj * HALF + n * 4);
            } else {
                u32x4 raw[4][2];
#pragma unroll
                for (int m = 0; m < 4; ++m)
#pragma unroll
                    for (int bj = 0; bj < 2; ++bj) raw[m][bj] = *(const u32x4*)(rowp + (size_t)m * 16 * 1024 + bj * HALF);
#pragma unroll
                for (int m = 0; m < 4; ++m)
#pragma unroll
                    for (int bj = 0; bj < 2; ++bj) { const u32x4 r = raw[m][bj];
                        xv[m][bj][0] = (f32x4){__uint_as_float(r.x << 16), __uint_as_float(r.x & 0xffff0000u), __uint_as_float(r.y << 16), __uint_as_float(r.y & 0xffff0000u)};
                        xv[m][bj][1] = (f32x4){__uint_as_float(r.z << 16), __uint_as_float(r.z & 0xffff0000u), __uint_as_float(r.w << 16), __uint_as_float(r.w & 0xffff0000u)}; }
            }
#pragma unroll
            for (int m = 0; m < 4; ++m)
#pragma unroll
                for (int bj = 0; bj < 2; ++bj) { const f32x4 y0 = xv[m][bj][0] + gv[bj][0] * acc[ai][bj][m][0], y1 = xv[m][bj][1] + gv[bj][1] * acc[ai][bj][m][1];
                    u32x4 w; w.x = cvt_pk_bf16(y0[0], y0[1]); w.y = cvt_pk_bf16(y0[2], y0[3]); w.z = cvt_pk_bf16(y1[0], y1[1]); w.w = cvt_pk_bf16(y1[2], y1[3]);
                    *(u32x4*)(rowp + (size_t)m * 16 * 1024 + bj * HALF) = w; }
        }
    }
};
struct ResidOrder {
    StaticOrder so; int single, pm, pn;
    __device__ __forceinline__ bool next(int i, Unit& u) const { if (single) { if (i > 0) return false; u.pm = pm; u.pn = pn; return true; } return so.next(i, u); }
    __device__ __forceinline__ void a_ready(const Unit&) const {}
    __device__ __forceinline__ void done(const Unit&) const {}
};
struct EpiWin {
    static constexpr bool PERM = false, AFTER_DRAIN = false;
    bf16_t *Q, *K, *V, *U5; const PG8_LAS float* tab; float qscale;
    __device__ __forceinline__ void operator()(const f32x4 (&acc)[2][2][4][2], const Unit& u, int wr, int wc, int fr, int fq) const {
        const int row0 = u.pm * BM + wr * 64 + fr;
        if (u.pn >= 3) {
            bf16_t* base = U5 + (size_t)(u.pn - 3) * ((size_t)67584 * 256) + wc * 32 + 8 * fq;
#pragma unroll
            for (int ai = 0; ai < 2; ++ai)
#pragma unroll
                for (int m = 0; m < 4; ++m) { bf16_t* rowp = base + (size_t)(row0 + ai * HALF + m * 16) * 256;
#pragma unroll
                    for (int bj = 0; bj < 2; ++bj) { const f32x4 v0 = acc[ai][bj][m][0], v1 = acc[ai][bj][m][1];
                        u32x4 w; w.x = cvt_pk_bf16(v0[0], v0[1]); w.y = cvt_pk_bf16(v0[2], v0[3]); w.z = cvt_pk_bf16(v1[0], v1[1]); w.w = cvt_pk_bf16(v1[2], v1[3]);
                        *(u32x4*)(rowp + bj * HALF) = w; } }
            return;
        }
        const int kind = u.pn < 2 ? 0 : (wc < 2 ? 1 : 2);
        const bool latent = u.pm < 256;
        const PG8_LAS float* gsrc = tab + 4096 + (kind == 0 ? 0 : 64);
#pragma unroll
        for (int ai = 0; ai < 2; ++ai)
#pragma unroll
            for (int m = 0; m < 4; ++m) {
                const int row = row0 + ai * HALF + m * 16;
                f32x4 y[2][2];
#pragma unroll
                for (int bj = 0; bj < 2; ++bj)
#pragma unroll
                    for (int n = 0; n < 2; ++n) y[bj][n] = acc[ai][bj][m][n];
                if (kind != 2) {
                    float ss = 0.f;
#pragma unroll
                    for (int bj = 0; bj < 2; ++bj)
#pragma unroll
                        for (int n = 0; n < 2; ++n) { const f32x4 t = y[bj][n]; ss += (t[0] * t[0] + t[1] * t[1]) + (t[2] * t[2] + t[3] * t[3]); }
                    ss += __shfl_xor(ss, 16); ss += __shfl_xor(ss, 32);
                    const float r = 1.0f / sqrtf(ss * (1.0f / 64.0f) + 1e-6f);
#pragma unroll
                    for (int bj = 0; bj < 2; ++bj)
#pragma unroll
                        for (int n = 0; n < 2; ++n) y[bj][n] = y[bj][n] * r * *(const PG8_LAS f32x4*)(gsrc + 32 * bj + 16 * n + 4 * fq);
                    if (latent) {
                        const int s = row & 8191;
#pragma unroll
                        for (int bj = 0; bj < 2; ++bj) { const int pos = bj == 0 ? (s >> 6) : (s & 63);
                            const f32x4 c4 = *(const PG8_LAS f32x4*)(tab + pos * 16 + 4 * fq), s4 = *(const PG8_LAS f32x4*)(tab + 2048 + pos * 16 + 4 * fq);
                            const f32x4 x1 = y[bj][0], x2 = y[bj][1];
                            y[bj][0] = x1 * c4 - x2 * s4; y[bj][1] = x2 * c4 + x1 * s4; }
                    }
                }
                bf16_t* dst;
                if (kind == 0) { dst = Q + (size_t)row * 512 + (u.pn * 4 + wc) * 64;
#pragma unroll
                    for (int bj = 0; bj < 2; ++bj)
#pragma unroll
                        for (int n = 0; n < 2; ++n) y[bj][n] = y[bj][n] * qscale;
                } else {
                    size_t kr;
                    if (latent) kr = (size_t)(row >> 13) * 8448 + 256 + (row & 8191);
                    else { const int rc = row - 65536; kr = (size_t)(rc >> 8) * 8448 + (rc & 255); }
                    dst = (kind == 1 ? K : V) + kr * 128 + (wc & 1) * 64;
                }
                if (kind != 2) {
#pragma unroll
                    for (int bj = 0; bj < 2; ++bj) { u32x4 w; w.x = cvt_pk_bf16(y[bj][0][0], y[bj][0][1]); w.y = cvt_pk_bf16(y[bj][0][2], y[bj][0][3]); w.z = cvt_pk_bf16(y[bj][1][0], y[bj][1][1]); w.w = cvt_pk_bf16(y[bj][1][2], y[bj][1][3]);
                        *(u32x4*)(dst + 32 * bj + 8 * fq) = w; }
                } else {
#pragma unroll
                    for (int bj = 0; bj < 2; ++bj)
#pragma unroll
                        for (int n = 0; n < 2; ++n) { u32x2 w; w.x = cvt_pk_bf16(y[bj][n][0], y[bj][n][1]); w.y = cvt_pk_bf16(y[bj][n][2], y[bj][n][3]);
                            *(u32x2*)(dst + 32 * bj + 16 * n + 4 * fq) = w; }
                }
            }
    }
};
template <class Epi, class Sched, bool ALIGN_EPI = false, bool SP2 = false>
__device__ __forceinline__ void gemm_phase(PG8_LAS unsigned char* lds, const Gemm g, const Sched& S, const Epi& E) {
    const int tid = opaque_tid(), wid = __builtin_amdgcn_readfirstlane(tid >> 6), lane = tid & 63, wr = wid >> 2, wc = wid & 3, fr = lane & 15, fq = lane >> 4;
    const int K = g.K, nt = K / BK;
    unsigned voffA[2], voffB[2];
#pragma unroll
    for (int i = 0; i < 2; ++i) { int R, C; stage_rc(tid * 16 + i * 8192, R, C); const int Rb = Epi::PERM ? ((R & ~31) + perm32(R & 31)) : R;
        voffA[i] = (unsigned)(R * K + C) * 2u; voffB[i] = (unsigned)(Rb * K + C) * 2u; }
    const size_t kstep = (size_t)(BK * 2);
    const size_t hstep = (size_t)HALF * K * 2;
    const size_t tstep = 2 * hstep;
    const unsigned ldsw = (unsigned)wid * 1024u;
    const int aoff = lds_byte(wr * 64 + fr, fq * 8), boff = lds_byte(wc * 32 + fr, fq * 8);
#define PG8_SA(b, h) (((b) * 2 + (h)) * HTB)
#define PG8_SB(b, h) ((4 + (b) * 2 + (h)) * HTB)
#define PG8_STAGE(bufoff, gbase, voff) do { _Pragma("unroll") for (int _i = 0; _i < 2; ++_i) \
        __builtin_amdgcn_global_load_lds((const unsigned*)((const char*)(gbase) + (voff)[_i]), (PG8_LAS unsigned*)(lds + (bufoff) + ldsw + _i * 8192), 16, 0, 0); } while (0)
#define PG8_LDA(dst, b, h) do { _Pragma("unroll") for (int m = 0; m < 4; ++m) _Pragma("unroll") for (int k = 0; k < 2; ++k) dst[m][k] = *(const PG8_LAS bf16x8*)(lds + PG8_SA(b, h) + aoff + m * 2048 + k * 1024); } while (0)
#define PG8_LDB(dst, b, h) do { _Pragma("unroll") for (int n = 0; n < 2; ++n) _Pragma("unroll") for (int k = 0; k < 2; ++k) dst[n][k] = *(const PG8_LAS bf16x8*)(lds + PG8_SB(b, h) + boff + n * 2048 + k * 1024); } while (0)
#define PG8_MMA(ai, bj, At, Bt) do { __builtin_amdgcn_s_setprio(1); _Pragma("unroll") for (int m = 0; m < 4; ++m) _Pragma("unroll") for (int n = 0; n < 2; ++n) _Pragma("unroll") for (int k = 0; k < 2; ++k) \
        acc[ai][bj][m][n] = __builtin_amdgcn_mfma_f32_16x16x32_bf16(Bt[n][k], At[m][k], acc[ai][bj][m][n], 0, 0, 0); __builtin_amdgcn_s_setprio(0); } while (0)
#define PG8_WAIT_V(n) asm volatile("s_waitcnt vmcnt(" #n ")" ::: "memory")
#define PG8_WAIT_L(n) asm volatile("s_waitcnt lgkmcnt(" #n ")" ::: "memory")
#define PG8_BAR __builtin_amdgcn_s_barrier()
#define PG8_SCHED __builtin_amdgcn_sched_barrier(0)
    Unit cur, nxt; int ui = 0;
    if (!S.next(0, cur)) return;
    f32x4 acc[2][2][4][2];
#pragma unroll
    for (int a = 0; a < 2; ++a)
#pragma unroll
        for (int b = 0; b < 2; ++b)
#pragma unroll
            for (int m = 0; m < 4; ++m)
#pragma unroll
                for (int n = 0; n < 2; ++n) acc[a][b][m][n] = (f32x4){0.f, 0.f, 0.f, 0.f};
    bf16x8 At[4][2], B0[2][2], B1[2][2];
    const char* cA = (const char*)g.A + (size_t)cur.pm * tstep; const char* cB = (const char*)g.Bt + (size_t)cur.pn * tstep;
    S.a_ready(cur);
    if constexpr (SP2) {
        PG8_STAGE(PG8_SB(0, 0), cB, voffB); PG8_STAGE(PG8_SB(0, 1), cB + hstep, voffB); PG8_STAGE(PG8_SA(0, 0), cA, voffA); PG8_STAGE(PG8_SA(0, 1), cA + hstep, voffA);
        if (wr == 1) PG8_BAR;
        PG8_WAIT_V(2); PG8_BAR;
        PG8_STAGE(PG8_SB(1, 0), cB + kstep, voffB); PG8_STAGE(PG8_SA(1, 0), cA + kstep, voffA); PG8_STAGE(PG8_SB(1, 1), cB + hstep + kstep, voffB);
        PG8_WAIT_V(6); PG8_BAR;
    } else {
        PG8_STAGE(PG8_SB(0, 0), cB, voffB); PG8_STAGE(PG8_SA(0, 0), cA, voffA); PG8_STAGE(PG8_SB(0, 1), cB + hstep, voffB); PG8_STAGE(PG8_SA(0, 1), cA + hstep, voffA);
        if (wr == 1) PG8_BAR;
        PG8_WAIT_V(4); PG8_BAR;
        PG8_STAGE(PG8_SB(1, 0), cB + kstep, voffB); PG8_STAGE(PG8_SA(1, 0), cA + kstep, voffA); PG8_STAGE(PG8_SB(1, 1), cB + hstep + kstep, voffB);
        PG8_WAIT_V(6); PG8_BAR;
    }
    for (;;) {
        const bool has_next = S.next(ui + 1, nxt);
        const char* nA = has_next ? (const char*)g.A + (size_t)nxt.pm * tstep : cA; const char* nB = has_next ? (const char*)g.Bt + (size_t)nxt.pn * tstep : cB;
        for (int t = 0; t < nt; t += 2) {
            const bool last = (t == nt - 2);
            const char* a1 = cA + (size_t)(t + 1) * kstep;
            const char* a2 = last ? nA : cA + (size_t)(t + 2) * kstep; const char* b2 = last ? nB : cB + (size_t)(t + 2) * kstep;
            const char* a3 = a2 + kstep; const char* b3 = b2 + kstep;
            if (last && has_next) S.a_ready(nxt);
            if constexpr (SP2) {
            PG8_LDB(B0, 0, 0); PG8_LDB(B1, 0, 1); PG8_SCHED; PG8_LDA(At, 0, 0); PG8_STAGE(PG8_SA(1, 1), a1 + hstep, voffA);
            PG8_WAIT_V(8); PG8_WAIT_L(0); PG8_BAR; PG8_MMA(0, 0, At, B0); PG8_MMA(0, 1, At, B1); PG8_BAR; PG8_SCHED;
            PG8_LDA(At, 0, 1); PG8_STAGE(PG8_SB(0, 0), b2, voffB); PG8_STAGE(PG8_SB(0, 1), b2 + hstep, voffB); PG8_STAGE(PG8_SA(0, 0), a2, voffA);
            PG8_WAIT_V(8); PG8_WAIT_L(0); PG8_BAR; PG8_MMA(1, 0, At, B0); PG8_MMA(1, 1, At, B1); PG8_BAR; PG8_SCHED;
            PG8_LDB(B0, 1, 0); PG8_LDB(B1, 1, 1); PG8_SCHED; PG8_LDA(At, 1, 0); PG8_STAGE(PG8_SA(0, 1), a2 + hstep, voffA);
            PG8_WAIT_V(8); PG8_WAIT_L(0); PG8_BAR; PG8_MMA(0, 0, At, B0); PG8_MMA(0, 1, At, B1); PG8_BAR; PG8_SCHED;
            PG8_LDA(At, 1, 1); PG8_STAGE(PG8_SB(1, 0), b3, voffB); PG8_STAGE(PG8_SB(1, 1), b3 + hstep, voffB); PG8_STAGE(PG8_SA(1, 0), a3, voffA);
            PG8_WAIT_V(8); PG8_WAIT_L(0); PG8_BAR; PG8_MMA(1, 0, At, B0); PG8_MMA(1, 1, At, B1); PG8_BAR; PG8_SCHED;
            } else {
            PG8_LDB(B0, 0, 0); PG8_SCHED; PG8_LDA(At, 0, 0); PG8_STAGE(PG8_SA(1, 1), a1 + hstep, voffA);
            PG8_WAIT_L(8); PG8_BAR; PG8_WAIT_L(0); PG8_MMA(0, 0, At, B0); PG8_BAR; PG8_SCHED;
            PG8_LDB(B1, 0, 1); PG8_STAGE(PG8_SB(0, 0), b2, voffB);
            PG8_BAR; PG8_WAIT_L(0); PG8_MMA(0, 1, At, B1); PG8_BAR;
            PG8_LDA(At, 0, 1); PG8_STAGE(PG8_SA(0, 0), a2, voffA);
            PG8_BAR; PG8_WAIT_L(0); PG8_MMA(1, 0, At, B0); PG8_BAR; PG8_SCHED;
            PG8_STAGE(PG8_SB(0, 1), b2 + hstep, voffB);
            PG8_WAIT_V(6); PG8_BAR; PG8_MMA(1, 1, At, B1); PG8_BAR;
            PG8_LDB(B0, 1, 0); PG8_SCHED; PG8_LDA(At, 1, 0); PG8_STAGE(PG8_SA(0, 1), a2 + hstep, voffA);
            PG8_WAIT_L(8); PG8_BAR; PG8_WAIT_L(0); PG8_MMA(0, 0, At, B0); PG8_BAR; PG8_SCHED;
            PG8_LDB(B1, 1, 1); PG8_STAGE(PG8_SB(1, 0), b3, voffB);
            PG8_BAR; PG8_WAIT_L(0); PG8_MMA(0, 1, At, B1); PG8_BAR;
            PG8_LDA(At, 1, 1); PG8_STAGE(PG8_SA(1, 0), a3, voffA);
            PG8_BAR; PG8_WAIT_L(0); PG8_MMA(1, 0, At, B0); PG8_BAR; PG8_SCHED;
            PG8_STAGE(PG8_SB(1, 1), b3 + hstep, voffB);
            PG8_WAIT_V(6); PG8_BAR; PG8_MMA(1, 1, At, B1); PG8_BAR;
            }
        }
        if constexpr (ALIGN_EPI) { if (wr == 0) PG8_BAR; }
        if constexpr (!Epi::AFTER_DRAIN) { E(acc, cur, wr, wc, fr, fq); S.done(cur); }
        if (!has_next) break;
#pragma unroll
        for (int a = 0; a < 2; ++a)
#pragma unroll
            for (int b = 0; b < 2; ++b)
#pragma unroll
                for (int m = 0; m < 4; ++m)
#pragma unroll
                    for (int n = 0; n < 2; ++n) acc[a][b][m][n] = (f32x4){0.f, 0.f, 0.f, 0.f};
        cur = nxt; cA = nA; cB = nB; ++ui;
        if constexpr (ALIGN_EPI) { if (wr == 1) PG8_BAR; }
    }
    PG8_WAIT_V(0);
    if constexpr (!ALIGN_EPI) { if (wr == 0) PG8_BAR; }
    PG8_BAR;
    if constexpr (Epi::AFTER_DRAIN) { E.fused(acc, cur, wr, wc, fr, fq, lds, wid, lane); S.done(cur); }
#undef PG8_SA
#undef PG8_SB
#undef PG8_STAGE
#undef PG8_LDA
#undef PG8_LDB
#undef PG8_MMA
#undef PG8_WAIT_V
#undef PG8_WAIT_L
#undef PG8_BAR
#undef PG8_SCHED
}
}

namespace attn_body {
using bf16=__hip_bfloat16;
using bf16x8=__attribute__((ext_vector_type(8)))short;
using s16x4=__attribute__((ext_vector_type(4)))short;
using f32x16=__attribute__((ext_vector_type(16)))float;
using u32x4=__attribute__((ext_vector_type(4)))unsigned;
constexpr int D=64, QP=512, KP=128, OP=512;
constexpr int NW=8,QBLK=32,QB=QBLK*NW,KVBLK=64;
__device__ __forceinline__ int crow(int r,int hi){return (r&3)+8*(r>>2)+4*hi;}
#define SBAR() __builtin_amdgcn_sched_barrier(0)
#define ATTN_STORE16(p,v) (*(u32x4*)(p)=(v))
constexpr int NSLOT=3, SLOTB=8192;
constexpr int LDS_K=0, LDS_V=NSLOT*SLOTB, LDS_WS=2*NSLOT*SLOTB, LDS_OST=LDS_WS+NW*64*4, LDS_BYTES=LDS_OST+NW*4096;
constexpr float C2=0.125f*1.4426950408889634f;
__device__ __forceinline__ void glds16(const void*gsrc,unsigned lds_dst){unsigned keep;
  asm volatile("s_mov_b32 %0, m0\n\ts_mov_b32 m0, %2\n\ts_nop 0\n\tglobal_load_lds_dwordx4 %1, off\n\ts_mov_b32 m0, %0":"=&s"(keep):"v"(gsrc),"s"(lds_dst):"memory");}
__device__ __forceinline__ float max3f(float a,float b,float c){float r;asm("v_max3_f32 %0, %1, %2, %3":"=v"(r):"v"(a),"v"(b),"v"(c));return r;}
__device__ __forceinline__ float max2f(float a,float b){float r;asm("v_max_f32_e32 %0, %1, %2":"=v"(r):"v"(a),"v"(b));return r;}
__device__ __forceinline__ float fadd_s(float a,float b){float r;asm("v_add_f32_e32 %0, %1, %2":"=v"(r):"v"(a),"v"(b));return r;}
__device__ __forceinline__ float fsub_s(float a,float b){float r;asm("v_sub_f32_e32 %0, %1, %2":"=v"(r):"v"(a),"v"(b));return r;}
typedef float f32x2_t __attribute__((ext_vector_type(2))); typedef __bf16 bf16x2_t __attribute__((ext_vector_type(2)));
__device__ __forceinline__ unsigned cvtpk_s(float lo,float hi){f32x2_t v={lo,hi};bf16x2_t b=__builtin_convertvector(v,bf16x2_t);return __builtin_bit_cast(unsigned,b);}
#define WAIT_BAR(N) asm volatile("s_waitcnt vmcnt(" #N ") lgkmcnt(0)\n\ts_barrier":::"memory")

__device__ __forceinline__ void qkt(f32x16&p0,f32x16&p1,const char*Kslot,const bf16x8*qr,const f32x16&negm,int r32,int hi){
  const char*kb=Kslot+hi*1024+r32*16;
  #pragma unroll
  for(int d0=0;d0<4;++d0){
    const bf16x8 b0=*reinterpret_cast<const bf16x8*>(kb+d0*2048);
    const bf16x8 b1=*reinterpret_cast<const bf16x8*>(kb+d0*2048+512);
    if(d0==0){p0=__builtin_amdgcn_mfma_f32_32x32x16_bf16(b0,qr[0],negm,0,0,0);p1=__builtin_amdgcn_mfma_f32_32x32x16_bf16(b1,qr[0],negm,0,0,0);}
    else{p0=__builtin_amdgcn_mfma_f32_32x32x16_bf16(b0,qr[d0],p0,0,0,0);p1=__builtin_amdgcn_mfma_f32_32x32x16_bf16(b1,qr[d0],p1,0,0,0);}}
}
typedef __attribute__((address_space(3))) const char* lds_cptr;
typedef short v4i16_t __attribute__((ext_vector_type(4)));
__device__ __forceinline__ void kload8(bf16x8*kf,lds_cptr kp){
  kf[0]=*(const __attribute__((address_space(3))) bf16x8*)(kp);      kf[1]=*(const __attribute__((address_space(3))) bf16x8*)(kp+512);
  kf[2]=*(const __attribute__((address_space(3))) bf16x8*)(kp+2048); kf[3]=*(const __attribute__((address_space(3))) bf16x8*)(kp+2560);
  kf[4]=*(const __attribute__((address_space(3))) bf16x8*)(kp+4096); kf[5]=*(const __attribute__((address_space(3))) bf16x8*)(kp+4608);
  kf[6]=*(const __attribute__((address_space(3))) bf16x8*)(kp+6144); kf[7]=*(const __attribute__((address_space(3))) bf16x8*)(kp+6656);
}
__device__ __forceinline__ void kload2(bf16x8*kf,lds_cptr kp,int j){ kf[2*j]=*(const __attribute__((address_space(3))) bf16x8*)(kp+j*2048); kf[2*j+1]=*(const __attribute__((address_space(3))) bf16x8*)(kp+j*2048+512); }
__device__ __forceinline__ s16x4 vtr(lds_cptr p){ return __builtin_bit_cast(s16x4,__builtin_amdgcn_ds_read_tr16_b64_v4i16((__attribute__((address_space(3))) v4i16_t*)p)); }
__device__ __forceinline__ float rowmax(const f32x16&p0,const f32x16&p1){
  float a=max3f(p0[0],p0[1],p1[0]),b=max3f(p0[2],p0[3],p1[1]);a=max3f(a,p1[2],p1[3]);
  #pragma unroll
  for(int r=4;r<16;r+=4){a=max3f(a,p0[r],p0[r+1]);b=max3f(b,p0[r+2],p0[r+3]);a=max3f(a,p1[r],p1[r+1]);b=max3f(b,p1[r+2],p1[r+3]);}
  const float m=max2f(a,b);
  auto rr=__builtin_amdgcn_permlane32_swap(__float_as_uint(m),__float_as_uint(m),false,false);
  return max2f(__uint_as_float(rr[0]),__uint_as_float(rr[1]));
}
__device__ __forceinline__ void pv(f32x16*o,int vb,bf16x8 pa0,bf16x8 pa1,bf16x8 pa2,bf16x8 pa3){
  #pragma unroll
  for(int d0=0;d0<2;++d0){s16x4 lo[4],hi[4];
    #pragma unroll
    for(int ks=0;ks<4;++ks){
      asm volatile("ds_read_b64_tr_b16 %0,%1 offset:%c2":"=&v"(lo[ks]):"v"(vb),"i"(d0*4096+ks*1024):"memory");
      asm volatile("ds_read_b64_tr_b16 %0,%1 offset:%c2":"=&v"(hi[ks]):"v"(vb),"i"(d0*4096+ks*1024+512):"memory");}
    asm volatile("s_waitcnt lgkmcnt(0)":::"memory");SBAR();
    #define PK(k) (bf16x8){lo[k][0],lo[k][1],lo[k][2],lo[k][3],hi[k][0],hi[k][1],hi[k][2],hi[k][3]}
    o[d0]=__builtin_amdgcn_mfma_f32_32x32x16_bf16(pa0,PK(0),o[d0],0,0,0);
    o[d0]=__builtin_amdgcn_mfma_f32_32x32x16_bf16(pa1,PK(1),o[d0],0,0,0);
    o[d0]=__builtin_amdgcn_mfma_f32_32x32x16_bf16(pa2,PK(2),o[d0],0,0,0);
    o[d0]=__builtin_amdgcn_mfma_f32_32x32x16_bf16(pa3,PK(3),o[d0],0,0,0);
    #undef PK
  }
}
template<int THRL> __device__ __forceinline__ void attn_unit(const bf16*Qw0,const bf16*__restrict__ Kh,const bf16*__restrict__ Vh,bf16*Ow0,const int NT,char*shm){
  const int tid=opaque_tid(),lane=tid&63,r32=lane&31,hi=lane>>5; const int wid=__builtin_amdgcn_readfirstlane(tid>>6);
  const bf16*Qw=Qw0+(long)wid*QBLK*QP;
  const unsigned lds0=(unsigned)(uintptr_t)shm;
  float*wsf=(float*)(shm+LDS_WS)+wid*64;
  const bf16*ksrc=Kh+(long)lane*KP+wid*8;
  const bf16*vsrc=Vh+(long)(16*(wid&3)+(lane>>2))*KP+(wid>>2)*32+(lane&3)*8;
  const unsigned kdst=lds0+LDS_K+wid*1024, vdst=lds0+LDS_V+wid*1024;
  #define DMA_K(t,slot) glds16(ksrc+(long)(t)*KVBLK*KP,(unsigned)__builtin_amdgcn_readfirstlane(kdst+(slot)))
  #define DMA_V(t,slot) glds16(vsrc+(long)(t)*KVBLK*KP,(unsigned)__builtin_amdgcn_readfirstlane(vdst+(slot)))
  const int vb0=(int)(lds0+LDS_V)+((lane>>4)&1)*32+(lane&3)*8+(4*hi+((lane&15)>>2))*64;
  const char*Kbase=shm+LDS_K; bf16x8 kf[8];
  const lds_cptr shm3=(lds_cptr)shm; const lds_cptr kp0=shm3+LDS_K+hi*1024+r32*16; const lds_cptr vp0=shm3+LDS_V+((lane>>4)&1)*32+(lane&3)*8+(4*hi+((lane&15)>>2))*64;
  DMA_K(0,0);DMA_V(0,0);DMA_K(1,SLOTB);
  bf16x8 qr[4];
  #pragma unroll
  for(int d0=0;d0<4;++d0)qr[d0]=*reinterpret_cast<const bf16x8*>(&Qw[(long)r32*QP+d0*16+hi*8]);
  float mhat=0.f,l_reg=0.f;f32x16 o[2];o[0]=f32x16{};o[1]=f32x16{};f32x16 negm=f32x16{};asm volatile("":"+v"(negm));
  #define CMASK(P0,P1,t) do{}while(0)
  bool resc=false;
  #define START(P0,P1) do{ const float rm=rowmax(P0,P1); resc=false; \
    { const float dl=rm; mhat=fadd_s(mhat,dl); \
      _Pragma("unroll") for(int r=0;r<16;++r){P0[r]=fsub_s(P0[r],dl);P1[r]=fsub_s(P1[r],dl);} \
      _Pragma("unroll") for(int r=0;r<16;++r)negm[r]=-mhat; asm volatile("":"+v"(negm)); } \
    _Pragma("unroll") for(int r=0;r<16;++r)P0[r]=__builtin_amdgcn_exp2f(P0[r]); }while(0)
  #define RESC() do{ if(resc){ asm volatile("s_waitcnt lgkmcnt(0)":::"memory"); \
      _Pragma("unroll") for(int d_=0;d_<2;++d_) _Pragma("unroll") for(int r=0;r<16;++r)o[d_][r]*=wsf[crow(r,hi)]; } }while(0)
  f32x16 pA0,pA1,pB0,pB1;
  int sl_prev=0,sl_cur=0,sl_next=SLOTB;
  #define ROT() do{sl_prev=sl_cur;sl_cur=sl_next;sl_next=(sl_next==(NSLOT-1)*SLOTB)?0:sl_next+SLOTB;}while(0)
  DMA_K(2,2*SLOTB);
  WAIT_BAR(3);
  qkt(pA0,pA1,Kbase,qr,negm,r32,hi);asm volatile("s_nop 15\n\ts_nop 7":"+v"(pA0),"+v"(pA1));CMASK(pA0,pA1,0);
  START(pA0,pA1);
  _Pragma("unroll") for(int r=0;r<16;++r)pA1[r]=__builtin_amdgcn_exp2f(pA1[r]);
  WAIT_BAR(0);
  DMA_K(3,0);DMA_V(1,SLOTB);
  ROT();
  kload8(kf,kp0+sl_cur);
  WAIT_BAR(2);
  s16x4 vlo[8],vhi[8]; u32x4 pw0,pw1,pw2,pw3;
  #define PKW(P,B) cvtpk_s(P[B],P[B+1])
  #define PAF(k) __builtin_bit_cast(bf16x8,pw##k)
  #define VFR(i) (bf16x8){vlo[i][0],vlo[i][1],vlo[i][2],vlo[i][3],vhi[i][0],vhi[i][1],vhi[i][2],vhi[i][3]}
  #define PIN(x) asm volatile("":"+v"(x))
  #define MX3(a,b,c) __builtin_fmaxf(__builtin_fmaxf((a),(b)),(c))
  #define GAPA(MF,A0,A1,A2,A3,W0,W1,PW) do{ MF; sacc+=A0; sacc+=A1; sacc+=A2; sacc+=A3; PIN(sacc); W0; W1; PIN(PW); SBAR(); }while(0)
  #define EX(v) __builtin_amdgcn_exp2f(v)
  #define GAPB(MF,X,B) do{ MF; X[B]=EX(X[B]); X[B+1]=EX(X[B+1]); X[B+2]=EX(X[B+2]); X[B+3]=EX(X[B+3]); PIN(X); SBAR(); }while(0)
  #define VRD(i) do{ vlo[i]=vtr(vp_+(((i)>>2)*4096+((i)&3)*1024)); vhi[i]=vtr(vp_+(((i)>>2)*4096+((i)&3)*1024+512)); }while(0)
  #define KRD(G,j) do{ if(G){ kload2(kf,kp0+sl_next,j); SBAR(); } }while(0)
  #define STEP(C0,C1,P0,P1,t,GK,GV,GL) do{ SBAR(); \
    const lds_cptr vp_=vp0+sl_prev; \
    VRD(0); SBAR(); float sacc=(P0[0]+P0[1]); \
    GAPA(C0=__builtin_amdgcn_mfma_f32_32x32x16_bf16(kf[0],qr[0],negm,0,0,0), P0[2],P0[3],P0[4],P0[5],     pw0[0]=PKW(P0,0), pw0[1]=PKW(P0,2), pw0); \
    VRD(4); SBAR(); GAPA(C1=__builtin_amdgcn_mfma_f32_32x32x16_bf16(kf[1],qr[0],negm,0,0,0), P0[6],P0[7],P0[8],P0[9],     pw0[2]=PKW(P0,4), pw0[3]=PKW(P0,6), pw0); \
    VRD(1); SBAR(); GAPA(C0=__builtin_amdgcn_mfma_f32_32x32x16_bf16(kf[2],qr[1],C0,0,0,0),   P0[10],P0[11],P0[12],P0[13], pw1[0]=PKW(P0,8), pw1[1]=PKW(P0,10), pw1); \
    VRD(5); SBAR(); GAPA(C1=__builtin_amdgcn_mfma_f32_32x32x16_bf16(kf[3],qr[1],C1,0,0,0),   P0[14],P0[15],P1[0],P1[1],   pw1[2]=PKW(P0,12),pw1[3]=PKW(P0,14), pw1); \
    VRD(2); SBAR(); GAPA(C0=__builtin_amdgcn_mfma_f32_32x32x16_bf16(kf[4],qr[2],C0,0,0,0),   P1[2],P1[3],P1[4],P1[5],     pw2[0]=PKW(P1,0), pw2[1]=PKW(P1,2), pw2); \
    VRD(6); SBAR(); GAPA(C1=__builtin_amdgcn_mfma_f32_32x32x16_bf16(kf[5],qr[2],C1,0,0,0),   P1[6],P1[7],P1[8],P1[9],     pw2[2]=PKW(P1,4), pw2[3]=PKW(P1,6), pw2); \
    VRD(3); SBAR(); GAPA(C0=__builtin_amdgcn_mfma_f32_32x32x16_bf16(kf[6],qr[3],C0,0,0,0),   P1[10],P1[11],P1[12],P1[13], pw3[0]=PKW(P1,8), pw3[1]=PKW(P1,10), pw3); \
    VRD(7); SBAR(); GAPA(C1=__builtin_amdgcn_mfma_f32_32x32x16_bf16(kf[7],qr[3],C1,0,0,0),   P1[14],P1[15],0.f,0.f,       pw3[2]=PKW(P1,12),pw3[3]=PKW(P1,14), pw3); \
    l_reg+=sacc; \
    if(GK){DMA_K((t)+3,sl_cur);} if(GV){DMA_V((t)+1,sl_next);} \
    CMASK(C0,C1,t); \
    { float a=MX3(C0[0],C0[1],C1[0]),b=MX3(C0[2],C0[3],C1[1]); a=MX3(a,C1[2],C1[3]); \
      _Pragma("unroll") for(int r=4;r<16;r+=4){a=MX3(a,C0[r],C0[r+1]);b=MX3(b,C0[r+2],C0[r+3]);a=MX3(a,C1[r],C1[r+1]);b=MX3(b,C1[r+2],C1[r+3]);} \
      float rm=__builtin_fmaxf(a,b); { auto rr=__builtin_amdgcn_permlane32_swap(__float_as_uint(rm),__float_as_uint(rm),false,false); rm=__builtin_fmaxf(__uint_as_float(rr[0]),__uint_as_float(rr[1])); } \
      resc=false; \
      if(__builtin_expect(__any(rm>(float)THRL),0)){ const float dl=__builtin_fmaxf(rm,0.f); mhat+=dl; \
        _Pragma("unroll") for(int r=0;r<16;++r){C0[r]-=dl;C1[r]-=dl;} \
        _Pragma("unroll") for(int r=0;r<16;++r)negm[r]=-mhat; asm volatile("":"+v"(negm)); \
        const float f=__builtin_amdgcn_exp2f(-dl); l_reg*=f; if(hi==0)wsf[r32]=f; resc=true; } } \
    SBAR(); \
    GAPB(o[0]=__builtin_amdgcn_mfma_f32_32x32x16_bf16(PAF(0),VFR(0),o[0],0,0,0), C0,0); \
    GAPB(o[1]=__builtin_amdgcn_mfma_f32_32x32x16_bf16(PAF(0),VFR(4),o[1],0,0,0), C0,4); \
    KRD(GL,0); GAPB(o[0]=__builtin_amdgcn_mfma_f32_32x32x16_bf16(PAF(1),VFR(1),o[0],0,0,0), C0,8); \
    KRD(GL,1); GAPB(o[1]=__builtin_amdgcn_mfma_f32_32x32x16_bf16(PAF(1),VFR(5),o[1],0,0,0), C0,12); \
    KRD(GL,2); GAPB(o[0]=__builtin_amdgcn_mfma_f32_32x32x16_bf16(PAF(2),VFR(2),o[0],0,0,0), C1,0); \
    KRD(GL,3); GAPB(o[1]=__builtin_amdgcn_mfma_f32_32x32x16_bf16(PAF(2),VFR(6),o[1],0,0,0), C1,4); \
    GAPB(o[0]=__builtin_amdgcn_mfma_f32_32x32x16_bf16(PAF(3),VFR(3),o[0],0,0,0), C1,8); \
    GAPB(o[1]=__builtin_amdgcn_mfma_f32_32x32x16_bf16(PAF(3),VFR(7),o[1],0,0,0), C1,12); \
    }while(0)
  int t=1;
  #undef CMASK
  #define CMASK(P0,P1,t) do{}while(0)
  for(;t+5<NT;t+=2){
    STEP(pB0,pB1,pA0,pA1,t,true,true,true);     WAIT_BAR(2); RESC(); ROT();
    STEP(pA0,pA1,pB0,pB1,t+1,true,true,true);   WAIT_BAR(2); RESC(); ROT();
  }
  #undef CMASK
  #define CMASK(P0,P1,t) do{}while(0)
  #define ENDW(tt) do{ if((tt)+3<NT){WAIT_BAR(2);} else if((tt)+2<NT){WAIT_BAR(1);} else {WAIT_BAR(0);} }while(0)
  for(;t+1<NT;t+=2){
    STEP(pB0,pB1,pA0,pA1,t,(t+3<NT),(t+1<NT),(t+1<NT));       ENDW(t);   RESC(); ROT();
    STEP(pA0,pA1,pB0,pB1,t+1,(t+4<NT),(t+2<NT),(t+2<NT));     ENDW(t+1); RESC(); ROT();
  }
  STEP(pB0,pB1,pA0,pA1,NT-1,false,false,false); RESC();
  { float sacc=pB0[0]+pB0[1]; _Pragma("unroll") for(int r=2;r<16;++r)sacc+=pB0[r]; _Pragma("unroll") for(int r=0;r<16;++r)sacc+=pB1[r]; l_reg+=sacc;
    pw0=(u32x4){PKW(pB0,0),PKW(pB0,2),PKW(pB0,4),PKW(pB0,6)};pw1=(u32x4){PKW(pB0,8),PKW(pB0,10),PKW(pB0,12),PKW(pB0,14)};pw2=(u32x4){PKW(pB1,0),PKW(pB1,2),PKW(pB1,4),PKW(pB1,6)};pw3=(u32x4){PKW(pB1,8),PKW(pB1,10),PKW(pB1,12),PKW(pB1,14)};
    SBAR(); pv(o,vb0+sl_cur,PAF(0),PAF(1),PAF(2),PAF(3)); }
  #undef PKW
  #undef PAF
  #undef VFR
  #undef PIN
  #undef MX3
  #undef GAPA
  #undef GAPB
  #undef EX
  #undef VRD
  #undef KRD
  #undef STEP
  #undef ENDW
  {auto rr=__builtin_amdgcn_permlane32_swap(__float_as_uint(l_reg),__float_as_uint(l_reg),false,false);l_reg=__uint_as_float(rr[0])+__uint_as_float(rr[1]);}
  if(hi==0)wsf[32+r32]=l_reg;asm volatile("s_waitcnt lgkmcnt(0)":::"memory");
  float rli[16];
  #pragma unroll
  for(int r=0;r<16;++r)rli[r]=__builtin_amdgcn_rcpf(wsf[32+crow(r,hi)]);
  bf16*Ow=Ow0+(long)wid*QBLK*OP;
  { bf16*stg=(bf16*)(shm+LDS_OST)+wid*2048;
    #pragma unroll
    for(int r=0;r<16;++r){const int orow=crow(r,hi);
      #pragma unroll
      for(int d0=0;d0<2;++d0)stg[orow*64+d0*32+r32]=__float2bfloat16(o[d0][r]*rli[r]);}
    asm volatile("s_waitcnt lgkmcnt(0)":::"memory");
    #pragma unroll
    for(int i=0;i<4;++i){const int row=i*8+(lane>>3),ch=lane&7; const u32x4 v=*(const u32x4*)(stg+row*64+ch*8); ATTN_STORE16(Ow+(long)row*OP+ch*8,v);} }
  asm volatile("s_waitcnt lgkmcnt(0)\n\ts_barrier":::"memory");
  #undef DMA_K
  #undef DMA_V
  #undef CMASK
  #undef START
  #undef RESC
  #undef ROT
}

#undef SBAR
#undef WAIT_BAR
}

typedef short bf16x8_t __attribute__((ext_vector_type(8)));
#define LDS_WAIT() asm volatile("s_waitcnt lgkmcnt(0)" ::: "memory")

__device__ __forceinline__ int inv32(int c) { return 16 * ((c >> 2) & 1) + 4 * (c >> 3) + (c & 3); }
__device__ __forceinline__ int dest_row(int type, int n) {
    if (type == 0) return n;
    if (type == 3) return (n & ~31) + inv32(n & 31);
    if (type == 1) { const int half = n >= DFF ? 1 : 0, j = n - half * DFF, pn = j >> 7, c = j & 127; return pn * 256 + half * 128 + (c & ~31) + inv32(c & 31); }
    if (n < 768) { const int hd = n >> 6, d = n & 63, a = d >> 5, t = (d >> 4) & 1, p = d & 15; return (hd >> 2) * 256 + a * 128 + (hd & 3) * 32 + t * 16 + p; }
    const int pn = n >> 8, c = n & 255, half = c >> 7, c7 = c & 127; return pn * 256 + half * 128 + (c7 & ~31) + inv32(c7 & 31);
}
__device__ __forceinline__ void transpose_item(const float* W, int K, int N, bf16_t* WT, int type, LAS float* scr, int item, int lane) {
    const int nblk = N / 32, kb = item / nblk, nb = item % nblk, k0 = 64 * kb, n0 = 32 * nb;
#pragma unroll
    for (int h = 0; h < 2; ++h) { float wv[16];
#pragma unroll
        for (int i = 0; i < 16; ++i) wv[i] = W[(size_t)(k0 + 2 * (16 * h + i) + (lane >> 5)) * N + n0 + (lane & 31)];
#pragma unroll
        for (int i = 0; i < 16; ++i) scr[(2 * (16 * h + i) + (lane >> 5)) * 33 + (lane & 31)] = wv[i]; }
    LDS_WAIT(); asm volatile("" ::: "memory");
    const int c = lane & 7;
#pragma unroll
    for (int j = 0; j < 4; ++j) { const int n = (lane >> 3) + 8 * j; const LAS float* s = scr + (8 * c) * 33 + n;
        u32x4 o; o.x = cvt_pk(s[0 * 33], s[1 * 33]); o.y = cvt_pk(s[2 * 33], s[3 * 33]); o.z = cvt_pk(s[4 * 33], s[5 * 33]); o.w = cvt_pk(s[6 * 33], s[7 * 33]);
        *(u32x4*)(WT + (size_t)dest_row(type, n0 + n) * K + k0 + 8 * c) = o; }
    LDS_WAIT(); asm volatile("" ::: "memory");
}

__device__ __forceinline__ void prologue_phase(const Params& P, LAS unsigned char* lds, int G) {
    const int tid = opaque_tid(), lane = tid & 63, wid = __builtin_amdgcn_readfirstlane(tid >> 6), bid = blockIdx.x;
    unsigned char* ws = P.ws;
    {
        LAS float* sc = (LAS float*)lds;
        LAS float* red = (LAS float*)(lds + 36864);
        for (int i = tid; i < 9 * 1024; i += NTHREADS) { const int v = i >> 10, k = i & 1023; const float cv = v < 8 ? P.in[1][v * 1024 + k] : P.in[3][k]; sc[i] = cv / (1.0f + expf(-cv)); }
        __syncthreads();
        float* mod = (float*)(ws + OFF_MOD);
        for (int item = bid; item < 2 * 144; item += G) {
            const int l = item / 144, cgp = item % 144, col = cgp * 64 + lane, kc = wid;
            const float* W = P.in[4] + (size_t)l * 1024 * MODW + col;
            float acc[9];
#pragma unroll
            for (int v = 0; v < 9; ++v) acc[v] = 0.f;
#pragma unroll 1
            for (int k0 = kc * 128; k0 < kc * 128 + 128; k0 += 16) { float wv[16];
#pragma unroll
                for (int q = 0; q < 16; ++q) wv[q] = W[(size_t)(k0 + q) * MODW];
#pragma unroll
                for (int q = 0; q < 16; ++q)
#pragma unroll
                    for (int v = 0; v < 9; ++v) acc[v] += sc[v * 1024 + k0 + q] * wv[q]; }
#pragma unroll
            for (int v = 0; v < 9; ++v) red[(kc * 9 + v) * 64 + lane] = acc[v];
            __syncthreads();
            for (int i = tid; i < 576; i += NTHREADS) { const int v = i >> 6, cc = i & 63; float s = 0.f;
#pragma unroll
                for (int q = 0; q < 8; ++q) s += red[(q * 9 + v) * 64 + cc];
                mod[(size_t)(l * 9 + v) * MODW + cgp * 64 + cc] = s + P.in[5][l * MODW + cgp * 64 + cc]; }
            __syncthreads();
        }
    }
    __syncthreads();
    {
        LAS float* scr = (LAS float*)(lds + wid * 16384);
        const int gw = bid * 8 + wid, NGW = G * 8;
        constexpr int I_FI = 16 * (NFF2 / 32), I_FO = (DFF / 64) * 32, I_WI = 16 * (INW / 32), I_WO = 16 * 32;
        constexpr int PER_L = 2 * I_FI + 2 * I_FO + I_WI + I_WO;
        for (int it = gw; it < DEPTH * PER_L; it += NGW) {
            const int l = it / PER_L; int r = it % PER_L;
            unsigned char* wb = ws + OFF_WB + (size_t)l * WB_LAYER;
            if (r < 2 * I_FI) { const int f = r / I_FI; transpose_item(P.in[7] + (size_t)(l * 2 + f) * DM * NFF2, DM, NFF2, (bf16_t*)(wb + WB_FFIN + f * WB_FFIN_SZ), 1, scr, r % I_FI, lane); continue; } r -= 2 * I_FI;
            if (r < 2 * I_FO) { const int f = r / I_FO; transpose_item(P.in[8] + (size_t)(l * 2 + f) * DFF * DM, DFF, DM, (bf16_t*)(wb + WB_FFOUT + f * WB_FFOUT_SZ), 3, scr, r % I_FO, lane); continue; } r -= 2 * I_FO;
            if (r < I_WI) { transpose_item(P.in[9] + (size_t)l * DM * INW, DM, INW, (bf16_t*)(wb + WB_WIN), 2, scr, r, lane); continue; } r -= I_WI;
            transpose_item(P.in[22] + (size_t)l * DM * DM, DM, DM, (bf16_t*)(wb + WB_WOUT), 3, scr, r, lane);
        }
        bf16_t* LW = (bf16_t*)(ws + OFF_LW);
        const int gt = bid * NTHREADS + tid, NGT = G * NTHREADS;
        for (int i = gt; i < DEPTH * 4 * 256 * 64; i += NGT) {
            const int d = i & 63, c = (i >> 6) & 255, g = (i >> 14) & 3, l = i >> 16, n = c >> 6, e = c & 63;
            const float* src = (g & 1) ? P.in[16] : P.in[14];
            const float v = src[((((size_t)l * 2 + (g >> 1)) * 4 + n) * 64 + d) * 64 + e];
            LW[i] = (bf16_t)(cvt_pk(v * -1.4426950408889634f, 0.f) & 0xffffu);
        }
        float* rc = (float*)(ws + OFF_ROPE); float* rs = rc + 2048;
        for (int i = gt; i < 2048; i += NGT) { const int pos = i >> 4, p = i & 15; const float inv = powf(10000.0f, -(float)p / 16.0f), ang = (float)pos * inv; rc[i] = cosf(ang); rs[i] = sinf(ang); }
    }
}

__device__ __forceinline__ void norm_phase(const Params& P, int l, int idx, int row_lo, int row_hi, bool first, int wg0, int nwg) {
    const int tid = opaque_tid(), lane = tid & 63, wid = __builtin_amdgcn_readfirstlane(tid >> 6);
    if ((int)blockIdx.x < wg0 || (int)blockIdx.x >= wg0 + nwg) return;
    const int gw = ((int)blockIdx.x - wg0) * 8 + wid, NGW = nwg * 8, per = (row_hi - row_lo + NGW - 1) / NGW;
    const int r0 = row_lo + gw * per, r1 = (r0 + per < row_hi) ? r0 + per : row_hi;
    const float* mod = (const float*)(P.ws + OFF_MOD) + (size_t)l * 9 * MODW;
    const float* gsrc = P.in[6] + (size_t)(l * 3 + idx) * DM;
    const bf16_t* xres = (const bf16_t*)(P.ws + OFF_XRES); bf16_t* hb = (bf16_t*)(P.ws + OFF_HBUF);
    int curv = -1; f32x4 Aa[4], Bb[4];
    for (int row = r0; row < r1; ++row) {
        const int v = row < MLAT ? (row >> 13) : 8;
        if (v != curv) { curv = v;
#pragma unroll
            for (int j = 0; j < 4; ++j) { const int c = 4 * lane + 256 * j; const f32x4 g4 = *(const f32x4*)(gsrc + c), sh = *(const f32x4*)(mod + (size_t)v * MODW + (3 * idx) * DM + c), sc = *(const f32x4*)(mod + (size_t)v * MODW + (3 * idx + 1) * DM + c);
                Aa[j] = g4 * (sc + 1.0f); Bb[j] = sh; } }
        f32x4 x[4]; float ss = 0.f;
        if (first) { const float* xr = row < MLAT ? P.in[0] + (size_t)row * DM : P.in[2] + (size_t)(row - MLAT) * DM;
#pragma unroll
            for (int j = 0; j < 4; ++j) x[j] = *(const f32x4*)(xr + 4 * lane + 256 * j);
        } else {
#pragma unroll
            for (int j = 0; j < 4; ++j) { const u32x2 r = *(const u32x2*)(xres + (size_t)row * DM + 4 * lane + 256 * j); x[j] = (f32x4){bf_lo(r.x), bf_hi(r.x), bf_lo(r.y), bf_hi(r.y)}; }
        }
#pragma unroll
        for (int j = 0; j < 4; ++j) { ss += (x[j][0] * x[j][0] + x[j][1] * x[j][1]) + (x[j][2] * x[j][2] + x[j][3] * x[j][3]); }
        const float rstd = 1.0f / sqrtf(wave_sum(ss) * (1.0f / DM) + EPS);
#pragma unroll
        for (int j = 0; j < 4; ++j) { const f32x4 y = x[j] * rstd * Aa[j] + Bb[j]; u32x2 w; w.x = cvt_pk(y[0], y[1]); w.y = cvt_pk(y[2], y[3]);
            *(u32x2*)(hb + (size_t)row * DM + 4 * lane + 256 * j) = w;
 }
    }
}
__device__ __forceinline__ void final_norm_phase(const Params& P, int G) {
    const int tid = opaque_tid(), lane = tid & 63, wid = __builtin_amdgcn_readfirstlane(tid >> 6);
    const int gw = blockIdx.x * 8 + wid, NGW = G * 8;
    const bf16_t* xres = (const bf16_t*)(P.ws + OFF_XRES);
    f32x4 g4[4];
#pragma unroll
    for (int j = 0; j < 4; ++j) g4[j] = *(const f32x4*)(P.in[23] + 4 * lane + 256 * j);
    for (int row = gw; row < MLAT; row += NGW) {
        f32x4 x[4]; float ss = 0.f;
#pragma unroll
        for (int j = 0; j < 4; ++j) { const u32x2 r = *(const u32x2*)(xres + (size_t)row * DM + 4 * lane + 256 * j); x[j] = (f32x4){bf_lo(r.x), bf_hi(r.x), bf_lo(r.y), bf_hi(r.y)}; ss += (x[j][0] * x[j][0] + x[j][1] * x[j][1]) + (x[j][2] * x[j][2] + x[j][3] * x[j][3]); }
        const float rstd = 1.0f / sqrtf(wave_sum(ss) * (1.0f / DM) + EPS);
#pragma unroll
        for (int j = 0; j < 4; ++j) *(f32x4*)(P.out + (size_t)row * DM + 4 * lane + 256 * j) = x[j] * rstd * g4[j];
    }
}

constexpr int L1_AST = 528;
constexpr int L1_UST = 260;
constexpr int L1_UOFF = 66560;
#define LDS_BARRIER() asm volatile("s_waitcnt lgkmcnt(0)\n\ts_barrier" ::: "memory")
__device__ __forceinline__ void lru1_phase(const Params& P, int l, LAS unsigned char* lds, int G) {
    const int tid = opaque_tid(), lane = tid & 63, wid = __builtin_amdgcn_readfirstlane(tid >> 6), fr = lane & 15, fq = lane >> 4;
    LAS unsigned char* ldsA = lds; LAS float* ldsU = (LAS float*)(lds + L1_UOFF);
    const bf16_t* Ubuf = (const bf16_t*)(P.ws + OFF_U5);
    float* Sg = (float*)(P.ws + OFF_S); unsigned* PPg = (unsigned*)(P.ws + OFF_PP); float* csum = (float*)(P.ws + OFF_CSUM);
    const bf16_t* LW = (const bf16_t*)(P.ws + OFF_LW) + (size_t)l * 4 * 256 * 64;
    const int ch4 = (tid & 63) * 4, pg = tid >> 6;
    f32x4 cw[4], cbias;
#pragma unroll
    for (int i = 0; i < 4; ++i) cw[i] = *(const f32x4*)(P.in[12] + (size_t)(l * 4 + i) * 256 + ch4);
    cbias = *(const f32x4*)(P.in[13] + (size_t)l * 256 + ch4);
    const int nblk = wid >> 1;
    for (int tile = blockIdx.x; tile < NBATCH * NCHUNK; tile += G) {
        const int b = tile / NCHUNK, cidx = tile % NCHUNK, P0 = cidx * 64; const bool latent = cidx >= 4;
        const int seg_lo = latent ? 256 : 0, seg_hi = latent ? KEYS : 256;
        const int rbase = latent ? b * SEQ - 256 : MLAT + b * CTXL;
        {
            const int pp0 = P0 + pg * 8;
            f32x4 win[11];
#pragma unroll
            for (int i = 0; i < 11; ++i) { const int Pq = pp0 - 2 + i; f32x4 w4 = {0.f, 0.f, 0.f, 0.f};
                if (Pq >= seg_lo && Pq < seg_hi) { const u32x2 raw = *(const u32x2*)(Ubuf + (size_t)(rbase + Pq) * 256 + ch4); w4 = (f32x4){bf_lo(raw.x), bf_hi(raw.x), bf_lo(raw.y), bf_hi(raw.y)}; }
                win[i] = w4; }
#pragma unroll
            for (int q = 0; q < 8; ++q) { f32x4 y = cbias;
#pragma unroll
                for (int i = 0; i < 4; ++i) y = y + cw[i] * win[q + i];
                const int pos = pg * 8 + q;
                u32x2 w; w.x = cvt_pk(y[0], y[1]); w.y = cvt_pk(y[2], y[3]);
                *(LAS u32x2*)(ldsA + pos * L1_AST + ch4 * 2) = w;
                *(LAS f32x4*)(ldsU + pos * L1_UST + ch4) = y; }
        }
        LDS_BARRIER();
#pragma unroll 1
        for (int cc = 0; cc < 2; ++cc) {
            const int c = 32 * wid + 16 * cc + fr;
            const float NL2E = -1.4426950408889634f;
            const float baf = NL2E * P.in[15][(l * 2 + 0) * 256 + c], bab = NL2E * P.in[15][(l * 2 + 1) * 256 + c], bxf = NL2E * P.in[17][(l * 2 + 0) * 256 + c], bxb = NL2E * P.in[17][(l * 2 + 1) * 256 + c];
            const float nspf = -8.0f * 1.4426950408889634f * log1pf(expf(-P.in[18][(l * 2 + 0) * 256 + c])), nspb = -8.0f * 1.4426950408889634f * log1pf(expf(-P.in[18][(l * 2 + 1) * 256 + c]));
            f32x4 acc[4][4];
            {
                bf16x8_t bw[4][2];
#pragma unroll
                for (int g = 0; g < 4; ++g)
#pragma unroll
                    for (int kk = 0; kk < 2; ++kk) bw[g][kk] = *(const bf16x8_t*)(LW + ((size_t)(g * 256 + c) * 64 + kk * 32 + fq * 8));
#pragma unroll
                for (int m = 0; m < 4; ++m) {
#pragma unroll
                    for (int g = 0; g < 4; ++g) acc[m][g] = (f32x4){0.f, 0.f, 0.f, 0.f};
#pragma unroll
                    for (int kk = 0; kk < 2; ++kk) { const bf16x8_t a = *(const LAS bf16x8_t*)(ldsA + (16 * m + fr) * L1_AST + (64 * nblk + 32 * kk + 8 * fq) * 2);
#pragma unroll
                        for (int g = 0; g < 4; ++g) acc[m][g] = __builtin_amdgcn_mfma_f32_16x16x32_bf16(a, bw[g][kk], acc[m][g], 0, 0, 0); }
                }
            }
#pragma unroll
            for (int m = 0; m < 4; ++m)
#pragma unroll
                for (int j = 0; j < 4; ++j) {
                    const float u = ldsU[(16 * m + 4 * fq + j) * L1_UST + c];
                    {   const float r = __builtin_amdgcn_rcpf(1.0f + __builtin_amdgcn_exp2f(acc[m][0][j] + baf)), ig = __builtin_amdgcn_rcpf(1.0f + __builtin_amdgcn_exp2f(acc[m][1][j] + bxf));
                        const float a = __builtin_amdgcn_exp2f(nspf * r);
                        acc[m][0][j] = a; acc[m][1][j] = __builtin_amdgcn_sqrtf(__builtin_fmaf(-a, a, 1.0f)) * (ig * u); }
                    {   const float r = __builtin_amdgcn_rcpf(1.0f + __builtin_amdgcn_exp2f(acc[m][2][j] + bab)), ig = __builtin_amdgcn_rcpf(1.0f + __builtin_amdgcn_exp2f(acc[m][3][j] + bxb));
                        const float a = __builtin_amdgcn_exp2f(nspb * r);
                        acc[m][2][j] = a; acc[m][3][j] = __builtin_amdgcn_sqrtf(__builtin_fmaf(-a, a, 1.0f)) * (ig * u); }
                }
            f32x4 hf[4], pf[4];
            {
                float TAi[4], THi[4], EAi[4], EHi[4], gAi[4], gHi[4]; f32x4 Aj[4], Hj[4];
#pragma unroll
                for (int m = 0; m < 4; ++m) {
                    const f32x4 a = acc[m][0], x = acc[m][1];
                    const float A0 = a[0], H0 = x[0], A1 = A0 * a[1], H1 = a[1] * H0 + x[1], A2 = A1 * a[2], H2 = a[2] * H1 + x[2], A3 = A2 * a[3], H3 = a[3] * H2 + x[3];
                    Aj[m] = (f32x4){A0, A1, A2, A3}; Hj[m] = (f32x4){H0, H1, H2, H3};
                    float TA = A3, TH = H3;
                    float tA = __shfl_up(TA, 16), tH = __shfl_up(TH, 16); if (fq >= 1) { TH = TA * tH + TH; TA = TA * tA; }
                    tA = __shfl_up(TA, 32); tH = __shfl_up(TH, 32); if (fq >= 2) { TH = TA * tH + TH; TA = TA * tA; }
                    float EA = __shfl_up(TA, 16), EH = __shfl_up(TH, 16); if (fq == 0) { EA = 1.f; EH = 0.f; }
                    TAi[m] = TA; THi[m] = TH; EAi[m] = EA; EHi[m] = EH;
                    gAi[m] = __shfl(TA, fr + 48); gHi[m] = __shfl(TH, fr + 48);
                }
                float cA = 1.f, cH = 0.f;
#pragma unroll
                for (int m = 0; m < 4; ++m) {
                    const float inA = cA * EAi[m], inH = EAi[m] * cH + EHi[m];
                    pf[m] = Aj[m] * inA;
                    hf[m] = Aj[m] * inH + Hj[m];
                    cH = gAi[m] * cH + gHi[m]; cA = cA * gAi[m];
                }
                if (fq == 0) { float* cs = csum + ((size_t)(b * NCHUNK + cidx) * 2 + 0) * 512 + c; cs[0] = cA; cs[256] = cH; }
            }
            {
                float EAi[4], EHi[4], gAi[4], gHi[4]; f32x4 Aj[4], Hj[4];
#pragma unroll
                for (int m = 0; m < 4; ++m) {
                    const f32x4 a = acc[m][2], x = acc[m][3];
                    const float A3 = a[3], H3 = x[3], A2 = A3 * a[2], H2 = a[2] * H3 + x[2], A1 = A2 * a[1], H1 = a[1] * H2 + x[1], A0 = A1 * a[0], H0 = a[0] * H1 + x[0];
                    Aj[m] = (f32x4){A0, A1, A2, A3}; Hj[m] = (f32x4){H0, H1, H2, H3};
                    float TA = A0, TH = H0;
                    float tA = __shfl_down(TA, 16), tH = __shfl_down(TH, 16); if (fq <= 2) { TH = TA * tH + TH; TA = TA * tA; }
                    tA = __shfl_down(TA, 32); tH = __shfl_down(TH, 32); if (fq <= 1) { TH = TA * tH + TH; TA = TA * tA; }
                    float EA = __shfl_down(TA, 16), EH = __shfl_down(TH, 16); if (fq == 3) { EA = 1.f; EH = 0.f; }
                    EAi[m] = EA; EHi[m] = EH;
                    gAi[m] = __shfl(TA, fr); gHi[m] = __shfl(TH, fr);
                }
                float cA = 1.f, cH = 0.f;
#pragma unroll
                for (int mm = 0; mm < 4; ++mm) { const int m = 3 - mm;
                    const float inA = cA * EAi[m], inH = EAi[m] * cH + EHi[m];
                    const f32x4 pb = Aj[m] * inA, hb = Aj[m] * inH + Hj[m];
#pragma unroll
                    for (int j = 0; j < 4; ++j) { const int tk = 16 * m + 4 * fq + j;
                        ldsU[tk * L1_UST + c] = hf[m][j] + hb[j];
                        PPg[(size_t)(rbase + P0 + tk) * 256 + c] = (cvt_pk(pf[m][j], 0.f) & 0xffffu) | (cvt_pk(0.f, pb[j]) & 0xffff0000u); }
                    cH = gAi[m] * cH + gHi[m]; cA = cA * gAi[m];
                }
                if (fq == 0) { float* cs = csum + ((size_t)(b * NCHUNK + cidx) * 2 + 1) * 512 + c; cs[0] = cA; cs[256] = cH; }
            }
        }
        LDS_BARRIER();
#pragma unroll
        for (int it = 0; it < 8; ++it) { const int idx = it * NTHREADS + tid, r = idx >> 6, c16 = idx & 63; const size_t grow = (size_t)(rbase + P0 + r) * 256 + c16 * 4;
            *(f32x4*)(Sg + grow) = *(const LAS f32x4*)(ldsU + r * L1_UST + c16 * 4);
 }
        LDS_BARRIER();
    }
}
__device__ __forceinline__ void lru2_batch(const Params& P, int b) {
    const int tid = opaque_tid(), dir = tid >> 8, c = tid & 255;
    const float* csum = (const float*)(P.ws + OFF_CSUM); float* carry = (float*)(P.ws + OFF_CARRY);
    float h = 0.f;
#pragma unroll 1
    for (int k0 = 0; k0 < NCHUNK; k0 += 33) {
        float A[33], H[33]; int ci[33];
#pragma unroll
        for (int q = 0; q < 33; ++q) { const int k = k0 + q; ci[q] = dir == 0 ? k : (k < 4 ? 3 - k : 135 - k);
            const float* cs = csum + ((size_t)(b * NCHUNK + ci[q]) * 2 + dir) * 512 + c; A[q] = cs[0]; H[q] = cs[256]; }
#pragma unroll
        for (int q = 0; q < 33; ++q) { carry[((size_t)(b * NCHUNK + ci[q]) * 2 + dir) * 256 + c] = h; h = A[q] * h + H[q]; }
    }
}
__device__ __forceinline__ float gelu_tanh(float x) { const float z = 0.7978845608f * (x + 0.044715f * x * x * x); const float t = 1.0f - 2.0f * __builtin_amdgcn_rcpf(1.0f + __expf(2.0f * z)); return 0.5f * x * (1.0f + t); }
__device__ __forceinline__ void merge_phase(const Params& P, int l, int Mrows, int G) {
    const int tid = opaque_tid(), lane = tid & 63, wid = __builtin_amdgcn_readfirstlane(tid >> 6);
    const int gw = blockIdx.x * 8 + wid, NGW = G * 8, c4 = 4 * lane;
    const bf16_t* U5 = (const bf16_t*)(P.ws + OFF_U5);
    const bf16_t *Gb = U5 + U5_STRIDE, *BGb = U5 + 2 * U5_STRIDE, *CGb = U5 + 3 * U5_STRIDE, *SSb = U5 + 4 * U5_STRIDE;
    const float* Sg = (const float*)(P.ws + OFF_S); const unsigned* PPg = (const unsigned*)(P.ws + OFF_PP); const float* carry = (const float*)(P.ws + OFF_CARRY);
    bf16_t* hb = (bf16_t*)(P.ws + OFF_HBUF); const bf16_t* att = (const bf16_t*)(P.ws + OFF_ATT);
    f32x4 w0 = *(const f32x4*)(P.in[19] + (size_t)(l * 3 + 0) * 256 + c4), w1 = *(const f32x4*)(P.in[19] + (size_t)(l * 3 + 1) * 256 + c4), w2 = *(const f32x4*)(P.in[19] + (size_t)(l * 3 + 2) * 256 + c4);
    f32x4 cb4 = *(const f32x4*)(P.in[20] + (size_t)l * 256 + c4);
    const float* gg = P.in[21] + (size_t)l * 1024;
    const f32x4 ga0 = *(const f32x4*)(gg + 8 * lane), ga1 = *(const f32x4*)(gg + 8 * lane + 4), gl = *(const f32x4*)(gg + 512 + c4), gs = *(const f32x4*)(gg + 768 + c4);
    const int per = (Mrows + NGW - 1) / NGW, r0 = gw * per, r1 = (r0 + per < Mrows) ? r0 + per : Mrows;
    int curc = -1; f32x4 cf = {0.f, 0.f, 0.f, 0.f}, cbk = {0.f, 0.f, 0.f, 0.f};
    f32x4 pm1, p0, pp1;
    auto prodrow = [&](int r) -> f32x4 { const size_t o = (size_t)r * 256 + c4; const u32x2 a = *(const u32x2*)(CGb + o), s2 = *(const u32x2*)(SSb + o);
        return (f32x4){bf_lo(a.x) * bf_lo(s2.x), bf_hi(a.x) * bf_hi(s2.x), bf_lo(a.y) * bf_lo(s2.y), bf_hi(a.y) * bf_hi(s2.y)}; };
    const f32x4 zero4 = {0.f, 0.f, 0.f, 0.f};
    if (r0 < r1) { const int sp = r0 < MLAT ? (r0 & 8191) : ((r0 - MLAT) & 255); pm1 = sp == 0 ? zero4 : prodrow(r0 - 1); p0 = prodrow(r0); }
    for (int row = r0; row < r1; ++row) {
        int b, cidx, sp, slen;
        if (row < MLAT) { b = row >> 13; sp = row & 8191; cidx = 4 + (sp >> 6); slen = SEQ; } else { const int rc = row - MLAT; b = rc >> 8; sp = rc & 255; cidx = sp >> 6; slen = CTXL; }
        const int ckey = b * NCHUNK + cidx;
        if (ckey != curc) { curc = ckey; cf = *(const f32x4*)(carry + ((size_t)ckey * 2 + 0) * 256 + c4); cbk = *(const f32x4*)(carry + ((size_t)ckey * 2 + 1) * 256 + c4); }
        if (sp == 0) { pm1 = zero4; if (row != r0) p0 = prodrow(row); }
        pp1 = (sp + 1 == slen) ? zero4 : prodrow(row + 1);
        {   const size_t o = (size_t)row * 256 + c4;
            const f32x4 S4 = *(const f32x4*)(Sg + o); const u32x4 pp = *(const u32x4*)(PPg + o);
            const u32x2 g2 = *(const u32x2*)(Gb + o), bg2 = *(const u32x2*)(BGb + o);
            const u32x4 at = *(const u32x4*)(att + (size_t)row * 512 + 8 * lane);
            f32x4 hv;
#pragma unroll
            for (int j = 0; j < 4; ++j) hv[j] = S4[j] + bf_lo(pp[j]) * cf[j] + bf_hi(pp[j]) * cbk[j];
            const f32x4 g4 = (f32x4){bf_lo(g2.x), bf_hi(g2.x), bf_lo(g2.y), bf_hi(g2.y)}, bg4 = (f32x4){bf_lo(bg2.x), bf_hi(bg2.x), bf_lo(bg2.y), bf_hi(bg2.y)};
            f32x4 lru, scv;
#pragma unroll
            for (int j = 0; j < 4; ++j) { lru[j] = hv[j] * gelu_tanh(g4[j]); scv[j] = bg4[j] * (w0[j] * pm1[j] + w1[j] * p0[j] + w2[j] * pp1[j] + cb4[j]); }
            float av[8];
#pragma unroll
            for (int j = 0; j < 4; ++j) { av[2 * j] = bf_lo(at[j]); av[2 * j + 1] = bf_hi(at[j]); }
            float ssa = 0.f, ssl = 0.f, sss = 0.f;
#pragma unroll
            for (int j = 0; j < 8; ++j) ssa += av[j] * av[j];
#pragma unroll
            for (int j = 0; j < 4; ++j) { ssl += lru[j] * lru[j]; sss += scv[j] * scv[j]; }
            ssa = wave_sum(ssa); ssl = wave_sum(ssl); sss = wave_sum(sss);
            const float ra = 1.0f / sqrtf(ssa * (1.0f / 512.0f) + EPS), rl = 1.0f / sqrtf(ssl * (1.0f / 256.0f) + EPS), rs = 1.0f / sqrtf(sss * (1.0f / 256.0f) + EPS);
            u32x4 wa; wa.x = cvt_pk(av[0] * ra * ga0[0], av[1] * ra * ga0[1]); wa.y = cvt_pk(av[2] * ra * ga0[2], av[3] * ra * ga0[3]); wa.z = cvt_pk(av[4] * ra * ga1[0], av[5] * ra * ga1[1]); wa.w = cvt_pk(av[6] * ra * ga1[2], av[7] * ra * ga1[3]);
            *(u32x4*)(hb + (size_t)row * DM + 8 * lane) = wa;
            u32x2 wl; wl.x = cvt_pk(lru[0] * rl * gl[0], lru[1] * rl * gl[1]); wl.y = cvt_pk(lru[2] * rl * gl[2], lru[3] * rl * gl[3]);
            *(u32x2*)(hb + (size_t)row * DM + 512 + c4) = wl;
            u32x2 wsv; wsv.x = cvt_pk(scv[0] * rs * gs[0], scv[1] * rs * gs[1]); wsv.y = cvt_pk(scv[2] * rs * gs[2], scv[3] * rs * gs[3]);
            *(u32x2*)(hb + (size_t)row * DM + 768 + c4) = wsv;
        }
        pm1 = p0; p0 = pp1;
    }
}
__device__ __forceinline__ void attention_phase(const Params& P, int l, char* lds, int G) {
    using abf = attn_body::bf16;
    const abf* Q = (const abf*)(P.ws + OFF_Q); const abf* K = (const abf*)(P.ws + OFF_K); const abf* V = (const abf*)(P.ws + OFF_V); abf* O = (abf*)(P.ws + OFF_ATT);
    if (blockIdx.x < NBATCH) lru2_batch(P, blockIdx.x);
    const int nunits = NBATCH * 8 * 32 + ((l + 1 < DEPTH) ? NBATCH * 8 : 0);
    for (int uid = blockIdx.x; uid < nunits; uid += G) {
        int b, h, NT; size_t qrow;
        if (uid < NBATCH * 8 * 32) { b = uid & 7; const int rest = uid >> 3, kvh = rest >> 7, u = rest & 127; h = kvh * 4 + (u >> 5); qrow = (size_t)b * SEQ + (u & 31) * 256; NT = NCHUNK; }
        else { const int v = uid - NBATCH * 8 * 32; b = v & 7; h = v >> 3; qrow = (size_t)MLAT + b * CTXL; NT = 4; }
        const size_t kvoff = (size_t)b * KEYS * 128 + (h >> 2) * 64;
        attn_body::attn_unit<8>(Q + qrow * 512 + h * 64, K + kvoff, V + kvoff, O + qrow * 512 + h * 64, NT, lds);
    }
}

#define XB_TMO      128
#define XB_XCNT(j)  (256  + 64 * (j))
#define XB_XSUB(j)  (1280 + 64 * (j))
#define XB_XGEN(j)  (2304 + 64 * (j))
#define XB_TOP      3328
#define XB_TOPGEN   3392
#define XCD_BAR_WORDS 3456
#define XB_SPIN_CAP (1u << 18)

__device__ __forceinline__ unsigned xb_ld(unsigned* p)              { return __hip_atomic_load(p, __ATOMIC_RELAXED, __HIP_MEMORY_SCOPE_AGENT); }
__device__ __forceinline__ unsigned xb_add(unsigned* p, unsigned v) { return __hip_atomic_fetch_add(p, v, __ATOMIC_RELAXED, __HIP_MEMORY_SCOPE_AGENT); }
__device__ __forceinline__ unsigned xb_xcc_id() { return (unsigned)__builtin_amdgcn_s_getreg((3 << 11) | 20) & 0xFu; }
#define XB_SPIN(cond, bar) do { unsigned _sp = 0; while (cond) { __builtin_amdgcn_s_sleep(1); \
    if ((++_sp & 255u) == 0u) { if (xb_ld(&(bar)[XB_TMO])) break; if (_sp > XB_SPIN_CAP) { atomicAdd(&(bar)[XB_TMO], 1u); break; } } } } while (0)

struct XcdBarrier {
    unsigned* bar; unsigned x;
    volatile LAS unsigned* st;
};

__device__ __forceinline__ XcdBarrier xcd_barrier_post(unsigned* bar, volatile LAS unsigned* st) {
    XcdBarrier b; b.bar = bar; b.x = xb_xcc_id(); b.st = st;
    if (threadIdx.x == 0) (void)xb_add(&bar[XB_XCNT(b.x)], 1u);
    return b;
}
__device__ __forceinline__ void xcd_barrier_complete(unsigned* bar, unsigned x, unsigned& nloc, unsigned& nx) {
    const unsigned G = gridDim.x * gridDim.y * gridDim.z;
    unsigned sum, cnt, mine, sp = 0u;
    for (;;) {
        sum = 0u; cnt = 0u; mine = 0u;
#pragma unroll
        for (unsigned j = 0; j < 16; ++j) { const unsigned c = xb_ld(&bar[XB_XCNT(j)]); sum += c; cnt += (c > 0u) ? 1u : 0u; mine = (j == x) ? c : mine; }
        if (sum == G) break;
        __builtin_amdgcn_s_sleep(1);
        if ((++sp & 255u) == 0u) { if (xb_ld(&bar[XB_TMO])) break; if (sp > XB_SPIN_CAP) { atomicAdd(&bar[XB_TMO], 1u); break; } }
    }
    nloc = mine > 0u ? mine : 1u; nx = cnt > 0u ? cnt : 1u;
}

__device__ __forceinline__ void xcd_barrier(const XcdBarrier& b) {
    asm volatile("s_waitcnt vmcnt(0)" ::: "memory");
    __syncthreads();
    if (threadIdx.x == 0) {
        unsigned* bar = b.bar; unsigned bx_ = b.x; asm volatile("" : "+s"(bx_));
        __builtin_amdgcn_s_waitcnt(0);
        unsigned nloc = b.st[0], nx = b.st[1];
        if (nloc == 0u) { xcd_barrier_complete(bar, bx_, nloc, nx); b.st[0] = nloc; b.st[1] = nx; }
        const unsigned old = xb_add(&bar[XB_XSUB(bx_)], 1u);
        const unsigned gen = old / nloc;
        if (old + 1u == (gen + 1u) * nloc) {
            __builtin_amdgcn_fence(__ATOMIC_RELEASE, "agent");
            asm volatile("s_waitcnt vmcnt(0)" ::: "memory");
            const unsigned og = xb_add(&bar[XB_TOP], 1u);
            const unsigned tg = og / nx;
            if (og + 1u == (tg + 1u) * nx) xb_add(&bar[XB_TOPGEN], 1u);
            else XB_SPIN(xb_ld(&bar[XB_TOPGEN]) == tg, bar);
            __builtin_amdgcn_fence(__ATOMIC_ACQUIRE, "agent");
            xb_add(&bar[XB_XGEN(bx_)], 1u);
            asm volatile("s_waitcnt vmcnt(0)" ::: "memory");
        } else {
            XB_SPIN(xb_ld(&bar[XB_XGEN(bx_)]) == gen, bar);
            __builtin_amdgcn_fence(__ATOMIC_ACQUIRE, "agent");
            asm volatile("s_waitcnt vmcnt(0)" ::: "memory");
        }
    }
    __syncthreads();
}

#ifndef PH_MASK
#define PH_MASK 0x1FF
#endif
__global__ void __launch_bounds__(NTHREADS, 2) fwd_megakernel(Params P) {
    extern __shared__ __attribute__((aligned(16))) unsigned char lds_raw[];
    LAS unsigned char* lds = (LAS unsigned char*)lds_raw;
    cg::grid_group grid = cg::this_grid();
    volatile LAS unsigned* bst = (volatile LAS unsigned*)(lds + LDS_BAR_OFF);
    if (threadIdx.x < 2) bst[threadIdx.x] = 0u;
    __syncthreads();
    const XcdBarrier xbar = xcd_barrier_post((unsigned*)(P.ws + OFF_CTL), bst);
#define GRID_SYNC() xcd_barrier(xbar)
    const int G = gridDim.x;
    unsigned char* ws = P.ws;
    if constexpr (PH_MASK & 1) prologue_phase(P, lds, G);
    grid.sync();
    if constexpr (PH_MASK & 2) norm_phase(P, 0, 0, 0, MTOT, true, 0, G);
    GRID_SYNC();
    for (int step = 0; step < DEPTH * 3; ++step) {
        const int l = step / 3, s3 = step % 3;
        const bool last = (l == DEPTH - 1);
        const int Mn = (last && s3 == 2) ? MLAT : MTOT;
        unsigned char* wb = ws + OFF_WB + (size_t)l * WB_LAYER;
        pg8::Gemm gr; pg8::EpiResid er; int Mr;
        const float* modl = (const float*)(ws + OFF_MOD) + (size_t)l * 9 * MODW;
        if (s3 != 1) {
            const int f = s3 >> 1;
            { pg8::Gemm g{(const bf16_t*)(ws + OFF_HBUF), (const bf16_t*)(wb + WB_FFIN + f * WB_FFIN_SZ), Mn, NFF2, DM};
              pg8::StaticOrder S; S.init(Mn, NFF2, G, (int)blockIdx.x);
              pg8::EpiSwiglu E{(bf16_t*)(ws + OFF_MID)};
              if constexpr (PH_MASK & 4) pg8::gemm_phase<pg8::EpiSwiglu, pg8::StaticOrder, true, true>(lds, g, S, E); }
            GRID_SYNC();
            Mr = Mn;
            gr = pg8::Gemm{(const bf16_t*)(ws + OFF_MID), (const bf16_t*)(wb + WB_FFOUT + f * WB_FFOUT_SZ), Mr, DM, DFF};
            er = pg8::EpiResid{(bf16_t*)(ws + OFF_XRES), P.in[0], P.in[2], modl + (3 * s3 + 2) * DM, 0.5f, step == 0 ? 1 : 0};
        } else {
            { LAS float* tab = (LAS float*)(lds + LDS_TAB_OFF);
              for (int i = opaque_tid(); i < 4096 + 128; i += NTHREADS) tab[i] = i < 4096 ? ((const float*)(ws + OFF_ROPE))[i] : (i < 4160 ? P.in[10][l * 64 + i - 4096] : P.in[11][l * 64 + i - 4160]);
              __syncthreads(); }
            { pg8::Gemm g{(const bf16_t*)(ws + OFF_HBUF), (const bf16_t*)(wb + WB_WIN), MTOT, INW, DM};
              pg8::StaticOrder S; S.init(MTOT, INW, G, (int)blockIdx.x);
              pg8::EpiWin E{(bf16_t*)(ws + OFF_Q), (bf16_t*)(ws + OFF_K), (bf16_t*)(ws + OFF_V), (bf16_t*)(ws + OFF_U5), (const LAS float*)(lds + LDS_TAB_OFF), 0.125f * 1.4426950408889634f};
              if constexpr (PH_MASK & 8) pg8::gemm_phase<pg8::EpiWin, pg8::StaticOrder, true, true>(lds, g, S, E); }
            GRID_SYNC();
            if constexpr (PH_MASK & 16) lru1_phase(P, l, lds, G);
            GRID_SYNC();
            if constexpr (PH_MASK & 32) attention_phase(P, l, (char*)lds_raw, G);
            GRID_SYNC();
            Mr = last ? MLAT : MTOT;
            if constexpr (PH_MASK & 64) merge_phase(P, l, Mr, G);
            GRID_SYNC();
            gr = pg8::Gemm{(const bf16_t*)(ws + OFF_HBUF), (const bf16_t*)(wb + WB_WOUT), Mr, DM, DM};
            er = pg8::EpiResid{(bf16_t*)(ws + OFF_XRES), P.in[0], P.in[2], modl + 5 * DM, 1.0f, 0};
        }
        const bool ctxr = (Mr == MTOT), has_next = step + 1 < DEPTH * 3;
        const int l2 = (step + 1) / 3, s32 = (step + 1) % 3, Mn2 = (l2 == DEPTH - 1 && s32 == 2) ? MLAT : MTOT;
        for (int pass = 0; pass < (ctxr ? 2 : 1); ++pass) {
            pg8::ResidOrder S; S.so.init(MLAT, DM, G, (int)blockIdx.x); S.single = pass; S.pm = 256 + ((int)blockIdx.x >> 2); S.pn = (int)blockIdx.x & 3;
            if (pass == 1 && (int)blockIdx.x >= 32) { if constexpr (PH_MASK & 2) norm_phase(P, l2, s32, 0, MLAT, false, 32, G - 32); }
            else { if constexpr (PH_MASK & 128) pg8::gemm_phase<pg8::EpiResid, pg8::ResidOrder, true, true>(lds, gr, S, er); }
            GRID_SYNC();
        }
        if (has_next) {
            if (ctxr) { if constexpr (PH_MASK & 2) norm_phase(P, l2, s32, MLAT, MTOT, false, 0, G); }
            else { if constexpr (PH_MASK & 2) norm_phase(P, l2, s32, 0, Mn2, false, 0, G); }
            GRID_SYNC();
        }
    }
    if constexpr (PH_MASK & 256) final_norm_phase(P, G);
}

extern "C" void kernel_launch(void* const* d_in, const int* in_sizes, int n_in, void* d_out, int out_size, void* d_ws, size_t ws_size, hipStream_t stream) {
    static int grid = 0;
    if (grid == 0) {
        if (n_in != 24 || out_size != MLAT * DM || ws_size < WS_NEED) { fprintf(stderr, "kernel_launch: unexpected shapes (n_in %d, out %d, ws %zu, need %zu)\n", n_in, out_size, ws_size, (size_t)WS_NEED); grid = -1; return; }
        int dev = 0, cus = 0, per_cu = 0;
        hipGetDevice(&dev); hipDeviceGetAttribute(&cus, hipDeviceAttributeMultiprocessorCount, dev);
        if (hipFuncSetAttribute((const void*)fwd_megakernel, hipFuncAttributeMaxDynamicSharedMemorySize, LDS_BYTES) != hipSuccess) { fprintf(stderr, "kernel_launch: hipFuncSetAttribute failed\n"); grid = -1; return; }
        if (hipOccupancyMaxActiveBlocksPerMultiprocessor(&per_cu, (const void*)fwd_megakernel, NTHREADS, LDS_BYTES) != hipSuccess || per_cu < 1) { fprintf(stderr, "kernel_launch: occupancy query says %d\n", per_cu); per_cu = 1; (void)hipGetLastError(); }
        grid = cus * 1;
        if (grid % 8 != 0 || grid <= 0) grid = 256;
        fprintf(stderr, "kernel_launch: grid %d (cus %d, per_cu %d)\n", grid, cus, per_cu);
    }
    if (grid < 0) return;
    Params p{};
    for (int i = 0; i < 24; ++i) p.in[i] = (const float*)d_in[i];
    p.out = (float*)d_out; p.ws = (unsigned char*)d_ws;
    if (hipMemsetAsync((unsigned char*)d_ws + OFF_CTL, 0, CTL_BYTES, stream) != hipSuccess) { fprintf(stderr, "kernel_launch: memset of the barrier words failed\n"); return; }
    void* args[] = {&p};
    hipError_t e = hipLaunchCooperativeKernel((const void*)fwd_megakernel, dim3(grid), dim3(NTHREADS), args, LDS_BYTES, stream);
    if (e != hipSuccess) fprintf(stderr, "kernel_launch: cooperative launch failed: %s (grid %d)\n", hipGetErrorString(e), grid);
}
```

```cpp
#include <hip/hip_runtime.h>
#include <hip/hip_bf16.h>
#include <hip/hip_cooperative_groups.h>
#include <cstdio>
#include <cstdint>
#include <cmath>
namespace cg = cooperative_groups;

constexpr int DM = 1024, NBATCH = 8, SEQ = 8192, CTXL = 256, DEPTH = 2;
constexpr int MLAT = NBATCH * SEQ, MCTX = NBATCH * CTXL, MTOT = MLAT + MCTX;
constexpr int DFF = 2816, NFF2 = 2 * DFF, INW = 2048, NMODV = 9, MODW = 9 * DM;
constexpr int KEYS = SEQ + CTXL, NCHUNK = KEYS / 64;
constexpr float EPS = 1e-6f;
constexpr int NTHREADS = 512;
constexpr int LDS_BYTES = 155648;
constexpr int LDS_TAB_OFF = 131072;

constexpr size_t MiB = 1u << 20;
constexpr size_t OFF_MOD = 0;
constexpr size_t OFF_ROPE = 1 * MiB;
constexpr size_t OFF_LW = 1 * MiB + 65536;
constexpr size_t OFF_CSUM = 2 * MiB;
constexpr size_t OFF_CARRY = 7 * MiB;
constexpr size_t OFF_CTL = 9 * MiB + 524288, CTL_BYTES = 65536;
constexpr int LDS_BAR_OFF = 155392;
constexpr size_t OFF_WB = 10 * MiB;
constexpr size_t WB_LAYER = 39 * MiB;
constexpr size_t WB_FFIN = 0, WB_FFIN_SZ = (size_t)NFF2 * DM * 2;
constexpr size_t WB_FFOUT = 2 * WB_FFIN_SZ, WB_FFOUT_SZ = (size_t)DM * DFF * 2;
constexpr size_t WB_WIN = WB_FFOUT + 2 * WB_FFOUT_SZ, WB_WIN_SZ = (size_t)INW * DM * 2;
constexpr size_t WB_WOUT = WB_WIN + WB_WIN_SZ;
static_assert(WB_WOUT + (size_t)DM * DM * 2 == WB_LAYER, "weight map");
constexpr size_t OFF_XRES = 88 * MiB;
constexpr size_t OFF_HBUF = 352 * MiB;
constexpr size_t OFF_R1 = 484 * MiB;
constexpr size_t OFF_MID = OFF_R1;
constexpr size_t OFF_Q = OFF_R1;
constexpr size_t OFF_K = OFF_R1 + 66 * MiB;
constexpr size_t OFF_V = OFF_K + 16 * MiB + 524288;
constexpr size_t OFF_U5 = OFF_R1 + 99 * MiB;
constexpr size_t U5_STRIDE = (size_t)MTOT * 256;
constexpr size_t OFF_S = OFF_R1 + 264 * MiB;
constexpr size_t OFF_PP = OFF_R1 + 330 * MiB;
constexpr size_t OFF_ATT = OFF_R1 + 396 * MiB;
constexpr size_t WS_NEED = OFF_ATT + 66 * MiB;

#define LAS __attribute__((address_space(3)))
typedef unsigned short bf16_t;
typedef float f32x4 __attribute__((ext_vector_type(4)));
typedef float f32x2 __attribute__((ext_vector_type(2)));
typedef unsigned u32x4 __attribute__((ext_vector_type(4)));
typedef unsigned u32x2 __attribute__((ext_vector_type(2)));

struct Params { const float* in[24]; float* out; unsigned char* ws; };

__device__ __forceinline__ unsigned cvt_pk(float lo, float hi) { unsigned r; asm volatile("v_cvt_pk_bf16_f32 %0, %1, %2" : "=v"(r) : "v"(lo), "v"(hi)); return r; }
__device__ __forceinline__ float bf_lo(unsigned w) { return __uint_as_float(w << 16); }
__device__ __forceinline__ float bf_hi(unsigned w) { return __uint_as_float(w & 0xffff0000u); }
__device__ __forceinline__ float rows4_sum(float v) {
    { const auto r = __builtin_amdgcn_permlane16_swap(__float_as_uint(v), __float_as_uint(v), false, false); v = __uint_as_float(r[0]) + __uint_as_float(r[1]); }
    { const auto r = __builtin_amdgcn_permlane32_swap(__float_as_uint(v), __float_as_uint(v), false, false); v = __uint_as_float(r[0]) + __uint_as_float(r[1]); }
    return v;
}
#define DPP_F(v, ctrl) __int_as_float(__builtin_amdgcn_mov_dpp(__float_as_int(v), (ctrl), 0xF, 0xF, true))
__device__ __forceinline__ float wave_sum(float v) {
    v += DPP_F(v, 0xB1);
    v += DPP_F(v, 0x4E);
    v += DPP_F(v, 0x141);
    v += DPP_F(v, 0x140);
    return rows4_sum(v);
}
__device__ __forceinline__ int opaque_tid() { int t = threadIdx.x; asm volatile("" : "+v"(t)); return t; }
__device__ __forceinline__ float sigmoidf_(float z) { return __builtin_amdgcn_rcpf(1.0f + __expf(-z)); }
namespace pg8 {
#define PG8_LAS __attribute__((address_space(3)))
typedef unsigned short bf16_t;
typedef short bf16x8 __attribute__((ext_vector_type(8)));
typedef float f32x4 __attribute__((ext_vector_type(4)));
typedef unsigned u32x4 __attribute__((ext_vector_type(4)));
constexpr int BM = 256, BK = 64, HALF = 128, HTB = HALF * BK * 2  , STAGE_BYTES = 8 * HTB, NXCD = 8, WGM = 4;

__host__ __device__ __forceinline__ int lds_byte(int r, int c) { const int st = (r >> 4) * 2 + (c >> 5), rr = r & 15, cc = c & 31, ob = rr * 64 + cc * 2; return st * 1024 + (ob ^ (((ob >> 9) & 1) << 5)); }
__host__ __device__ __forceinline__ void stage_rc(int b, int& R, int& C) { const int st = b / 1024, sb = b % 1024, swz = sb ^ (((sb >> 9) & 1) << 5); R = (st >> 1) * 16 + swz / 64; C = (st & 1) * 32 + (swz % 64) / 2; }
__host__ __device__ __forceinline__ int perm32(int rho) { const int n = rho >> 4, i = rho & 15; return 8 * (i >> 2) + 4 * n + (i & 3); }

struct Unit { int pm, pn; };
struct Gemm { const bf16_t* A; const bf16_t* Bt; int M, N, K; };

struct StaticOrder {
    int nM, nN, nwg, G, c;
    __host__ __device__ void init(int M, int N, int G_, int c_) { nM = M / BM; nN = N / BM; nwg = nM * nN; G = G_; c = c_; }
    __host__ __device__ bool next(int i, Unit& u) const {
        const long L = (long)i * G + c; if (L >= nwg) return false;
        int wgid = (int)L; { const int q = nwg / NXCD, r = nwg % NXCD, xcd = wgid % NXCD, off = wgid / NXCD; wgid = (xcd < r ? xcd * (q + 1) : r * (q + 1) + (xcd - r) * q) + off; }
        const int nig = WGM * nN, gid = wgid / nig, fm = gid * WGM, gsz = (nM - fm) < WGM ? (nM - fm) : WGM;
        u.pm = fm + ((wgid % nig) % gsz); u.pn = (wgid % nig) / gsz; return true;
    }
    __device__ __forceinline__ void a_ready(const Unit&) const {}
    __device__ __forceinline__ void done(const Unit&) const {}
};
__device__ __forceinline__ unsigned cvt_pk_bf16(float lo, float hi) { unsigned r; asm volatile("v_cvt_pk_bf16_f32 %0, %1, %2" : "=v"(r) : "v"(lo), "v"(hi)); return r; }

struct EpiSwiglu {
    static constexpr bool PERM = false, AFTER_DRAIN = false;
    bf16_t* O;
    __device__ __forceinline__ void operator()(const f32x4 (&acc)[2][2][4][2], const Unit& u, int wr, int wc, int fr, int fq) const {
        const int row0 = u.pm * BM + wr * 64 + fr, col0 = u.pn * 128 + wc * 32 + 8 * fq;
#pragma unroll
        for (int ai = 0; ai < 2; ++ai)
#pragma unroll
            for (int m = 0; m < 4; ++m) {
                bf16_t* rowp = O + (size_t)(row0 + ai * HALF + m * 16) * 2816 + col0;
                float v[8];
#pragma unroll
                for (int n = 0; n < 2; ++n)
#pragma unroll
                    for (int j = 0; j < 4; ++j) { const float g = acc[ai][0][m][n][j], up = acc[ai][1][m][n][j]; v[n * 4 + j] = g * __builtin_amdgcn_rcpf(1.0f + __expf(-g)) * up; }
                u32x4 w; w.x = cvt_pk_bf16(v[0], v[1]); w.y = cvt_pk_bf16(v[2], v[3]); w.z = cvt_pk_bf16(v[4], v[5]); w.w = cvt_pk_bf16(v[6], v[7]);
                *(u32x4*)rowp = w;
            }
    }
};
struct EpiResid {
    static constexpr bool PERM = false, AFTER_DRAIN = false;
    bf16_t* X; const float* Xlat; const float* Xctx; const float* gate; float scale; int first;
    __device__ __forceinline__ void operator()(const f32x4 (&acc)[2][2][4][2], const Unit& u, int wr, int wc, int fr, int fq) const {
        const int v = u.pm < 256 ? (u.pm >> 5) : 8;
        const int row0 = u.pm * BM + wr * 64 + fr, col0 = u.pn * BM + wc * 32 + 8 * fq;
        const float* gp = gate + (size_t)v * 9216 + col0;
        f32x4 gv[2][2];
#pragma unroll
        for (int bj = 0; bj < 2; ++bj)
#pragma unroll
            for (int n = 0; n < 2; ++n) gv[bj][n] = *(const f32x4*)(gp + bj * HALF + n * 4) * scale;
#pragma unroll
        for (int ai = 0; ai < 2; ++ai) {
            bf16_t* rowp = X + (size_t)(row0 + ai * HALF) * 1024 + col0;
            f32x4 xv[4][2][2];
            if (first) {
                const float* rowr = (u.pm < 256 ? Xlat + (size_t)(row0 + ai * HALF) * 1024 : Xctx + (size_t)(row0 + ai * HALF - 65536) * 1024) + col0;
#pragma unroll
                for (int m = 0; m < 4; ++m)
#pragma unroll
                    for (int bj = 0; bj < 2; ++bj)
#pragma unroll
                        for (int n = 0; n < 2; ++n) xv[m][bj][n] = *(const f32x4*)(rowr + (size_t)m * 16 * 1024 + bj * HALF + n * 4);
            } else {
                u32x4 raw[4][2];
#pragma unroll
                for (int m = 0; m < 4; ++m)
#pragma unroll
                    for (int bj = 0; bj < 2; ++bj) raw[m][bj] = *(const u32x4*)(rowp + (size_t)m * 16 * 1024 + bj * HALF);
#pragma unroll
                for (int m = 0; m < 4; ++m)
#pragma unroll
                    for (int bj = 0; bj < 2; ++bj) { const u32x4 r = raw[m][bj];
                        xv[m][bj][0] = (f32x4){__uint_as_float(r.x << 16), __uint_as_float(r.x & 0xffff0000u), __uint_as_float(r.y << 16), __uint_as_float(r.y & 0xffff0000u)};
                        xv[m][bj][1] = (f32x4){__uint_as_float(r.z << 16), __uint_as_float(r.z & 0xffff0000u), __uint_as_float(r.w << 16), __uint_as_float(r.w & 0xffff0000u)}; }
            }
#pragma unroll
            for (int m = 0; m < 4; ++m)
#pragma unroll
                for (int bj = 0; bj < 2; ++bj) { const f32x4 y0 = xv[m][bj][0] + gv[bj][0] * acc[ai][bj][m][0], y1 = xv[m][bj][1] + gv[bj][1] * acc[ai][bj][m][1];
                    u32x4 w; w.x = cvt_pk_bf16(y0[0], y0[1]); w.y = cvt_pk_bf16(y0[2], y0[3]); w.z = cvt_pk_bf16(y1[0], y1[1]); w.w = cvt_pk_bf16(y1[2], y1[3]);
                    *(u32x4*)(rowp + (size_t)m * 16 * 1024 + bj * HALF) = w; }
        }
    }
};
struct ResidOrder {
    StaticOrder so; int single, pm, pn;
    __device__ __forceinline__ bool next(int i, Unit& u) const { if (single) { if (i > 0) return false; u.pm = pm; u.pn = pn; return true; } return so.next(i, u); }
    __device__ __forceinline__ void a_ready(const Unit&) const {}
    __device__ __forceinline__ void done(const Unit&) const {}
};
struct EpiWin {
    static constexpr bool PERM = false, AFTER_DRAIN = false;
    bf16_t *Q, *K, *V, *U5; const PG8_LAS float* tab; float qscale;
    __device__ __forceinline__ void operator()(const f32x4 (&acc)[2][2][4][2], const Unit& u, int wr, int wc, int fr, int fq) const {
        const int row0 = u.pm * BM + wr * 64 + fr;
        if (u.pn >= 3) {
            bf16_t* base = U5 + (size_t)(u.pn - 3) * ((size_t)67584 * 256) + wc * 32 + 8 * fq;
#pragma unroll
            for (int ai = 0; ai < 2; ++ai)
#pragma unroll
                for (int m = 0; m < 4; ++m) { bf16_t* rowp = base + (size_t)(row0 + ai * HALF + m * 16) * 256;
#pragma unroll
                    for (int bj = 0; bj < 2; ++bj) { const f32x4 v0 = acc[ai][bj][m][0], v1 = acc[ai][bj][m][1];
                        u32x4 w; w.x = cvt_pk_bf16(v0[0], v0[1]); w.y = cvt_pk_bf16(v0[2], v0[3]); w.z = cvt_pk_bf16(v1[0], v1[1]); w.w = cvt_pk_bf16(v1[2], v1[3]);
                        *(u32x4*)(rowp + bj * HALF) = w; } }
            return;
        }
        const int kind = u.pn < 2 ? 0 : (wc < 2 ? 1 : 2);
        const bool latent = u.pm < 256;
        const PG8_LAS float* gsrc = tab + 4096 + (kind == 0 ? 0 : 64);
        float rinv[8];
#pragma unroll
        for (int q = 0; q < 8; ++q) { float ss = 0.f;
#pragma unroll
            for (int bj = 0; bj < 2; ++bj)
#pragma unroll
                for (int n = 0; n < 2; ++n) { const f32x4 t = acc[q >> 2][bj][q & 3][n]; ss += (t[0] * t[0] + t[1] * t[1]) + (t[2] * t[2] + t[3] * t[3]); }
            rinv[q] = ss; }
        if (kind != 2) {
#pragma unroll
            for (int q = 0; q < 8; ++q) rinv[q] = __builtin_amdgcn_rsqf(rows4_sum(rinv[q]) * (1.0f / 64.0f) + 1e-6f);
        }
#pragma unroll
        for (int ai = 0; ai < 2; ++ai)
#pragma unroll
            for (int m = 0; m < 4; ++m) {
                const int row = row0 + ai * HALF + m * 16;
                f32x4 y[2][2];
#pragma unroll
                for (int bj = 0; bj < 2; ++bj)
#pragma unroll
                    for (int n = 0; n < 2; ++n) y[bj][n] = acc[ai][bj][m][n];
                if (kind != 2) {
                    const float r = rinv[ai * 4 + m];
#pragma unroll
                    for (int bj = 0; bj < 2; ++bj)
#pragma unroll
                        for (int n = 0; n < 2; ++n) y[bj][n] = y[bj][n] * r * *(const PG8_LAS f32x4*)(gsrc + 32 * bj + 16 * n + 4 * fq);
                    if (latent) {
                        const int s = row & 8191;
#pragma unroll
                        for (int bj = 0; bj < 2; ++bj) { const int pos = bj == 0 ? (s >> 6) : (s & 63);
                            const f32x4 c4 = *(const PG8_LAS f32x4*)(tab + pos * 16 + 4 * fq), s4 = *(const PG8_LAS f32x4*)(tab + 2048 + pos * 16 + 4 * fq);
                            const f32x4 x1 = y[bj][0], x2 = y[bj][1];
                            y[bj][0] = x1 * c4 - x2 * s4; y[bj][1] = x2 * c4 + x1 * s4; }
                    }
                }
                bf16_t* dst;
                if (kind == 0) { dst = Q + (size_t)row * 512 + (u.pn * 4 + wc) * 64;
#pragma unroll
                    for (int bj = 0; bj < 2; ++bj)
#pragma unroll
                        for (int n = 0; n < 2; ++n) y[bj][n] = y[bj][n] * qscale;
                } else {
                    size_t kr;
                    if (latent) kr = (size_t)(row >> 13) * 8448 + 256 + (row & 8191);
                    else { const int rc = row - 65536; kr = (size_t)(rc >> 8) * 8448 + (rc & 255); }
                    dst = (kind == 1 ? K : V) + kr * 128 + (wc & 1) * 64;
                }
                if (kind != 2) {
#pragma unroll
                    for (int bj = 0; bj < 2; ++bj) { u32x4 w; w.x = cvt_pk_bf16(y[bj][0][0], y[bj][0][1]); w.y = cvt_pk_bf16(y[bj][0][2], y[bj][0][3]); w.z = cvt_pk_bf16(y[bj][1][0], y[bj][1][1]); w.w = cvt_pk_bf16(y[bj][1][2], y[bj][1][3]);
                        *(u32x4*)(dst + 32 * bj + 8 * fq) = w; }
                } else {
#pragma unroll
                    for (int bj = 0; bj < 2; ++bj)
#pragma unroll
                        for (int n = 0; n < 2; ++n) { u32x2 w; w.x = cvt_pk_bf16(y[bj][n][0], y[bj][n][1]); w.y = cvt_pk_bf16(y[bj][n][2], y[bj][n][3]);
                            *(u32x2*)(dst + 32 * bj + 16 * n + 4 * fq) = w; }
                }
            }
    }
};
template <class Epi, class Sched, bool ALIGN_EPI = false, bool SP2 = false>
__device__ __forceinline__ void gemm_phase(PG8_LAS unsigned char* lds, const Gemm g, const Sched& S, const Epi& E) {
    const int tid = opaque_tid(), wid = __builtin_amdgcn_readfirstlane(tid >> 6), lane = tid & 63, wr = wid >> 2, wc = wid & 3, fr = lane & 15, fq = lane >> 4;
    const int K = g.K, nt = K / BK;
    unsigned voffA[2], voffB[2];
#pragma unroll
    for (int i = 0; i < 2; ++i) { int R, C; stage_rc(tid * 16 + i * 8192, R, C); const int Rb = Epi::PERM ? ((R & ~31) + perm32(R & 31)) : R;
        voffA[i] = (unsigned)(R * K + C) * 2u; voffB[i] = (unsigned)(Rb * K + C) * 2u; }
    const size_t kstep = (size_t)(BK * 2);
    const size_t hstep = (size_t)HALF * K * 2;
    const size_t tstep = 2 * hstep;
    const unsigned ldsw = (unsigned)wid * 1024u;
    const int aoff = lds_byte(wr * 64 + fr, fq * 8), boff = lds_byte(wc * 32 + fr, fq * 8);
#define PG8_SA(b, h) (((b) * 2 + (h)) * HTB)
#define PG8_SB(b, h) ((4 + (b) * 2 + (h)) * HTB)
#define PG8_STAGE(bufoff, gbase, voff) do { _Pragma("unroll") for (int _i = 0; _i < 2; ++_i) \
        __builtin_amdgcn_global_load_lds((const unsigned*)((const char*)(gbase) + (voff)[_i]), (PG8_LAS unsigned*)(lds + (bufoff) + ldsw + _i * 8192), 16, 0, 0); } while (0)
#define PG8_LDA(dst, b, h) do { _Pragma("unroll") for (int m = 0; m < 4; ++m) _Pragma("unroll") for (int k = 0; k < 2; ++k) dst[m][k] = *(const PG8_LAS bf16x8*)(lds + PG8_SA(b, h) + aoff + m * 2048 + k * 1024); } while (0)
#define PG8_LDB(dst, b, h) do { _Pragma("unroll") for (int n = 0; n < 2; ++n) _Pragma("unroll") for (int k = 0; k < 2; ++k) dst[n][k] = *(const PG8_LAS bf16x8*)(lds + PG8_SB(b, h) + boff + n * 2048 + k * 1024); } while (0)
#define PG8_MMA(ai, bj, At, Bt) do { __builtin_amdgcn_s_setprio(1); _Pragma("unroll") for (int m = 0; m < 4; ++m) _Pragma("unroll") for (int n = 0; n < 2; ++n) _Pragma("unroll") for (int k = 0; k < 2; ++k) \
        acc[ai][bj][m][n] = __builtin_amdgcn_mfma_f32_16x16x32_bf16(Bt[n][k], At[m][k], acc[ai][bj][m][n], 0, 0, 0); __builtin_amdgcn_s_setprio(0); } while (0)
#define PG8_WAIT_V(n) asm volatile("s_waitcnt vmcnt(" #n ")" ::: "memory")
#define PG8_WAIT_L(n) asm volatile("s_waitcnt lgkmcnt(" #n ")" ::: "memory")
#define PG8_BAR __builtin_amdgcn_s_barrier()
#define PG8_SCHED __builtin_amdgcn_sched_barrier(0)
    Unit cur, nxt; int ui = 0;
    if (!S.next(0, cur)) return;
    f32x4 acc[2][2][4][2];
#pragma unroll
    for (int a = 0; a < 2; ++a)
#pragma unroll
        for (int b = 0; b < 2; ++b)
#pragma unroll
            for (int m = 0; m < 4; ++m)
#pragma unroll
                for (int n = 0; n < 2; ++n) acc[a][b][m][n] = (f32x4){0.f, 0.f, 0.f, 0.f};
    bf16x8 At[4][2], B0[2][2], B1[2][2];
    const char* cA = (const char*)g.A + (size_t)cur.pm * tstep; const char* cB = (const char*)g.Bt + (size_t)cur.pn * tstep;
    S.a_ready(cur);
    if constexpr (SP2) {
        PG8_STAGE(PG8_SB(0, 0), cB, voffB); PG8_STAGE(PG8_SB(0, 1), cB + hstep, voffB); PG8_STAGE(PG8_SA(0, 0), cA, voffA); PG8_STAGE(PG8_SA(0, 1), cA + hstep, voffA);
        if (wr == 1) PG8_BAR;
        PG8_WAIT_V(2); PG8_BAR;
        PG8_STAGE(PG8_SB(1, 0), cB + kstep, voffB); PG8_STAGE(PG8_SA(1, 0), cA + kstep, voffA); PG8_STAGE(PG8_SB(1, 1), cB + hstep + kstep, voffB);
        PG8_WAIT_V(6); PG8_BAR;
    } else {
        PG8_STAGE(PG8_SB(0, 0), cB, voffB); PG8_STAGE(PG8_SA(0, 0), cA, voffA); PG8_STAGE(PG8_SB(0, 1), cB + hstep, voffB); PG8_STAGE(PG8_SA(0, 1), cA + hstep, voffA);
        if (wr == 1) PG8_BAR;
        PG8_WAIT_V(4); PG8_BAR;
        PG8_STAGE(PG8_SB(1, 0), cB + kstep, voffB); PG8_STAGE(PG8_SA(1, 0), cA + kstep, voffA); PG8_STAGE(PG8_SB(1, 1), cB + hstep + kstep, voffB);
        PG8_WAIT_V(6); PG8_BAR;
    }
    for (;;) {
        const bool has_next = S.next(ui + 1, nxt);
        const char* nA = has_next ? (const char*)g.A + (size_t)nxt.pm * tstep : cA; const char* nB = has_next ? (const char*)g.Bt + (size_t)nxt.pn * tstep : cB;
        for (int t = 0; t < nt; t += 2) {
            const bool last = (t == nt - 2);
            const char* a1 = cA + (size_t)(t + 1) * kstep;
            const char* a2 = last ? nA : cA + (size_t)(t + 2) * kstep; const char* b2 = last ? nB : cB + (size_t)(t + 2) * kstep;
            const char* a3 = a2 + kstep; const char* b3 = b2 + kstep;
            if (last && has_next) S.a_ready(nxt);
            if constexpr (SP2) {
            PG8_LDB(B0, 0, 0); PG8_LDB(B1, 0, 1); PG8_SCHED; PG8_LDA(At, 0, 0); PG8_STAGE(PG8_SA(1, 1), a1 + hstep, voffA);
            PG8_WAIT_V(8); PG8_WAIT_L(0); PG8_BAR; PG8_MMA(0, 0, At, B0); PG8_MMA(0, 1, At, B1); PG8_BAR; PG8_SCHED;
            PG8_LDA(At, 0, 1); PG8_STAGE(PG8_SB(0, 0), b2, voffB); PG8_STAGE(PG8_SB(0, 1), b2 + hstep, voffB); PG8_STAGE(PG8_SA(0, 0), a2, voffA);
            PG8_WAIT_V(8); PG8_WAIT_L(0); PG8_BAR; PG8_MMA(1, 0, At, B0); PG8_MMA(1, 1, At, B1); PG8_BAR; PG8_SCHED;
            PG8_LDB(B0, 1, 0); PG8_LDB(B1, 1, 1); PG8_SCHED; PG8_LDA(At, 1, 0); PG8_STAGE(PG8_SA(0, 1), a2 + hstep, voffA);
            PG8_WAIT_V(8); PG8_WAIT_L(0); PG8_BAR; PG8_MMA(0, 0, At, B0); PG8_MMA(0, 1, At, B1); PG8_BAR; PG8_SCHED;
            PG8_LDA(At, 1, 1); PG8_STAGE(PG8_SB(1, 0), b3, voffB); PG8_STAGE(PG8_SB(1, 1), b3 + hstep, voffB); PG8_STAGE(PG8_SA(1, 0), a3, voffA);
            PG8_WAIT_V(8); PG8_WAIT_L(0); PG8_BAR; PG8_MMA(1, 0, At, B0); PG8_MMA(1, 1, At, B1); PG8_BAR; PG8_SCHED;
            } else {
            PG8_LDB(B0, 0, 0); PG8_SCHED; PG8_LDA(At, 0, 0); PG8_STAGE(PG8_SA(1, 1), a1 + hstep, voffA);
            PG8_WAIT_L(8); PG8_BAR; PG8_WAIT_L(0); PG8_MMA(0, 0, At, B0); PG8_BAR; PG8_SCHED;
            PG8_LDB(B1, 0, 1); PG8_STAGE(PG8_SB(0, 0), b2, voffB);
            PG8_BAR; PG8_WAIT_L(0); PG8_MMA(0, 1, At, B1); PG8_BAR;
            PG8_LDA(At, 0, 1); PG8_STAGE(PG8_SA(0, 0), a2, voffA);
            PG8_BAR; PG8_WAIT_L(0); PG8_MMA(1, 0, At, B0); PG8_BAR; PG8_SCHED;
            PG8_STAGE(PG8_SB(0, 1), b2 + hstep, voffB);
            PG8_WAIT_V(6); PG8_BAR; PG8_MMA(1, 1, At, B1); PG8_BAR;
            PG8_LDB(B0, 1, 0); PG8_SCHED; PG8_LDA(At, 1, 0); PG8_STAGE(PG8_SA(0, 1), a2 + hstep, voffA);
            PG8_WAIT_L(8); PG8_BAR; PG8_WAIT_L(0); PG8_MMA(0, 0, At, B0); PG8_BAR; PG8_SCHED;
            PG8_LDB(B1, 1, 1); PG8_STAGE(PG8_SB(1, 0), b3, voffB);
            PG8_BAR; PG8_WAIT_L(0); PG8_MMA(0, 1, At, B1); PG8_BAR;
            PG8_LDA(At, 1, 1); PG8_STAGE(PG8_SA(1, 0), a3, voffA);
            PG8_BAR; PG8_WAIT_L(0); PG8_MMA(1, 0, At, B0); PG8_BAR; PG8_SCHED;
            PG8_STAGE(PG8_SB(1, 1), b3 + hstep, voffB);
            PG8_WAIT_V(6); PG8_BAR; PG8_MMA(1, 1, At, B1); PG8_BAR;
            }
        }
        if constexpr (ALIGN_EPI) { if (wr == 0) PG8_BAR; }
        if constexpr (!Epi::AFTER_DRAIN) { E(acc, cur, wr, wc, fr, fq); S.done(cur); }
        if (!has_next) break;
#pragma unroll
        for (int a = 0; a < 2; ++a)
#pragma unroll
            for (int b = 0; b < 2; ++b)
#pragma unroll
                for (int m = 0; m < 4; ++m)
#pragma unroll
                    for (int n = 0; n < 2; ++n) acc[a][b][m][n] = (f32x4){0.f, 0.f, 0.f, 0.f};
        cur = nxt; cA = nA; cB = nB; ++ui;
        if constexpr (ALIGN_EPI) { if (wr == 1) PG8_BAR; }
    }
    PG8_WAIT_V(0);
    if constexpr (!ALIGN_EPI) { if (wr == 0) PG8_BAR; }
    PG8_BAR;
    if constexpr (Epi::AFTER_DRAIN) { E.fused(acc, cur, wr, wc, fr, fq, lds, wid, lane); S.done(cur); }
#undef PG8_SA
#undef PG8_SB
#undef PG8_STAGE
#undef PG8_LDA
#undef PG8_LDB
#undef PG8_MMA
#undef PG8_WAIT_V
#undef PG8_WAIT_L
#undef PG8_BAR
#undef PG8_SCHED
}
}

namespace attn_body {
using bf16=__hip_bfloat16;
using bf16x8=__attribute__((ext_vector_type(8)))short;
using s16x4=__attribute__((ext_vector_type(4)))short;
using f32x16=__attribute__((ext_vector_type(16)))float;
using u32x4=__attribute__((ext_vector_type(4)))unsigned;
constexpr int D=64, QP=512, KP=128, OP=512;
constexpr int NW=8,QBLK=32,QB=QBLK*NW,KVBLK=64;
__device__ __forceinline__ int crow(int r,int hi){return (r&3)+8*(r>>2)+4*hi;}
#define SBAR() __builtin_amdgcn_sched_barrier(0)
#define ATTN_STORE16(p,v) (*(u32x4*)(p)=(v))
constexpr int NSLOT=3, SLOTB=8192;
constexpr int LDS_K=0, LDS_V=NSLOT*SLOTB, LDS_WS=2*NSLOT*SLOTB, LDS_OST=LDS_WS+NW*64*4, LDS_BYTES=LDS_OST+NW*4096;
constexpr float C2=0.125f*1.4426950408889634f;
__device__ __forceinline__ void glds16(const void*gsrc,unsigned lds_dst){unsigned keep;
  asm volatile("s_mov_b32 %0, m0\n\ts_mov_b32 m0, %2\n\ts_nop 0\n\tglobal_load_lds_dwordx4 %1, off\n\ts_mov_b32 m0, %0":"=&s"(keep):"v"(gsrc),"s"(lds_dst):"memory");}
__device__ __forceinline__ float max3f(float a,float b,float c){float r;asm("v_max3_f32 %0, %1, %2, %3":"=v"(r):"v"(a),"v"(b),"v"(c));return r;}
__device__ __forceinline__ float max2f(float a,float b){float r;asm("v_max_f32_e32 %0, %1, %2":"=v"(r):"v"(a),"v"(b));return r;}
__device__ __forceinline__ float fadd_s(float a,float b){float r;asm("v_add_f32_e32 %0, %1, %2":"=v"(r):"v"(a),"v"(b));return r;}
__device__ __forceinline__ float fsub_s(float a,float b){float r;asm("v_sub_f32_e32 %0, %1, %2":"=v"(r):"v"(a),"v"(b));return r;}
typedef float f32x2_t __attribute__((ext_vector_type(2))); typedef __bf16 bf16x2_t __attribute__((ext_vector_type(2)));
__device__ __forceinline__ unsigned cvtpk_s(float lo,float hi){f32x2_t v={lo,hi};bf16x2_t b=__builtin_convertvector(v,bf16x2_t);return __builtin_bit_cast(unsigned,b);}
#define WAIT_BAR(N) asm volatile("s_waitcnt vmcnt(" #N ") lgkmcnt(0)\n\ts_barrier":::"memory")

__device__ __forceinline__ void qkt(f32x16&p0,f32x16&p1,const char*Kslot,const bf16x8*qr,const f32x16&negm,int r32,int hi){
  const char*kb=Kslot+hi*1024+r32*16;
  #pragma unroll
  for(int d0=0;d0<4;++d0){
    const bf16x8 b0=*reinterpret_cast<const bf16x8*>(kb+d0*2048);
    const bf16x8 b1=*reinterpret_cast<const bf16x8*>(kb+d0*2048+512);
    if(d0==0){p0=__builtin_amdgcn_mfma_f32_32x32x16_bf16(b0,qr[0],negm,0,0,0);p1=__builtin_amdgcn_mfma_f32_32x32x16_bf16(b1,qr[0],negm,0,0,0);}
    else{p0=__builtin_amdgcn_mfma_f32_32x32x16_bf16(b0,qr[d0],p0,0,0,0);p1=__builtin_amdgcn_mfma_f32_32x32x16_bf16(b1,qr[d0],p1,0,0,0);}}
}
typedef __attribute__((address_space(3))) const char* lds_cptr;
typedef short v4i16_t __attribute__((ext_vector_type(4)));
__device__ __forceinline__ void kload8(bf16x8*kf,lds_cptr kp){
  kf[0]=*(const __attribute__((address_space(3))) bf16x8*)(kp);      kf[1]=*(const __attribute__((address_space(3))) bf16x8*)(kp+512);
  kf[2]=*(const __attribute__((address_space(3))) bf16x8*)(kp+2048); kf[3]=*(const __attribute__((address_space(3))) bf16x8*)(kp+2560);
  kf[4]=*(const __attribute__((address_space(3))) bf16x8*)(kp+4096); kf[5]=*(const __attribute__((address_space(3))) bf16x8*)(kp+4608);
  kf[6]=*(const __attribute__((address_space(3))) bf16x8*)(kp+6144); kf[7]=*(const __attribute__((address_space(3))) bf16x8*)(kp+6656);
}
__device__ __forceinline__ void kload2(bf16x8*kf,lds_cptr kp,int j){ kf[2*j]=*(const __attribute__((address_space(3))) bf16x8*)(kp+j*2048); kf[2*j+1]=*(const __attribute__((address_space(3))) bf16x8*)(kp+j*2048+512); }
__device__ __forceinline__ s16x4 vtr(lds_cptr p){ return __builtin_bit_cast(s16x4,__builtin_amdgcn_ds_read_tr16_b64_v4i16((__attribute__((address_space(3))) v4i16_t*)p)); }
__device__ __forceinline__ float rowmax(const f32x16&p0,const f32x16&p1){
  float a=max3f(p0[0],p0[1],p1[0]),b=max3f(p0[2],p0[3],p1[1]);a=max3f(a,p1[2],p1[3]);
  #pragma unroll
  for(int r=4;r<16;r+=4){a=max3f(a,p0[r],p0[r+1]);b=max3f(b,p0[r+2],p0[r+3]);a=max3f(a,p1[r],p1[r+1]);b=max3f(b,p1[r+2],p1[r+3]);}
  const float m=max2f(a,b);
  auto rr=__builtin_amdgcn_permlane32_swap(__float_as_uint(m),__float_as_uint(m),false,false);
  return max2f(__uint_as_float(rr[0]),__uint_as_float(rr[1]));
}
__device__ __forceinline__ void pv(f32x16*o,int vb,bf16x8 pa0,bf16x8 pa1,bf16x8 pa2,bf16x8 pa3){
  #pragma unroll
  for(int d0=0;d0<2;++d0){s16x4 lo[4],hi[4];
    #pragma unroll
    for(int ks=0;ks<4;++ks){
      asm volatile("ds_read_b64_tr_b16 %0,%1 offset:%c2":"=&v"(lo[ks]):"v"(vb),"i"(d0*4096+ks*1024):"memory");
      asm volatile("ds_read_b64_tr_b16 %0,%1 offset:%c2":"=&v"(hi[ks]):"v"(vb),"i"(d0*4096+ks*1024+512):"memory");}
    asm volatile("s_waitcnt lgkmcnt(0)":::"memory");SBAR();
    #define PK(k) (bf16x8){lo[k][0],lo[k][1],lo[k][2],lo[k][3],hi[k][0],hi[k][1],hi[k][2],hi[k][3]}
    o[d0]=__builtin_amdgcn_mfma_f32_32x32x16_bf16(pa0,PK(0),o[d0],0,0,0);
    o[d0]=__builtin_amdgcn_mfma_f32_32x32x16_bf16(pa1,PK(1),o[d0],0,0,0);
    o[d0]=__builtin_amdgcn_mfma_f32_32x32x16_bf16(pa2,PK(2),o[d0],0,0,0);
    o[d0]=__builtin_amdgcn_mfma_f32_32x32x16_bf16(pa3,PK(3),o[d0],0,0,0);
    #undef PK
  }
}
template<int THRL> __device__ __forceinline__ void attn_unit(const bf16*Qw0,const bf16*__restrict__ Kh,const bf16*__restrict__ Vh,bf16*Ow0,const int NT,char*shm){
  const int tid=opaque_tid(),lane=tid&63,r32=lane&31,hi=lane>>5; const int wid=__builtin_amdgcn_readfirstlane(tid>>6);
  const bf16*Qw=Qw0+(long)wid*QBLK*QP;
  const unsigned lds0=(unsigned)(uintptr_t)shm;
  float*wsf=(float*)(shm+LDS_WS)+wid*64;
  const bf16*ksrc=Kh+(long)lane*KP+wid*8;
  const bf16*vsrc=Vh+(long)(16*(wid&3)+(lane>>2))*KP+(wid>>2)*32+(lane&3)*8;
  const unsigned kdst=lds0+LDS_K+wid*1024, vdst=lds0+LDS_V+wid*1024;
  #define DMA_K(t,slot) glds16(ksrc+(long)(t)*KVBLK*KP,(unsigned)__builtin_amdgcn_readfirstlane(kdst+(slot)))
  #define DMA_V(t,slot) glds16(vsrc+(long)(t)*KVBLK*KP,(unsigned)__builtin_amdgcn_readfirstlane(vdst+(slot)))
  const int vb0=(int)(lds0+LDS_V)+((lane>>4)&1)*32+(lane&3)*8+(4*hi+((lane&15)>>2))*64;
  const char*Kbase=shm+LDS_K; bf16x8 kf[8];
  const lds_cptr shm3=(lds_cptr)shm; const lds_cptr kp0=shm3+LDS_K+hi*1024+r32*16; const lds_cptr vp0=shm3+LDS_V+((lane>>4)&1)*32+(lane&3)*8+(4*hi+((lane&15)>>2))*64;
  DMA_K(0,0);DMA_V(0,0);DMA_K(1,SLOTB);
  bf16x8 qr[4];
  #pragma unroll
  for(int d0=0;d0<4;++d0)qr[d0]=*reinterpret_cast<const bf16x8*>(&Qw[(long)r32*QP+d0*16+hi*8]);
  float mhat=0.f,l_reg=0.f;f32x16 o[2];o[0]=f32x16{};o[1]=f32x16{};f32x16 negm=f32x16{};asm volatile("":"+v"(negm));
  #define CMASK(P0,P1,t) do{}while(0)
  bool resc=false;
  #define START(P0,P1) do{ const float rm=rowmax(P0,P1); resc=false; \
    { const float dl=rm; mhat=fadd_s(mhat,dl); \
      _Pragma("unroll") for(int r=0;r<16;++r){P0[r]=fsub_s(P0[r],dl);P1[r]=fsub_s(P1[r],dl);} \
      _Pragma("unroll") for(int r=0;r<16;++r)negm[r]=-mhat; asm volatile("":"+v"(negm)); } \
    _Pragma("unroll") for(int r=0;r<16;++r)P0[r]=__builtin_amdgcn_exp2f(P0[r]); }while(0)
  #define RESC() do{ if(resc){ asm volatile("s_waitcnt lgkmcnt(0)":::"memory"); \
      _Pragma("unroll") for(int d_=0;d_<2;++d_) _Pragma("unroll") for(int r=0;r<16;++r)o[d_][r]*=wsf[crow(r,hi)]; } }while(0)
  f32x16 pA0,pA1,pB0,pB1;
  int sl_prev=0,sl_cur=0,sl_next=SLOTB;
  #define ROT() do{sl_prev=sl_cur;sl_cur=sl_next;sl_next=(sl_next==(NSLOT-1)*SLOTB)?0:sl_next+SLOTB;}while(0)
  DMA_K(2,2*SLOTB);
  WAIT_BAR(3);
  qkt(pA0,pA1,Kbase,qr,negm,r32,hi);asm volatile("s_nop 15\n\ts_nop 7":"+v"(pA0),"+v"(pA1));CMASK(pA0,pA1,0);
  START(pA0,pA1);
  _Pragma("unroll") for(int r=0;r<16;++r)pA1[r]=__builtin_amdgcn_exp2f(pA1[r]);
  WAIT_BAR(0);
  DMA_K(3,0);DMA_V(1,SLOTB);
  ROT();
  kload8(kf,kp0+sl_cur);
  WAIT_BAR(2);
  s16x4 vlo[8],vhi[8]; u32x4 pw0,pw1,pw2,pw3;
  #define PKW(P,B) cvtpk_s(P[B],P[B+1])
  #define PAF(k) __builtin_bit_cast(bf16x8,pw##k)
  #define VFR(i) (bf16x8){vlo[i][0],vlo[i][1],vlo[i][2],vlo[i][3],vhi[i][0],vhi[i][1],vhi[i][2],vhi[i][3]}
  #define PIN(x) asm volatile("":"+v"(x))
  #define MX3(a,b,c) __builtin_fmaxf(__builtin_fmaxf((a),(b)),(c))
  #define GAPA(MF,A0,A1,A2,A3,W0,W1,PW) do{ MF; sacc+=A0; sacc+=A1; sacc+=A2; sacc+=A3; PIN(sacc); W0; W1; PIN(PW); SBAR(); }while(0)
  #define EX(v) __builtin_amdgcn_exp2f(v)
  #define GAPB(MF,X,B) do{ MF; X[B]=EX(X[B]); X[B+1]=EX(X[B+1]); X[B+2]=EX(X[B+2]); X[B+3]=EX(X[B+3]); PIN(X); SBAR(); }while(0)
  #define VRD(i) do{ vlo[i]=vtr(vp_+(((i)>>2)*4096+((i)&3)*1024)); vhi[i]=vtr(vp_+(((i)>>2)*4096+((i)&3)*1024+512)); }while(0)
  #define KRD(G,j) do{ if(G){ kload2(kf,kp0+sl_next,j); SBAR(); } }while(0)
  #define STEP(C0,C1,P0,P1,t,GK,GV,GL) do{ SBAR(); \
    const lds_cptr vp_=vp0+sl_prev; \
    VRD(0); SBAR(); float sacc=(P0[0]+P0[1]); \
    GAPA(C0=__builtin_amdgcn_mfma_f32_32x32x16_bf16(kf[0],qr[0],negm,0,0,0), P0[2],P0[3],P0[4],P0[5],     pw0[0]=PKW(P0,0), pw0[1]=PKW(P0,2), pw0); \
    VRD(4); SBAR(); GAPA(C1=__builtin_amdgcn_mfma_f32_32x32x16_bf16(kf[1],qr[0],negm,0,0,0), P0[6],P0[7],P0[8],P0[9],     pw0[2]=PKW(P0,4), pw0[3]=PKW(P0,6), pw0); \
    VRD(1); SBAR(); GAPA(C0=__builtin_amdgcn_mfma_f32_32x32x16_bf16(kf[2],qr[1],C0,0,0,0),   P0[10],P0[11],P0[12],P0[13], pw1[0]=PKW(P0,8), pw1[1]=PKW(P0,10), pw1); \
    VRD(5); SBAR(); GAPA(C1=__builtin_amdgcn_mfma_f32_32x32x16_bf16(kf[3],qr[1],C1,0,0,0),   P0[14],P0[15],P1[0],P1[1],   pw1[2]=PKW(P0,12),pw1[3]=PKW(P0,14), pw1); \
    VRD(2); SBAR(); GAPA(C0=__builtin_amdgcn_mfma_f32_32x32x16_bf16(kf[4],qr[2],C0,0,0,0),   P1[2],P1[3],P1[4],P1[5],     pw2[0]=PKW(P1,0), pw2[1]=PKW(P1,2), pw2); \
    VRD(6); SBAR(); GAPA(C1=__builtin_amdgcn_mfma_f32_32x32x16_bf16(kf[5],qr[2],C1,0,0,0),   P1[6],P1[7],P1[8],P1[9],     pw2[2]=PKW(P1,4), pw2[3]=PKW(P1,6), pw2); \
    VRD(3); SBAR(); GAPA(C0=__builtin_amdgcn_mfma_f32_32x32x16_bf16(kf[6],qr[3],C0,0,0,0),   P1[10],P1[11],P1[12],P1[13], pw3[0]=PKW(P1,8), pw3[1]=PKW(P1,10), pw3); \
    VRD(7); SBAR(); GAPA(C1=__builtin_amdgcn_mfma_f32_32x32x16_bf16(kf[7],qr[3],C1,0,0,0),   P1[14],P1[15],0.f,0.f,       pw3[2]=PKW(P1,12),pw3[3]=PKW(P1,14), pw3); \
    l_reg+=sacc; \
    if(GK){DMA_K((t)+3,sl_cur);} if(GV){DMA_V((t)+1,sl_next);} \
    CMASK(C0,C1,t); \
    { float a=MX3(C0[0],C0[1],C1[0]),b=MX3(C0[2],C0[3],C1[1]); a=MX3(a,C1[2],C1[3]); \
      _Pragma("unroll") for(int r=4;r<16;r+=4){a=MX3(a,C0[r],C0[r+1]);b=MX3(b,C0[r+2],C0[r+3]);a=MX3(a,C1[r],C1[r+1]);b=MX3(b,C1[r+2],C1[r+3]);} \
      float rm=__builtin_fmaxf(a,b); { auto rr=__builtin_amdgcn_permlane32_swap(__float_as_uint(rm),__float_as_uint(rm),false,false); rm=__builtin_fmaxf(__uint_as_float(rr[0]),__uint_as_float(rr[1])); } \
      resc=false; \
      if(__builtin_expect(__any(rm>(float)THRL),0)){ const float dl=__builtin_fmaxf(rm,0.f); mhat+=dl; \
        _Pragma("unroll") for(int r=0;r<16;++r){C0[r]-=dl;C1[r]-=dl;} \
        _Pragma("unroll") for(int r=0;r<16;++r)negm[r]=-mhat; asm volatile("":"+v"(negm)); \
        const float f=__builtin_amdgcn_exp2f(-dl); l_reg*=f; if(hi==0)wsf[r32]=f; resc=true; } } \
    SBAR(); \
    GAPB(o[0]=__builtin_amdgcn_mfma_f32_32x32x16_bf16(PAF(0),VFR(0),o[0],0,0,0), C0,0); \
    GAPB(o[1]=__builtin_amdgcn_mfma_f32_32x32x16_bf16(PAF(0),VFR(4),o[1],0,0,0), C0,4); \
    KRD(GL,0); GAPB(o[0]=__builtin_amdgcn_mfma_f32_32x32x16_bf16(PAF(1),VFR(1),o[0],0,0,0), C0,8); \
    KRD(GL,1); GAPB(o[1]=__builtin_amdgcn_mfma_f32_32x32x16_bf16(PAF(1),VFR(5),o[1],0,0,0), C0,12); \
    KRD(GL,2); GAPB(o[0]=__builtin_amdgcn_mfma_f32_32x32x16_bf16(PAF(2),VFR(2),o[0],0,0,0), C1,0); \
    KRD(GL,3); GAPB(o[1]=__builtin_amdgcn_mfma_f32_32x32x16_bf16(PAF(2),VFR(6),o[1],0,0,0), C1,4); \
    GAPB(o[0]=__builtin_amdgcn_mfma_f32_32x32x16_bf16(PAF(3),VFR(3),o[0],0,0,0), C1,8); \
    GAPB(o[1]=__builtin_amdgcn_mfma_f32_32x32x16_bf16(PAF(3),VFR(7),o[1],0,0,0), C1,12); \
    }while(0)
  int t=1;
  #undef CMASK
  #define CMASK(P0,P1,t) do{}while(0)
  for(;t+5<NT;t+=2){
    STEP(pB0,pB1,pA0,pA1,t,true,true,true);     WAIT_BAR(2); RESC(); ROT();
    STEP(pA0,pA1,pB0,pB1,t+1,true,true,true);   WAIT_BAR(2); RESC(); ROT();
  }
  #undef CMASK
  #define CMASK(P0,P1,t) do{}while(0)
  #define ENDW(tt) do{ if((tt)+3<NT){WAIT_BAR(2);} else if((tt)+2<NT){WAIT_BAR(1);} else {WAIT_BAR(0);} }while(0)
  for(;t+1<NT;t+=2){
    STEP(pB0,pB1,pA0,pA1,t,(t+3<NT),(t+1<NT),(t+1<NT));       ENDW(t);   RESC(); ROT();
    STEP(pA0,pA1,pB0,pB1,t+1,(t+4<NT),(t+2<NT),(t+2<NT));     ENDW(t+1); RESC(); ROT();
  }
  STEP(pB0,pB1,pA0,pA1,NT-1,false,false,false); RESC();
  { float sacc=pB0[0]+pB0[1]; _Pragma("unroll") for(int r=2;r<16;++r)sacc+=pB0[r]; _Pragma("unroll") for(int r=0;r<16;++r)sacc+=pB1[r]; l_reg+=sacc;
    pw0=(u32x4){PKW(pB0,0),PKW(pB0,2),PKW(pB0,4),PKW(pB0,6)};pw1=(u32x4){PKW(pB0,8),PKW(pB0,10),PKW(pB0,12),PKW(pB0,14)};pw2=(u32x4){PKW(pB1,0),PKW(pB1,2),PKW(pB1,4),PKW(pB1,6)};pw3=(u32x4){PKW(pB1,8),PKW(pB1,10),PKW(pB1,12),PKW(pB1,14)};
    SBAR(); pv(o,vb0+sl_cur,PAF(0),PAF(1),PAF(2),PAF(3)); }
  #undef PKW
  #undef PAF
  #undef VFR
  #undef PIN
  #undef MX3
  #undef GAPA
  #undef GAPB
  #undef EX
  #undef VRD
  #undef KRD
  #undef STEP
  #undef ENDW
  {auto rr=__builtin_amdgcn_permlane32_swap(__float_as_uint(l_reg),__float_as_uint(l_reg),false,false);l_reg=__uint_as_float(rr[0])+__uint_as_float(rr[1]);}
  if(hi==0)wsf[32+r32]=l_reg;asm volatile("s_waitcnt lgkmcnt(0)":::"memory");
  float rli[16];
  #pragma unroll
  for(int r=0;r<16;++r)rli[r]=__builtin_amdgcn_rcpf(wsf[32+crow(r,hi)]);
  bf16*Ow=Ow0+(long)wid*QBLK*OP;
  { bf16*stg=(bf16*)(shm+LDS_OST)+wid*2048;
    #pragma unroll
    for(int r=0;r<16;++r){const int orow=crow(r,hi);
      #pragma unroll
      for(int d0=0;d0<2;++d0)stg[orow*64+d0*32+r32]=__float2bfloat16(o[d0][r]*rli[r]);}
    asm volatile("s_waitcnt lgkmcnt(0)":::"memory");
    #pragma unroll
    for(int i=0;i<4;++i){const int row=i*8+(lane>>3),ch=lane&7; const u32x4 v=*(const u32x4*)(stg+row*64+ch*8); ATTN_STORE16(Ow+(long)row*OP+ch*8,v);} }
  asm volatile("s_waitcnt lgkmcnt(0)\n\ts_barrier":::"memory");
  #undef DMA_K
  #undef DMA_V
  #undef CMASK
  #undef START
  #undef RESC
  #undef ROT
}

#undef SBAR
#undef WAIT_BAR
}

typedef short bf16x8_t __attribute__((ext_vector_type(8)));
#define LDS_WAIT() asm volatile("s_waitcnt lgkmcnt(0)" ::: "memory")

__device__ __forceinline__ int inv32(int c) { return 16 * ((c >> 2) & 1) + 4 * (c >> 3) + (c & 3); }
__device__ __forceinline__ int dest_row(int type, int n) {
    if (type == 0) return n;
    if (type == 3) return (n & ~31) + inv32(n & 31);
    if (type == 1) { const int half = n >= DFF ? 1 : 0, j = n - half * DFF, pn = j >> 7, c = j & 127; return pn * 256 + half * 128 + (c & ~31) + inv32(c & 31); }
    if (n < 768) { const int hd = n >> 6, d = n & 63, a = d >> 5, t = (d >> 4) & 1, p = d & 15; return (hd >> 2) * 256 + a * 128 + (hd & 3) * 32 + t * 16 + p; }
    const int pn = n >> 8, c = n & 255, half = c >> 7, c7 = c & 127; return pn * 256 + half * 128 + (c7 & ~31) + inv32(c7 & 31);
}
__device__ __forceinline__ void transpose_item(const float* W, int K, int N, bf16_t* WT, int type, LAS float* scr, int item, int lane) {
    const int nblk = N / 32, kb = item / nblk, nb = item % nblk, k0 = 64 * kb, n0 = 32 * nb;
#pragma unroll
    for (int h = 0; h < 2; ++h) { float wv[16];
#pragma unroll
        for (int i = 0; i < 16; ++i) wv[i] = W[(size_t)(k0 + 2 * (16 * h + i) + (lane >> 5)) * N + n0 + (lane & 31)];
#pragma unroll
        for (int i = 0; i < 16; ++i) scr[(2 * (16 * h + i) + (lane >> 5)) * 33 + (lane & 31)] = wv[i]; }
    LDS_WAIT(); asm volatile("" ::: "memory");
    const int c = lane & 7;
#pragma unroll
    for (int j = 0; j < 4; ++j) { const int n = (lane >> 3) + 8 * j; const LAS float* s = scr + (8 * c) * 33 + n;
        u32x4 o; o.x = cvt_pk(s[0 * 33], s[1 * 33]); o.y = cvt_pk(s[2 * 33], s[3 * 33]); o.z = cvt_pk(s[4 * 33], s[5 * 33]); o.w = cvt_pk(s[6 * 33], s[7 * 33]);
        *(u32x4*)(WT + (size_t)dest_row(type, n0 + n) * K + k0 + 8 * c) = o; }
    LDS_WAIT(); asm volatile("" ::: "memory");
}

__device__ __forceinline__ void prologue_phase(const Params& P, LAS unsigned char* lds, int G) {
    const int tid = opaque_tid(), lane = tid & 63, wid = __builtin_amdgcn_readfirstlane(tid >> 6), bid = blockIdx.x;
    unsigned char* ws = P.ws;
    {
        LAS float* sc = (LAS float*)lds;
        LAS float* red = (LAS float*)(lds + 36864);
        for (int i = tid; i < 9 * 1024; i += NTHREADS) { const int v = i >> 10, k = i & 1023; const float cv = v < 8 ? P.in[1][v * 1024 + k] : P.in[3][k]; sc[i] = cv / (1.0f + expf(-cv)); }
        __syncthreads();
        float* mod = (float*)(ws + OFF_MOD);
        for (int item = bid; item < 2 * 144; item += G) {
            const int l = item / 144, cgp = item % 144, col = cgp * 64 + lane, kc = wid;
            const float* W = P.in[4] + (size_t)l * 1024 * MODW + col;
            float acc[9];
#pragma unroll
            for (int v = 0; v < 9; ++v) acc[v] = 0.f;
#pragma unroll 1
            for (int k0 = kc * 128; k0 < kc * 128 + 128; k0 += 16) { float wv[16];
#pragma unroll
                for (int q = 0; q < 16; ++q) wv[q] = W[(size_t)(k0 + q) * MODW];
#pragma unroll
                for (int q = 0; q < 16; ++q)
#pragma unroll
                    for (int v = 0; v < 9; ++v) acc[v] += sc[v * 1024 + k0 + q] * wv[q]; }
#pragma unroll
            for (int v = 0; v < 9; ++v) red[(kc * 9 + v) * 64 + lane] = acc[v];
            __syncthreads();
            for (int i = tid; i < 576; i += NTHREADS) { const int v = i >> 6, cc = i & 63; float s = 0.f;
#pragma unroll
                for (int q = 0; q < 8; ++q) s += red[(q * 9 + v) * 64 + cc];
                mod[(size_t)(l * 9 + v) * MODW + cgp * 64 + cc] = s + P.in[5][l * MODW + cgp * 64 + cc]; }
            __syncthreads();
        }
    }
    __syncthreads();
    {
        LAS float* scr = (LAS float*)(lds + wid * 16384);
        const int gw = bid * 8 + wid, NGW = G * 8;
        constexpr int I_FI = 16 * (NFF2 / 32), I_FO = (DFF / 64) * 32, I_WI = 16 * (INW / 32), I_WO = 16 * 32;
        constexpr int PER_L = 2 * I_FI + 2 * I_FO + I_WI + I_WO;
        for (int it = gw; it < DEPTH * PER_L; it += NGW) {
            const int l = it / PER_L; int r = it % PER_L;
            unsigned char* wb = ws + OFF_WB + (size_t)l * WB_LAYER;
            if (r < 2 * I_FI) { const int f = r / I_FI; transpose_item(P.in[7] + (size_t)(l * 2 + f) * DM * NFF2, DM, NFF2, (bf16_t*)(wb + WB_FFIN + f * WB_FFIN_SZ), 1, scr, r % I_FI, lane); continue; } r -= 2 * I_FI;
            if (r < 2 * I_FO) { const int f = r / I_FO; transpose_item(P.in[8] + (size_t)(l * 2 + f) * DFF * DM, DFF, DM, (bf16_t*)(wb + WB_FFOUT + f * WB_FFOUT_SZ), 3, scr, r % I_FO, lane); continue; } r -= 2 * I_FO;
            if (r < I_WI) { transpose_item(P.in[9] + (size_t)l * DM * INW, DM, INW, (bf16_t*)(wb + WB_WIN), 2, scr, r, lane); continue; } r -= I_WI;
            transpose_item(P.in[22] + (size_t)l * DM * DM, DM, DM, (bf16_t*)(wb + WB_WOUT), 3, scr, r, lane);
        }
        bf16_t* LW = (bf16_t*)(ws + OFF_LW);
        const int gt = bid * NTHREADS + tid, NGT = G * NTHREADS;
        for (int i = gt; i < DEPTH * 4 * 256 * 64; i += NGT) {
            const int d = i & 63, c = (i >> 6) & 255, g = (i >> 14) & 3, l = i >> 16, n = c >> 6, e = c & 63;
            const float* src = (g & 1) ? P.in[16] : P.in[14];
            const float v = src[((((size_t)l * 2 + (g >> 1)) * 4 + n) * 64 + d) * 64 + e];
            LW[i] = (bf16_t)(cvt_pk(v * -1.4426950408889634f, 0.f) & 0xffffu);
        }
        float* rc = (float*)(ws + OFF_ROPE); float* rs = rc + 2048;
        for (int i = gt; i < 2048; i += NGT) { const int pos = i >> 4, p = i & 15; const float inv = powf(10000.0f, -(float)p / 16.0f), ang = (float)pos * inv; rc[i] = cosf(ang); rs[i] = sinf(ang); }
    }
}

__device__ __forceinline__ void norm_phase(const Params& P, int l, int idx, int row_lo, int row_hi, bool first, int wg0, int nwg) {
    const int tid = opaque_tid(), lane = tid & 63, wid = __builtin_amdgcn_readfirstlane(tid >> 6);
    if ((int)blockIdx.x < wg0 || (int)blockIdx.x >= wg0 + nwg) return;
    const int gw = ((int)blockIdx.x - wg0) * 8 + wid, NGW = nwg * 8, per = (row_hi - row_lo + NGW - 1) / NGW;
    const int r0 = row_lo + gw * per, r1 = (r0 + per < row_hi) ? r0 + per : row_hi;
    const float* mod = (const float*)(P.ws + OFF_MOD) + (size_t)l * 9 * MODW;
    const float* gsrc = P.in[6] + (size_t)(l * 3 + idx) * DM;
    const bf16_t* xres = (const bf16_t*)(P.ws + OFF_XRES); bf16_t* hb = (bf16_t*)(P.ws + OFF_HBUF);
    int curv = -1; f32x4 Aa[4], Bb[4];
    for (int row = r0; row < r1; ++row) {
        const int v = row < MLAT ? (row >> 13) : 8;
        if (v != curv) { curv = v;
#pragma unroll
            for (int j = 0; j < 4; ++j) { const int c = 4 * lane + 256 * j; const f32x4 g4 = *(const f32x4*)(gsrc + c), sh = *(const f32x4*)(mod + (size_t)v * MODW + (3 * idx) * DM + c), sc = *(const f32x4*)(mod + (size_t)v * MODW + (3 * idx + 1) * DM + c);
                Aa[j] = g4 * (sc + 1.0f); Bb[j] = sh; } }
        f32x4 x[4]; float ss = 0.f;
        if (first) { const float* xr = row < MLAT ? P.in[0] + (size_t)row * DM : P.in[2] + (size_t)(row - MLAT) * DM;
#pragma unroll
            for (int j = 0; j < 4; ++j) x[j] = *(const f32x4*)(xr + 4 * lane + 256 * j);
        } else {
#pragma unroll
            for (int j = 0; j < 4; ++j) { const u32x2 r = *(const u32x2*)(xres + (size_t)row * DM + 4 * lane + 256 * j); x[j] = (f32x4){bf_lo(r.x), bf_hi(r.x), bf_lo(r.y), bf_hi(r.y)}; }
        }
#pragma unroll
        for (int j = 0; j < 4; ++j) { ss += (x[j][0] * x[j][0] + x[j][1] * x[j][1]) + (x[j][2] * x[j][2] + x[j][3] * x[j][3]); }
        const float rstd = 1.0f / sqrtf(wave_sum(ss) * (1.0f / DM) + EPS);
#pragma unroll
        for (int j = 0; j < 4; ++j) { const f32x4 y = x[j] * rstd * Aa[j] + Bb[j]; u32x2 w; w.x = cvt_pk(y[0], y[1]); w.y = cvt_pk(y[2], y[3]);
            *(u32x2*)(hb + (size_t)row * DM + 4 * lane + 256 * j) = w;
 }
    }
}
__device__ __forceinline__ void final_norm_phase(const Params& P, int G) {
    const int tid = opaque_tid(), lane = tid & 63, wid = __builtin_amdgcn_readfirstlane(tid >> 6);
    const int gw = blockIdx.x * 8 + wid, NGW = G * 8;
    const bf16_t* xres = (const bf16_t*)(P.ws + OFF_XRES);
    f32x4 g4[4];
#pragma unroll
    for (int j = 0; j < 4; ++j) g4[j] = *(const f32x4*)(P.in[23] + 4 * lane + 256 * j);
    for (int row = gw; row < MLAT; row += NGW) {
        f32x4 x[4]; float ss = 0.f;
#pragma unroll
        for (int j = 0; j < 4; ++j) { const u32x2 r = *(const u32x2*)(xres + (size_t)row * DM + 4 * lane + 256 * j); x[j] = (f32x4){bf_lo(r.x), bf_hi(r.x), bf_lo(r.y), bf_hi(r.y)}; ss += (x[j][0] * x[j][0] + x[j][1] * x[j][1]) + (x[j][2] * x[j][2] + x[j][3] * x[j][3]); }
        const float rstd = 1.0f / sqrtf(wave_sum(ss) * (1.0f / DM) + EPS);
#pragma unroll
        for (int j = 0; j < 4; ++j) *(f32x4*)(P.out + (size_t)row * DM + 4 * lane + 256 * j) = x[j] * rstd * g4[j];
    }
}

constexpr int L1_AST = 528;
constexpr int L1_UST = 260;
constexpr int L1_UOFF = 66560;
#define LDS_BARRIER() asm volatile("s_waitcnt lgkmcnt(0)\n\ts_barrier" ::: "memory")
__device__ __forceinline__ void lru1_phase(const Params& P, int l, LAS unsigned char* lds, int G) {
    const int tid = opaque_tid(), lane = tid & 63, wid = __builtin_amdgcn_readfirstlane(tid >> 6), fr = lane & 15, fq = lane >> 4;
    LAS unsigned char* ldsA = lds; LAS float* ldsU = (LAS float*)(lds + L1_UOFF);
    const bf16_t* Ubuf = (const bf16_t*)(P.ws + OFF_U5);
    float* Sg = (float*)(P.ws + OFF_S); unsigned* PPg = (unsigned*)(P.ws + OFF_PP); float* csum = (float*)(P.ws + OFF_CSUM);
    const bf16_t* LW = (const bf16_t*)(P.ws + OFF_LW) + (size_t)l * 4 * 256 * 64;
    const int ch4 = (tid & 63) * 4, pg = tid >> 6;
    f32x4 cw[4], cbias;
#pragma unroll
    for (int i = 0; i < 4; ++i) cw[i] = *(const f32x4*)(P.in[12] + (size_t)(l * 4 + i) * 256 + ch4);
    cbias = *(const f32x4*)(P.in[13] + (size_t)l * 256 + ch4);
    const int nblk = wid >> 1;
    for (int tile = blockIdx.x; tile < NBATCH * NCHUNK; tile += G) {
        const int b = tile / NCHUNK, cidx = tile % NCHUNK, P0 = cidx * 64; const bool latent = cidx >= 4;
        const int seg_lo = latent ? 256 : 0, seg_hi = latent ? KEYS : 256;
        const int rbase = latent ? b * SEQ - 256 : MLAT + b * CTXL;
        {
            const int pp0 = P0 + pg * 8;
            f32x4 win[11];
#pragma unroll
            for (int i = 0; i < 11; ++i) { const int Pq = pp0 - 2 + i; f32x4 w4 = {0.f, 0.f, 0.f, 0.f};
                if (Pq >= seg_lo && Pq < seg_hi) { const u32x2 raw = *(const u32x2*)(Ubuf + (size_t)(rbase + Pq) * 256 + ch4); w4 = (f32x4){bf_lo(raw.x), bf_hi(raw.x), bf_lo(raw.y), bf_hi(raw.y)}; }
                win[i] = w4; }
#pragma unroll
            for (int q = 0; q < 8; ++q) { f32x4 y = cbias;
#pragma unroll
                for (int i = 0; i < 4; ++i) y = y + cw[i] * win[q + i];
                const int pos = pg * 8 + q;
                u32x2 w; w.x = cvt_pk(y[0], y[1]); w.y = cvt_pk(y[2], y[3]);
                *(LAS u32x2*)(ldsA + pos * L1_AST + ch4 * 2) = w;
                *(LAS f32x4*)(ldsU + pos * L1_UST + ch4) = y; }
        }
        LDS_BARRIER();
#pragma unroll 1
        for (int cc = 0; cc < 2; ++cc) {
            const int c = 32 * wid + 16 * cc + fr;
            const float NL2E = -1.4426950408889634f;
            const float baf = NL2E * P.in[15][(l * 2 + 0) * 256 + c], bab = NL2E * P.in[15][(l * 2 + 1) * 256 + c], bxf = NL2E * P.in[17][(l * 2 + 0) * 256 + c], bxb = NL2E * P.in[17][(l * 2 + 1) * 256 + c];
            const float nspf = -8.0f * 1.4426950408889634f * log1pf(expf(-P.in[18][(l * 2 + 0) * 256 + c])), nspb = -8.0f * 1.4426950408889634f * log1pf(expf(-P.in[18][(l * 2 + 1) * 256 + c]));
            f32x4 acc[4][4];
            {
                bf16x8_t bw[4][2];
#pragma unroll
                for (int g = 0; g < 4; ++g)
#pragma unroll
                    for (int kk = 0; kk < 2; ++kk) bw[g][kk] = *(const bf16x8_t*)(LW + ((size_t)(g * 256 + c) * 64 + kk * 32 + fq * 8));
#pragma unroll
                for (int m = 0; m < 4; ++m) {
#pragma unroll
                    for (int g = 0; g < 4; ++g) acc[m][g] = (f32x4){0.f, 0.f, 0.f, 0.f};
#pragma unroll
                    for (int kk = 0; kk < 2; ++kk) { const bf16x8_t a = *(const LAS bf16x8_t*)(ldsA + (16 * m + fr) * L1_AST + (64 * nblk + 32 * kk + 8 * fq) * 2);
#pragma unroll
                        for (int g = 0; g < 4; ++g) acc[m][g] = __builtin_amdgcn_mfma_f32_16x16x32_bf16(a, bw[g][kk], acc[m][g], 0, 0, 0); }
                }
            }
#pragma unroll
            for (int m = 0; m < 4; ++m)
#pragma unroll
                for (int j = 0; j < 4; ++j) {
                    const float u = ldsU[(16 * m + 4 * fq + j) * L1_UST + c];
                    {   const float r = __builtin_amdgcn_rcpf(1.0f + __builtin_amdgcn_exp2f(acc[m][0][j] + baf)), ig = __builtin_amdgcn_rcpf(1.0f + __builtin_amdgcn_exp2f(acc[m][1][j] + bxf));
                        const float a = __builtin_amdgcn_exp2f(nspf * r);
                        acc[m][0][j] = a; acc[m][1][j] = __builtin_amdgcn_sqrtf(__builtin_fmaf(-a, a, 1.0f)) * (ig * u); }
                    {   const float r = __builtin_amdgcn_rcpf(1.0f + __builtin_amdgcn_exp2f(acc[m][2][j] + bab)), ig = __builtin_amdgcn_rcpf(1.0f + __builtin_amdgcn_exp2f(acc[m][3][j] + bxb));
                        const float a = __builtin_amdgcn_exp2f(nspb * r);
                        acc[m][2][j] = a; acc[m][3][j] = __builtin_amdgcn_sqrtf(__builtin_fmaf(-a, a, 1.0f)) * (ig * u); }
                }
            f32x4 hf[4], pf[4];
            {
                float TAi[4], THi[4], EAi[4], EHi[4], gAi[4], gHi[4]; f32x4 Aj[4], Hj[4];
#pragma unroll
                for (int m = 0; m < 4; ++m) {
                    const f32x4 a = acc[m][0], x = acc[m][1];
                    const float A0 = a[0], H0 = x[0], A1 = A0 * a[1], H1 = a[1] * H0 + x[1], A2 = A1 * a[2], H2 = a[2] * H1 + x[2], A3 = A2 * a[3], H3 = a[3] * H2 + x[3];
                    Aj[m] = (f32x4){A0, A1, A2, A3}; Hj[m] = (f32x4){H0, H1, H2, H3};
                    float TA = A3, TH = H3;
                    float tA = __shfl_up(TA, 16), tH = __shfl_up(TH, 16); if (fq >= 1) { TH = TA * tH + TH; TA = TA * tA; }
                    tA = __shfl_up(TA, 32); tH = __shfl_up(TH, 32); if (fq >= 2) { TH = TA * tH + TH; TA = TA * tA; }
                    float EA = __shfl_up(TA, 16), EH = __shfl_up(TH, 16); if (fq == 0) { EA = 1.f; EH = 0.f; }
                    TAi[m] = TA; THi[m] = TH; EAi[m] = EA; EHi[m] = EH;
                    gAi[m] = __shfl(TA, fr + 48); gHi[m] = __shfl(TH, fr + 48);
                }
                float cA = 1.f, cH = 0.f;
#pragma unroll
                for (int m = 0; m < 4; ++m) {
                    const float inA = cA * EAi[m], inH = EAi[m] * cH + EHi[m];
                    pf[m] = Aj[m] * inA;
                    hf[m] = Aj[m] * inH + Hj[m];
                    cH = gAi[m] * cH + gHi[m]; cA = cA * gAi[m];
                }
                if (fq == 0) { float* cs = csum + ((size_t)(b * NCHUNK + cidx) * 2 + 0) * 512 + c; cs[0] = cA; cs[256] = cH; }
            }
            {
                float EAi[4], EHi[4], gAi[4], gHi[4]; f32x4 Aj[4], Hj[4];
#pragma unroll
                for (int m = 0; m < 4; ++m) {
                    const f32x4 a = acc[m][2], x = acc[m][3];
                    const float A3 = a[3], H3 = x[3], A2 = A3 * a[2], H2 = a[2] * H3 + x[2], A1 = A2 * a[1], H1 = a[1] * H2 + x[1], A0 = A1 * a[0], H0 = a[0] * H1 + x[0];
                    Aj[m] = (f32x4){A0, A1, A2, A3}; Hj[m] = (f32x4){H0, H1, H2, H3};
                    float TA = A0, TH = H0;
                    float tA = __shfl_down(TA, 16), tH = __shfl_down(TH, 16); if (fq <= 2) { TH = TA * tH + TH; TA = TA * tA; }
                    tA = __shfl_down(TA, 32); tH = __shfl_down(TH, 32); if (fq <= 1) { TH = TA * tH + TH; TA = TA * tA; }
                    float EA = __shfl_down(TA, 16), EH = __shfl_down(TH, 16); if (fq == 3) { EA = 1.f; EH = 0.f; }
                    EAi[m] = EA; EHi[m] = EH;
                    gAi[m] = __shfl(TA, fr); gHi[m] = __shfl(TH, fr);
                }
                float cA = 1.f, cH = 0.f;
#pragma unroll
                for (int mm = 0; mm < 4; ++mm) { const int m = 3 - mm;
                    const float inA = cA * EAi[m], inH = EAi[m] * cH + EHi[m];
                    const f32x4 pb = Aj[m] * inA, hb = Aj[m] * inH + Hj[m];
#pragma unroll
                    for (int j = 0; j < 4; ++j) { const int tk = 16 * m + 4 * fq + j;
                        ldsU[tk * L1_UST + c] = hf[m][j] + hb[j];
                        PPg[(size_t)(rbase + P0 + tk) * 256 + c] = (cvt_pk(pf[m][j], 0.f) & 0xffffu) | (cvt_pk(0.f, pb[j]) & 0xffff0000u); }
                    cH = gAi[m] * cH + gHi[m]; cA = cA * gAi[m];
                }
                if (fq == 0) { float* cs = csum + ((size_t)(b * NCHUNK + cidx) * 2 + 1) * 512 + c; cs[0] = cA; cs[256] = cH; }
            }
        }
        LDS_BARRIER();
#pragma unroll
        for (int it = 0; it < 8; ++it) { const int idx = it * NTHREADS + tid, r = idx >> 6, c16 = idx & 63; const size_t grow = (size_t)(rbase + P0 + r) * 256 + c16 * 4;
            *(f32x4*)(Sg + grow) = *(const LAS f32x4*)(ldsU + r * L1_UST + c16 * 4);
 }
        LDS_BARRIER();
    }
}
__device__ __forceinline__ void lru2_batch(const Params& P, int b) {
    const int tid = opaque_tid(), dir = tid >> 8, c = tid & 255;
    const float* csum = (const float*)(P.ws + OFF_CSUM); float* carry = (float*)(P.ws + OFF_CARRY);
    float h = 0.f;
#pragma unroll 1
    for (int k0 = 0; k0 < NCHUNK; k0 += 33) {
        float A[33], H[33]; int ci[33];
#pragma unroll
        for (int q = 0; q < 33; ++q) { const int k = k0 + q; ci[q] = dir == 0 ? k : (k < 4 ? 3 - k : 135 - k);
            const float* cs = csum + ((size_t)(b * NCHUNK + ci[q]) * 2 + dir) * 512 + c; A[q] = cs[0]; H[q] = cs[256]; }
#pragma unroll
        for (int q = 0; q < 33; ++q) { carry[((size_t)(b * NCHUNK + ci[q]) * 2 + dir) * 256 + c] = h; h = A[q] * h + H[q]; }
    }
}
__device__ __forceinline__ float gelu_tanh(float x) { const float z = 0.7978845608f * (x + 0.044715f * x * x * x); const float t = 1.0f - 2.0f * __builtin_amdgcn_rcpf(1.0f + __expf(2.0f * z)); return 0.5f * x * (1.0f + t); }
__device__ __forceinline__ void merge_phase(const Params& P, int l, int Mrows, int G) {
    const int tid = opaque_tid(), lane = tid & 63, wid = __builtin_amdgcn_readfirstlane(tid >> 6);
    const int gw = blockIdx.x * 8 + wid, NGW = G * 8, c4 = 4 * lane;
    const bf16_t* U5 = (const bf16_t*)(P.ws + OFF_U5);
    const bf16_t *Gb = U5 + U5_STRIDE, *BGb = U5 + 2 * U5_STRIDE, *CGb = U5 + 3 * U5_STRIDE, *SSb = U5 + 4 * U5_STRIDE;
    const float* Sg = (const float*)(P.ws + OFF_S); const unsigned* PPg = (const unsigned*)(P.ws + OFF_PP); const float* carry = (const float*)(P.ws + OFF_CARRY);
    bf16_t* hb = (bf16_t*)(P.ws + OFF_HBUF); const bf16_t* att = (const bf16_t*)(P.ws + OFF_ATT);
    f32x4 w0 = *(const f32x4*)(P.in[19] + (size_t)(l * 3 + 0) * 256 + c4), w1 = *(const f32x4*)(P.in[19] + (size_t)(l * 3 + 1) * 256 + c4), w2 = *(const f32x4*)(P.in[19] + (size_t)(l * 3 + 2) * 256 + c4);
    f32x4 cb4 = *(const f32x4*)(P.in[20] + (size_t)l * 256 + c4);
    const float* gg = P.in[21] + (size_t)l * 1024;
    const f32x4 ga0 = *(const f32x4*)(gg + 8 * lane), ga1 = *(const f32x4*)(gg + 8 * lane + 4), gl = *(const f32x4*)(gg + 512 + c4), gs = *(const f32x4*)(gg + 768 + c4);
    const int per = (Mrows + NGW - 1) / NGW, r0 = gw * per, r1 = (r0 + per < Mrows) ? r0 + per : Mrows;
    int curc = -1; f32x4 cf = {0.f, 0.f, 0.f, 0.f}, cbk = {0.f, 0.f, 0.f, 0.f};
    f32x4 pm1, p0, pp1;
    auto prodrow = [&](int r) -> f32x4 { const size_t o = (size_t)r * 256 + c4; const u32x2 a = *(const u32x2*)(CGb + o), s2 = *(const u32x2*)(SSb + o);
        return (f32x4){bf_lo(a.x) * bf_lo(s2.x), bf_hi(a.x) * bf_hi(s2.x), bf_lo(a.y) * bf_lo(s2.y), bf_hi(a.y) * bf_hi(s2.y)}; };
    const f32x4 zero4 = {0.f, 0.f, 0.f, 0.f};
    if (r0 < r1) { const int sp = r0 < MLAT ? (r0 & 8191) : ((r0 - MLAT) & 255); pm1 = sp == 0 ? zero4 : prodrow(r0 - 1); p0 = prodrow(r0); }
    for (int row = r0; row < r1; ++row) {
        int b, cidx, sp, slen;
        if (row < MLAT) { b = row >> 13; sp = row & 8191; cidx = 4 + (sp >> 6); slen = SEQ; } else { const int rc = row - MLAT; b = rc >> 8; sp = rc & 255; cidx = sp >> 6; slen = CTXL; }
        const int ckey = b * NCHUNK + cidx;
        if (ckey != curc) { curc = ckey; cf = *(const f32x4*)(carry + ((size_t)ckey * 2 + 0) * 256 + c4); cbk = *(const f32x4*)(carry + ((size_t)ckey * 2 + 1) * 256 + c4); }
        if (sp == 0) { pm1 = zero4; if (row != r0) p0 = prodrow(row); }
        pp1 = (sp + 1 == slen) ? zero4 : prodrow(row + 1);
        {   const size_t o = (size_t)row * 256 + c4;
            const f32x4 S4 = *(const f32x4*)(Sg + o); const u32x4 pp = *(const u32x4*)(PPg + o);
            const u32x2 g2 = *(const u32x2*)(Gb + o), bg2 = *(const u32x2*)(BGb + o);
            const u32x4 at = *(const u32x4*)(att + (size_t)row * 512 + 8 * lane);
            f32x4 hv;
#pragma unroll
            for (int j = 0; j < 4; ++j) hv[j] = S4[j] + bf_lo(pp[j]) * cf[j] + bf_hi(pp[j]) * cbk[j];
            const f32x4 g4 = (f32x4){bf_lo(g2.x), bf_hi(g2.x), bf_lo(g2.y), bf_hi(g2.y)}, bg4 = (f32x4){bf_lo(bg2.x), bf_hi(bg2.x), bf_lo(bg2.y), bf_hi(bg2.y)};
            f32x4 lru, scv;
#pragma unroll
            for (int j = 0; j < 4; ++j) { lru[j] = hv[j] * gelu_tanh(g4[j]); scv[j] = bg4[j] * (w0[j] * pm1[j] + w1[j] * p0[j] + w2[j] * pp1[j] + cb4[j]); }
            float av[8];
#pragma unroll
            for (int j = 0; j < 4; ++j) { av[2 * j] = bf_lo(at[j]); av[2 * j + 1] = bf_hi(at[j]); }
            float ssa = 0.f, ssl = 0.f, sss = 0.f;
#pragma unroll
            for (int j = 0; j < 8; ++j) ssa += av[j] * av[j];
#pragma unroll
            for (int j = 0; j < 4; ++j) { ssl += lru[j] * lru[j]; sss += scv[j] * scv[j]; }
            ssa = wave_sum(ssa); ssl = wave_sum(ssl); sss = wave_sum(sss);
            const float ra = 1.0f / sqrtf(ssa * (1.0f / 512.0f) + EPS), rl = 1.0f / sqrtf(ssl * (1.0f / 256.0f) + EPS), rs = 1.0f / sqrtf(sss * (1.0f / 256.0f) + EPS);
            u32x4 wa; wa.x = cvt_pk(av[0] * ra * ga0[0], av[1] * ra * ga0[1]); wa.y = cvt_pk(av[2] * ra * ga0[2], av[3] * ra * ga0[3]); wa.z = cvt_pk(av[4] * ra * ga1[0], av[5] * ra * ga1[1]); wa.w = cvt_pk(av[6] * ra * ga1[2], av[7] * ra * ga1[3]);
            *(u32x4*)(hb + (size_t)row * DM + 8 * lane) = wa;
            u32x2 wl; wl.x = cvt_pk(lru[0] * rl * gl[0], lru[1] * rl * gl[1]); wl.y = cvt_pk(lru[2] * rl * gl[2], lru[3] * rl * gl[3]);
            *(u32x2*)(hb + (size_t)row * DM + 512 + c4) = wl;
            u32x2 wsv; wsv.x = cvt_pk(scv[0] * rs * gs[0], scv[1] * rs * gs[1]); wsv.y = cvt_pk(scv[2] * rs * gs[2], scv[3] * rs * gs[3]);
            *(u32x2*)(hb + (size_t)row * DM + 768 + c4) = wsv;
        }
        pm1 = p0; p0 = pp1;
    }
}
__device__ __forceinline__ void attention_phase(const Params& P, int l, char* lds, int G) {
    using abf = attn_body::bf16;
    const abf* Q = (const abf*)(P.ws + OFF_Q); const abf* K = (const abf*)(P.ws + OFF_K); const abf* V = (const abf*)(P.ws + OFF_V); abf* O = (abf*)(P.ws + OFF_ATT);
    if (blockIdx.x < NBATCH) lru2_batch(P, blockIdx.x);
    const int nunits = NBATCH * 8 * 32 + ((l + 1 < DEPTH) ? NBATCH * 8 : 0);
    for (int uid = blockIdx.x; uid < nunits; uid += G) {
        int b, h, NT; size_t qrow;
        if (uid < NBATCH * 8 * 32) { b = uid & 7; const int rest = uid >> 3, kvh = rest >> 7, u = rest & 127; h = kvh * 4 + (u >> 5); qrow = (size_t)b * SEQ + (u & 31) * 256; NT = NCHUNK; }
        else { const int v = uid - NBATCH * 8 * 32; b = v & 7; h = v >> 3; qrow = (size_t)MLAT + b * CTXL; NT = 4; }
        const size_t kvoff = (size_t)b * KEYS * 128 + (h >> 2) * 64;
        attn_body::attn_unit<8>(Q + qrow * 512 + h * 64, K + kvoff, V + kvoff, O + qrow * 512 + h * 64, NT, lds);
    }
}

#define XB_TMO      128
#define XB_XCNT(j)  (256  + 64 * (j))
#define XB_XSUB(j)  (1280 + 64 * (j))
#define XB_XGEN(j)  (2304 + 64 * (j))
#define XB_TOP      3328
#define XB_TOPGEN   3392
#define XCD_BAR_WORDS 3456
#define XB_SPIN_CAP (1u << 18)

__device__ __forceinline__ unsigned xb_ld(unsigned* p)              { return __hip_atomic_load(p, __ATOMIC_RELAXED, __HIP_MEMORY_SCOPE_AGENT); }
__device__ __forceinline__ unsigned xb_add(unsigned* p, unsigned v) { return __hip_atomic_fetch_add(p, v, __ATOMIC_RELAXED, __HIP_MEMORY_SCOPE_AGENT); }
__device__ __forceinline__ unsigned xb_xcc_id() { return (unsigned)__builtin_amdgcn_s_getreg((3 << 11) | 20) & 0xFu; }
#define XB_SPIN(cond, bar) do { unsigned _sp = 0; while (cond) { __builtin_amdgcn_s_sleep(1); \
    if ((++_sp & 255u) == 0u) { if (xb_ld(&(bar)[XB_TMO])) break; if (_sp > XB_SPIN_CAP) { atomicAdd(&(bar)[XB_TMO], 1u); break; } } } } while (0)

struct XcdBarrier {
    unsigned* bar; unsigned x;
    volatile LAS unsigned* st;
};

__device__ __forceinline__ XcdBarrier xcd_barrier_post(unsigned* bar, volatile LAS unsigned* st) {
    XcdBarrier b; b.bar = bar; b.x = xb_xcc_id(); b.st = st;
    if (threadIdx.x == 0) (void)xb_add(&bar[XB_XCNT(b.x)], 1u);
    return b;
}
__device__ __forceinline__ void xcd_barrier_complete(unsigned* bar, unsigned x, unsigned& nloc, unsigned& nx) {
    const unsigned G = gridDim.x * gridDim.y * gridDim.z;
    unsigned sum, cnt, mine, sp = 0u;
    for (;;) {
        sum = 0u; cnt = 0u; mine = 0u;
#pragma unroll
        for (unsigned j = 0; j < 16; ++j) { const unsigned c = xb_ld(&bar[XB_XCNT(j)]); sum += c; cnt += (c > 0u) ? 1u : 0u; mine = (j == x) ? c : mine; }
        if (sum == G) break;
        __builtin_amdgcn_s_sleep(1);
        if ((++sp & 255u) == 0u) { if (xb_ld(&bar[XB_TMO])) break; if (sp > XB_SPIN_CAP) { atomicAdd(&bar[XB_TMO], 1u); break; } }
    }
    nloc = mine > 0u ? mine : 1u; nx = cnt > 0u ? cnt : 1u;
}

__device__ __forceinline__ void xcd_barrier(const XcdBarrier& b) {
    asm volatile("s_waitcnt vmcnt(0)" ::: "memory");
    __syncthreads();
    if (threadIdx.x == 0) {
        unsigned* bar = b.bar; unsigned bx_ = b.x; asm volatile("" : "+s"(bx_));
        __builtin_amdgcn_s_waitcnt(0);
        unsigned nloc = b.st[0], nx = b.st[1];
        if (nloc == 0u) { xcd_barrier_complete(bar, bx_, nloc, nx); b.st[0] = nloc; b.st[1] = nx; }
        const unsigned old = xb_add(&bar[XB_XSUB(bx_)], 1u);
        const unsigned gen = old / nloc;
        if (old + 1u == (gen + 1u) * nloc) {
            __builtin_amdgcn_fence(__ATOMIC_RELEASE, "agent");
            asm volatile("s_waitcnt vmcnt(0)" ::: "memory");
            const unsigned og = xb_add(&bar[XB_TOP], 1u);
            const unsigned tg = og / nx;
            if (og + 1u == (tg + 1u) * nx) xb_add(&bar[XB_TOPGEN], 1u);
            else XB_SPIN(xb_ld(&bar[XB_TOPGEN]) == tg, bar);
            __builtin_amdgcn_fence(__ATOMIC_ACQUIRE, "agent");
            xb_add(&bar[XB_XGEN(bx_)], 1u);
            asm volatile("s_waitcnt vmcnt(0)" ::: "memory");
        } else {
            XB_SPIN(xb_ld(&bar[XB_XGEN(bx_)]) == gen, bar);
            __builtin_amdgcn_fence(__ATOMIC_ACQUIRE, "agent");
            asm volatile("s_waitcnt vmcnt(0)" ::: "memory");
        }
    }
    __syncthreads();
}

#ifndef PH_MASK
#define PH_MASK 0x1FF
#endif
__global__ void __launch_bounds__(NTHREADS, 2) fwd_megakernel(Params P) {
    extern __shared__ __attribute__((aligned(16))) unsigned char lds_raw[];
    LAS unsigned char* lds = (LAS unsigned char*)lds_raw;
    cg::grid_group grid = cg::this_grid();
    volatile LAS unsigned* bst = (volatile LAS unsigned*)(lds + LDS_BAR_OFF);
    if (threadIdx.x < 2) bst[threadIdx.x] = 0u;
    __syncthreads();
    const XcdBarrier xbar = xcd_barrier_post((unsigned*)(P.ws + OFF_CTL), bst);
#define GRID_SYNC() xcd_barrier(xbar)
    const int G = gridDim.x;
    unsigned char* ws = P.ws;
    if constexpr (PH_MASK & 1) prologue_phase(P, lds, G);
    grid.sync();
    if constexpr (PH_MASK & 2) norm_phase(P, 0, 0, 0, MTOT, true, 0, G);
    GRID_SYNC();
    for (int step = 0; step < DEPTH * 3; ++step) {
        const int l = step / 3, s3 = step % 3;
        const bool last = (l == DEPTH - 1);
        const int Mn = (last && s3 == 2) ? MLAT : MTOT;
        unsigned char* wb = ws + OFF_WB + (size_t)l * WB_LAYER;
        pg8::Gemm gr; pg8::EpiResid er; int Mr;
        const float* modl = (const float*)(ws + OFF_MOD) + (size_t)l * 9 * MODW;
        if (s3 != 1) {
            const int f = s3 >> 1;
            { pg8::Gemm g{(const bf16_t*)(ws + OFF_HBUF), (const bf16_t*)(wb + WB_FFIN + f * WB_FFIN_SZ), Mn, NFF2, DM};
              pg8::StaticOrder S; S.init(Mn, NFF2, G, (int)blockIdx.x);
              pg8::EpiSwiglu E{(bf16_t*)(ws + OFF_MID)};
              if constexpr (PH_MASK & 4) pg8::gemm_phase<pg8::EpiSwiglu, pg8::StaticOrder, true, true>(lds, g, S, E); }
            GRID_SYNC();
            Mr = Mn;
            gr = pg8::Gemm{(const bf16_t*)(ws + OFF_MID), (const bf16_t*)(wb + WB_FFOUT + f * WB_FFOUT_SZ), Mr, DM, DFF};
            er = pg8::EpiResid{(bf16_t*)(ws + OFF_XRES), P.in[0], P.in[2], modl + (3 * s3 + 2) * DM, 0.5f, step == 0 ? 1 : 0};
        } else {
            { LAS float* tab = (LAS float*)(lds + LDS_TAB_OFF);
              for (int i = opaque_tid(); i < 4096 + 128; i += NTHREADS) tab[i] = i < 4096 ? ((const float*)(ws + OFF_ROPE))[i] : (i < 4160 ? P.in[10][l * 64 + i - 4096] : P.in[11][l * 64 + i - 4160]);
              __syncthreads(); }
            { pg8::Gemm g{(const bf16_t*)(ws + OFF_HBUF), (const bf16_t*)(wb + WB_WIN), MTOT, INW, DM};
              pg8::StaticOrder S; S.init(MTOT, INW, G, (int)blockIdx.x);
              pg8::EpiWin E{(bf16_t*)(ws + OFF_Q), (bf16_t*)(ws + OFF_K), (bf16_t*)(ws + OFF_V), (bf16_t*)(ws + OFF_U5), (const LAS float*)(lds + LDS_TAB_OFF), 0.125f * 1.4426950408889634f};
              if constexpr (PH_MASK & 8) pg8::gemm_phase<pg8::EpiWin, pg8::StaticOrder, true, true>(lds, g, S, E); }
            GRID_SYNC();
            if constexpr (PH_MASK & 16) lru1_phase(P, l, lds, G);
            GRID_SYNC();
            if constexpr (PH_MASK & 32) attention_phase(P, l, (char*)lds_raw, G);
            GRID_SYNC();
            Mr = last ? MLAT : MTOT;
            if constexpr (PH_MASK & 64) merge_phase(P, l, Mr, G);
            GRID_SYNC();
            gr = pg8::Gemm{(const bf16_t*)(ws + OFF_HBUF), (const bf16_t*)(wb + WB_WOUT), Mr, DM, DM};
            er = pg8::EpiResid{(bf16_t*)(ws + OFF_XRES), P.in[0], P.in[2], modl + 5 * DM, 1.0f, 0};
        }
        const bool ctxr = (Mr == MTOT), has_next = step + 1 < DEPTH * 3;
        const int l2 = (step + 1) / 3, s32 = (step + 1) % 3, Mn2 = (l2 == DEPTH - 1 && s32 == 2) ? MLAT : MTOT;
        for (int pass = 0; pass < (ctxr ? 2 : 1); ++pass) {
            pg8::ResidOrder S; S.so.init(MLAT, DM, G, (int)blockIdx.x); S.single = pass; S.pm = 256 + ((int)blockIdx.x >> 2); S.pn = (int)blockIdx.x & 3;
            if (pass == 1 && (int)blockIdx.x >= 32) { if constexpr (PH_MASK & 2) norm_phase(P, l2, s32, 0, MLAT, false, 32, G - 32); }
            else { if constexpr (PH_MASK & 128) pg8::gemm_phase<pg8::EpiResid, pg8::ResidOrder, true, true>(lds, gr, S, er); }
            GRID_SYNC();
        }
        if (has_next) {
            if (ctxr) { if constexpr (PH_MASK & 2) norm_phase(P, l2, s32, MLAT, MTOT, false, 0, G); }
            else { if constexpr (PH_MASK & 2) norm_phase(P, l2, s32, 0, Mn2, false, 0, G); }
            GRID_SYNC();
        }
    }
    if constexpr (PH_MASK & 256) final_norm_phase(P, G);
}

extern "C" void kernel_launch(void* const* d_in, const int* in_sizes, int n_in, void* d_out, int out_size, void* d_ws, size_t ws_size, hipStream_t stream) {
    static int grid = 0;
    if (grid == 0) {
        if (n_in != 24 || out_size != MLAT * DM || ws_size < WS_NEED) { fprintf(stderr, "kernel_launch: unexpected shapes (n_in %d, out %d, ws %zu, need %zu)\n", n_in, out_size, ws_size, (size_t)WS_NEED); grid = -1; return; }
        int dev = 0, cus = 0, per_cu = 0;
        hipGetDevice(&dev); hipDeviceGetAttribute(&cus, hipDeviceAttributeMultiprocessorCount, dev);
        if (hipFuncSetAttribute((const void*)fwd_megakernel, hipFuncAttributeMaxDynamicSharedMemorySize, LDS_BYTES) != hipSuccess) { fprintf(stderr, "kernel_launch: hipFuncSetAttribute failed\n"); grid = -1; return; }
        if (hipOccupancyMaxActiveBlocksPerMultiprocessor(&per_cu, (const void*)fwd_megakernel, NTHREADS, LDS_BYTES) != hipSuccess || per_cu < 1) { fprintf(stderr, "kernel_launch: occupancy query says %d\n", per_cu); per_cu = 1; (void)hipGetLastError(); }
        grid = cus * 1;
        if (grid % 8 != 0 || grid <= 0) grid = 256;
        fprintf(stderr, "kernel_launch: grid %d (cus %d, per_cu %d)\n", grid, cus, per_cu);
    }
    if (grid < 0) return;
    Params p{};
    for (int i = 0; i < 24; ++i) p.in[i] = (const float*)d_in[i];
    p.out = (float*)d_out; p.ws = (unsigned char*)d_ws;
    if (hipMemsetAsync((unsigned char*)d_ws + OFF_CTL, 0, CTL_BYTES, stream) != hipSuccess) { fprintf(stderr, "kernel_launch: memset of the barrier words failed\n"); return; }
    void* args[] = {&p};
    hipError_t e = hipLaunchCooperativeKernel((const void*)fwd_megakernel, dim3(grid), dim3(NTHREADS), args, LDS_BYTES, stream);
    if (e != hipSuccess) fprintf(stderr, "kernel_launch: cooperative launch failed: %s (grid %d)\n", hipGetErrorString(e), grid);
}
```
